# Optimizing an MI355X kernel written in HIP

```python
import math
import jax
import jax.numpy as jnp
from jax import lax
import numpy as np

D_MODEL = 1024
BATCH = 8
SEQ = 4096
DEPTH = 1

GRID_W = 64
CTX_LEN = 256
HY_WIDTH = 512
HY_ORDER = 2
HY_COLS = (HY_ORDER + 1) * HY_WIDTH
S5_WIDTH = 512
S5_GROUP = 16
S5_GROUPS = S5_WIDTH // S5_GROUP
S5_STATE = 64
MIX_WIDTH = HY_WIDTH + S5_WIDTH
IN_COLS = HY_COLS + S5_WIDTH
SHORT_CONV = 3
POS_EMB_DIM = 33
FILTER_WIDTH = 64
FILTER_OUT = HY_ORDER * 2 * HY_WIDTH
DECAY_FAST = 0.3
DECAY_SLOW = 1.5
DECAY_TARGET = 1e-2
N_EXPERTS = 16
EXPERT_FF = 2816
CAPACITY_FACTOR = 2
N_MOD = 6
NORM_EPS = 1e-6

kernel_name = "hybrid_hyena_s5_ec_dit_block"


def rmsnorm(x, g):
    xf = x.astype(jnp.float32)
    y = xf * lax.rsqrt(jnp.mean(xf * xf, axis=-1, keepdims=True) + NORM_EPS)
    return (y * g.astype(jnp.float32)).astype(x.dtype)


def adaln(cond, w, b):
    return jnp.split(jax.nn.silu(cond) @ w + b, N_MOD, axis=-1)


def modulate(h, shift, scale):
    return h * (1.0 + scale[:, None]) + shift[:, None]


def short_conv_rows(z, rows, w, b):
    bsz, length, ch = z.shape
    zr = z.reshape(bsz, rows, length // rows, ch)
    p = jnp.pad(zr, ((0, 0), (0, 0), (1, 1), (0, 0)))
    y = p[:, :, :-2] * w[0] + p[:, :, 1:-1] * w[1] + p[:, :, 2:] * w[2] + b
    return y.reshape(bsz, length, ch)


def hyena_filter_spectra(length, w1, b1, freq, w2, b2, w3, b3):
    f32 = jnp.float32
    w1, b1, freq, w2, b2, w3, b3 = [a.astype(f32) for a in (w1, b1, freq, w2, b2, w3, b3)]
    t = jnp.linspace(0.0, 1.0, length, dtype=f32)[:, None]
    bands = (POS_EMB_DIM - 1) // 2
    omega = 2.0 * math.pi * jnp.arange(length, dtype=f32)[:, None] / length
    f = jnp.linspace(1e-4, bands - 1, bands, dtype=f32)[None, :]
    feats = jnp.concatenate([t, jnp.cos(f * omega), -jnp.sin(f * omega)], axis=-1)
    h = jnp.sin(freq[0] * (feats @ w1 + b1))
    h = jnp.sin(freq[1] * (h @ w2 + b2))
    h = (h @ w3 + b3).reshape(length, HY_ORDER, 2, HY_WIDTH)
    deltas = jnp.abs(jnp.linspace(math.log(DECAY_TARGET) / DECAY_FAST,
                                  math.log(DECAY_TARGET) / DECAY_SLOW, HY_WIDTH, dtype=f32))
    h = h * jnp.exp(-t * deltas)[:, None, None, :]
    fwd, bwd = h[:, :, 0], h[:, :, 1]
    k = jnp.concatenate([fwd, jnp.zeros((1,) + fwd.shape[1:], f32), bwd[:0:-1]], axis=0)
    k = k / jnp.sum(jnp.abs(k), axis=0, keepdims=True)
    return jnp.fft.rfft(k, axis=0)


def long_conv(u, kf, bias):
    length = u.shape[1]
    uf = jnp.fft.rfft(u, n=2 * length, axis=1)
    y = jnp.fft.irfft(uf * kf[None], n=2 * length, axis=1)[:, :length]
    return y + u * bias.astype(jnp.float32)


def hyena_branch(z, rows, conv_w, conv_b, filt, hy_bias):
    length = z.shape[1]
    z = short_conv_rows(z, rows, conv_w, conv_b).astype(jnp.float32)
    v, x1, x2 = jnp.split(z, 3, axis=-1)
    kf = hyena_filter_spectra(length, *filt)
    y = x1 * long_conv(v, kf[:, 0], hy_bias[0])
    return x2 * long_conv(y, kf[:, 1], hy_bias[1])


def _diag_binop(e1, e2):
    a1, b1 = e1
    a2, b2 = e2
    return a1 * a2, a2 * b1 + b2


def s5_discretize(lam_re, lam_im, log_step, b_re, b_im):
    f32 = jnp.float32
    lam = lax.complex(lam_re.astype(f32), lam_im.astype(f32))
    lam_bar = jnp.exp(lam * jnp.exp(log_step.astype(f32))[:, None])
    b_bar = ((lam_bar - 1.0) / lam)[..., None] * lax.complex(b_re.astype(f32), b_im.astype(f32))
    return lam_bar, b_bar


def s5_scan(u_tm, lam_bar, b_bar, init, reverse):
    bu = jnp.einsum('lbgh,gph->lbgp', u_tm.astype(jnp.complex64), b_bar)
    edge = bu.shape[0] - 1 if reverse else 0
    bu = bu.at[edge].add(lam_bar * init)
    a = jnp.broadcast_to(lam_bar[None, None], (bu.shape[0], 1) + lam_bar.shape)
    _, states = lax.associative_scan(_diag_binop, (a, bu), reverse=reverse, axis=0)
    return states


def s5_states(u, lam_re, lam_im, log_step, b_re, b_im, init_f, init_b):
    bsz, length, _ = u.shape
    u_tm = jnp.transpose(u.reshape(bsz, length, S5_GROUPS, S5_GROUP), (1, 0, 2, 3))
    lam_f, bb_f = s5_discretize(lam_re[0], lam_im[0], log_step[0], b_re[0], b_im[0])
    lam_b, bb_b = s5_discretize(lam_re[1], lam_im[1], log_step[1], b_re[1], b_im[1])
    st_f = s5_scan(u_tm, lam_f, bb_f, init_f, False)
    st_b = s5_scan(u_tm, lam_b, bb_b, init_b, True)
    return st_f, st_b


def s5_readout(u, st_f, st_b, c_re, c_im, d, glu_w, glu_b):
    f32 = jnp.float32
    bsz, length, _ = u.shape
    c_f = lax.complex(c_re[0].astype(f32), c_im[0].astype(f32))
    c_b = lax.complex(c_re[1].astype(f32), c_im[1].astype(f32))
    y = jnp.real(jnp.einsum('lbgp,ghp->blgh', st_f, c_f) + jnp.einsum('lbgp,ghp->blgh', st_b, c_b))
    y = y.reshape(bsz, length, S5_WIDTH) + d.astype(f32) * u
    y = jax.nn.gelu(y)
    return y * jax.nn.sigmoid(y @ glu_w.astype(f32) + glu_b.astype(f32))


def expert_choice_ffn(h, router_w, w_gate, w_up, w_down):
    n, dm = h.shape[1], h.shape[2]
    cap = CAPACITY_FACTOR * n // N_EXPERTS
    aff = jax.nn.softmax(jnp.einsum('bnd,de->bne', h, router_w).astype(jnp.float32), axis=-1)
    gates, idx = lax.top_k(jnp.swapaxes(aff, 1, 2), cap)
    xg = jax.vmap(lambda hb, ib: hb[ib])(h, idx)

    def expert(args):
        xe, wg, wu, wd = args
        return (jax.nn.silu(xe @ wg) * (xe @ wu)) @ wd

    ye = lax.map(expert, (jnp.swapaxes(xg, 0, 1), w_gate, w_up, w_down))
    ye = jnp.swapaxes(ye, 0, 1) * gates[..., None].astype(h.dtype)
    return jax.vmap(lambda ib, yb: jnp.zeros((n, dm), yb.dtype).at[ib.reshape(-1)].add(yb.reshape(-1, dm)))(idx, ye)


def setup_inputs(seed: int = 0) -> dict:
    key = jax.random.key(seed)
    ks = iter(jax.random.split(key, 40))
    f32 = jnp.float32

    def nrm(shape, scale):
        return scale * jax.random.normal(next(ks), shape, f32)

    D, L = D_MODEL, DEPTH
    G, P, H = S5_GROUPS, S5_STATE, S5_GROUP
    return {
        "x": nrm((BATCH, SEQ, D), 1.0),
        "c": nrm((BATCH, D), 1.0),
        "ctx": nrm((BATCH, CTX_LEN, D), 1.0),
        "c_ctx": nrm((D,), 1.0),
        "mod_w": nrm((L, D, N_MOD * D), D ** -0.5),
        "mod_b": nrm((L, N_MOD * D), 0.01),
        "norm1_g": 1.0 + nrm((L, D), 0.02),
        "norm2_g": 1.0 + nrm((L, D), 0.02),
        "w_in": nrm((L, D, IN_COLS), D ** -0.5),
        "w_out": nrm((L, MIX_WIDTH, D), MIX_WIDTH ** -0.5),
        "conv_w": nrm((L, SHORT_CONV, HY_COLS), SHORT_CONV ** -0.5),
        "conv_b": nrm((L, HY_COLS), 0.01),
        "hy_w1": nrm((L, POS_EMB_DIM, FILTER_WIDTH), POS_EMB_DIM ** -0.5),
        "hy_b1": nrm((L, FILTER_WIDTH), 0.1),
        "hy_freq": 1.0 + nrm((L, 2, FILTER_WIDTH), 0.02),
        "hy_w2": nrm((L, FILTER_WIDTH, FILTER_WIDTH), FILTER_WIDTH ** -0.5),
        "hy_b2": nrm((L, FILTER_WIDTH), 0.1),
        "hy_w3": nrm((L, FILTER_WIDTH, FILTER_OUT), FILTER_WIDTH ** -0.5),
        "hy_b3": nrm((L, FILTER_OUT), 0.01),
        "hy_bias": nrm((L, HY_ORDER, HY_WIDTH), 1.0),
        "s5_lam_re": -0.5 + nrm((L, 2, G, P), 0.01),
        "s5_lam_im": math.pi * jnp.arange(P, dtype=f32) + nrm((L, 2, G, P), 0.01),
        "s5_log_step": jax.random.uniform(next(ks), (L, 2, G), f32, math.log(1e-3), math.log(1e-1)),
        "s5_b_re": nrm((L, 2, G, P, H), (2.0 * H) ** -0.5),
        "s5_b_im": nrm((L, 2, G, P, H), (2.0 * H) ** -0.5),
        "s5_c_re": nrm((L, 2, G, H, P), (2.0 * P) ** -0.5),
        "s5_c_im": nrm((L, 2, G, H, P), (2.0 * P) ** -0.5),
        "s5_d": nrm((L, S5_WIDTH), 1.0),
        "s5_glu_w": nrm((L, S5_WIDTH, S5_WIDTH), S5_WIDTH ** -0.5),
        "s5_glu_b": nrm((L, S5_WIDTH), 0.01),
        "router_w": nrm((L, D, N_EXPERTS), D ** -0.5),
        "ex_w_gate": nrm((L, N_EXPERTS, D, EXPERT_FF), D ** -0.5),
        "ex_w_up": nrm((L, N_EXPERTS, D, EXPERT_FF), D ** -0.5),
        "ex_w_down": nrm((L, N_EXPERTS, EXPERT_FF, D), EXPERT_FF ** -0.5),
        "final_g": 1.0 + nrm((D,), 0.02),
    }


def reference(x, c, ctx, c_ctx, mod_w, mod_b, norm1_g, norm2_g, w_in, w_out, conv_w, conv_b,
              hy_w1, hy_b1, hy_freq, hy_w2, hy_b2, hy_w3, hy_b3, hy_bias,
              s5_lam_re, s5_lam_im, s5_log_step, s5_b_re, s5_b_im, s5_c_re, s5_c_im, s5_d,
              s5_glu_w, s5_glu_b, router_w, ex_w_gate, ex_w_up, ex_w_down, final_g):
    rows = x.shape[1] // GRID_W
    bsz = x.shape[0]
    for l in range(DEPTH):
        last = l == DEPTH - 1
        sh1, sc1, g1, sh2, sc2, g2 = adaln(c, mod_w[l], mod_b[l])
        csh1, csc1, cg1, csh2, csc2, cg2 = adaln(c_ctx[None], mod_w[l], mod_b[l])
        filt = (hy_w1[l], hy_b1[l], hy_freq[l], hy_w2[l], hy_b2[l], hy_w3[l], hy_b3[l])
        s5_par = (s5_lam_re[l], s5_lam_im[l], s5_log_step[l], s5_b_re[l], s5_b_im[l])
        s5_out = (s5_c_re[l], s5_c_im[l], s5_d[l], s5_glu_w[l], s5_glu_b[l])

        hc = modulate(rmsnorm(ctx, norm1_g[l]), csh1, csc1)
        u_c = (hc @ w_in[l][:, HY_COLS:]).astype(jnp.float32)
        zero = jnp.zeros((bsz, S5_GROUPS, S5_STATE), jnp.complex64)
        stc_f, stc_b = s5_states(u_c, *s5_par, zero, zero)
        init_f, init_b = stc_f[-1], stc_b[0]
        if not last:
            yc = jnp.concatenate([hyena_branch(hc @ w_in[l][:, :HY_COLS], 1, conv_w[l], conv_b[l], filt, hy_bias[l]),
                                  s5_readout(u_c, stc_f, stc_b, *s5_out)], axis=-1)
            ctx = ctx + cg1[:, None] * (yc.astype(ctx.dtype) @ w_out[l])
            hc2 = modulate(rmsnorm(ctx, norm2_g[l]), csh2, csc2)
            ctx = ctx + cg2[:, None] * expert_choice_ffn(hc2, router_w[l], ex_w_gate[l], ex_w_up[l], ex_w_down[l])

        h = modulate(rmsnorm(x, norm1_g[l]), sh1, sc1)
        z = h @ w_in[l]
        u = z[..., HY_COLS:].astype(jnp.float32)
        st_f, st_b = s5_states(u, *s5_par, init_f, init_b)
        y = jnp.concatenate([hyena_branch(z[..., :HY_COLS], rows, conv_w[l], conv_b[l], filt, hy_bias[l]),
                             s5_readout(u, st_f, st_b, *s5_out)], axis=-1)
        x = x + g1[:, None] * (y.astype(x.dtype) @ w_out[l])
        h2 = modulate(rmsnorm(x, norm2_g[l]), sh2, sc2)
        x = x + g2[:, None] * expert_choice_ffn(h2, router_w[l], ex_w_gate[l], ex_w_up[l], ex_w_down[l])
    return rmsnorm(x, final_g)
```

```cpp
#ifndef DBG_C3
#define DBG_C3 0
#endif
#ifndef DBG_BAD_THR
#define DBG_BAD_THR 16
#endif
#ifndef DBG_MOE_ALPHA
#define DBG_MOE_ALPHA 1.0f
#endif
#include <hip/hip_runtime.h>
#include <cstdio>
#include <cstdint>

#define LAS __attribute__((address_space(3)))
#define GAS __attribute__((address_space(1)))
typedef unsigned short bf16;
typedef short bf16x8 __attribute__((ext_vector_type(8)));
typedef float f32x4 __attribute__((ext_vector_type(4)));
typedef float f32x16 __attribute__((ext_vector_type(16)));
typedef unsigned u32x4 __attribute__((ext_vector_type(4)));
typedef unsigned u32x2 __attribute__((ext_vector_type(2)));
typedef GAS unsigned gu32;

constexpr int NB = 8, SEQ = 4096, DM = 1024, CTXL = 256;
constexpr int NTOK = NB * SEQ, NCTX = NB * CTXL, NROWS1 = NTOK + NCTX;
constexpr int HYW = 512, HYC = 1536, S5W = 512, INC = 2048;
constexpr int NG = 32, GH = 16, NP = 64;
constexpr int CT = 32, NCH = SEQ / CT, NCHC = CTXL / CT;
constexpr int UROWS = 1280, UCOLS = 768;
constexpr int NE = 16, FF = 2816, CAP = 512, EROWS = NB * CAP;
constexpr int NMOD = 6;
constexpr float NORM_EPS = 1e-6f;
constexpr int FLEN = 8448, FC0 = 4224;

constexpr size_t MiB = 1u << 20;
constexpr size_t WS_CTL = 0, CTL_ZERO_BYTES = 1 * MiB;
constexpr size_t WS_MOD = 1 * MiB;
constexpr size_t WS_LT = WS_MOD + 256 * 1024;
constexpr size_t WS_FH2 = 2 * MiB;
constexpr size_t WS_GLUT = 3 * MiB;
constexpr size_t WS_WINT = 4 * MiB;
constexpr size_t WS_WOUTT = 8 * MiB;
constexpr size_t WS_AFF = 10 * MiB;
constexpr size_t WS_IDX = 12 * MiB;
constexpr size_t WS_GATE = WS_IDX + 256 * 1024;
constexpr size_t WS_INV = 13 * MiB;
constexpr size_t WS_WDT = 16 * MiB;
constexpr size_t WS_WGUT = 104 * MiB;
constexpr size_t WS_Y = WS_WGUT;
constexpr size_t WS_R = 280 * MiB;
constexpr size_t WS_H1 = WS_R;
constexpr size_t WS_ZT = WS_R + 68 * MiB;
constexpr size_t WS_UG = WS_R + 164 * MiB;
constexpr size_t WS_EB = WS_R + 224 * MiB;
constexpr size_t WS_YHT = WS_EB;
constexpr size_t WS_MCT = WS_R + 264 * MiB;
constexpr size_t WS_WAT = WS_R + 288 * MiB;
constexpr size_t WS_FILT = WS_R + 296 * MiB;
constexpr size_t WS_YSG = WS_R + 330 * MiB;
constexpr int S5TAB_FLOATS = (2 * 33 * 64 * 2) + (2 * 64 * 16 * 2) + (2 * 32 * 256) + (2 * 16 * 64 * 2);
constexpr size_t WS_S5TAB = WS_YSG;
constexpr size_t WS_YCAT = WS_R;
constexpr size_t WS_H2 = WS_R;
constexpr size_t WS_HB = WS_R + 64 * MiB;
constexpr size_t WS_END = WS_R + 416 * MiB;
static_assert(WS_YSG + (size_t)NG * 1024 * 512 * 2 <= WS_END && WS_FILT + (size_t)4 * HYW * FLEN * 2 <= WS_YSG && WS_YCAT + (size_t)NTOK * DM * 2 <= WS_ZT && WS_HB + (size_t)NE * EROWS * FF * 2 <= WS_END, "ws map");

constexpr int CW_BAR = 4096;

constexpr int RING_BYTES = 131072;
constexpr int LDS_BYTES = 163840;
constexpr int LDSCTL_OFF = LDS_BYTES - 1024, MISC_OFF = LDSCTL_OFF + 320;
constexpr int NWAVES = 8, NTHR = 512;

__device__ __forceinline__ unsigned f2bf(float f) { unsigned u = __builtin_bit_cast(unsigned, f); return (u + 0x7fffu + ((u >> 16) & 1u)) >> 16; }
__device__ __forceinline__ unsigned pk2(float lo, float hi) { return f2bf(lo) | (f2bf(hi) << 16); }
__device__ __forceinline__ float bf2f(unsigned b) { return __builtin_bit_cast(float, (b & 0xffffu) << 16); }
__device__ __forceinline__ float bflo(unsigned w) { return __builtin_bit_cast(float, w << 16); }
__device__ __forceinline__ float bfhi(unsigned w) { return __builtin_bit_cast(float, w & 0xffff0000u); }
__device__ __forceinline__ float wave_sum(float v) {
#pragma unroll
    for (int o = 1; o < 64; o <<= 1) v += __shfl_xor(v, o);
    return v;
}
__device__ __forceinline__ float sigmoidf_(float x) { return __builtin_amdgcn_rcpf(1.0f + __builtin_amdgcn_exp2f(fminf(-1.4426950408889634f * x, 80.0f))); }
__device__ __forceinline__ float siluf_(float x) { return x * sigmoidf_(x); }
__device__ __forceinline__ float gelu_tanh(float y) {
    const float u2 = 1.5957691216057308f * (y + 0.044715f * y * y * y);
    return y * sigmoidf_(u2);
}
typedef int i32x8 __attribute__((ext_vector_type(8)));
typedef int i32x4 __attribute__((ext_vector_type(4)));
__device__ __forceinline__ unsigned pk4_fp8(float a, float b, float c, float d) { int w = 0; w = __builtin_amdgcn_cvt_pk_fp8_f32(a, b, w, false); w = __builtin_amdgcn_cvt_pk_fp8_f32(c, d, w, true); return (unsigned)w; }
constexpr float WGU_SCALE = 16.0f, WD_SCALE = 32.0f;
constexpr int WGU_E8M0 = 127 - 4, WD_E8M0 = 127 - 5;
#define LDS_WAIT() asm volatile("s_waitcnt lgkmcnt(0)" ::: "memory")
#define VM_WAIT() asm volatile("s_waitcnt vmcnt(0)" ::: "memory")

#define XB_TMO      128
#define XB_XCNT(j)  (256  + 64 * (j))
#define XB_XSUB(j)  (1280 + 64 * (j))
#define XB_XGEN(j)  (2304 + 64 * (j))
#define XB_TOP      3328
#define XB_TOPGEN   3392
#define XCD_BAR_WORDS 3456
#define XB_SPIN_CAP (1u << 22)
__device__ __forceinline__ unsigned xb_ld(unsigned* p)              { return __hip_atomic_load(p, __ATOMIC_RELAXED, __HIP_MEMORY_SCOPE_AGENT); }
__device__ __forceinline__ unsigned xb_add(unsigned* p, unsigned v) { return __hip_atomic_fetch_add(p, v, __ATOMIC_RELAXED, __HIP_MEMORY_SCOPE_AGENT); }
__device__ __forceinline__ unsigned xb_xcc_id() { return (unsigned)__builtin_amdgcn_s_getreg((3 << 11) | 20) & 0xFu; }
#define XB_SPIN(cond, bar) do { unsigned _sp = 0; while (cond) { __builtin_amdgcn_s_sleep(1); \
    if ((++_sp & 255u) == 0u) { if (xb_ld(&(bar)[XB_TMO])) break; if (_sp > XB_SPIN_CAP) { atomicAdd(&(bar)[XB_TMO], 1u); break; } } } } while (0)
struct XcdBarrier { unsigned* bar; unsigned x; volatile LAS unsigned* st; };
__device__ __forceinline__ XcdBarrier xcd_barrier_post(unsigned* bar, volatile LAS unsigned* st) {
    XcdBarrier b; b.bar = bar; b.x = xb_xcc_id(); b.st = st;
    if (threadIdx.x == 0) (void)xb_add(&bar[XB_XCNT(b.x)], 1u);
    return b;
}
__device__ __forceinline__ void xcd_barrier_complete(unsigned* bar, unsigned x, unsigned& nloc, unsigned& nx) {
    const unsigned G = gridDim.x * gridDim.y * gridDim.z;
    unsigned sum, cnt, mine, sp = 0u;
    for (;;) {
        sum = 0u; cnt = 0u; mine = 0u;
#pragma unroll
        for (unsigned j = 0; j < 16; ++j) { const unsigned c = xb_ld(&bar[XB_XCNT(j)]); sum += c; cnt += (c > 0u) ? 1u : 0u; mine = (j == x) ? c : mine; }
        if (sum == G) break;
        __builtin_amdgcn_s_sleep(1);
        if ((++sp & 255u) == 0u) { if (xb_ld(&bar[XB_TMO])) break; if (sp > XB_SPIN_CAP) { atomicAdd(&bar[XB_TMO], 1u); break; } }
    }
    nloc = mine > 0u ? mine : 1u; nx = cnt > 0u ? cnt : 1u;
}
__device__ __forceinline__ void xcd_barrier(const XcdBarrier& b) {
    asm volatile("s_waitcnt vmcnt(0)" ::: "memory");
    __syncthreads();
    if (threadIdx.x == 0) {
        unsigned* bar = b.bar;
        __builtin_amdgcn_s_waitcnt(0);
        unsigned nloc = b.st[0], nx = b.st[1];
        if (nloc == 0u) { xcd_barrier_complete(bar, b.x, nloc, nx); b.st[0] = nloc; b.st[1] = nx; }
        const unsigned old = xb_add(&bar[XB_XSUB(b.x)], 1u);
        const unsigned gen = old / nloc;
        if (old + 1u == (gen + 1u) * nloc) {
            __builtin_amdgcn_fence(__ATOMIC_RELEASE, "agent");
            asm volatile("s_waitcnt vmcnt(0)" ::: "memory");
            const unsigned og = xb_add(&bar[XB_TOP], 1u);
            const unsigned tg = og / nx;
            if (og + 1u == (tg + 1u) * nx) xb_add(&bar[XB_TOPGEN], 1u);
            else XB_SPIN(xb_ld(&bar[XB_TOPGEN]) == tg, bar);
            __builtin_amdgcn_fence(__ATOMIC_ACQUIRE, "agent");
            xb_add(&bar[XB_XGEN(b.x)], 1u);
            asm volatile("s_waitcnt vmcnt(0)" ::: "memory");
        } else {
            XB_SPIN(xb_ld(&bar[XB_XGEN(b.x)]) == gen, bar);
            __builtin_amdgcn_fence(__ATOMIC_ACQUIRE, "agent");
            asm volatile("s_waitcnt vmcnt(0)" ::: "memory");
        }
    }
    __syncthreads();
}

namespace gm {
constexpr int BM = 256, BK = 64, HALF = 128, HTB = HALF * BK * 2, STAGE_BYTES = 8 * HTB, NXCD = 8, WGM = 8;
__host__ __device__ __forceinline__ int lds_byte(int r, int c) { const int st = (r >> 4) * 2 + (c >> 5), rr = r & 15, cc = c & 31, ob = rr * 64 + cc * 2; return st * 1024 + (ob ^ (((ob >> 9) & 1) << 5)); }
__host__ __device__ __forceinline__ void stage_rc(int b, int& R, int& C) { const int st = b / 1024, sb = b % 1024, swz = sb ^ (((sb >> 9) & 1) << 5); R = (st >> 1) * 16 + swz / 64; C = (st & 1) * 32 + (swz % 64) / 2; }
__host__ __device__ __forceinline__ int perm32(int rho) { const int n = rho >> 4, i = rho & 15; return 8 * (i >> 2) + 4 * n + (i & 3); }

struct GUnit { const char* A; const char* B; int pm, pn; };
__device__ __forceinline__ const char* uni_ptr(const char* p) { const unsigned long long v = (unsigned long long)p; const unsigned lo = __builtin_amdgcn_readfirstlane((unsigned)v), hi = __builtin_amdgcn_readfirstlane((unsigned)(v >> 32));
    return (const char*)(const GAS char*)(((unsigned long long)hi << 32) | lo); }

struct TileOrder {
    int nM, nN, nwg, G, c;
    __device__ __forceinline__ void init(int nM_, int nN_, int G_, int c_) { nM = nM_; nN = nN_; nwg = nM * nN; G = G_; c = c_; }
    __device__ __forceinline__ bool get(int i, int& pm, int& pn) const {
        const long L = (long)i * G + c; if (L >= nwg) return false;
        int wgid = (int)L; { const int q = nwg / NXCD, r = nwg % NXCD, xcd = wgid % NXCD, off = wgid / NXCD; wgid = (xcd < r ? xcd * (q + 1) : r * (q + 1) + (xcd - r) * q) + off; }
        const int nig = WGM * nN, gid = wgid / nig, fm = gid * WGM, gsz = (nM - fm) < WGM ? (nM - fm) : WGM;
        pm = fm + ((wgid % nig) % gsz); pn = (wgid % nig) / gsz; return true;
    }
};

__device__ __forceinline__ unsigned cvt_pk_bf16(float lo, float hi) { unsigned r; asm volatile("v_cvt_pk_bf16_f32 %0, %1, %2" : "=v"(r) : "v"(lo), "v"(hi)); return r; }

template <class Epi, class Sched, bool TR>
__device__ __forceinline__ void gemm_phase(LAS unsigned char* lds, const Sched& S, const Epi& E) {
    int tid = threadIdx.x; asm volatile("" : "+v"(tid));
    const int wid = __builtin_amdgcn_readfirstlane(tid >> 6), lane = tid & 63, wr = wid >> 2, wc = wid & 3, fr = lane & 15, fq = lane >> 4;
    const int nt = S.nt;
    int sR0, sC0, sR1, sC1; stage_rc(tid * 16, sR0, sC0); stage_rc(tid * 16 + 8192, sR1, sC1);
    const unsigned vB0 = (unsigned)(Epi::PERM ? ((sR0 & ~31) + perm32(sR0 & 31)) : sR0) * S.ldb + (unsigned)sC0 * 2u;
    const unsigned vB1 = (unsigned)(Epi::PERM ? ((sR1 & ~31) + perm32(sR1 & 31)) : sR1) * S.ldb + (unsigned)sC1 * 2u;
    const size_t kA = S.kstepA, kB = S.kstepB;
    const size_t hstepB = (size_t)HALF * S.ldb;
    const unsigned ldsw = (unsigned)wid * 1024u;
    const int aoff = lds_byte(wr * 64 + fr, fq * 8), boff = lds_byte(wc * 32 + fr, fq * 8);
#define PG8_SA(b, h) (((b) * 2 + (h)) * HTB)
#define PG8_SB(b, h) ((4 + (b) * 2 + (h)) * HTB)
#define PG8_STAGE(bufoff, gbase, o0, o1) do { \
        __builtin_amdgcn_global_load_lds((const unsigned*)((const char*)(gbase) + (o0)), (LAS unsigned*)(lds + (bufoff) + ldsw), 16, 0, 0); \
        __builtin_amdgcn_global_load_lds((const unsigned*)((const char*)(gbase) + (o1)), (LAS unsigned*)(lds + (bufoff) + ldsw + 8192), 16, 0, 0); } while (0)
#define PG8_LDA(dst, b, h) do { _Pragma("unroll") for (int m = 0; m < 4; ++m) _Pragma("unroll") for (int k = 0; k < 2; ++k) dst[m][k] = *(const LAS bf16x8*)(lds + PG8_SA(b, h) + aoff + m * 2048 + k * 1024); } while (0)
#define PG8_LDB(dst, b, h) do { _Pragma("unroll") for (int n = 0; n < 2; ++n) _Pragma("unroll") for (int k = 0; k < 2; ++k) dst[n][k] = *(const LAS bf16x8*)(lds + PG8_SB(b, h) + boff + n * 2048 + k * 1024); } while (0)
#define PG8_MMA(ai, bj, At, Bt) do { __builtin_amdgcn_s_setprio(1); _Pragma("unroll") for (int m = 0; m < 4; ++m) _Pragma("unroll") for (int n = 0; n < 2; ++n) _Pragma("unroll") for (int k = 0; k < 2; ++k) \
        acc[ai][bj][m][n] = TR ? __builtin_amdgcn_mfma_f32_16x16x32_bf16(Bt[n][k], At[m][k], acc[ai][bj][m][n], 0, 0, 0) \
                               : __builtin_amdgcn_mfma_f32_16x16x32_bf16(At[m][k], Bt[n][k], acc[ai][bj][m][n], 0, 0, 0); __builtin_amdgcn_s_setprio(0); } while (0)
#define PG8_WAIT_V(n) asm volatile("s_waitcnt vmcnt(" #n ")" ::: "memory")
#define PG8_WAIT_L(n) asm volatile("s_waitcnt lgkmcnt(" #n ")" ::: "memory")
#define PG8_BAR __builtin_amdgcn_s_barrier()
#define PG8_SCHED __builtin_amdgcn_sched_barrier(0)
    GUnit cur, nxt; int ui = 0;
    if (!S.next(0, cur)) return;
    f32x4 acc[2][2][4][2];
#pragma unroll
    for (int a = 0; a < 2; ++a)
#pragma unroll
        for (int b = 0; b < 2; ++b)
#pragma unroll
            for (int m = 0; m < 4; ++m)
#pragma unroll
                for (int n = 0; n < 2; ++n) acc[a][b][m][n] = (f32x4){0.f, 0.f, 0.f, 0.f};
    bf16x8 At[4][2], B0[2][2], B1[2][2];
    unsigned c00 = S.aoff(cur, sR0, sC0), c01 = S.aoff(cur, sR1, sC1), c10 = S.aoff(cur, HALF + sR0, sC0), c11 = S.aoff(cur, HALF + sR1, sC1);
    const char* cA = uni_ptr(cur.A); const char* cB = uni_ptr(cur.B);
    PG8_STAGE(PG8_SB(0, 0), cB, vB0, vB1); PG8_STAGE(PG8_SB(0, 1), cB + hstepB, vB0, vB1); PG8_STAGE(PG8_SA(0, 0), cA, c00, c01); PG8_STAGE(PG8_SA(0, 1), cA, c10, c11);
    if (wr == 1) PG8_BAR;
    PG8_WAIT_V(2); PG8_BAR;
    PG8_STAGE(PG8_SB(1, 0), cB + kB, vB0, vB1); PG8_STAGE(PG8_SA(1, 0), cA + kA, c00, c01); PG8_STAGE(PG8_SB(1, 1), cB + hstepB + kB, vB0, vB1);
    PG8_WAIT_V(6); PG8_BAR;
    for (;;) {
        const bool has_next = S.next(ui + 1, nxt);
        if (!has_next) nxt = cur;
        const char* nA = uni_ptr(nxt.A); const char* nB = uni_ptr(nxt.B);
        unsigned n00 = c00, n01 = c01, n10 = c10, n11 = c11;
        if (!Sched::AOFF_PM_ONLY || nxt.pm != cur.pm) { n00 = S.aoff(nxt, sR0, sC0); n01 = S.aoff(nxt, sR1, sC1); n10 = S.aoff(nxt, HALF + sR0, sC0); n11 = S.aoff(nxt, HALF + sR1, sC1); }
        for (int t = 0; t < nt; t += 2) {
            const bool last = (t == nt - 2);
            const char* a1 = cA + (size_t)(t + 1) * kA;
            const char* a2 = last ? nA : cA + (size_t)(t + 2) * kA; const char* b2 = last ? nB : cB + (size_t)(t + 2) * kB;
            const char* a3 = a2 + kA; const char* b3 = b2 + kB;
            const unsigned x00 = last ? n00 : c00, x01 = last ? n01 : c01, x10 = last ? n10 : c10, x11 = last ? n11 : c11;
            PG8_LDB(B0, 0, 0); PG8_LDB(B1, 0, 1); PG8_SCHED; PG8_LDA(At, 0, 0); PG8_STAGE(PG8_SA(1, 1), a1, c10, c11);
            PG8_WAIT_V(8); PG8_WAIT_L(0); PG8_BAR; PG8_MMA(0, 0, At, B0); PG8_MMA(0, 1, At, B1); PG8_BAR; PG8_SCHED;
            PG8_LDA(At, 0, 1); PG8_STAGE(PG8_SB(0, 0), b2, vB0, vB1); PG8_STAGE(PG8_SB(0, 1), b2 + hstepB, vB0, vB1); PG8_STAGE(PG8_SA(0, 0), a2, x00, x01);
            PG8_WAIT_V(8); PG8_WAIT_L(0); PG8_BAR; PG8_MMA(1, 0, At, B0); PG8_MMA(1, 1, At, B1); PG8_BAR; PG8_SCHED;
            PG8_LDB(B0, 1, 0); PG8_LDB(B1, 1, 1); PG8_SCHED; PG8_LDA(At, 1, 0); PG8_STAGE(PG8_SA(0, 1), a2, x10, x11);
            PG8_WAIT_V(8); PG8_WAIT_L(0); PG8_BAR; PG8_MMA(0, 0, At, B0); PG8_MMA(0, 1, At, B1); PG8_BAR; PG8_SCHED;
            PG8_LDA(At, 1, 1); PG8_STAGE(PG8_SB(1, 0), b3, vB0, vB1); PG8_STAGE(PG8_SB(1, 1), b3 + hstepB, vB0, vB1); PG8_STAGE(PG8_SA(1, 0), a3, x00, x01);
            PG8_WAIT_V(8); PG8_WAIT_L(0); PG8_BAR; PG8_MMA(1, 0, At, B0); PG8_MMA(1, 1, At, B1); PG8_BAR; PG8_SCHED;
        }
        if (wr == 0) PG8_BAR;
        E(acc, cur, wr, wc, fr, fq);
        if (!has_next) break;
#pragma unroll
        for (int a = 0; a < 2; ++a)
#pragma unroll
            for (int b = 0; b < 2; ++b)
#pragma unroll
                for (int m = 0; m < 4; ++m)
#pragma unroll
                    for (int n = 0; n < 2; ++n) acc[a][b][m][n] = (f32x4){0.f, 0.f, 0.f, 0.f};
        cur = nxt; cA = nA; cB = nB; ++ui;
        c00 = n00; c01 = n01; c10 = n10; c11 = n11;
        if (wr == 1) PG8_BAR;
    }
    PG8_WAIT_V(0);
    PG8_BAR;
#undef PG8_SA
#undef PG8_SB
#undef PG8_STAGE
#undef PG8_LDA
#undef PG8_LDB
#undef PG8_MMA
#undef PG8_WAIT_V
#undef PG8_WAIT_L
#undef PG8_BAR
#undef PG8_SCHED
}
template <class Epi, class Sched, int SCALE_B>
__device__ __forceinline__ void gemm_phase_f8(LAS unsigned char* lds, const Sched& S, const Epi& E) {
    int tid = threadIdx.x; asm volatile("" : "+v"(tid));
    const int wid = __builtin_amdgcn_readfirstlane(tid >> 6), lane = tid & 63, wr = wid >> 2, wc = wid & 3, fr = lane & 15, fq = lane >> 4;
    const int nt = S.nt;
    int scA = 127, scB = SCALE_B; asm volatile("" : "+v"(scA), "+v"(scB));
    int sR0, sC0, sR1, sC1; stage_rc(tid * 16, sR0, sC0); stage_rc(tid * 16 + 8192, sR1, sC1);
    const unsigned vB0 = (unsigned)(Epi::PERM ? ((sR0 & ~31) + perm32(sR0 & 31)) : sR0) * S.ldb + (unsigned)sC0 * 2u;
    const unsigned vB1 = (unsigned)(Epi::PERM ? ((sR1 & ~31) + perm32(sR1 & 31)) : sR1) * S.ldb + (unsigned)sC1 * 2u;
    const size_t kA = S.kstepA, kB = S.kstepB;
    const size_t hstepB = (size_t)HALF * S.ldb;
    const unsigned ldsw = (unsigned)wid * 1024u;
    const int fcol = (fq >> 1) * 32 + (fq & 1) * 16;
    const int aoff = lds_byte(wr * 64 + fr, fcol), aoff2 = lds_byte(wr * 64 + fr, fcol + 8), boff = lds_byte(wc * 32 + fr, fcol), boff2 = lds_byte(wc * 32 + fr, fcol + 8);
#define PG8_SA(b, h) (((b) * 2 + (h)) * HTB)
#define PG8_SB(b, h) ((4 + (b) * 2 + (h)) * HTB)
#define PG8_STAGE(bufoff, gbase, o0, o1) do { \
        __builtin_amdgcn_global_load_lds((const unsigned*)((const char*)(gbase) + (o0)), (LAS unsigned*)(lds + (bufoff) + ldsw), 16, 0, 0); \
        __builtin_amdgcn_global_load_lds((const unsigned*)((const char*)(gbase) + (o1)), (LAS unsigned*)(lds + (bufoff) + ldsw + 8192), 16, 0, 0); } while (0)
#define PG8_LDA(dst, b, h) do { _Pragma("unroll") for (int m = 0; m < 4; ++m) dst[m] = __builtin_shufflevector(*(const LAS i32x4*)(lds + PG8_SA(b, h) + aoff + m * 2048), *(const LAS i32x4*)(lds + PG8_SA(b, h) + aoff2 + m * 2048), 0, 1, 2, 3, 4, 5, 6, 7); } while (0)
#define PG8_LDB(dst, b, h) do { _Pragma("unroll") for (int n = 0; n < 2; ++n) dst[n] = __builtin_shufflevector(*(const LAS i32x4*)(lds + PG8_SB(b, h) + boff + n * 2048), *(const LAS i32x4*)(lds + PG8_SB(b, h) + boff2 + n * 2048), 0, 1, 2, 3, 4, 5, 6, 7); } while (0)
#define PG8_F8(FRG) (i32x8){(int)FRG[0][0], (int)FRG[0][1], (int)FRG[0][2], (int)FRG[0][3], (int)FRG[1][0], (int)FRG[1][1], (int)FRG[1][2], (int)FRG[1][3]}
#define PG8_MMA(ai, bj, At, Bt) do { __builtin_amdgcn_s_setprio(1); _Pragma("unroll") for (int m = 0; m < 4; ++m) _Pragma("unroll") for (int n = 0; n < 2; ++n) \
        asm volatile("v_mfma_scale_f32_16x16x128_f8f6f4 %0, %1, %2, %0, %3, %4 op_sel_hi:[0,0,0]" : "+v"(acc[ai][bj][m][n]) : "v"(Bt[n]), "v"(At[m]), "v"(scB), "v"(scA)); __builtin_amdgcn_s_setprio(0); } while (0)
#define PG8_WAIT_V(n) asm volatile("s_waitcnt vmcnt(" #n ")" ::: "memory")
#define PG8_WAIT_L(n) asm volatile("s_waitcnt lgkmcnt(" #n ")" ::: "memory")
#define PG8_BAR __builtin_amdgcn_s_barrier()
#define PG8_SCHED __builtin_amdgcn_sched_barrier(0)
    GUnit cur, nxt; int ui = 0;
    if (!S.next(0, cur)) return;
    f32x4 acc[2][2][4][2];
#pragma unroll
    for (int a = 0; a < 2; ++a)
#pragma unroll
        for (int b = 0; b < 2; ++b)
#pragma unroll
            for (int m = 0; m < 4; ++m)
#pragma unroll
                for (int n = 0; n < 2; ++n) acc[a][b][m][n] = (f32x4){0.f, 0.f, 0.f, 0.f};
    i32x8 At[4], B0[2], B1[2];
    unsigned c00 = S.aoff(cur, sR0, sC0), c01 = S.aoff(cur, sR1, sC1), c10 = S.aoff(cur, HALF + sR0, sC0), c11 = S.aoff(cur, HALF + sR1, sC1);
    const char* cA = uni_ptr(cur.A); const char* cB = uni_ptr(cur.B);
    PG8_STAGE(PG8_SB(0, 0), cB, vB0, vB1); PG8_STAGE(PG8_SB(0, 1), cB + hstepB, vB0, vB1); PG8_STAGE(PG8_SA(0, 0), cA, c00, c01); PG8_STAGE(PG8_SA(0, 1), cA, c10, c11);
    if (wr == 1) PG8_BAR;
    PG8_WAIT_V(2); PG8_BAR;
    PG8_STAGE(PG8_SB(1, 0), cB + kB, vB0, vB1); PG8_STAGE(PG8_SA(1, 0), cA + kA, c00, c01); PG8_STAGE(PG8_SB(1, 1), cB + hstepB + kB, vB0, vB1);
    PG8_WAIT_V(6); PG8_BAR;
    for (;;) {
        const bool has_next = S.next(ui + 1, nxt);
        if (!has_next) nxt = cur;
        const char* nA = uni_ptr(nxt.A); const char* nB = uni_ptr(nxt.B);
        unsigned n00 = c00, n01 = c01, n10 = c10, n11 = c11;
        if constexpr (!Sched::AOFF_CONST) { if (!Sched::AOFF_PM_ONLY || nxt.pm != cur.pm) { n00 = S.aoff(nxt, sR0, sC0); n01 = S.aoff(nxt, sR1, sC1); n10 = S.aoff(nxt, HALF + sR0, sC0); n11 = S.aoff(nxt, HALF + sR1, sC1); } }
        for (int t = 0; t < nt; t += 2) {
            const bool last = (t == nt - 2);
            const char* a1 = cA + (size_t)(t + 1) * kA;
            const char* a2 = last ? nA : cA + (size_t)(t + 2) * kA; const char* b2 = last ? nB : cB + (size_t)(t + 2) * kB;
            const char* a3 = a2 + kA; const char* b3 = b2 + kB;
            const unsigned x00 = (!Sched::AOFF_CONST && last) ? n00 : c00, x01 = (!Sched::AOFF_CONST && last) ? n01 : c01, x10 = (!Sched::AOFF_CONST && last) ? n10 : c10, x11 = (!Sched::AOFF_CONST && last) ? n11 : c11;
            PG8_LDB(B0, 0, 0); PG8_LDB(B1, 0, 1); PG8_SCHED; PG8_LDA(At, 0, 0); PG8_STAGE(PG8_SA(1, 1), a1, c10, c11);
            PG8_WAIT_V(8); PG8_WAIT_L(0); PG8_BAR; PG8_MMA(0, 0, At, B0); PG8_MMA(0, 1, At, B1); PG8_BAR; PG8_SCHED;
            PG8_LDA(At, 0, 1); PG8_STAGE(PG8_SB(0, 0), b2, vB0, vB1); PG8_STAGE(PG8_SB(0, 1), b2 + hstepB, vB0, vB1); PG8_STAGE(PG8_SA(0, 0), a2, x00, x01);
            PG8_WAIT_V(8); PG8_WAIT_L(0); PG8_BAR; PG8_MMA(1, 0, At, B0); PG8_MMA(1, 1, At, B1); PG8_BAR; PG8_SCHED;
            PG8_LDB(B0, 1, 0); PG8_LDB(B1, 1, 1); PG8_SCHED; PG8_LDA(At, 1, 0); PG8_STAGE(PG8_SA(0, 1), a2, x10, x11);
            PG8_WAIT_V(8); PG8_WAIT_L(0); PG8_BAR; PG8_MMA(0, 0, At, B0); PG8_MMA(0, 1, At, B1); PG8_BAR; PG8_SCHED;
            PG8_LDA(At, 1, 1); PG8_STAGE(PG8_SB(1, 0), b3, vB0, vB1); PG8_STAGE(PG8_SB(1, 1), b3 + hstepB, vB0, vB1); PG8_STAGE(PG8_SA(1, 0), a3, x00, x01);
            PG8_WAIT_V(8); PG8_WAIT_L(0); PG8_BAR; PG8_MMA(1, 0, At, B0); PG8_MMA(1, 1, At, B1); PG8_BAR; PG8_SCHED;
        }
        if (wr == 0) PG8_BAR;
        asm volatile("s_nop 15\n\ts_nop 15" ::: "memory");
        E(acc, cur, wr, wc, fr, fq);
        if (!has_next) break;
#pragma unroll
        for (int a = 0; a < 2; ++a)
#pragma unroll
            for (int b = 0; b < 2; ++b)
#pragma unroll
                for (int m = 0; m < 4; ++m)
#pragma unroll
                    for (int n = 0; n < 2; ++n) acc[a][b][m][n] = (f32x4){0.f, 0.f, 0.f, 0.f};
        cur = nxt; cA = nA; cB = nB; ++ui;
        c00 = n00; c01 = n01; c10 = n10; c11 = n11;
        if (wr == 1) PG8_BAR;
    }
    PG8_WAIT_V(0);
    PG8_BAR;
#undef PG8_SA
#undef PG8_SB
#undef PG8_STAGE
#undef PG8_LDA
#undef PG8_LDB
#undef PG8_MMA
#undef PG8_F8
#undef PG8_WAIT_V
#undef PG8_WAIT_L
#undef PG8_BAR
#undef PG8_SCHED
}
}

struct Args { const float* in[35]; float* out; unsigned char* ws; int ph_lo, ph_hi; };
struct Frame {
    LAS unsigned char* lds;
    int tid, lane, wave, G, bid;
    float* out; unsigned char* ws;
};
__device__ __forceinline__ const float* inptr(const Frame& F, int i) {
    const LAS unsigned* t = (const LAS unsigned*)(F.lds + LDSCTL_OFF) + 2 * i;
    const unsigned lo = __builtin_amdgcn_readfirstlane(t[0]), hi = __builtin_amdgcn_readfirstlane(t[1]);
    const GAS float* g = (const GAS float*)(((unsigned long long)hi << 32) | lo);
    return (const float*)g;
}
enum { I_X = 0, I_C, I_CTX, I_CCTX, I_MODW, I_MODB, I_N1G, I_N2G, I_WIN, I_WOUT, I_CONVW, I_CONVB, I_HW1, I_HB1, I_HFREQ, I_HW2, I_HB2, I_HW3, I_HB3, I_HBIAS,
       I_LRE, I_LIM, I_LSTEP, I_BRE, I_BIM, I_CRE, I_CIM, I_S5D, I_GLUW, I_GLUB, I_RW, I_WG, I_WU, I_WD, I_FING };

struct SchedPlain {
    static constexpr bool AOFF_PM_ONLY = true, AOFF_CONST = true;
    gm::TileOrder T; const char* A; const char* B; unsigned lda, ldb, kstepA, kstepB; int nt; int mt; size_t az, bz;
    __device__ __forceinline__ bool next(int i, gm::GUnit& u) const {
        int pm, pn; if (!T.get(i, pm, pn)) return false; const int z = pm / mt, pl = pm - z * mt;
        u.pm = pm; u.pn = pn; u.A = A + (size_t)z * az + (size_t)pl * 256 * lda; u.B = B + (size_t)z * bz + (size_t)pn * 256 * ldb; return true; }
    __device__ __forceinline__ unsigned aoff(const gm::GUnit&, int row, int col) const { return (unsigned)row * lda + (unsigned)col * 2u; }
};
struct SchedMoe1 {
    static constexpr bool AOFF_PM_ONLY = true, AOFF_CONST = false;
    gm::TileOrder T; const char* A; const char* B; const int* idx; unsigned lda, ldb, kstepA, kstepB; int nt;
    __device__ __forceinline__ bool next(int i, gm::GUnit& u) const {
        int pm, pn; if (!T.get(i, pm, pn)) return false; const int e = pm >> 4;
        u.pm = pm; u.pn = pn; u.A = A; u.B = B + ((size_t)e * (2 * FF) + (size_t)pn * 256) * ldb; return true; }
    __device__ __forceinline__ unsigned aoff(const gm::GUnit& u, int row, int col) const { const int tok = idx[u.pm * 256 + row]; return (unsigned)tok * lda + (unsigned)col * 2u; }
};
struct SchedGlu {
    static constexpr bool AOFF_PM_ONLY = true;
    gm::TileOrder T; const char* A; const char* B; unsigned ldb, kstepA, kstepB; int nt;
    __device__ __forceinline__ bool next(int i, gm::GUnit& u) const {
        int pm, pn; if (!T.get(i, pm, pn)) return false;
        u.pm = pm; u.pn = pn; u.A = A + (size_t)pm * 256 * 32; u.B = B + (size_t)pn * 256 * ldb; return true; }
    __device__ __forceinline__ unsigned aoff(const gm::GUnit&, int row, int col) const { return (unsigned)(col >> 4) * (unsigned)(1024 * 512 * 2) + (unsigned)row * 32u + (unsigned)(col & 15) * 2u; }
};

using gm::GUnit; using gm::cvt_pk_bf16;
struct EpiZT { static constexpr bool PERM = false; bf16* ZT;
    __device__ __forceinline__ void operator()(const f32x4 (&acc)[2][2][4][2], const GUnit& u, int wr, int wc, int fr, int fq) const {
#pragma unroll
        for (int bj = 0; bj < 2; ++bj)
#pragma unroll
            for (int n = 0; n < 2; ++n) { const int ch = u.pn * 256 + bj * 128 + wc * 32 + n * 16 + fr; bf16* rowp = ZT + (size_t)ch * NTOK + u.pm * 256 + wr * 64 + 4 * fq;
#pragma unroll
                for (int ai = 0; ai < 2; ++ai)
#pragma unroll
                    for (int m = 0; m < 4; ++m) { const f32x4 v = acc[ai][bj][m][n]; u32x2 w; w.x = cvt_pk_bf16(v[0], v[1]); w.y = cvt_pk_bf16(v[2], v[3]); *(u32x2*)(rowp + ai * 128 + m * 16) = w; } }
    }
};
struct EpiUG { static constexpr bool PERM = true; bf16* UG;
    __device__ __forceinline__ void operator()(const f32x4 (&acc)[2][2][4][2], const GUnit& u, int wr, int wc, int fr, int fq) const {
#pragma unroll
        for (int ai = 0; ai < 2; ++ai)
#pragma unroll
            for (int m = 0; m < 4; ++m) { const int r = u.pm * 256 + ai * 128 + wr * 64 + m * 16 + fr; int crow, tau;
                if (r < NTOK) { crow = r >> 5; tau = r & 31; } else { const int rc = r - NTOK; crow = 1024 + (rc >> 5); tau = rc & 31; }
#pragma unroll
                for (int bj = 0; bj < 2; ++bj) { const int c0 = u.pn * 256 + bj * 128 + wc * 32 + 8 * fq; const int g = c0 >> 4, h0 = c0 & 15;
                    const f32x4 v0 = acc[ai][bj][m][0], v1 = acc[ai][bj][m][1]; u32x4 w; w.x = cvt_pk_bf16(v0[0], v0[1]); w.y = cvt_pk_bf16(v0[2], v0[3]); w.z = cvt_pk_bf16(v1[0], v1[1]); w.w = cvt_pk_bf16(v1[2], v1[3]);
                    *(u32x4*)(UG + ((size_t)g * UROWS + crow) * UCOLS + tau * 16 + h0) = w; } }
    }
};
struct EpiEB { static constexpr bool PERM = false; float* EB;
    __device__ __forceinline__ void operator()(const f32x4 (&acc)[2][2][4][2], const GUnit& u, int wr, int wc, int fr, int fq) const {
        const int g = u.pm / 5, pl = u.pm - g * 5;
#pragma unroll
        for (int ai = 0; ai < 2; ++ai)
#pragma unroll
            for (int m = 0; m < 4; ++m) { float* rowp = EB + ((size_t)g * UROWS + pl * 256 + ai * 128 + wr * 64 + m * 16 + fr) * 256 + wc * 32 + 4 * fq;
#pragma unroll
                for (int bj = 0; bj < 2; ++bj)
#pragma unroll
                    for (int n = 0; n < 2; ++n) *(f32x4*)(rowp + bj * 128 + n * 16) = acc[ai][bj][m][n]; }
    }
};
struct EpiYS { static constexpr bool PERM = true; bf16* YSG; const bf16* UG; const float* s5d;
    __device__ __forceinline__ void operator()(const f32x4 (&acc)[2][2][4][2], const GUnit& u, int wr, int wc, int fr, int fq) const {
        const int g = u.pm >> 2, pl = u.pm & 3;
        float dv[2][8];
#pragma unroll
        for (int bj = 0; bj < 2; ++bj) { const int c0 = u.pn * 256 + bj * 128 + wc * 32 + 8 * fq;
#pragma unroll
            for (int j = 0; j < 8; ++j) dv[bj][j] = s5d[g * 16 + ((c0 + j) & 15)]; }
#pragma unroll
        for (int ai = 0; ai < 2; ++ai)
#pragma unroll
            for (int m = 0; m < 4; ++m) { const int crow = pl * 256 + ai * 128 + wr * 64 + m * 16 + fr;
#pragma unroll
                for (int bj = 0; bj < 2; ++bj) { const int c0 = u.pn * 256 + bj * 128 + wc * 32 + 8 * fq;
                    const u32x4 uu = *(const u32x4*)(UG + ((size_t)g * UROWS + crow) * UCOLS + c0);
                    const f32x4 v0 = acc[ai][bj][m][0], v1 = acc[ai][bj][m][1];
                    float y[8]; y[0] = v0[0] + dv[bj][0] * bflo(uu.x); y[1] = v0[1] + dv[bj][1] * bfhi(uu.x); y[2] = v0[2] + dv[bj][2] * bflo(uu.y); y[3] = v0[3] + dv[bj][3] * bfhi(uu.y);
                    y[4] = v1[0] + dv[bj][4] * bflo(uu.z); y[5] = v1[1] + dv[bj][5] * bfhi(uu.z); y[6] = v1[2] + dv[bj][6] * bflo(uu.w); y[7] = v1[3] + dv[bj][7] * bfhi(uu.w);
#pragma unroll
                    for (int j = 0; j < 8; ++j) y[j] = gelu_tanh(y[j]);
                    u32x4 w; w.x = cvt_pk_bf16(y[0], y[1]); w.y = cvt_pk_bf16(y[2], y[3]); w.z = cvt_pk_bf16(y[4], y[5]); w.w = cvt_pk_bf16(y[6], y[7]);
                    *(u32x4*)(YSG + ((size_t)g * 1024 + crow) * 512 + c0) = w; } }
    }
};
struct EpiGlu { static constexpr bool PERM = true; bf16* YCAT; const bf16* YSG; const float* glub;
    __device__ __forceinline__ void operator()(const f32x4 (&acc)[2][2][4][2], const GUnit& u, int wr, int wc, int fr, int fq) const {
#pragma unroll
        for (int bj = 0; bj < 2; ++bj) { const int n0 = u.pn * 256 + bj * 128 + wc * 32 + 8 * fq; const int g = n0 >> 4, h0 = n0 & 15;
            const f32x4 b0 = *(const f32x4*)(glub + n0), b1 = *(const f32x4*)(glub + n0 + 4);
#pragma unroll
            for (int ai = 0; ai < 2; ++ai)
#pragma unroll
                for (int m = 0; m < 4; ++m) { const int tok = u.pm * 256 + ai * 128 + wr * 64 + m * 16 + fr;
                    const u32x4 ys = *(const u32x4*)(YSG + ((size_t)g * 1024 + (tok >> 5)) * 512 + (tok & 31) * 16 + h0);
                    const f32x4 v0 = acc[ai][bj][m][0] + b0, v1 = acc[ai][bj][m][1] + b1;
                    float y[8]; y[0] = bflo(ys.x) * sigmoidf_(v0[0]); y[1] = bfhi(ys.x) * sigmoidf_(v0[1]); y[2] = bflo(ys.y) * sigmoidf_(v0[2]); y[3] = bfhi(ys.y) * sigmoidf_(v0[3]);
                    y[4] = bflo(ys.z) * sigmoidf_(v1[0]); y[5] = bfhi(ys.z) * sigmoidf_(v1[1]); y[6] = bflo(ys.w) * sigmoidf_(v1[2]); y[7] = bfhi(ys.w) * sigmoidf_(v1[3]);
                    u32x4 w; w.x = cvt_pk_bf16(y[0], y[1]); w.y = cvt_pk_bf16(y[2], y[3]); w.z = cvt_pk_bf16(y[4], y[5]); w.w = cvt_pk_bf16(y[6], y[7]);
#ifdef DBG_S5_SCALE
                    w.x = cvt_pk_bf16(y[0] * DBG_S5_SCALE, y[1] * DBG_S5_SCALE); w.y = cvt_pk_bf16(y[2] * DBG_S5_SCALE, y[3] * DBG_S5_SCALE); w.z = cvt_pk_bf16(y[4] * DBG_S5_SCALE, y[5] * DBG_S5_SCALE); w.w = cvt_pk_bf16(y[6] * DBG_S5_SCALE, y[7] * DBG_S5_SCALE);
#endif
                    *(u32x4*)(YCAT + (size_t)tok * DM + 512 + n0) = w; } }
    }
};
struct EpiXmid { static constexpr bool PERM = false; const float* x; float* xmid; const float* mod;
    __device__ __forceinline__ void operator()(const f32x4 (&acc)[2][2][4][2], const GUnit& u, int wr, int wc, int fr, int fq) const {
        const int b = u.pm >> 4;
        const int col0 = u.pn * 256 + wc * 32 + 4 * fq;
        f32x4 gv[2][2];
#pragma unroll
        for (int bj = 0; bj < 2; ++bj)
#pragma unroll
            for (int n = 0; n < 2; ++n) gv[bj][n] = *(const f32x4*)(mod + (size_t)b * (NMOD * DM) + 2 * DM + col0 + bj * 128 + n * 16);
#pragma unroll
        for (int ai = 0; ai < 2; ++ai)
#pragma unroll
            for (int m = 0; m < 4; ++m) { const size_t off = (size_t)(u.pm * 256 + ai * 128 + wr * 64 + m * 16 + fr) * DM + col0;
#pragma unroll
                for (int bj = 0; bj < 2; ++bj)
#pragma unroll
                    for (int n = 0; n < 2; ++n) { const f32x4 xv = *(const f32x4*)(x + off + bj * 128 + n * 16); *(f32x4*)(xmid + off + bj * 128 + n * 16) = xv + gv[bj][n] * acc[ai][bj][m][n]; } }
    }
};
struct EpiMoe1 { static constexpr bool PERM = true; unsigned char* HB;
    __device__ __forceinline__ void operator()(const f32x4 (&acc)[2][2][4][2], const GUnit& u, int wr, int wc, int fr, int fq) const {
        const int c0 = u.pn * 128 + wc * 32 + 8 * fq;
#pragma unroll
        for (int ai = 0; ai < 2; ++ai)
#pragma unroll
            for (int m = 0; m < 4; ++m) { const size_t row = (size_t)u.pm * 256 + ai * 128 + wr * 64 + m * 16 + fr;
                float y[8];
#pragma unroll
                for (int n = 0; n < 2; ++n)
#pragma unroll
                    for (int j = 0; j < 4; ++j) y[n * 4 + j] = fminf(fmaxf(siluf_(acc[ai][0][m][n][j]) * acc[ai][1][m][n][j], -448.0f), 448.0f);
                u32x2 w; w.x = pk4_fp8(y[0], y[1], y[2], y[3]); w.y = pk4_fp8(y[4], y[5], y[6], y[7]);
                *(u32x2*)(HB + row * FF + c0) = w; }
    }
};
struct EpiMoe2 { static constexpr bool PERM = true; bf16* Y; const float* gate;
    __device__ __forceinline__ void operator()(const f32x4 (&acc)[2][2][4][2], const GUnit& u, int wr, int wc, int fr, int fq) const {
#pragma unroll
        for (int ai = 0; ai < 2; ++ai)
#pragma unroll
            for (int m = 0; m < 4; ++m) { const size_t row = (size_t)u.pm * 256 + ai * 128 + wr * 64 + m * 16 + fr; const float gt = gate[row];
#pragma unroll
                for (int bj = 0; bj < 2; ++bj) { const int c0 = u.pn * 256 + bj * 128 + wc * 32 + 8 * fq;
                    const f32x4 v0 = acc[ai][bj][m][0] * gt, v1 = acc[ai][bj][m][1] * gt;
                    u32x4 w; w.x = cvt_pk_bf16(v0[0], v0[1]); w.y = cvt_pk_bf16(v0[2], v0[3]); w.z = cvt_pk_bf16(v1[0], v1[1]); w.w = cvt_pk_bf16(v1[2], v1[3]);
                    *(u32x4*)(Y + row * DM + c0) = w; } }
    }
};

__device__ __forceinline__ void tr_item(const float* W, int N, bf16* WT, int ldk, int k0, int n0, int drow0, LAS float* scr, int lane) {
    float tv[32];
    const float* wp = W + (size_t)(k0 + (lane >> 5)) * N + n0 + (lane & 31);
#pragma unroll
    for (int i = 0; i < 32; ++i) tv[i] = wp[(size_t)(2 * i) * N];
#pragma unroll
    for (int i = 0; i < 32; ++i) scr[(2 * i + (lane >> 5)) * 33 + (lane & 31)] = tv[i];
    LDS_WAIT(); asm volatile("" ::: "memory");
    const int c = lane & 7;
#pragma unroll
    for (int j = 0; j < 4; ++j) { const int n = (lane >> 3) + 8 * j; const LAS float* s = scr + (8 * c) * 33 + n;
        u32x4 o; o.x = pk2(s[0 * 33], s[1 * 33]); o.y = pk2(s[2 * 33], s[3 * 33]); o.z = pk2(s[4 * 33], s[5 * 33]); o.w = pk2(s[6 * 33], s[7 * 33]);
        *(u32x4*)(WT + (size_t)(drow0 + n) * ldk + k0 + 8 * c) = o; }
    LDS_WAIT(); asm volatile("" ::: "memory");
}
__device__ __forceinline__ void p0_transposes(Frame& F) {
    LAS float* scr = (LAS float*)(F.lds + F.wave * 16384);
    if (F.bid >= 192) return;
    const int gw = F.bid * NWAVES + F.wave, NGW = 192 * NWAVES;
    constexpr int I0 = 16 * 64, I1 = 16 * 32, I2 = 8 * 16, IG = 16 * 16 * 88;
    constexpr int NIT = I0 + I1 + I2;
    bf16* ws16 = (bf16*)F.ws;
    for (int it = gw; it < NIT; it += NGW) {
        int r = it;
        if (r < I0) { const int kb = r / 64, nb = r % 64; tr_item(inptr(F, I_WIN), INC, (bf16*)(F.ws + WS_WINT), DM, kb * 64, nb * 32, nb * 32, scr, F.lane); continue; } r -= I0;
        if (r < I1) { const int kb = r / 32, nb = r % 32; tr_item(inptr(F, I_WOUT), DM, (bf16*)(F.ws + WS_WOUTT), DM, kb * 64, nb * 32, nb * 32, scr, F.lane); continue; } r -= I1;
        if (r < I2) { const int kb = r / 16, nb = r % 16; tr_item(inptr(F, I_GLUW), S5W, (bf16*)(F.ws + WS_GLUT), S5W, kb * 64, nb * 32, nb * 32, scr, F.lane); continue; } r -= I2;
        if (r < 2 * IG) { const int up = r >= IG; if (up) r -= IG; const int e = r / (16 * 88), q = r % (16 * 88), kb = q / 88, nb = q % 88, n0 = nb * 32;
            const float* W = inptr(F, up ? I_WU : I_WG) + (size_t)e * DM * FF;
            tr_item(W, FF, (bf16*)(F.ws + WS_WGUT) + (size_t)e * (2 * FF) * DM, DM, kb * 64, n0, 256 * (n0 >> 7) + (n0 & 127) + (up ? 128 : 0), scr, F.lane); continue; }
    }
    (void)ws16;
}
__device__ __forceinline__ void tr_item_f8(const float* W, int N, unsigned char* WT, int ldk, int k0, int n0, int drow0, float sc, LAS float* scr, int lane) {
    float tv[32];
    const float* wp = W + (size_t)(k0 + (lane >> 5)) * N + n0 + (lane & 31);
#pragma unroll
    for (int i = 0; i < 32; ++i) tv[i] = wp[(size_t)(2 * i) * N];
#pragma unroll
    for (int i = 0; i < 32; ++i) scr[(2 * i + (lane >> 5)) * 33 + (lane & 31)] = tv[i];
    LDS_WAIT(); asm volatile("" ::: "memory");
    const int c = lane & 7;
#pragma unroll
    for (int j = 0; j < 4; ++j) { const int n = (lane >> 3) + 8 * j; const LAS float* s = scr + (8 * c) * 33 + n;
        u32x2 o; o.x = pk4_fp8(s[0 * 33] * sc, s[1 * 33] * sc, s[2 * 33] * sc, s[3 * 33] * sc); o.y = pk4_fp8(s[4 * 33] * sc, s[5 * 33] * sc, s[6 * 33] * sc, s[7 * 33] * sc);
        *(u32x2*)(WT + (size_t)(drow0 + n) * ldk + k0 + 8 * c) = o; }
    LDS_WAIT(); asm volatile("" ::: "memory");
}
__device__ __forceinline__ void p_down_items(Frame& F, int first, int count, int stride);
__device__ __forceinline__ void p_down_items(Frame& F, int first, int count, int stride) {
    LAS float* scr = (LAS float*)(F.lds + F.wave * 16384);
    for (int k = 0; k < count; ++k) { const int r = first + k * stride; if (r >= 16 * 44 * 32) break;
        const int e = r / (44 * 32), q = r % (44 * 32), kb = q / 32, nb = q % 32;
        tr_item_f8(inptr(F, I_WD) + (size_t)e * FF * DM, DM, (unsigned char*)(F.ws + WS_WDT) + (size_t)e * DM * FF, FF, kb * 64, nb * 32, nb * 32, WD_SCALE, scr, F.lane); }
}
constexpr int DN_P4 = 8 * 8 * 128 - 512, DN_P9 = 10 * 8 * 128, DN_P3 = 0, DN_P0 = 22528 - DN_P4 - DN_P9 - DN_P3;
__device__ __forceinline__ void p0_adaln_item(Frame& F, int item) {
    LAS float* sl = (LAS float*)F.lds;
    LAS float* part = sl + 9 * 1024;
    for (int i = F.tid; i < 9 * 1024; i += NTHR) { const int r = i >> 10, k = i & 1023; const float v = (r < 8) ? inptr(F, I_C)[r * DM + k] : inptr(F, I_CCTX)[k]; sl[i] = siluf_(v); }
    __syncthreads();
    const int cl = F.tid & 31, kq = F.tid >> 5, j = item * 32 + cl;
    float a[9];
#pragma unroll
    for (int r = 0; r < 9; ++r) a[r] = 0.f;
    const float* W = inptr(F, I_MODW);
#pragma unroll 16
    for (int kk = 0; kk < 64; ++kk) { const int k = kq + 16 * kk; const float w = W[(size_t)k * (NMOD * DM) + j];
#pragma unroll
        for (int r = 0; r < 9; ++r) a[r] += sl[r * 1024 + k] * w; }
#pragma unroll
    for (int r = 0; r < 9; ++r) part[(kq * 9 + r) * 32 + cl] = a[r];
    __syncthreads();
    if (F.tid < 9 * 32) { const int r = F.tid >> 5, c2 = F.tid & 31; float s = inptr(F, I_MODB)[item * 32 + c2];
#pragma unroll
        for (int q = 0; q < 16; ++q) s += part[(q * 9 + r) * 32 + c2];
        ((float*)(F.ws + WS_MOD))[(size_t)r * (NMOD * DM) + item * 32 + c2] = s; }
    __syncthreads();
}
__device__ __forceinline__ void p0_s5_tables(Frame& F, int g) {
    typedef float f32x2 __attribute__((ext_vector_type(2)));
    LAS f32x2* PW = (LAS f32x2*)F.lds;
    LAS f32x2* BB = PW + 2 * 33 * 64;
    LAS float* KT = (LAS float*)(BB + 2 * 64 * 16);
    LAS f32x2* CC = (LAS f32x2*)(KT + 2 * 32 * 256);
    const float* lre = inptr(F, I_LRE); const float* lim = inptr(F, I_LIM); const float* lst = inptr(F, I_LSTEP);
    const float* cre = inptr(F, I_CRE); const float* cim = inptr(F, I_CIM);
    for (int i = F.tid; i < 2 * 33 * 64; i += NTHR) { const int dir = i / (33 * 64), e = (i / 64) % 33, p = i & 63;
        const double lr = lre[(dir * NG + g) * NP + p], li = lim[(dir * NG + g) * NP + p], dt = exp((double)lst[dir * NG + g]);
        double ph = li * dt * e; ph -= 6.283185307179586 * floor(ph * 0.15915494309189535);
        const float m = expf((float)(lr * dt * e)); float sn, cs; sincosf((float)ph, &sn, &cs); const float cr = m * cs, ci = m * sn;
        PW[i] = (f32x2){cr, ci};
        if (e == 32) { float* LT = (float*)(F.ws + WS_LT); LT[((dir * NG + g) * NP + p) * 2] = cr; LT[((dir * NG + g) * NP + p) * 2 + 1] = ci; } }
    __syncthreads();
    for (int i = F.tid; i < 2 * 16 * 64; i += NTHR) { const int dir = i >> 10, h = (i >> 6) & 15, p = i & 63; const size_t ci = (((size_t)dir * NG + g) * GH + h) * NP + p; CC[i] = (f32x2){cre[ci], cim[ci]}; }
    for (int i = F.tid; i < 2 * 64 * 16; i += NTHR) { const int dir = i >> 10, p = (i >> 4) & 63, h = i & 15;
        const double lr = lre[(dir * NG + g) * NP + p], li = lim[(dir * NG + g) * NP + p];
        const f32x2 lb = PW[(dir * 33 + 1) * 64 + p]; const double ar = (double)lb.x - 1.0, ai = (double)lb.y, den = lr * lr + li * li;
        const double fr_ = (ar * lr + ai * li) / den, fi_ = (ai * lr - ar * li) / den;
        const size_t bi = (((size_t)dir * NG + g) * NP + p) * GH + h; const double br = inptr(F, I_BRE)[bi], bim = inptr(F, I_BIM)[bi];
        BB[i] = (f32x2){(float)(fr_ * br - fi_ * bim), (float)(fr_ * bim + fi_ * br)}; }
    __syncthreads();
    {
        const int dir = F.tid >> 8, h = (F.tid >> 4) & 15, hp = F.tid & 15;
        for (int d = 0; d < 32; ++d) KT[(dir * 32 + d) * 256 + (F.tid & 255)] = 0.f;
        for (int pc = 0; pc < 4; ++pc) { float qr[16], qi[16];
#pragma unroll
            for (int j = 0; j < 16; ++j) { const int p = pc * 16 + j; const f32x2 cc = CC[(dir * 16 + h) * 64 + p]; const float cr = cc.x, cj = cc.y; const f32x2 b = BB[(dir * 64 + p) * 16 + hp];
                qr[j] = cr * b.x - cj * b.y; qi[j] = cr * b.y + cj * b.x; }
            for (int d = 0; d < 32; ++d) { float s = 0.f;
#pragma unroll
                for (int j = 0; j < 16; ++j) { const f32x2 w = PW[(dir * 33 + d) * 64 + pc * 16 + j]; s += qr[j] * w.x - qi[j] * w.y; }
                KT[(dir * 32 + d) * 256 + (F.tid & 255)] += s; } }
    }
    __syncthreads();
    { float* TAB = (float*)(F.ws + WS_S5TAB) + (size_t)g * S5TAB_FLOATS; const LAS float* src = (const LAS float*)F.lds;
      for (int i = F.tid; i < S5TAB_FLOATS / 4; i += NTHR) ((f32x4*)TAB)[i] = ((const LAS f32x4*)src)[i]; }
    __syncthreads();
}
__device__ __forceinline__ void p1_s5_expand(Frame& F) {
    typedef float f32x2 __attribute__((ext_vector_type(2)));
    const int g = F.bid >> 3, part = F.bid & 7;
    LAS f32x2* PW = (LAS f32x2*)F.lds;
    LAS f32x2* BB = PW + 2 * 33 * 64;
    LAS float* KT = (LAS float*)(BB + 2 * 64 * 16);
    LAS f32x2* CC = (LAS f32x2*)(KT + 2 * 32 * 256);
    { const float* TAB = (const float*)(F.ws + WS_S5TAB) + (size_t)g * S5TAB_FLOATS; LAS float* dst = (LAS float*)F.lds;
      for (int i = F.tid; i < S5TAB_FLOATS / 4; i += NTHR) ((LAS f32x4*)dst)[i] = ((const f32x4*)TAB)[i]; }
    __syncthreads();
    bf16* MCT = (bf16*)(F.ws + WS_MCT) + (size_t)g * 512 * UCOLS;
    for (int pc = F.tid; pc < 64 * 64; pc += NTHR) { const int rw = part * 64 + (pc >> 6), q = pc & 63, tau = rw >> 4, h = rw & 15, s = q >> 1, h0 = (q & 1) * 8;
        float v[8];
#pragma unroll
        for (int j = 0; j < 8; ++j) { float a = 0.f; if (s <= tau) a += KT[(0 * 32 + (tau - s)) * 256 + h * 16 + h0 + j]; if (s >= tau) a += KT[(1 * 32 + (s - tau)) * 256 + h * 16 + h0 + j]; v[j] = a; }
        u32x4 w; w.x = pk2(v[0], v[1]); w.y = pk2(v[2], v[3]); w.z = pk2(v[4], v[5]); w.w = pk2(v[6], v[7]);
        *(u32x4*)(MCT + (size_t)rw * UCOLS + s * 16 + h0) = w; }
    for (int pc = F.tid; pc < 64 * 32; pc += NTHR) { const int rw = part * 64 + (pc >> 5), q = pc & 31, tau = rw >> 4, h = rw & 15, dir = q >> 4, ri = (q >> 3) & 1, p0 = (q & 7) * 8;
        const int e = dir ? (32 - tau) : (tau + 1);
        float v[8];
#pragma unroll
        for (int j = 0; j < 8; ++j) { const int p = p0 + j; const f32x2 cc = CC[(dir * 16 + h) * 64 + p]; const float cr = cc.x, cj = cc.y; const f32x2 w = PW[(dir * 33 + e) * 64 + p];
            v[j] = ri ? -(cr * w.y + cj * w.x) : (cr * w.x - cj * w.y); }
        u32x4 w; w.x = pk2(v[0], v[1]); w.y = pk2(v[2], v[3]); w.z = pk2(v[4], v[5]); w.w = pk2(v[6], v[7]);
        *(u32x4*)(MCT + (size_t)rw * UCOLS + 512 + dir * 128 + ri * 64 + p0) = w; }
    bf16* WAT = (bf16*)(F.ws + WS_WAT) + (size_t)g * 256 * 512;
    for (int pc = F.tid; pc < 32 * 64; pc += NTHR) { const int rw = part * 32 + (pc >> 6), q = pc & 63, dir = rw >> 7, ri = (rw >> 6) & 1, p = rw & 63, s = q >> 1, h0 = (q & 1) * 8;
        const f32x2 w = PW[(dir * 33 + (dir ? s : (31 - s))) * 64 + p];
        float v[8];
#pragma unroll
        for (int j = 0; j < 8; ++j) { const f32x2 b = BB[(dir * 64 + p) * 16 + h0 + j]; v[j] = ri ? (w.x * b.y + w.y * b.x) : (w.x * b.x - w.y * b.y); }
        u32x4 o; o.x = pk2(v[0], v[1]); o.y = pk2(v[2], v[3]); o.z = pk2(v[4], v[5]); o.w = pk2(v[6], v[7]);
        *(u32x4*)(WAT + (size_t)rw * 512 + s * 16 + h0) = o; }
    __syncthreads();
}
__device__ __forceinline__ void p0_filter_l12(Frame& F, int i0, int npos) {
    LAS float* sc = (LAS float*)(F.lds + F.wave * 1024);
    const int j = F.lane;
    const float* hw1 = inptr(F, I_HW1); const float* hw2 = inptr(F, I_HW2); const float* hfq = inptr(F, I_HFREQ);
    float w1c[33], w2c[64];
#pragma unroll
    for (int f = 0; f < 33; ++f) w1c[f] = hw1[f * 64 + j];
#pragma unroll
    for (int k = 0; k < 64; ++k) w2c[k] = hw2[k * 64 + j];
    const float b1 = inptr(F, I_HB1)[j], b2 = inptr(F, I_HB2)[j], f0 = hfq[j], f1 = hfq[64 + j];
    for (int q = 0; q < npos; ++q) { const int i = i0 + q;
        if (j < 33) { const double L = (double)SEQ; double v;
            if (j == 0) v = (double)i / (L - 1.0);
            else { const int k = (j - 1) & 15; const double f = 1e-4 + (double)k * ((15.0 - 1e-4) / 15.0), om = 6.283185307179586 * (double)i / L; v = (j <= 16) ? cos(f * om) : -sin(f * om); }
            sc[j] = (float)v; }
        LDS_WAIT(); asm volatile("" ::: "memory");
        float a = b1;
#pragma unroll
        for (int f = 0; f < 33; ++f) a += sc[f] * w1c[f];
        sc[64 + j] = sinf(f0 * a);
        LDS_WAIT(); asm volatile("" ::: "memory");
        float b = b2;
#pragma unroll
        for (int k = 0; k < 64; ++k) b += sc[64 + k] * w2c[k];
        ((float*)(F.ws + WS_FH2))[(size_t)j * SEQ + i] = sinf(f1 * b);
        LDS_WAIT(); asm volatile("" ::: "memory"); }
}
__device__ __forceinline__ void phase0(Frame& F) {
    if (F.bid < 192) p0_adaln_item(F, F.bid);
    else if (F.bid < 224) p0_s5_tables(F, F.bid - 192);
    else p0_filter_l12(F, (F.bid - 224) * 128 + F.wave * 16, 16);
    __syncthreads();
    p0_transposes(F);
    if (F.bid < 192) p_down_items(F, DN_P4 + DN_P9 + DN_P3 + F.bid * 8 + F.wave, 3, 192 * 8);
}

__device__ __forceinline__ void norm_mod_row(const float* xrow, const float* gam, const float* shift, const float* scale, bf16* orow, int lane) {
    const f32x4* xr = (const f32x4*)xrow + lane;
    f32x4 v[4]; float s = 0.f;
#pragma unroll
    for (int j = 0; j < 4; ++j) { v[j] = xr[64 * j]; s += (v[j].x * v[j].x + v[j].y * v[j].y) + (v[j].z * v[j].z + v[j].w * v[j].w); }
    const float rstd = 1.0f / sqrtf(wave_sum(s) * (1.0f / DM) + NORM_EPS);
    unsigned long long* o8 = (unsigned long long*)orow + lane;
#pragma unroll
    for (int j = 0; j < 4; ++j) { const f32x4 g = ((const f32x4*)gam)[lane + 64 * j], sh = ((const f32x4*)shift)[lane + 64 * j], sc = ((const f32x4*)scale)[lane + 64 * j];
        const f32x4 y = (v[j] * rstd * g) * (sc + 1.0f) + sh;
        o8[64 * j] = (unsigned long long)pk2(y.x, y.y) | ((unsigned long long)pk2(y.z, y.w) << 32); }
}
__device__ __forceinline__ void p1_norm(Frame& F) {
    const int gw = F.bid * NWAVES + F.wave, NGW = F.G * NWAVES, lane = F.lane;
    const float* mod = (const float*)(F.ws + WS_MOD);
    bf16* H1 = (bf16*)(F.ws + WS_H1);
    const float* xin = inptr(F, I_X); const float* cin = inptr(F, I_CTX); const float* gam = inptr(F, I_N1G);
    f32x4 vn[4];
    { const f32x4* xr = (const f32x4*)(xin + (size_t)gw * DM) + lane;
#pragma unroll
      for (int j = 0; j < 4; ++j) vn[j] = xr[64 * j]; }
    for (int r = gw; r < NROWS1; r += NGW) {
        f32x4 v[4]; float s = 0.f;
#pragma unroll
        for (int j = 0; j < 4; ++j) v[j] = vn[j];
        { const int rn = (r + NGW < NROWS1) ? r + NGW : r; const float* xrow = (rn < NTOK) ? xin + (size_t)rn * DM : cin + (size_t)(rn - NTOK) * DM;
          const f32x4* xr = (const f32x4*)xrow + lane;
#pragma unroll
          for (int j = 0; j < 4; ++j) vn[j] = xr[64 * j]; }
#pragma unroll
        for (int j = 0; j < 4; ++j) s += (v[j].x * v[j].x + v[j].y * v[j].y) + (v[j].z * v[j].z + v[j].w * v[j].w);
        const float rstd = 1.0f / sqrtf(wave_sum(s) * (1.0f / DM) + NORM_EPS);
        const int mr = (r < NTOK) ? (r >> 12) : 8; const float* sh = mod + (size_t)mr * (NMOD * DM);
        unsigned long long* o8 = (unsigned long long*)(H1 + (size_t)r * DM) + lane;
#pragma unroll
        for (int j = 0; j < 4; ++j) { const f32x4 g = ((const f32x4*)gam)[lane + 64 * j], shv = ((const f32x4*)sh)[lane + 64 * j], sc = ((const f32x4*)(sh + DM))[lane + 64 * j];
            const f32x4 y = (v[j] * rstd * g) * (sc + 1.0f) + shv;
            o8[64 * j] = (unsigned long long)pk2(y.x, y.y) | ((unsigned long long)pk2(y.z, y.w) << 32); }
    }
}
__device__ __forceinline__ void p1_filter(Frame& F) {
    LAS float* w3s = (LAS float*)F.lds;
    LAS float* b3s = w3s + 512;
    LAS float* red = b3s + 8;
    LAS float* nrm = red + 32;
    const int c0 = F.bid * 2;
    for (int i = F.tid; i < 512; i += NTHR) { const int k = i >> 3, q = i & 7, ch = q >> 2, o = (q >> 1) & 1, dir = q & 1; w3s[i] = inptr(F, I_HW3)[(size_t)k * 2048 + o * 1024 + dir * 512 + c0 + ch]; }
    if (F.tid < 8) { const int q = F.tid, ch = q >> 2, o = (q >> 1) & 1, dir = q & 1; b3s[q] = inptr(F, I_HB3)[o * 1024 + dir * 512 + c0 + ch]; }
    __syncthreads();
    const float* FH2 = (const float*)(F.ws + WS_FH2);
    const double la = -4.605170185988091 / 0.3, lb = -4.605170185988091 / 1.5;
    float delta[2];
#pragma unroll
    for (int ch = 0; ch < 2; ++ch) delta[ch] = (float)fabs(la + (double)(c0 + ch) * (lb - la) / 511.0);
    bf16* FILT = (bf16*)(F.ws + WS_FILT);
    float asum[4] = {0.f, 0.f, 0.f, 0.f};
    unsigned val[8][4];
#pragma unroll
    for (int j = 0; j < 8; ++j) { const int i = F.tid + 512 * j; const float* hr = FH2 + i;
        float a[8];
#pragma unroll
        for (int q = 0; q < 8; ++q) a[q] = b3s[q];
#pragma unroll 16
        for (int k = 0; k < 64; ++k) { const float hvk = hr[(size_t)k * SEQ]; const LAS f32x4* wp = (const LAS f32x4*)(w3s + k * 8); const f32x4 wa = wp[0], wb = wp[1];
            a[0] += hvk * wa.x; a[1] += hvk * wa.y; a[2] += hvk * wa.z; a[3] += hvk * wa.w; a[4] += hvk * wb.x; a[5] += hvk * wb.y; a[6] += hvk * wb.z; a[7] += hvk * wb.w; }
        const float t = (float)i * (1.0f / 4095.0f);
#pragma unroll
        for (int q = 0; q < 8; ++q) { const int ch = q >> 2, dir = q & 1; const float v = a[q] * expf(-t * delta[ch]); a[q] = v; if (dir == 0 || i != 0) asum[q >> 1] += fabsf(v); }
#pragma unroll
        for (int q = 0; q < 4; ++q) val[j][q] = pk2(a[2 * q], a[2 * q + 1]);
        asm volatile("" ::: "memory"); }
#pragma unroll
    for (int q = 0; q < 4; ++q) { const float s2 = wave_sum(asum[q]); if (F.lane == 0) red[F.wave * 4 + q] = s2; }
    __syncthreads();
    if (F.tid < 4) { float s2 = 0.f; for (int w = 0; w < 8; ++w) s2 += red[w * 4 + F.tid]; nrm[F.tid] = 1.0f / s2; }
    __syncthreads();
#pragma unroll
    for (int j = 0; j < 8; ++j) { const int i = F.tid + 512 * j;
#pragma unroll
        for (int q = 0; q < 8; ++q) { const int ch = q >> 2, o = (q >> 1) & 1, dir = q & 1; const float sc = nrm[ch * 2 + o]; bf16* G = FILT + ((size_t)o * HYW + c0 + ch) * (2 * FLEN); const bf16 hv = (bf16)f2bf(((q & 1) ? bfhi(val[j][q >> 1]) : bflo(val[j][q >> 1])) * sc);
            if (dir == 0) { G[FC0 - i] = hv; G[FLEN + FC0 - i - 1] = hv; } else if (i != 0) { G[FC0 + i] = hv; G[FLEN + FC0 + i - 1] = hv; } } }
    for (int i = F.tid; i < 4 * (FLEN - 8191); i += NTHR) { const int a = i / (FLEN - 8191), x = i % (FLEN - 8191); const int ch = a >> 1, o = a & 1; bf16* G = FILT + ((size_t)o * HYW + c0 + ch) * (2 * FLEN);
        const int xx = (x < FC0 - 4095) ? x : (x - (FC0 - 4095) + FC0 + 4096); G[xx] = 0; if (xx >= 1) G[FLEN + xx - 1] = 0; if (xx == FLEN - 1) G[FLEN + FLEN - 1] = 0; }
    __syncthreads();
}
__device__ __forceinline__ void phase1(Frame& F) { p1_s5_expand(F); p1_filter(F); p1_norm(F); }

constexpr int HY_USTRIDE = 8464, HY_UOFF = 272, HY_G0 = 68096, HY_G1 = HY_G0 + 16896 + 68;
__device__ __forceinline__ bf16x8 hy_ldA(const LAS unsigned char* p) { const LAS unsigned* q = (const LAS unsigned*)p; u32x4 v; v.x = q[0]; v.y = q[1]; v.z = q[2]; v.w = q[3]; return __builtin_bit_cast(bf16x8, v); }
constexpr int HT_IG2 = 2 * 16 * 16 * 88, HT_TOTAL = 2 * HT_IG2, HT_PER_WAVE = 48, HT_SCR = 102400;
struct HyTr { const float* wg; const float* wu; bf16* wgut; LAS float* scr; int base; int lane; float tv[2][16]; };
__device__ __forceinline__ void hytr_issue(HyTr& T, int slot) {
#pragma unroll
    for (int j = 0; j < 2; ++j) { const int h = T.base + slot * 2 + j;
        if (h < HT_TOTAL) { const int up = h >= HT_IG2, r = up ? h - HT_IG2 : h, e = r / (32 * 88), q = r % (32 * 88), kb = q / 88, nb = q % 88;
            const float* wp = (up ? T.wu : T.wg) + (size_t)e * DM * FF + (size_t)(kb * 32 + (T.lane >> 5)) * FF + nb * 32 + (T.lane & 31);
#pragma unroll
            for (int i = 0; i < 16; ++i) T.tv[j][i] = wp[(size_t)(2 * i) * FF]; } }
}
__device__ __forceinline__ void hytr_finish(HyTr& T, int slot) {
#pragma unroll
    for (int j = 0; j < 2; ++j) { const int h = T.base + slot * 2 + j;
        if (h < HT_TOTAL) { const int up = h >= HT_IG2, r = up ? h - HT_IG2 : h, e = r / (32 * 88), q = r % (32 * 88), kb = q / 88, nb = q % 88, n0 = nb * 32;
            bf16* WT = (bf16*)((unsigned char*)T.wgut + (size_t)e * (2 * FF) * DM); const int drow0 = 256 * (n0 >> 7) + (n0 & 127) + (up ? 128 : 0);
#pragma unroll
            for (int i = 0; i < 16; ++i) T.scr[(2 * i + (T.lane >> 5)) * 33 + (T.lane & 31)] = T.tv[j][i];
            LDS_WAIT(); asm volatile("" ::: "memory");
            const int c = T.lane & 3;
#pragma unroll
            for (int p = 0; p < 2; ++p) { const int n = (T.lane >> 2) + 16 * p; const LAS float* sp = T.scr + (8 * c) * 33 + n;
                u32x2 o; o.x = pk4_fp8(sp[0 * 33] * WGU_SCALE, sp[1 * 33] * WGU_SCALE, sp[2 * 33] * WGU_SCALE, sp[3 * 33] * WGU_SCALE); o.y = pk4_fp8(sp[4 * 33] * WGU_SCALE, sp[5 * 33] * WGU_SCALE, sp[6 * 33] * WGU_SCALE, sp[7 * 33] * WGU_SCALE);
                *(u32x2*)((unsigned char*)WT + (size_t)(drow0 + n) * DM + kb * 32 + 8 * c) = o; }
            LDS_WAIT(); asm volatile("" ::: "memory"); } }
}
__device__ __forceinline__ void hy_conv(const LAS unsigned char* lds, int w, int lane, f32x16 (&acc)[4], HyTr& T, int slot0) {
    const int r = lane & 31, hh = lane >> 5, n = lane & 31, b = n >> 2, i = n & 3;
    const LAS unsigned char* abase = lds + ((r & 1) ? (HY_G1 + 2 * (FC0 - r + 8 * hh - 1)) : (HY_G0 + 2 * (FC0 - r + 8 * hh)));
    const LAS unsigned char* bbase = lds + HY_UOFF + b * HY_USTRIDE + 64 * i + 16 * hh;
#pragma unroll
    for (int q = 0; q < 4; ++q)
#pragma unroll
        for (int j = 0; j < 16; ++j) acc[q][j] = 0.f;
#define HY_MM(XN, XP1, XP2, XP3, BB) do { \
        acc[0] = __builtin_amdgcn_mfma_f32_32x32x16_bf16(XN, BB, acc[0], 0, 0, 0); acc[1] = __builtin_amdgcn_mfma_f32_32x32x16_bf16(XP1, BB, acc[1], 0, 0, 0); \
        acc[2] = __builtin_amdgcn_mfma_f32_32x32x16_bf16(XP2, BB, acc[2], 0, 0, 0); acc[3] = __builtin_amdgcn_mfma_f32_32x32x16_bf16(XP3, BB, acc[3], 0, 0, 0); } while (0)
#pragma unroll 1
    for (int s = 0; s < 8; ++s) {
        const LAS unsigned char* pa = abase - 256 * (4 * w + 1) + 32 * s;
        const LAS unsigned char* pb = bbase - 256 + 32 * s;
        bf16x8 X0, X1, X2, X3, X4, X5, X6, X7, Ba, Bb;
        if (s < 6) hytr_issue(T, slot0 + s);
        X7 = hy_ldA(pa - 256); X6 = hy_ldA(pa - 512); X5 = hy_ldA(pa - 768);
        X0 = hy_ldA(pa); Ba = *(const LAS bf16x8*)pb;
#pragma unroll 1
        for (int g8 = 0; g8 < 4; ++g8) {
            X1 = hy_ldA(pa + 256); Bb = *(const LAS bf16x8*)(pb + 256); HY_MM(X0, X7, X6, X5, Ba);
            X2 = hy_ldA(pa + 512); Ba = *(const LAS bf16x8*)(pb + 512); HY_MM(X1, X0, X7, X6, Bb);
            X3 = hy_ldA(pa + 768); Bb = *(const LAS bf16x8*)(pb + 768); HY_MM(X2, X1, X0, X7, Ba);
            X4 = hy_ldA(pa + 1024); Ba = *(const LAS bf16x8*)(pb + 1024); HY_MM(X3, X2, X1, X0, Bb);
            X5 = hy_ldA(pa + 1280); Bb = *(const LAS bf16x8*)(pb + 1280); HY_MM(X4, X3, X2, X1, Ba);
            X6 = hy_ldA(pa + 1536); Ba = *(const LAS bf16x8*)(pb + 1536); HY_MM(X5, X4, X3, X2, Bb);
            X7 = hy_ldA(pa + 1792); Bb = *(const LAS bf16x8*)(pb + 1792); HY_MM(X6, X5, X4, X3, Ba);
            X0 = hy_ldA(pa + 2048); Ba = *(const LAS bf16x8*)(pb + 2048); HY_MM(X7, X6, X5, X4, Bb);
            pa += 2048; pb += 2048;
        }
        HY_MM(X0, X7, X6, X5, Ba);
        if (s < 6) hytr_finish(T, slot0 + s);
    }
#undef HY_MM
}
__device__ __forceinline__ void hy_load_filter(Frame& F, const bf16* G) {
    LAS unsigned char* lds = F.lds;
#pragma unroll
    for (int k = 0; k < 5; ++k) { const int i = F.tid + k * NTHR;
        if (i < 2 * (FLEN * 2 / 16)) { const u32x4 v = *(const u32x4*)(G + 8 * i); const int cp = i >= (FLEN * 2 / 16), ii = cp ? i - (FLEN * 2 / 16) : i;
            LAS unsigned* d = (LAS unsigned*)(lds + (cp ? HY_G1 : HY_G0) + 16 * ii); d[0] = v.x; d[1] = v.y; d[2] = v.z; d[3] = v.w; } }
}
__device__ __forceinline__ f32x4 hy_sconv4(const bf16* zrow, int t0, float w0, float w1, float w2, float cb) {
    const u32x2 z = *(const u32x2*)(zrow + t0);
    const float zl = (t0 & 63) ? bf2f(zrow[t0 - 1]) : 0.f, zr = ((t0 + 4) & 63) ? bf2f(zrow[t0 + 4]) : 0.f;
    const float e0 = bflo(z.x), e1 = bfhi(z.x), e2 = bflo(z.y), e3 = bfhi(z.y);
    return (f32x4){w0 * zl + w1 * e0 + w2 * e1 + cb, w0 * e0 + w1 * e1 + w2 * e2 + cb, w0 * e1 + w1 * e2 + w2 * e3 + cb, w0 * e2 + w1 * e3 + w2 * zr + cb};
}
__device__ __forceinline__ u32x4 hy_ld_piece(const bf16* p) { const unsigned* pp = (const unsigned*)(p - 2); u32x4 v; v.x = pp[0]; v.y = pp[1]; v.z = pp[2]; v.w = pp[3]; return v; }
__device__ __forceinline__ f32x4 hy_sconv4r(u32x4 z, bool lz, bool rz, float w0, float w1, float w2, float cb) {
    const float zl = lz ? 0.f : bfhi(z.x), zr = rz ? 0.f : bflo(z.w), e0 = bflo(z.y), e1 = bfhi(z.y), e2 = bflo(z.z), e3 = bfhi(z.z);
    return (f32x4){w0 * zl + w1 * e0 + w2 * e1 + cb, w0 * e0 + w1 * e1 + w2 * e2 + cb, w0 * e1 + w1 * e2 + w2 * e3 + cb, w0 * e2 + w1 * e3 + w2 * zr + cb};
}
__device__ __forceinline__ void hyena_channel(Frame& F, int c, int citer) {
    LAS unsigned char* lds = F.lds;
    const int tid = F.tid, lane = F.lane, w = F.wave;
    HyTr T; T.wg = inptr(F, I_WG); T.wu = inptr(F, I_WU); T.wgut = (bf16*)(F.ws + WS_WGUT); T.scr = (LAS float*)(F.lds + HT_SCR + w * 4224); T.base = (F.bid * NWAVES + w) * HT_PER_WAVE; T.lane = lane;
    bf16* ZT = (bf16*)(F.ws + WS_ZT);
    const bf16* FILT = (const bf16*)(F.ws + WS_FILT);
    const float* cw = inptr(F, I_CONVW); const float* cbp = inptr(F, I_CONVB);
    for (int i = tid; i < HY_G0 / 16; i += NTHR) *(LAS u32x4*)(lds + 16 * i) = (u32x4){0u, 0u, 0u, 0u};
    __syncthreads();
    {
        const float w0 = cw[c], w1 = cw[HYC + c], w2 = cw[2 * HYC + c], cb = cbp[c];
#pragma unroll 2
        for (int b = 0; b < 8; ++b) { const bf16* zr = ZT + (size_t)c * NTOK + b * SEQ + 8 * tid;
            const u32x4 z = *(const u32x4*)zr;
            const float zl = (tid & 7) ? bf2f(zr[-1]) : 0.f, zrt = ((tid & 7) != 7) ? bf2f(zr[8]) : 0.f;
            float e[10]; e[0] = zl; e[1] = bflo(z.x); e[2] = bfhi(z.x); e[3] = bflo(z.y); e[4] = bfhi(z.y); e[5] = bflo(z.z); e[6] = bfhi(z.z); e[7] = bflo(z.w); e[8] = bfhi(z.w); e[9] = zrt;
            float o[8];
#pragma unroll
            for (int j = 0; j < 8; ++j) o[j] = w0 * e[j] + w1 * e[j + 1] + w2 * e[j + 2] + cb;
            u32x4 pk; pk.x = pk2(o[0], o[1]); pk.y = pk2(o[2], o[3]); pk.z = pk2(o[4], o[5]); pk.w = pk2(o[6], o[7]);
            *(LAS u32x4*)(lds + HY_UOFF + b * HY_USTRIDE + 16 * tid) = pk; }
    }
    hy_load_filter(F, FILT + ((size_t)0 * HYW + c) * (2 * FLEN));
    __syncthreads();
    f32x16 acc[4];
    hy_conv(lds, w, lane, acc, T, (citer * 2 + 0) * 6);
#ifdef DBG_CONV_SCALE
    for (int q = 0; q < 4; ++q) for (int j = 0; j < 16; ++j) acc[q][j] *= DBG_CONV_SCALE;
#endif
    __syncthreads();
    hy_load_filter(F, FILT + ((size_t)1 * HYW + c) * (2 * FLEN));
    const int n = lane & 31, hh = lane >> 5, b = n >> 2, ii = n & 3;
    {
        const float w0 = cw[HYW + c], w1 = cw[HYC + HYW + c], w2 = cw[2 * HYC + HYW + c], cb = cbp[HYW + c], bias = inptr(F, I_HBIAS)[c];
        const bf16* zrow = ZT + (size_t)(HYW + c) * NTOK + b * SEQ + 512 * w + 32 * ii + 4 * hh;
        const bool lz0 = ((ii & 1) == 0) && (hh == 0), rz3 = ((ii & 1) == 1) && (hh == 1);
        u32x4 zp[16];
#pragma unroll
        for (int g = 0; g < 16; ++g) zp[g] = hy_ld_piece(zrow + 128 * (g >> 2) + 8 * (g & 3));
#pragma unroll
        for (int q = 0; q < 4; ++q) {
#pragma unroll
            for (int rg = 0; rg < 4; ++rg) { const int t0 = 128 * (4 * w + q) + 32 * ii + 8 * rg + 4 * hh;
                const f32x4 x1 = hy_sconv4r(zp[q * 4 + rg], rg == 0 && lz0, rg == 3 && rz3, w0, w1, w2, cb);
                LAS u32x2* up = (LAS u32x2*)(lds + HY_UOFF + b * HY_USTRIDE + 2 * t0); const u32x2 uv = *up;
                const float y0 = x1[0] * (acc[q][4 * rg + 0] + bias * bflo(uv.x)), y1 = x1[1] * (acc[q][4 * rg + 1] + bias * bfhi(uv.x));
                const float y2 = x1[2] * (acc[q][4 * rg + 2] + bias * bflo(uv.y)), y3 = x1[3] * (acc[q][4 * rg + 3] + bias * bfhi(uv.y));
                u32x2 o; o.x = pk2(y0, y1); o.y = pk2(y2, y3); *up = o; }
            asm volatile("" ::: "memory"); }
    }
    __syncthreads();
    hy_conv(lds, w, lane, acc, T, (citer * 2 + 1) * 6);
#ifdef DBG_CONV_SCALE
    for (int q = 0; q < 4; ++q) for (int j = 0; j < 16; ++j) acc[q][j] *= DBG_CONV_SCALE;
#endif
    {
        const float w0 = cw[2 * HYW + c], w1 = cw[HYC + 2 * HYW + c], w2 = cw[2 * HYC + 2 * HYW + c], cb = cbp[2 * HYW + c], bias = inptr(F, I_HBIAS)[HYW + c];
        const bf16* zrow = ZT + (size_t)(2 * HYW + c) * NTOK + b * SEQ + 512 * w + 32 * ii + 4 * hh;
        const bool lz0 = ((ii & 1) == 0) && (hh == 0), rz3 = ((ii & 1) == 1) && (hh == 1);
        bf16* orow = (bf16*)(F.ws + WS_YHT) + (size_t)c * NTOK + b * SEQ;
        u32x4 zp[16];
#pragma unroll
        for (int g = 0; g < 16; ++g) zp[g] = hy_ld_piece(zrow + 128 * (g >> 2) + 8 * (g & 3));
#pragma unroll
        for (int q = 0; q < 4; ++q) {
#pragma unroll
            for (int rg = 0; rg < 4; ++rg) { const int t0 = 128 * (4 * w + q) + 32 * ii + 8 * rg + 4 * hh;
                const f32x4 x2 = hy_sconv4r(zp[q * 4 + rg], rg == 0 && lz0, rg == 3 && rz3, w0, w1, w2, cb);
                const u32x2 uv = *(const LAS u32x2*)(lds + HY_UOFF + b * HY_USTRIDE + 2 * t0);
                const float y0 = x2[0] * (acc[q][4 * rg + 0] + bias * bflo(uv.x)), y1 = x2[1] * (acc[q][4 * rg + 1] + bias * bfhi(uv.x));
                const float y2 = x2[2] * (acc[q][4 * rg + 2] + bias * bflo(uv.y)), y3 = x2[3] * (acc[q][4 * rg + 3] + bias * bfhi(uv.y));
                u32x2 o; o.x = pk2(y0, y1); o.y = pk2(y2, y3); *(u32x2*)(orow + t0) = o; }
            asm volatile("" ::: "memory"); }
    }
    __syncthreads();
}

__device__ __forceinline__ void carry_chain(Frame& F, int g, int b, int dir, int p) {
    const float* EB = (const float*)(F.ws + WS_EB) + (size_t)g * UROWS * 256 + dir * 128 + p;
    bf16* UG = (bf16*)(F.ws + WS_UG) + (size_t)g * UROWS * UCOLS + 512 + dir * 128 + p;
    const float* LT = (const float*)(F.ws + WS_LT) + ((dir * NG + g) * NP + p) * 2;
    const float lr = LT[0], li = LT[1];
    float xr = 0.f, xi = 0.f;
    {   float er[8], ei[8];
#pragma unroll
        for (int k = 0; k < 8; ++k) { const int c = dir ? (7 - k) : k; const float* e = EB + (size_t)(1024 + b * 8 + c) * 256; er[k] = e[0]; ei[k] = e[64]; }
#pragma unroll
        for (int k = 0; k < 8; ++k) { const float nr = lr * xr - li * xi + er[k], ni = lr * xi + li * xr + ei[k]; xr = nr; xi = ni; }
    }
#pragma unroll 1
    for (int c8 = 0; c8 < 4; ++c8) { float er[32], ei[32];
#pragma unroll
        for (int k = 0; k < 32; ++k) { const int c = dir ? (127 - (c8 * 32 + k)) : (c8 * 32 + k); const float* e = EB + (size_t)(b * 128 + c) * 256; er[k] = e[0]; ei[k] = e[64]; }
#pragma unroll
        for (int k = 0; k < 32; ++k) { const int c = dir ? (127 - (c8 * 32 + k)) : (c8 * 32 + k); bf16* u = UG + (size_t)(b * 128 + c) * UCOLS; u[0] = (bf16)f2bf(xr); u[64] = (bf16)f2bf(xi);
            const float nr = lr * xr - li * xi + er[k], ni = lr * xi + li * xr + ei[k]; xr = nr; xi = ni; }
    }
}
struct SchedE2 {
    static constexpr bool AOFF_PM_ONLY = true;
    const char* A; const char* B; int g, pl; unsigned lda, ldb, kstepA, kstepB; int nt;
    __device__ __forceinline__ bool next(int i, gm::GUnit& u) const { if (i >= 2) return false; const int t = i ? 4 : pl; u.pm = g * 5 + t; u.pn = 0;
        u.A = A + (size_t)g * ((size_t)UROWS * UCOLS * 2) + (size_t)t * 256 * lda; u.B = B + (size_t)g * ((size_t)256 * 1024); return true; }
    __device__ __forceinline__ unsigned aoff(const gm::GUnit&, int row, int col) const { return (unsigned)row * lda + (unsigned)col * 2u; }
};
__device__ __forceinline__ void phase_s5_states(Frame& F) {
    if (F.bid >= 128) { const int wv = (F.bid - 128) * 8 + F.wave; for (int k = 0; k < 8; ++k) { const int r = wv + k * 1024; if (r < DN_P4) p_down_items(F, r, 1, 1); } return; }
    const int g = F.bid >> 2, pl = F.bid & 3;
    SchedE2 S; S.A = (const char*)(F.ws + WS_UG); S.B = (const char*)(F.ws + WS_WAT); S.g = g; S.pl = pl; S.lda = UCOLS * 2; S.ldb = 1024; S.kstepA = 128; S.kstepB = 128; S.nt = 8;
    EpiEB E{(float*)(F.ws + WS_EB)}; gm::gemm_phase<EpiEB, SchedE2, true>(F.lds, S, E);
    VM_WAIT(); __syncthreads();
    if (F.tid < 256) carry_chain(F, g, 2 * pl + (F.tid >> 7), (F.tid >> 6) & 1, F.tid & 63);
}

__device__ __forceinline__ void phase_tr_hy(Frame& F) {
    LAS unsigned char* lds = F.lds;
    const bf16* ZT = (const bf16*)(F.ws + WS_YHT); bf16* YCAT = (bf16*)(F.ws + WS_YCAT);
    constexpr int S = 132;
    for (int pass = 0; pass < 2; ++pass) { const int tok0 = F.bid * 128 + pass * 64;
        for (int pc = F.tid; pc < 4096; pc += NTHR) { const int ch = pc >> 3, gq = pc & 7; const u32x4 v = *(const u32x4*)(ZT + (size_t)ch * NTOK + tok0 + 8 * gq);
            LAS unsigned* d = (LAS unsigned*)(lds + ch * S + 16 * gq); d[0] = v.x; d[1] = v.y; d[2] = v.z; d[3] = v.w; }
        __syncthreads();
        for (int it = 0; it < 8; ++it) { const int tok = it * 8 + (F.lane & 7), cg = F.wave * 8 + (F.lane >> 3);
            const LAS unsigned short* s = (const LAS unsigned short*)(lds + (8 * cg) * S + 2 * tok);
            unsigned e[8];
#pragma unroll
            for (int j = 0; j < 8; ++j) e[j] = s[j * (S / 2)];
            u32x4 o; o.x = e[0] | (e[1] << 16); o.y = e[2] | (e[3] << 16); o.z = e[4] | (e[5] << 16); o.w = e[6] | (e[7] << 16);
#ifdef DBG_HY_SCALE
            for (int j = 0; j < 8; ++j) e[j] = f2bf(bf2f(e[j]) * DBG_HY_SCALE);
            o.x = e[0] | (e[1] << 16); o.y = e[2] | (e[3] << 16); o.z = e[4] | (e[5] << 16); o.w = e[6] | (e[7] << 16);
#endif
            *(u32x4*)(YCAT + (size_t)(tok0 + tok) * DM + 8 * cg) = o; }
        __syncthreads();
    }
}

__device__ __forceinline__ void phase_norm2(Frame& F) {
    LAS float* rwT = (LAS float*)F.lds;
    for (int i = F.tid; i < 16 * 1024; i += NTHR) { const int e = i >> 10, k = i & 1023; rwT[i] = inptr(F, I_RW)[k * NE + e]; }
    __syncthreads();
    const int gw = F.bid * NWAVES + F.wave, NGW = F.G * NWAVES, lane = F.lane;
    const float* mod = (const float*)(F.ws + WS_MOD); const float* xm = F.out;
    bf16* H2 = (bf16*)(F.ws + WS_H2); float* AFF = (float*)(F.ws + WS_AFF);
    f32x4 vn[4];
    { const f32x4* xr = (const f32x4*)(xm + (size_t)gw * DM) + lane;
#pragma unroll
      for (int j = 0; j < 4; ++j) vn[j] = xr[64 * j]; }
    for (int r = gw; r < NTOK; r += NGW) { const int b = r >> 12, t = r & 4095;
        f32x4 v[4]; float s = 0.f;
#pragma unroll
        for (int j = 0; j < 4; ++j) v[j] = vn[j];
        { const int rn = (r + NGW < NTOK) ? r + NGW : r; const f32x4* xr = (const f32x4*)(xm + (size_t)rn * DM) + lane;
#pragma unroll
          for (int j = 0; j < 4; ++j) vn[j] = xr[64 * j]; }
#pragma unroll
        for (int j = 0; j < 4; ++j) s += (v[j].x * v[j].x + v[j].y * v[j].y) + (v[j].z * v[j].z + v[j].w * v[j].w);
        const float rstd = 1.0f / sqrtf(wave_sum(s) * (1.0f / DM) + NORM_EPS);
        const float* mb = mod + (size_t)b * (NMOD * DM);
        unsigned* o4 = (unsigned*)((unsigned char*)H2 + (size_t)r * DM) + lane;
#pragma unroll
        for (int j = 0; j < 4; ++j) { const f32x4 g = ((const f32x4*)inptr(F, I_N2G))[lane + 64 * j], sh = ((const f32x4*)(mb + 3 * DM))[lane + 64 * j], sc = ((const f32x4*)(mb + 4 * DM))[lane + 64 * j];
            v[j] = (v[j] * rstd * g) * (sc + 1.0f) + sh;
            o4[64 * j] = pk4_fp8(v[j].x, v[j].y, v[j].z, v[j].w); }
        float a16[16];
#pragma unroll
        for (int e = 0; e < 16; ++e) { float a = 0.f;
#pragma unroll
            for (int j = 0; j < 4; ++j) { const f32x4 wv = *(const LAS f32x4*)(rwT + e * 1024 + 4 * lane + 256 * j); a += (v[j].x * wv.x + v[j].y * wv.y) + (v[j].z * wv.z + v[j].w * wv.w); }
            a16[e] = a; if ((e & 1) == 1) asm volatile("" ::: "memory"); }
        float a8[8], a4[4], a2[2], mine;
        { const bool up = (lane & 32) != 0;
#pragma unroll
          for (int e = 0; e < 8; ++e) { const float keep = up ? a16[e + 8] : a16[e], send = up ? a16[e] : a16[e + 8]; a8[e] = keep + __shfl_xor(send, 32); } }
        { const bool up = (lane & 16) != 0;
#pragma unroll
          for (int e = 0; e < 4; ++e) { const float keep = up ? a8[e + 4] : a8[e], send = up ? a8[e] : a8[e + 4]; a4[e] = keep + __shfl_xor(send, 16); } }
        { const bool up = (lane & 8) != 0;
#pragma unroll
          for (int e = 0; e < 2; ++e) { const float keep = up ? a4[e + 2] : a4[e], send = up ? a4[e] : a4[e + 2]; a2[e] = keep + __shfl_xor(send, 8); } }
        { const bool up = (lane & 4) != 0; const float keep = up ? a2[1] : a2[0], send = up ? a2[0] : a2[1]; mine = keep + __shfl_xor(send, 4); }
        mine += __shfl_xor(mine, 2); mine += __shfl_xor(mine, 1);
        float mx = mine;
#pragma unroll
        for (int o = 4; o < 64; o <<= 1) mx = fmaxf(mx, __shfl_xor(mx, o));
        mine = expf(mine - mx);
        float den = mine;
#pragma unroll
        for (int o = 4; o < 64; o <<= 1) den += __shfl_xor(den, o);
        if ((lane & 3) == 0) { const int ex = (lane >> 2) & 15; AFF[((size_t)b * NE + ex) * SEQ + t] = mine / den; }
    }
    __syncthreads();
}

__device__ __forceinline__ int block_sum_i(LAS int* red, int v, int wave, int lane, int slot) {
#pragma unroll
    for (int o = 1; o < 64; o <<= 1) v += __shfl_xor(v, o);
    if (lane == 0) red[slot * 8 + wave] = v;
    __syncthreads();
    int s = 0;
#pragma unroll
    for (int w = 0; w < 8; ++w) s += red[slot * 8 + w];
    return s;
}
__device__ __forceinline__ void phase_topk(Frame& F) {
    if (F.bid >= NB * NE) { const int wv = (F.bid - 128) * 8 + F.wave; p_down_items(F, DN_P4 + wv, 10, 8 * 128); return; }
    const int b = F.bid >> 4, e = F.bid & 15, tid = F.tid, lane = F.lane, wave = F.wave;
    LAS int* red = (LAS int*)F.lds;
    LAS int* wtot = red + 16;
    const float* aff = (const float*)(F.ws + WS_AFF) + ((size_t)b * NE + e) * SEQ + 8 * tid;
    unsigned key[8];
#ifndef DBG_PLAIN_AFF
#pragma unroll
    for (int j = 0; j < 8; ++j) key[j] = __hip_atomic_load((const unsigned*)aff + j, __ATOMIC_RELAXED, __HIP_MEMORY_SCOPE_AGENT);
#else
    { const f32x4 a0 = *(const f32x4*)aff, a1 = *(const f32x4*)(aff + 4);
    key[0] = __builtin_bit_cast(unsigned, a0.x); key[1] = __builtin_bit_cast(unsigned, a0.y); key[2] = __builtin_bit_cast(unsigned, a0.z); key[3] = __builtin_bit_cast(unsigned, a0.w);
    key[4] = __builtin_bit_cast(unsigned, a1.x); key[5] = __builtin_bit_cast(unsigned, a1.y); key[6] = __builtin_bit_cast(unsigned, a1.z); key[7] = __builtin_bit_cast(unsigned, a1.w); }
#endif
    unsigned prefix = 0u; int it = 0;
    LAS int* red3 = (LAS int*)F.lds + 64;
    { const unsigned cand = 1u << 30; int c = 0;
#pragma unroll
      for (int j = 0; j < 8; ++j) c += __builtin_popcountll(__ballot(key[j] >= cand));
      if (lane == 0) red[wave] = c;
      __syncthreads();
      int tot = 0;
#pragma unroll
      for (int w2 = 0; w2 < 8; ++w2) tot += red[w2];
      if (tot >= CAP) prefix = cand; }
    for (int bit = 28; bit >= 0; bit -= 2, ++it) { const unsigned c1 = prefix | (1u << bit), c2 = prefix | (2u << bit), c3 = prefix | (3u << bit); int n1 = 0, n2 = 0, n3 = 0;
#pragma unroll
        for (int j = 0; j < 8; ++j) { n1 += __builtin_popcountll(__ballot(key[j] >= c1)); n2 += __builtin_popcountll(__ballot(key[j] >= c2)); n3 += __builtin_popcountll(__ballot(key[j] >= c3)); }
        LAS int* rr = red3 + (it & 1) * 24;
        if (lane == 0) { rr[wave] = n1; rr[8 + wave] = n2; rr[16 + wave] = n3; }
        __syncthreads();
        int t1 = 0, t2 = 0, t3 = 0;
#pragma unroll
        for (int w2 = 0; w2 < 8; ++w2) { t1 += rr[w2]; t2 += rr[8 + w2]; t3 += rr[16 + w2]; }
        prefix = (t3 >= CAP) ? c3 : (t2 >= CAP) ? c2 : (t1 >= CAP) ? c1 : prefix; }
    const unsigned thr = prefix;
    int cgt = 0, ceq = 0;
#pragma unroll
    for (int j = 0; j < 8; ++j) { cgt += (key[j] > thr) ? 1 : 0; ceq += (key[j] == thr) ? 1 : 0; }
    int sg = cgt, se = ceq;
#pragma unroll
    for (int o = 1; o < 64; o <<= 1) { const int tg = __shfl_up(sg, o), te = __shfl_up(se, o); if (lane >= o) { sg += tg; se += te; } }
    __syncthreads();
    if (lane == 63) { wtot[wave] = sg; wtot[8 + wave] = se; }
    __syncthreads();
    int bg = 0, be = 0, totg = 0;
#pragma unroll
    for (int w2 = 0; w2 < 8; ++w2) { const int g2 = wtot[w2], e2 = wtot[8 + w2]; if (w2 < wave) { bg += g2; be += e2; } totg += g2; }
    int rg = bg + sg - cgt, re = be + se - ceq;
    const int need_eq = CAP - totg;
    int* IDX = (int*)(F.ws + WS_IDX); float* GATE = (float*)(F.ws + WS_GATE); int* INV = (int*)(F.ws + WS_INV);
    const size_t rowbase = ((size_t)e * NB + b) * CAP;
#pragma unroll
    for (int j = 0; j < 8; ++j) { const int t = 8 * tid + j; int slot = -1;
        if (key[j] > thr) { slot = rg; ++rg; } else if (key[j] == thr) { if (re < need_eq) slot = totg + re; ++re; }
        if (slot >= 0) { IDX[rowbase + slot] = b * SEQ + t; GATE[rowbase + slot] = __builtin_bit_cast(float, key[j]); }
        INV[((size_t)b * SEQ + t) * NE + e] = slot; }
}

__device__ __forceinline__ void final_accum(const bf16* Y, int b, unsigned long long mask, int myinv, int lane, f32x4 (&mo)[4]) {
    while (mask) { const int e = __builtin_ctzll(mask); mask &= mask - 1; const int s = __shfl(myinv, e);
        const unsigned long long* yr = (const unsigned long long*)(Y + (((size_t)e * NB + b) * CAP + s) * DM) + lane;
        unsigned long long w[4];
#pragma unroll
        for (int j = 0; j < 4; ++j) w[j] = yr[64 * j];
#pragma unroll
        for (int j = 0; j < 4; ++j) { const unsigned lo = (unsigned)w[j], hi = (unsigned)(w[j] >> 32); mo[j].x += bflo(lo); mo[j].y += bfhi(lo); mo[j].z += bflo(hi); mo[j].w += bfhi(hi); } }
}
__device__ __forceinline__ void phase_final(Frame& F) {
    const int gw = F.bid * NWAVES + F.wave, NGW = F.G * NWAVES, lane = F.lane;
    const float* mod = (const float*)(F.ws + WS_MOD); float* xm = F.out;
    const bf16* Y = (const bf16*)(F.ws + WS_Y); const int* INV = (const int*)(F.ws + WS_INV);
    const float* fing = inptr(F, I_FING);
    for (int r0 = gw; r0 < NTOK; r0 += 2 * NGW) { const int r1 = r0 + NGW;
        const int b0 = r0 >> 12, b1 = r1 >> 12;
        f32x4* xr0 = (f32x4*)(xm + (size_t)r0 * DM) + lane; f32x4* xr1 = (f32x4*)(xm + (size_t)r1 * DM) + lane;
        const int inv0 = (lane < 16) ? (int)__hip_atomic_load((const unsigned*)INV + (size_t)r0 * NE + lane, __ATOMIC_RELAXED, __HIP_MEMORY_SCOPE_AGENT) : -1;
        const int inv1 = (lane < 16) ? (int)__hip_atomic_load((const unsigned*)INV + (size_t)r1 * NE + lane, __ATOMIC_RELAXED, __HIP_MEMORY_SCOPE_AGENT) : -1;
        f32x4 v0[4], v1[4], m0[4], m1[4];
#pragma unroll
        for (int j = 0; j < 4; ++j) { v0[j] = xr0[64 * j]; v1[j] = xr1[64 * j]; m0[j] = (f32x4){0.f, 0.f, 0.f, 0.f}; m1[j] = (f32x4){0.f, 0.f, 0.f, 0.f}; }
        const unsigned long long k0 = __ballot(inv0 >= 0), k1 = __ballot(inv1 >= 0);
        final_accum(Y, b0, k0, inv0, lane, m0);
        final_accum(Y, b1, k1, inv1, lane, m1);
        const float* g20 = mod + (size_t)b0 * (NMOD * DM) + 5 * DM; const float* g21 = mod + (size_t)b1 * (NMOD * DM) + 5 * DM; float s0 = 0.f, s1 = 0.f;
#pragma unroll
        for (int j = 0; j < 4; ++j) { const f32x4 ga = ((const f32x4*)g20)[lane + 64 * j], gb = ((const f32x4*)g21)[lane + 64 * j];
            v0[j] = v0[j] + ga * m0[j] * DBG_MOE_ALPHA; v1[j] = v1[j] + gb * m1[j] * DBG_MOE_ALPHA;
            s0 += (v0[j].x * v0[j].x + v0[j].y * v0[j].y) + (v0[j].z * v0[j].z + v0[j].w * v0[j].w); s1 += (v1[j].x * v1[j].x + v1[j].y * v1[j].y) + (v1[j].z * v1[j].z + v1[j].w * v1[j].w); }
        const float rs0 = 1.0f / sqrtf(wave_sum(s0) * (1.0f / DM) + NORM_EPS), rs1 = 1.0f / sqrtf(wave_sum(s1) * (1.0f / DM) + NORM_EPS);
#pragma unroll
        for (int j = 0; j < 4; ++j) { const f32x4 fg = ((const f32x4*)fing)[lane + 64 * j]; xr0[64 * j] = v0[j] * rs0 * fg; xr1[64 * j] = v1[j] * rs1 * fg; }
    }
}

#ifdef DBG_CHECK_MOE
__device__ __forceinline__ void phase_dbg_moe(Frame& F) {
    LAS float* hs = (LAS float*)F.lds;
    LAS float* Hs = hs + 1024;
    LAS float* red = Hs + 2816;
    const int row = (F.bid * 257) & 65535, e = row >> 12, b = (row >> 9) & 7;
    const int tok = ((const int*)(F.ws + WS_IDX))[row]; const float gate = ((const float*)(F.ws + WS_GATE))[row];
    const bf16* H2 = (const bf16*)(F.ws + WS_H2) + (size_t)tok * DM;
    for (int i = F.tid; i < DM; i += NTHR) hs[i] = bf2f(H2[i]);
    __syncthreads();
    const float* Wg = inptr(F, I_WG) + (size_t)e * DM * FF; const float* Wu = inptr(F, I_WU) + (size_t)e * DM * FF; const float* Wd = inptr(F, I_WD) + (size_t)e * FF * DM;
    float e1n = 0.f, e1d = 0.f;
    for (int f = F.tid; f < FF; f += NTHR) { float g = 0.f, u = 0.f;
        for (int k = 0; k < DM; ++k) { g += hs[k] * Wg[(size_t)k * FF + f]; u += hs[k] * Wu[(size_t)k * FF + f]; }
        const float h = siluf_(g) * u; Hs[f] = h;
        const float hb = bf2f(((const bf16*)(F.ws + WS_HB))[(size_t)row * FF + f]); e1n += (hb - h) * (hb - h); e1d += h * h; }
    __syncthreads();
    float e2n = 0.f, e2d = 0.f;
    for (int n = F.tid; n < DM; n += NTHR) { float y = 0.f;
        for (int f = 0; f < FF; ++f) y += Hs[f] * Wd[(size_t)f * DM + n];
        y *= gate; const float yb = bf2f(((const bf16*)(F.ws + WS_Y))[(size_t)row * DM + n]); e2n += (yb - y) * (yb - y); e2d += y * y; }
    const float* aff = (const float*)(F.ws + WS_AFF) + ((size_t)b * NE + e) * SEQ; int cnt = 0;
    for (int t = F.tid; t < SEQ; t += NTHR) cnt += (aff[t] > gate) ? 1 : 0;
    float vals[5] = {e1n, e1d, e2n, e2d, (float)cnt};
#pragma unroll
    for (int q = 0; q < 5; ++q) { const float s2 = wave_sum(vals[q]); if (F.lane == 0) red[F.wave * 5 + q] = s2; }
    __syncthreads();
    if (F.tid == 0) { float t5[5] = {0, 0, 0, 0, 0}; for (int w = 0; w < 8; ++w) for (int q = 0; q < 5; ++q) t5[q] += red[w * 5 + q];
        float* D = (float*)(F.ws + WS_CTL + 65536) + F.bid * 4;
        D[0] = t5[0] / (t5[1] + 1e-30f); D[1] = t5[2] / (t5[3] + 1e-30f); D[2] = (t5[4] >= (float)CAP) ? 1.f : 0.f;
        int dup = 0; const int* IDXs = (const int*)(F.ws + WS_IDX) + ((size_t)e * NB + b) * CAP; for (int q = 0; q < CAP; ++q) dup += (IDXs[q] == tok) ? 1 : 0;
        const int inv = ((const int*)(F.ws + WS_INV))[(size_t)tok * NE + e];
        const int c3 = DBG_C3;
        D[3] = (c3 == 0) ? ((fabsf(aff[tok - b * SEQ] - gate) > 1e-6f) ? 1.f : 0.f) : (c3 == 1) ? (((tok >> 12) != b) ? 1.f : 0.f) : (c3 == 2) ? ((dup != 1) ? 1.f : 0.f) : ((inv != (row & 511)) ? 1.f : 0.f); }
    __syncthreads();
}
__device__ __forceinline__ void phase_dbg_apply(Frame& F) {
    const float* D = (const float*)(F.ws + WS_CTL + 65536);
    int bad[4] = {0, 0, 0, 0};
    for (int k = 0; k < 256; ++k) { if (D[k * 4 + 0] > 1e-3f) ++bad[0]; if (D[k * 4 + 1] > 1e-3f) ++bad[1]; if (D[k * 4 + 2] > 0.5f) ++bad[2]; if (D[k * 4 + 3] > 0.5f) ++bad[3]; }
    int code = 0;
    for (int q = 0; q < 4; ++q) if (((DBG_CHECK_MOE >> q) & 1) && bad[q] > DBG_BAD_THR) code += 1;
    const float sc = 1.0f + 0.5f * (float)code;
    const int gw = F.bid * NWAVES + F.wave, NGW = F.G * NWAVES;
    for (int r = gw; r < NTOK; r += NGW) { f32x4* xr = (f32x4*)(F.out + (size_t)r * DM) + F.lane;
#pragma unroll
        for (int j = 0; j < 4; ++j) xr[64 * j] = xr[64 * j] * sc; }
}
#endif

#ifdef DBG_CHECK_MOE
constexpr int NPHASE = 15;
#else
constexpr int NPHASE = 13;
#endif
__global__ void __launch_bounds__(NTHR, 2) fwd_kernel(Args args) {
    extern __shared__ __attribute__((aligned(16))) unsigned char lds_raw[];
    Frame F;
    F.lds = (LAS unsigned char*)lds_raw;
    F.tid = threadIdx.x; F.lane = F.tid & 63; F.wave = __builtin_amdgcn_readfirstlane(F.tid >> 6);
    F.G = gridDim.x; F.bid = blockIdx.x;
    F.out = args.out; F.ws = args.ws;
    for (int u = F.tid; u < (LDS_BYTES - LDSCTL_OFF) / 4; u += NTHR) ((LAS unsigned*)(F.lds + LDSCTL_OFF))[u] = 0u;
    __syncthreads();
    if (F.tid < 35) { const float* const* tab = args.in; *(LAS unsigned long long*)(F.lds + LDSCTL_OFF + 8 * F.tid) = (unsigned long long)tab[F.tid]; }
    __syncthreads();
    const int lo = args.ph_lo, hi = args.ph_hi;
    const bool single = (hi - lo) > 1;
    XcdBarrier bar; bar.bar = (unsigned*)(args.ws + WS_CTL) + CW_BAR; bar.x = 0; bar.st = nullptr;
    if (single) bar = xcd_barrier_post((unsigned*)(args.ws + WS_CTL) + CW_BAR, (volatile LAS unsigned*)(F.lds + MISC_OFF) + 8);
#ifndef PHASE_MASK
#define PHASE_MASK 0x7fff
#endif
#define IN(k) ((((PHASE_MASK) >> (k)) & 1) && lo <= (k) && (k) < hi)
#ifndef DBG_REPEAT_MASK
#define DBG_REPEAT_MASK 0
#endif
#define SEAM(k) do { if (IN(k) && IN((k) + 1)) xcd_barrier(bar); } while (0)
#define REP(k) for (int rep_ = 0; rep_ < ((((DBG_REPEAT_MASK) >> (k)) & 1) ? 2 : 1); ++rep_)
    LAS unsigned char* ring = F.lds;
    const unsigned char* ws = args.ws;

    REP(0) { if (rep_) xcd_barrier(bar); asm volatile("" : "+v"(F.tid), "+v"(F.lane)); if (IN(0)) { phase0(F); } } SEAM(0);
    REP(1) { if (rep_) xcd_barrier(bar); asm volatile("" : "+v"(F.tid), "+v"(F.lane)); if (IN(1)) { phase1(F); } } SEAM(1);
    REP(2) { if (rep_) xcd_barrier(bar); asm volatile("" : "+v"(F.tid), "+v"(F.lane)); if (IN(2)) {
        { SchedPlain S; S.T.init(128, 6, F.G, F.bid); S.A = (const char*)(ws + WS_H1); S.B = (const char*)(ws + WS_WINT); S.lda = 2048; S.ldb = 2048; S.kstepA = 128; S.kstepB = 128; S.nt = 16; S.mt = 1 << 20; S.az = 0; S.bz = 0;
          EpiZT E{(bf16*)(ws + WS_ZT)}; gm::gemm_phase<EpiZT, SchedPlain, false>(ring, S, E); }
        __syncthreads();
        { SchedPlain S; S.T.init(136, 2, F.G, F.bid); S.A = (const char*)(ws + WS_H1); S.B = (const char*)(ws + WS_WINT) + (size_t)HYC * 2048; S.lda = 2048; S.ldb = 2048; S.kstepA = 128; S.kstepB = 128; S.nt = 16; S.mt = 1 << 20; S.az = 0; S.bz = 0;
          EpiUG E{(bf16*)(ws + WS_UG)}; gm::gemm_phase<EpiUG, SchedPlain, true>(ring, S, E); }
    } } SEAM(2);
    REP(3) { if (rep_) xcd_barrier(bar); asm volatile("" : "+v"(F.tid), "+v"(F.lane)); if (IN(3)) { phase_s5_states(F); } } SEAM(4);
    REP(5) { if (rep_) xcd_barrier(bar); asm volatile("" : "+v"(F.tid), "+v"(F.lane)); if (IN(5)) {
        { SchedPlain S; S.T.init(128, 2, F.G, F.bid); S.A = (const char*)(ws + WS_UG); S.B = (const char*)(ws + WS_MCT); S.lda = UCOLS * 2; S.ldb = UCOLS * 2; S.kstepA = 128; S.kstepB = 128; S.nt = 12; S.mt = 4;
          S.az = (size_t)UROWS * UCOLS * 2; S.bz = (size_t)512 * UCOLS * 2;
          EpiYS E{(bf16*)(ws + WS_YSG), (const bf16*)(ws + WS_UG), inptr(F, I_S5D)};
#ifndef NO_YS
          gm::gemm_phase<EpiYS, SchedPlain, true>(ring, S, E);
#endif
        }
        __syncthreads();
#ifndef NO_HY
        { int citer = 0; for (int c = F.bid; c < HYW; c += F.G, ++citer) hyena_channel(F, c, citer); }
#endif
    } } SEAM(5);
    REP(6) { if (rep_) xcd_barrier(bar); asm volatile("" : "+v"(F.tid), "+v"(F.lane)); if (IN(6)) {
        { SchedGlu S; S.T.init(128, 2, F.G, F.bid); S.A = (const char*)(ws + WS_YSG); S.B = (const char*)(ws + WS_GLUT); S.ldb = 1024; S.kstepA = 4u * 1024u * 512u * 2u; S.kstepB = 128; S.nt = 8;
          EpiGlu E{(bf16*)(ws + WS_YCAT), (const bf16*)(ws + WS_YSG), inptr(F, I_GLUB)}; gm::gemm_phase<EpiGlu, SchedGlu, true>(ring, S, E); }
        __syncthreads();
        phase_tr_hy(F);
    } } SEAM(6);
    REP(7) { if (rep_) xcd_barrier(bar); asm volatile("" : "+v"(F.tid), "+v"(F.lane)); if (IN(7)) {
        SchedPlain S; S.T.init(128, 4, F.G, F.bid); S.A = (const char*)(ws + WS_YCAT); S.B = (const char*)(ws + WS_WOUTT); S.lda = 2048; S.ldb = 2048; S.kstepA = 128; S.kstepB = 128; S.nt = 16; S.mt = 1 << 20; S.az = 0; S.bz = 0;
        EpiXmid E{inptr(F, I_X), F.out, (const float*)(ws + WS_MOD)}; gm::gemm_phase<EpiXmid, SchedPlain, true>(ring, S, E);
    } } SEAM(7);
    REP(8) { if (rep_) xcd_barrier(bar); asm volatile("" : "+v"(F.tid), "+v"(F.lane)); if (IN(8)) { phase_norm2(F); } } SEAM(8);
    REP(9) { if (rep_) xcd_barrier(bar); asm volatile("" : "+v"(F.tid), "+v"(F.lane)); if (IN(9)) { phase_topk(F); } } SEAM(9);
    REP(10) { if (rep_) xcd_barrier(bar); asm volatile("" : "+v"(F.tid), "+v"(F.lane)); if (IN(10)) {
        SchedMoe1 S; S.T.init(256, 22, F.G, F.bid); S.A = (const char*)(ws + WS_H2); S.B = (const char*)(ws + WS_WGUT); S.idx = (const int*)(ws + WS_IDX); S.lda = 1024; S.ldb = 1024; S.kstepA = 128; S.kstepB = 128; S.nt = 8;
        EpiMoe1 E{(unsigned char*)(ws + WS_HB)}; gm::gemm_phase_f8<EpiMoe1, SchedMoe1, WGU_E8M0>(ring, S, E);
    } } SEAM(10);
    REP(11) { if (rep_) xcd_barrier(bar); asm volatile("" : "+v"(F.tid), "+v"(F.lane)); if (IN(11)) {
        SchedPlain S; S.T.init(256, 4, F.G, F.bid); S.A = (const char*)(ws + WS_HB); S.B = (const char*)(ws + WS_WDT); S.lda = FF; S.ldb = FF; S.kstepA = 128; S.kstepB = 128; S.nt = 22; S.mt = 16;
        S.az = (size_t)EROWS * FF; S.bz = (size_t)DM * FF;
        EpiMoe2 E{(bf16*)(ws + WS_Y), (const float*)(ws + WS_GATE)}; gm::gemm_phase_f8<EpiMoe2, SchedPlain, WD_E8M0>(ring, S, E);
    } } SEAM(11);
    if (IN(12)) { phase_final(F); }
#ifdef DBG_CHECK_MOE
    if (IN(13)) { phase_dbg_moe(F); }
    if (IN(14)) { phase_dbg_apply(F); }
#endif
#undef IN
#undef SEAM
}

#ifndef N_LAUNCHES
#define N_LAUNCHES 1
#endif
extern "C" void kernel_launch(void* const* d_in, const int* in_sizes, int n_in, void* d_out, int out_size, void* d_ws, size_t ws_size, hipStream_t stream) {
    static int grid = 0;
    if (grid == 0) {
        if (n_in != 35 || out_size != NTOK * DM || ws_size < WS_END) { fprintf(stderr, "kernel_launch: unexpected shapes (n_in %d out %d ws %zu)\n", n_in, out_size, ws_size); grid = -1; return; }
        int dev = 0, cus = 0;
        if (hipGetDevice(&dev) != hipSuccess || hipDeviceGetAttribute(&cus, hipDeviceAttributeMultiprocessorCount, dev) != hipSuccess) { grid = -1; return; }
        if (hipFuncSetAttribute((const void*)fwd_kernel, hipFuncAttributeMaxDynamicSharedMemorySize, LDS_BYTES) != hipSuccess) { fprintf(stderr, "kernel_launch: hipFuncSetAttribute failed\n"); grid = -1; return; }
        int per_cu = 0;
        if (hipOccupancyMaxActiveBlocksPerMultiprocessor(&per_cu, (const void*)fwd_kernel, NTHR, LDS_BYTES) != hipSuccess || per_cu < 1) fprintf(stderr, "kernel_launch: occupancy query reports %d\n", per_cu);
        (void)hipGetLastError();
        grid = 256;
        if (cus != 256) fprintf(stderr, "kernel_launch: device has %d CUs, kernel expects 256\n", cus);
    }
    if (grid < 0) return;
    (void)hipMemsetAsync((char*)d_ws + WS_CTL, 0, CTL_ZERO_BYTES, stream);
    Args a{};
    for (int i = 0; i < 35; ++i) a.in[i] = (const float*)d_in[i];
    a.out = (float*)d_out; a.ws = (unsigned char*)d_ws;
    if (N_LAUNCHES == 1) { a.ph_lo = 0; a.ph_hi = NPHASE; hipLaunchKernelGGL(fwd_kernel, dim3(grid), dim3(NTHR), LDS_BYTES, stream, a); }
    else for (int p = 0; p < NPHASE; ++p) { a.ph_lo = p; a.ph_hi = p + 1; hipLaunchKernelGGL(fwd_kernel, dim3(grid), dim3(NTHR), LDS_BYTES, stream, a); }
}
```

```cpp
#ifndef DBG_C3
#define DBG_C3 0
#endif
#ifndef DBG_BAD_THR
#define DBG_BAD_THR 16
#endif
#ifndef DBG_MOE_ALPHA
#define DBG_MOE_ALPHA 1.0f
#endif
#include <hip/hip_runtime.h>
#include <cstdio>
#include <cstdint>

#define LAS __attribute__((address_space(3)))
#define GAS __attribute__((address_space(1)))
typedef unsigned short bf16;
typedef short bf16x8 __attribute__((ext_vector_type(8)));
typedef float f32x4 __attribute__((ext_vector_type(4)));
typedef float f32x16 __attribute__((ext_vector_type(16)));
typedef unsigned u32x4 __attribute__((ext_vector_type(4)));
typedef unsigned u32x2 __attribute__((ext_vector_type(2)));
typedef GAS unsigned gu32;

constexpr int NB = 8, SEQ = 4096, DM = 1024, CTXL = 256;
constexpr int NTOK = NB * SEQ, NCTX = NB * CTXL, NROWS1 = NTOK + NCTX;
constexpr int HYW = 512, HYC = 1536, S5W = 512, INC = 2048;
constexpr int NG = 32, GH = 16, NP = 64;
constexpr int CT = 32, NCH = SEQ / CT, NCHC = CTXL / CT;
constexpr int UROWS = 1280, UCOLS = 768;
constexpr int NE = 16, FF = 2816, CAP = 512, EROWS = NB * CAP;
constexpr int NMOD = 6;
constexpr float NORM_EPS = 1e-6f;
constexpr int FLEN = 8448, FC0 = 4224, F8LEN = 8480, F8GS = 8576;

constexpr size_t MiB = 1u << 20;
constexpr size_t WS_CTL = 0, CTL_ZERO_BYTES = 1 * MiB;
constexpr size_t WS_MOD = 1 * MiB;
constexpr size_t WS_LT = WS_MOD + 256 * 1024;
constexpr size_t WS_FH2 = 2 * MiB;
constexpr size_t WS_GLUT = 3 * MiB;
constexpr size_t WS_WINT = 4 * MiB;
constexpr size_t WS_WOUTT = 8 * MiB;
constexpr size_t WS_AFF = 10 * MiB;
constexpr size_t WS_IDX = 12 * MiB;
constexpr size_t WS_GATE = WS_IDX + 256 * 1024;
constexpr size_t WS_INV = 13 * MiB;
constexpr size_t WS_WDT = 16 * MiB;
constexpr size_t WS_WGUT = 104 * MiB;
constexpr size_t WS_Y = WS_WGUT;
constexpr size_t WS_R = 280 * MiB;
constexpr size_t WS_H1 = WS_R;
constexpr size_t WS_ZT = WS_R + 68 * MiB;
constexpr size_t WS_UG = WS_R + 164 * MiB;
constexpr size_t WS_EB = WS_R + 224 * MiB;
constexpr size_t WS_YHT = WS_EB;
constexpr size_t WS_MCT = WS_R + 264 * MiB;
constexpr size_t WS_WAT = WS_R + 288 * MiB;
constexpr size_t WS_FILT = WS_R + 296 * MiB;
constexpr size_t WS_FSC = WS_FILT + (size_t)2 * 512 * 8576;
constexpr size_t WS_VS = WS_R;
constexpr size_t WS_YSG = WS_R + 330 * MiB;
constexpr int S5TAB_FLOATS = (2 * 33 * 64 * 2) + (2 * 64 * 16 * 2) + (2 * 32 * 256) + (2 * 16 * 64 * 2);
constexpr size_t WS_S5TAB = WS_YSG;
constexpr size_t WS_YCAT = WS_R;
constexpr size_t WS_H2 = WS_R;
constexpr size_t WS_HB = WS_R + 64 * MiB;
constexpr size_t WS_END = WS_R + 416 * MiB;
static_assert(WS_YSG + (size_t)NG * 1024 * 512 * 2 <= WS_END && WS_FILT + (size_t)4 * HYW * FLEN * 2 <= WS_YSG && WS_YCAT + (size_t)NTOK * DM * 2 <= WS_ZT && WS_HB + (size_t)NE * EROWS * FF * 2 <= WS_END, "ws map");

constexpr int CW_BAR = 4096;

constexpr int RING_BYTES = 131072;
constexpr int LDS_BYTES = 163840;
constexpr int LDSCTL_OFF = LDS_BYTES - 1024, MISC_OFF = LDSCTL_OFF + 320;
constexpr int NWAVES = 8, NTHR = 512;

__device__ __forceinline__ unsigned f2bf(float f) { unsigned u = __builtin_bit_cast(unsigned, f); return (u + 0x7fffu + ((u >> 16) & 1u)) >> 16; }
__device__ __forceinline__ unsigned pk2(float lo, float hi) { return f2bf(lo) | (f2bf(hi) << 16); }
__device__ __forceinline__ float bf2f(unsigned b) { return __builtin_bit_cast(float, (b & 0xffffu) << 16); }
__device__ __forceinline__ float bflo(unsigned w) { return __builtin_bit_cast(float, w << 16); }
__device__ __forceinline__ float bfhi(unsigned w) { return __builtin_bit_cast(float, w & 0xffff0000u); }
__device__ __forceinline__ float wave_sum(float v) {
#pragma unroll
    for (int o = 1; o < 64; o <<= 1) v += __shfl_xor(v, o);
    return v;
}
__device__ __forceinline__ float sigmoidf_(float x) { return __builtin_amdgcn_rcpf(1.0f + __builtin_amdgcn_exp2f(fminf(-1.4426950408889634f * x, 80.0f))); }
__device__ __forceinline__ float siluf_(float x) { return x * sigmoidf_(x); }
__device__ __forceinline__ float gelu_tanh(float y) {
    const float u2 = 1.5957691216057308f * (y + 0.044715f * y * y * y);
    return y * sigmoidf_(u2);
}
typedef int i32x8 __attribute__((ext_vector_type(8)));
typedef int i32x4 __attribute__((ext_vector_type(4)));
__device__ __forceinline__ unsigned pk4_fp8(float a, float b, float c, float d) { int w = 0; w = __builtin_amdgcn_cvt_pk_fp8_f32(a, b, w, false); w = __builtin_amdgcn_cvt_pk_fp8_f32(c, d, w, true); return (unsigned)w; }
constexpr float WGU_SCALE = 16.0f, WD_SCALE = 32.0f;
constexpr int WGU_E8M0 = 127 - 4, WD_E8M0 = 127 - 5;
#define LDS_WAIT() asm volatile("s_waitcnt lgkmcnt(0)" ::: "memory")
#define VM_WAIT() asm volatile("s_waitcnt vmcnt(0)" ::: "memory")

#define XB_TMO      128
#define XB_XCNT(j)  (256  + 64 * (j))
#define XB_XSUB(j)  (1280 + 64 * (j))
#define XB_XGEN(j)  (2304 + 64 * (j))
#define XB_TOP      3328
#define XB_TOPGEN   3392
#define XCD_BAR_WORDS 3456
#define XB_SPIN_CAP (1u << 22)
__device__ __forceinline__ unsigned xb_ld(unsigned* p)              { return __hip_atomic_load(p, __ATOMIC_RELAXED, __HIP_MEMORY_SCOPE_AGENT); }
__device__ __forceinline__ unsigned xb_add(unsigned* p, unsigned v) { return __hip_atomic_fetch_add(p, v, __ATOMIC_RELAXED, __HIP_MEMORY_SCOPE_AGENT); }
__device__ __forceinline__ unsigned xb_xcc_id() { return (unsigned)__builtin_amdgcn_s_getreg((3 << 11) | 20) & 0xFu; }
#define XB_SPIN(cond, bar) do { unsigned _sp = 0; while (cond) { __builtin_amdgcn_s_sleep(1); \
    if ((++_sp & 255u) == 0u) { if (xb_ld(&(bar)[XB_TMO])) break; if (_sp > XB_SPIN_CAP) { atomicAdd(&(bar)[XB_TMO], 1u); break; } } } } while (0)
struct XcdBarrier { unsigned* bar; unsigned x; volatile LAS unsigned* st; };
__device__ __forceinline__ XcdBarrier xcd_barrier_post(unsigned* bar, volatile LAS unsigned* st) {
    XcdBarrier b; b.bar = bar; b.x = xb_xcc_id(); b.st = st;
    if (threadIdx.x == 0) (void)xb_add(&bar[XB_XCNT(b.x)], 1u);
    return b;
}
__device__ __forceinline__ void xcd_barrier_complete(unsigned* bar, unsigned x, unsigned& nloc, unsigned& nx) {
    const unsigned G = gridDim.x * gridDim.y * gridDim.z;
    unsigned sum, cnt, mine, sp = 0u;
    for (;;) {
        sum = 0u; cnt = 0u; mine = 0u;
#pragma unroll
        for (unsigned j = 0; j < 16; ++j) { const unsigned c = xb_ld(&bar[XB_XCNT(j)]); sum += c; cnt += (c > 0u) ? 1u : 0u; mine = (j == x) ? c : mine; }
        if (sum == G) break;
        __builtin_amdgcn_s_sleep(1);
        if ((++sp & 255u) == 0u) { if (xb_ld(&bar[XB_TMO])) break; if (sp > XB_SPIN_CAP) { atomicAdd(&bar[XB_TMO], 1u); break; } }
    }
    nloc = mine > 0u ? mine : 1u; nx = cnt > 0u ? cnt : 1u;
}
__device__ __forceinline__ void xcd_barrier(const XcdBarrier& b) {
    asm volatile("s_waitcnt vmcnt(0)" ::: "memory");
    __syncthreads();
    if (threadIdx.x == 0) {
        unsigned* bar = b.bar;
        __builtin_amdgcn_s_waitcnt(0);
        unsigned nloc = b.st[0], nx = b.st[1];
        if (nloc == 0u) { xcd_barrier_complete(bar, b.x, nloc, nx); b.st[0] = nloc; b.st[1] = nx; }
        const unsigned old = xb_add(&bar[XB_XSUB(b.x)], 1u);
        const unsigned gen = old / nloc;
        if (old + 1u == (gen + 1u) * nloc) {
            __builtin_amdgcn_fence(__ATOMIC_RELEASE, "agent");
            asm volatile("s_waitcnt vmcnt(0)" ::: "memory");
            const unsigned og = xb_add(&bar[XB_TOP], 1u);
            const unsigned tg = og / nx;
            if (og + 1u == (tg + 1u) * nx) xb_add(&bar[XB_TOPGEN], 1u);
            else XB_SPIN(xb_ld(&bar[XB_TOPGEN]) == tg, bar);
            __builtin_amdgcn_fence(__ATOMIC_ACQUIRE, "agent");
            xb_add(&bar[XB_XGEN(b.x)], 1u);
            asm volatile("s_waitcnt vmcnt(0)" ::: "memory");
        } else {
            XB_SPIN(xb_ld(&bar[XB_XGEN(b.x)]) == gen, bar);
            __builtin_amdgcn_fence(__ATOMIC_ACQUIRE, "agent");
            asm volatile("s_waitcnt vmcnt(0)" ::: "memory");
        }
    }
    __syncthreads();
}

namespace gm {
constexpr int BM = 256, BK = 64, HALF = 128, HTB = HALF * BK * 2, STAGE_BYTES = 8 * HTB, NXCD = 8, WGM = 8;
__host__ __device__ __forceinline__ int lds_byte(int r, int c) { const int st = (r >> 4) * 2 + (c >> 5), rr = r & 15, cc = c & 31, ob = rr * 64 + cc * 2; return st * 1024 + (ob ^ (((ob >> 9) & 1) << 5)); }
__host__ __device__ __forceinline__ void stage_rc(int b, int& R, int& C) { const int st = b / 1024, sb = b % 1024, swz = sb ^ (((sb >> 9) & 1) << 5); R = (st >> 1) * 16 + swz / 64; C = (st & 1) * 32 + (swz % 64) / 2; }
__host__ __device__ __forceinline__ int perm32(int rho) { const int n = rho >> 4, i = rho & 15; return 8 * (i >> 2) + 4 * n + (i & 3); }

struct GUnit { const char* A; const char* B; int pm, pn; };
__device__ __forceinline__ const char* uni_ptr(const char* p) { const unsigned long long v = (unsigned long long)p; const unsigned lo = __builtin_amdgcn_readfirstlane((unsigned)v), hi = __builtin_amdgcn_readfirstlane((unsigned)(v >> 32));
    return (const char*)(const GAS char*)(((unsigned long long)hi << 32) | lo); }

struct TileOrder {
    int nM, nN, nwg, G, c;
    __device__ __forceinline__ void init(int nM_, int nN_, int G_, int c_) { nM = nM_; nN = nN_; nwg = nM * nN; G = G_; c = c_; }
    __device__ __forceinline__ bool get(int i, int& pm, int& pn) const {
        const long L = (long)i * G + c; if (L >= nwg) return false;
        int wgid = (int)L; { const int q = nwg / NXCD, r = nwg % NXCD, xcd = wgid % NXCD, off = wgid / NXCD; wgid = (xcd < r ? xcd * (q + 1) : r * (q + 1) + (xcd - r) * q) + off; }
        const int nig = WGM * nN, gid = wgid / nig, fm = gid * WGM, gsz = (nM - fm) < WGM ? (nM - fm) : WGM;
        pm = fm + ((wgid % nig) % gsz); pn = (wgid % nig) / gsz; return true;
    }
};

__device__ __forceinline__ unsigned cvt_pk_bf16(float lo, float hi) { unsigned r; asm volatile("v_cvt_pk_bf16_f32 %0, %1, %2" : "=v"(r) : "v"(lo), "v"(hi)); return r; }

template <class Epi, class Sched, bool TR>
__device__ __forceinline__ void gemm_phase(LAS unsigned char* lds, const Sched& S, const Epi& E) {
    int tid = threadIdx.x; asm volatile("" : "+v"(tid));
    const int wid = __builtin_amdgcn_readfirstlane(tid >> 6), lane = tid & 63, wr = wid >> 2, wc = wid & 3, fr = lane & 15, fq = lane >> 4;
    const int nt = S.nt;
    int sR0, sC0, sR1, sC1; stage_rc(tid * 16, sR0, sC0); stage_rc(tid * 16 + 8192, sR1, sC1);
    const unsigned vB0 = (unsigned)(Epi::PERM ? ((sR0 & ~31) + perm32(sR0 & 31)) : sR0) * S.ldb + (unsigned)sC0 * 2u;
    const unsigned vB1 = (unsigned)(Epi::PERM ? ((sR1 & ~31) + perm32(sR1 & 31)) : sR1) * S.ldb + (unsigned)sC1 * 2u;
    const size_t kA = S.kstepA, kB = S.kstepB;
    const size_t hstepB = (size_t)HALF * S.ldb;
    const unsigned ldsw = (unsigned)wid * 1024u;
    const int aoff = lds_byte(wr * 64 + fr, fq * 8), boff = lds_byte(wc * 32 + fr, fq * 8);
#define PG8_SA(b, h) (((b) * 2 + (h)) * HTB)
#define PG8_SB(b, h) ((4 + (b) * 2 + (h)) * HTB)
#define PG8_STAGE(bufoff, gbase, o0, o1) do { \
        __builtin_amdgcn_global_load_lds((const unsigned*)((const char*)(gbase) + (o0)), (LAS unsigned*)(lds + (bufoff) + ldsw), 16, 0, 0); \
        __builtin_amdgcn_global_load_lds((const unsigned*)((const char*)(gbase) + (o1)), (LAS unsigned*)(lds + (bufoff) + ldsw + 8192), 16, 0, 0); } while (0)
#define PG8_LDA(dst, b, h) do { _Pragma("unroll") for (int m = 0; m < 4; ++m) _Pragma("unroll") for (int k = 0; k < 2; ++k) dst[m][k] = *(const LAS bf16x8*)(lds + PG8_SA(b, h) + aoff + m * 2048 + k * 1024); } while (0)
#define PG8_LDB(dst, b, h) do { _Pragma("unroll") for (int n = 0; n < 2; ++n) _Pragma("unroll") for (int k = 0; k < 2; ++k) dst[n][k] = *(const LAS bf16x8*)(lds + PG8_SB(b, h) + boff + n * 2048 + k * 1024); } while (0)
#define PG8_MMA(ai, bj, At, Bt) do { __builtin_amdgcn_s_setprio(1); _Pragma("unroll") for (int m = 0; m < 4; ++m) _Pragma("unroll") for (int n = 0; n < 2; ++n) _Pragma("unroll") for (int k = 0; k < 2; ++k) \
        acc[ai][bj][m][n] = TR ? __builtin_amdgcn_mfma_f32_16x16x32_bf16(Bt[n][k], At[m][k], acc[ai][bj][m][n], 0, 0, 0) \
                               : __builtin_amdgcn_mfma_f32_16x16x32_bf16(At[m][k], Bt[n][k], acc[ai][bj][m][n], 0, 0, 0); __builtin_amdgcn_s_setprio(0); } while (0)
#define PG8_WAIT_V(n) asm volatile("s_waitcnt vmcnt(" #n ")" ::: "memory")
#define PG8_WAIT_L(n) asm volatile("s_waitcnt lgkmcnt(" #n ")" ::: "memory")
#define PG8_BAR __builtin_amdgcn_s_barrier()
#define PG8_SCHED __builtin_amdgcn_sched_barrier(0)
    GUnit cur, nxt; int ui = 0;
    if (!S.next(0, cur)) return;
    f32x4 acc[2][2][4][2];
#pragma unroll
    for (int a = 0; a < 2; ++a)
#pragma unroll
        for (int b = 0; b < 2; ++b)
#pragma unroll
            for (int m = 0; m < 4; ++m)
#pragma unroll
                for (int n = 0; n < 2; ++n) acc[a][b][m][n] = (f32x4){0.f, 0.f, 0.f, 0.f};
    bf16x8 At[4][2], B0[2][2], B1[2][2];
    unsigned c00 = S.aoff(cur, sR0, sC0), c01 = S.aoff(cur, sR1, sC1), c10 = S.aoff(cur, HALF + sR0, sC0), c11 = S.aoff(cur, HALF + sR1, sC1);
    const char* cA = uni_ptr(cur.A); const char* cB = uni_ptr(cur.B);
    PG8_STAGE(PG8_SB(0, 0), cB, vB0, vB1); PG8_STAGE(PG8_SB(0, 1), cB + hstepB, vB0, vB1); PG8_STAGE(PG8_SA(0, 0), cA, c00, c01); PG8_STAGE(PG8_SA(0, 1), cA, c10, c11);
    if (wr == 1) PG8_BAR;
    PG8_WAIT_V(2); PG8_BAR;
    PG8_STAGE(PG8_SB(1, 0), cB + kB, vB0, vB1); PG8_STAGE(PG8_SA(1, 0), cA + kA, c00, c01); PG8_STAGE(PG8_SB(1, 1), cB + hstepB + kB, vB0, vB1);
    PG8_WAIT_V(6); PG8_BAR;
    for (;;) {
        const bool has_next = S.next(ui + 1, nxt);
        if (!has_next) nxt = cur;
        const char* nA = uni_ptr(nxt.A); const char* nB = uni_ptr(nxt.B);
        unsigned n00 = c00, n01 = c01, n10 = c10, n11 = c11;
        if (!Sched::AOFF_PM_ONLY || nxt.pm != cur.pm) { n00 = S.aoff(nxt, sR0, sC0); n01 = S.aoff(nxt, sR1, sC1); n10 = S.aoff(nxt, HALF + sR0, sC0); n11 = S.aoff(nxt, HALF + sR1, sC1); }
        for (int t = 0; t < nt; t += 2) {
            const bool last = (t == nt - 2);
            const char* a1 = cA + (size_t)(t + 1) * kA;
            const char* a2 = last ? nA : cA + (size_t)(t + 2) * kA; const char* b2 = last ? nB : cB + (size_t)(t + 2) * kB;
            const char* a3 = a2 + kA; const char* b3 = b2 + kB;
            const unsigned x00 = last ? n00 : c00, x01 = last ? n01 : c01, x10 = last ? n10 : c10, x11 = last ? n11 : c11;
            PG8_LDB(B0, 0, 0); PG8_LDB(B1, 0, 1); PG8_SCHED; PG8_LDA(At, 0, 0); PG8_STAGE(PG8_SA(1, 1), a1, c10, c11);
            PG8_WAIT_V(8); PG8_WAIT_L(0); PG8_BAR; PG8_MMA(0, 0, At, B0); PG8_MMA(0, 1, At, B1); PG8_BAR; PG8_SCHED;
            PG8_LDA(At, 0, 1); PG8_STAGE(PG8_SB(0, 0), b2, vB0, vB1); PG8_STAGE(PG8_SB(0, 1), b2 + hstepB, vB0, vB1); PG8_STAGE(PG8_SA(0, 0), a2, x00, x01);
            PG8_WAIT_V(8); PG8_WAIT_L(0); PG8_BAR; PG8_MMA(1, 0, At, B0); PG8_MMA(1, 1, At, B1); PG8_BAR; PG8_SCHED;
            PG8_LDB(B0, 1, 0); PG8_LDB(B1, 1, 1); PG8_SCHED; PG8_LDA(At, 1, 0); PG8_STAGE(PG8_SA(0, 1), a2, x10, x11);
            PG8_WAIT_V(8); PG8_WAIT_L(0); PG8_BAR; PG8_MMA(0, 0, At, B0); PG8_MMA(0, 1, At, B1); PG8_BAR; PG8_SCHED;
            PG8_LDA(At, 1, 1); PG8_STAGE(PG8_SB(1, 0), b3, vB0, vB1); PG8_STAGE(PG8_SB(1, 1), b3 + hstepB, vB0, vB1); PG8_STAGE(PG8_SA(1, 0), a3, x00, x01);
            PG8_WAIT_V(8); PG8_WAIT_L(0); PG8_BAR; PG8_MMA(1, 0, At, B0); PG8_MMA(1, 1, At, B1); PG8_BAR; PG8_SCHED;
        }
        if (wr == 0) PG8_BAR;
        E(acc, cur, wr, wc, fr, fq);
        if (!has_next) break;
#pragma unroll
        for (int a = 0; a < 2; ++a)
#pragma unroll
            for (int b = 0; b < 2; ++b)
#pragma unroll
                for (int m = 0; m < 4; ++m)
#pragma unroll
                    for (int n = 0; n < 2; ++n) acc[a][b][m][n] = (f32x4){0.f, 0.f, 0.f, 0.f};
        cur = nxt; cA = nA; cB = nB; ++ui;
        c00 = n00; c01 = n01; c10 = n10; c11 = n11;
        if (wr == 1) PG8_BAR;
    }
    PG8_WAIT_V(0);
    PG8_BAR;
#undef PG8_SA
#undef PG8_SB
#undef PG8_STAGE
#undef PG8_LDA
#undef PG8_LDB
#undef PG8_MMA
#undef PG8_WAIT_V
#undef PG8_WAIT_L
#undef PG8_BAR
#undef PG8_SCHED
}
template <class Epi, class Sched, int SCALE_B>
__device__ __forceinline__ void gemm_phase_f8(LAS unsigned char* lds, const Sched& S, const Epi& E) {
    int tid = threadIdx.x; asm volatile("" : "+v"(tid));
    const int wid = __builtin_amdgcn_readfirstlane(tid >> 6), lane = tid & 63, wr = wid >> 2, wc = wid & 3, fr = lane & 15, fq = lane >> 4;
    const int nt = S.nt;
    int scA = 127, scB = SCALE_B; asm volatile("" : "+v"(scA), "+v"(scB));
    int sR0, sC0, sR1, sC1; stage_rc(tid * 16, sR0, sC0); stage_rc(tid * 16 + 8192, sR1, sC1);
    const unsigned vB0 = (unsigned)(Epi::PERM ? ((sR0 & ~31) + perm32(sR0 & 31)) : sR0) * S.ldb + (unsigned)sC0 * 2u;
    const unsigned vB1 = (unsigned)(Epi::PERM ? ((sR1 & ~31) + perm32(sR1 & 31)) : sR1) * S.ldb + (unsigned)sC1 * 2u;
    const size_t kA = S.kstepA, kB = S.kstepB;
    const size_t hstepB = (size_t)HALF * S.ldb;
    const unsigned ldsw = (unsigned)wid * 1024u;
    const int fcol = (fq >> 1) * 32 + (fq & 1) * 16;
    const int aoff = lds_byte(wr * 64 + fr, fcol), aoff2 = lds_byte(wr * 64 + fr, fcol + 8), boff = lds_byte(wc * 32 + fr, fcol), boff2 = lds_byte(wc * 32 + fr, fcol + 8);
#define PG8_SA(b, h) (((b) * 2 + (h)) * HTB)
#define PG8_SB(b, h) ((4 + (b) * 2 + (h)) * HTB)
#define PG8_STAGE(bufoff, gbase, o0, o1) do { \
        __builtin_amdgcn_global_load_lds((const unsigned*)((const char*)(gbase) + (o0)), (LAS unsigned*)(lds + (bufoff) + ldsw), 16, 0, 0); \
        __builtin_amdgcn_global_load_lds((const unsigned*)((const char*)(gbase) + (o1)), (LAS unsigned*)(lds + (bufoff) + ldsw + 8192), 16, 0, 0); } while (0)
#define PG8_LDA(dst, b, h) do { _Pragma("unroll") for (int m = 0; m < 4; ++m) dst[m] = __builtin_shufflevector(*(const LAS i32x4*)(lds + PG8_SA(b, h) + aoff + m * 2048), *(const LAS i32x4*)(lds + PG8_SA(b, h) + aoff2 + m * 2048), 0, 1, 2, 3, 4, 5, 6, 7); } while (0)
#define PG8_LDB(dst, b, h) do { _Pragma("unroll") for (int n = 0; n < 2; ++n) dst[n] = __builtin_shufflevector(*(const LAS i32x4*)(lds + PG8_SB(b, h) + boff + n * 2048), *(const LAS i32x4*)(lds + PG8_SB(b, h) + boff2 + n * 2048), 0, 1, 2, 3, 4, 5, 6, 7); } while (0)
#define PG8_F8(FRG) (i32x8){(int)FRG[0][0], (int)FRG[0][1], (int)FRG[0][2], (int)FRG[0][3], (int)FRG[1][0], (int)FRG[1][1], (int)FRG[1][2], (int)FRG[1][3]}
#define PG8_MMA(ai, bj, At, Bt) do { __builtin_amdgcn_s_setprio(1); _Pragma("unroll") for (int m = 0; m < 4; ++m) _Pragma("unroll") for (int n = 0; n < 2; ++n) \
        asm volatile("v_mfma_scale_f32_16x16x128_f8f6f4 %0, %1, %2, %0, %3, %4 op_sel_hi:[0,0,0]" : "+v"(acc[ai][bj][m][n]) : "v"(Bt[n]), "v"(At[m]), "v"(scB), "v"(scA)); __builtin_amdgcn_s_setprio(0); } while (0)
#define PG8_WAIT_V(n) asm volatile("s_waitcnt vmcnt(" #n ")" ::: "memory")
#define PG8_WAIT_L(n) asm volatile("s_waitcnt lgkmcnt(" #n ")" ::: "memory")
#define PG8_BAR __builtin_amdgcn_s_barrier()
#define PG8_SCHED __builtin_amdgcn_sched_barrier(0)
    GUnit cur, nxt; int ui = 0;
    if (!S.next(0, cur)) return;
    f32x4 acc[2][2][4][2];
#pragma unroll
    for (int a = 0; a < 2; ++a)
#pragma unroll
        for (int b = 0; b < 2; ++b)
#pragma unroll
            for (int m = 0; m < 4; ++m)
#pragma unroll
                for (int n = 0; n < 2; ++n) acc[a][b][m][n] = (f32x4){0.f, 0.f, 0.f, 0.f};
    i32x8 At[4], B0[2], B1[2];
    unsigned c00 = S.aoff(cur, sR0, sC0), c01 = S.aoff(cur, sR1, sC1), c10 = S.aoff(cur, HALF + sR0, sC0), c11 = S.aoff(cur, HALF + sR1, sC1);
    const char* cA = uni_ptr(cur.A); const char* cB = uni_ptr(cur.B);
    PG8_STAGE(PG8_SB(0, 0), cB, vB0, vB1); PG8_STAGE(PG8_SB(0, 1), cB + hstepB, vB0, vB1); PG8_STAGE(PG8_SA(0, 0), cA, c00, c01); PG8_STAGE(PG8_SA(0, 1), cA, c10, c11);
    if (wr == 1) PG8_BAR;
    PG8_WAIT_V(2); PG8_BAR;
    PG8_STAGE(PG8_SB(1, 0), cB + kB, vB0, vB1); PG8_STAGE(PG8_SA(1, 0), cA + kA, c00, c01); PG8_STAGE(PG8_SB(1, 1), cB + hstepB + kB, vB0, vB1);
    PG8_WAIT_V(6); PG8_BAR;
    for (;;) {
        const bool has_next = S.next(ui + 1, nxt);
        if (!has_next) nxt = cur;
        const char* nA = uni_ptr(nxt.A); const char* nB = uni_ptr(nxt.B);
        unsigned n00 = c00, n01 = c01, n10 = c10, n11 = c11;
        if constexpr (!Sched::AOFF_CONST) { if (!Sched::AOFF_PM_ONLY || nxt.pm != cur.pm) { n00 = S.aoff(nxt, sR0, sC0); n01 = S.aoff(nxt, sR1, sC1); n10 = S.aoff(nxt, HALF + sR0, sC0); n11 = S.aoff(nxt, HALF + sR1, sC1); } }
        for (int t = 0; t < nt; t += 2) {
            const bool last = (t == nt - 2);
            const char* a1 = cA + (size_t)(t + 1) * kA;
            const char* a2 = last ? nA : cA + (size_t)(t + 2) * kA; const char* b2 = last ? nB : cB + (size_t)(t + 2) * kB;
            const char* a3 = a2 + kA; const char* b3 = b2 + kB;
            const unsigned x00 = (!Sched::AOFF_CONST && last) ? n00 : c00, x01 = (!Sched::AOFF_CONST && last) ? n01 : c01, x10 = (!Sched::AOFF_CONST && last) ? n10 : c10, x11 = (!Sched::AOFF_CONST && last) ? n11 : c11;
            PG8_LDB(B0, 0, 0); PG8_LDB(B1, 0, 1); PG8_SCHED; PG8_LDA(At, 0, 0); PG8_STAGE(PG8_SA(1, 1), a1, c10, c11);
            PG8_WAIT_V(8); PG8_WAIT_L(0); PG8_BAR; PG8_MMA(0, 0, At, B0); PG8_MMA(0, 1, At, B1); PG8_BAR; PG8_SCHED;
            PG8_LDA(At, 0, 1); PG8_STAGE(PG8_SB(0, 0), b2, vB0, vB1); PG8_STAGE(PG8_SB(0, 1), b2 + hstepB, vB0, vB1); PG8_STAGE(PG8_SA(0, 0), a2, x00, x01);
            PG8_WAIT_V(8); PG8_WAIT_L(0); PG8_BAR; PG8_MMA(1, 0, At, B0); PG8_MMA(1, 1, At, B1); PG8_BAR; PG8_SCHED;
            PG8_LDB(B0, 1, 0); PG8_LDB(B1, 1, 1); PG8_SCHED; PG8_LDA(At, 1, 0); PG8_STAGE(PG8_SA(0, 1), a2, x10, x11);
            PG8_WAIT_V(8); PG8_WAIT_L(0); PG8_BAR; PG8_MMA(0, 0, At, B0); PG8_MMA(0, 1, At, B1); PG8_BAR; PG8_SCHED;
            PG8_LDA(At, 1, 1); PG8_STAGE(PG8_SB(1, 0), b3, vB0, vB1); PG8_STAGE(PG8_SB(1, 1), b3 + hstepB, vB0, vB1); PG8_STAGE(PG8_SA(1, 0), a3, x00, x01);
            PG8_WAIT_V(8); PG8_WAIT_L(0); PG8_BAR; PG8_MMA(1, 0, At, B0); PG8_MMA(1, 1, At, B1); PG8_BAR; PG8_SCHED;
        }
        if (wr == 0) PG8_BAR;
        asm volatile("s_nop 15\n\ts_nop 15" ::: "memory");
        E(acc, cur, wr, wc, fr, fq);
        if (!has_next) break;
#pragma unroll
        for (int a = 0; a < 2; ++a)
#pragma unroll
            for (int b = 0; b < 2; ++b)
#pragma unroll
                for (int m = 0; m < 4; ++m)
#pragma unroll
                    for (int n = 0; n < 2; ++n) acc[a][b][m][n] = (f32x4){0.f, 0.f, 0.f, 0.f};
        cur = nxt; cA = nA; cB = nB; ++ui;
        c00 = n00; c01 = n01; c10 = n10; c11 = n11;
        if (wr == 1) PG8_BAR;
    }
    PG8_WAIT_V(0);
    PG8_BAR;
#undef PG8_SA
#undef PG8_SB
#undef PG8_STAGE
#undef PG8_LDA
#undef PG8_LDB
#undef PG8_MMA
#undef PG8_F8
#undef PG8_WAIT_V
#undef PG8_WAIT_L
#undef PG8_BAR
#undef PG8_SCHED
}
}

struct Args { const float* in[35]; float* out; unsigned char* ws; int ph_lo, ph_hi; };
struct Frame {
    LAS unsigned char* lds;
    int tid, lane, wave, G, bid;
    float* out; unsigned char* ws;
};
__device__ __forceinline__ const float* inptr(const Frame& F, int i) {
    const LAS unsigned* t = (const LAS unsigned*)(F.lds + LDSCTL_OFF) + 2 * i;
    const unsigned lo = __builtin_amdgcn_readfirstlane(t[0]), hi = __builtin_amdgcn_readfirstlane(t[1]);
    const GAS float* g = (const GAS float*)(((unsigned long long)hi << 32) | lo);
    return (const float*)g;
}
enum { I_X = 0, I_C, I_CTX, I_CCTX, I_MODW, I_MODB, I_N1G, I_N2G, I_WIN, I_WOUT, I_CONVW, I_CONVB, I_HW1, I_HB1, I_HFREQ, I_HW2, I_HB2, I_HW3, I_HB3, I_HBIAS,
       I_LRE, I_LIM, I_LSTEP, I_BRE, I_BIM, I_CRE, I_CIM, I_S5D, I_GLUW, I_GLUB, I_RW, I_WG, I_WU, I_WD, I_FING };

struct SchedPlain {
    static constexpr bool AOFF_PM_ONLY = true, AOFF_CONST = true;
    gm::TileOrder T; const char* A; const char* B; unsigned lda, ldb, kstepA, kstepB; int nt; int mt; size_t az, bz;
    __device__ __forceinline__ bool next(int i, gm::GUnit& u) const {
        int pm, pn; if (!T.get(i, pm, pn)) return false; const int z = pm / mt, pl = pm - z * mt;
        u.pm = pm; u.pn = pn; u.A = A + (size_t)z * az + (size_t)pl * 256 * lda; u.B = B + (size_t)z * bz + (size_t)pn * 256 * ldb; return true; }
    __device__ __forceinline__ unsigned aoff(const gm::GUnit&, int row, int col) const { return (unsigned)row * lda + (unsigned)col * 2u; }
};
struct SchedMoe1 {
    static constexpr bool AOFF_PM_ONLY = true, AOFF_CONST = false;
    gm::TileOrder T; const char* A; const char* B; const int* idx; unsigned lda, ldb, kstepA, kstepB; int nt;
    __device__ __forceinline__ bool next(int i, gm::GUnit& u) const {
        int pm, pn; if (!T.get(i, pm, pn)) return false; const int e = pm >> 4;
        u.pm = pm; u.pn = pn; u.A = A; u.B = B + ((size_t)e * (2 * FF) + (size_t)pn * 256) * ldb; return true; }
    __device__ __forceinline__ unsigned aoff(const gm::GUnit& u, int row, int col) const { const int tok = idx[u.pm * 256 + row]; return (unsigned)tok * lda + (unsigned)col * 2u; }
};
struct SchedGlu {
    static constexpr bool AOFF_PM_ONLY = true;
    gm::TileOrder T; const char* A; const char* B; unsigned ldb, kstepA, kstepB; int nt;
    __device__ __forceinline__ bool next(int i, gm::GUnit& u) const {
        int pm, pn; if (!T.get(i, pm, pn)) return false;
        u.pm = pm; u.pn = pn; u.A = A + (size_t)pm * 256 * 32; u.B = B + (size_t)pn * 256 * ldb; return true; }
    __device__ __forceinline__ unsigned aoff(const gm::GUnit&, int row, int col) const { return (unsigned)(col >> 4) * (unsigned)(1024 * 512 * 2) + (unsigned)row * 32u + (unsigned)(col & 15) * 2u; }
};

using gm::GUnit; using gm::cvt_pk_bf16;
struct EpiZT { static constexpr bool PERM = false; bf16* ZT;
    __device__ __forceinline__ void operator()(const f32x4 (&acc)[2][2][4][2], const GUnit& u, int wr, int wc, int fr, int fq) const {
#pragma unroll
        for (int bj = 0; bj < 2; ++bj)
#pragma unroll
            for (int n = 0; n < 2; ++n) { const int ch = u.pn * 256 + bj * 128 + wc * 32 + n * 16 + fr; bf16* rowp = ZT + (size_t)ch * NTOK + u.pm * 256 + wr * 64 + 4 * fq;
#pragma unroll
                for (int ai = 0; ai < 2; ++ai)
#pragma unroll
                    for (int m = 0; m < 4; ++m) { const f32x4 v = acc[ai][bj][m][n]; u32x2 w; w.x = cvt_pk_bf16(v[0], v[1]); w.y = cvt_pk_bf16(v[2], v[3]); *(u32x2*)(rowp + ai * 128 + m * 16) = w; } }
    }
};
struct EpiUG { static constexpr bool PERM = true; bf16* UG;
    __device__ __forceinline__ void operator()(const f32x4 (&acc)[2][2][4][2], const GUnit& u, int wr, int wc, int fr, int fq) const {
#pragma unroll
        for (int ai = 0; ai < 2; ++ai)
#pragma unroll
            for (int m = 0; m < 4; ++m) { const int r = u.pm * 256 + ai * 128 + wr * 64 + m * 16 + fr; int crow, tau;
                if (r < NTOK) { crow = r >> 5; tau = r & 31; } else { const int rc = r - NTOK; crow = 1024 + (rc >> 5); tau = rc & 31; }
#pragma unroll
                for (int bj = 0; bj < 2; ++bj) { const int c0 = u.pn * 256 + bj * 128 + wc * 32 + 8 * fq; const int g = c0 >> 4, h0 = c0 & 15;
                    const f32x4 v0 = acc[ai][bj][m][0], v1 = acc[ai][bj][m][1]; u32x4 w; w.x = cvt_pk_bf16(v0[0], v0[1]); w.y = cvt_pk_bf16(v0[2], v0[3]); w.z = cvt_pk_bf16(v1[0], v1[1]); w.w = cvt_pk_bf16(v1[2], v1[3]);
                    *(u32x4*)(UG + ((size_t)g * UROWS + crow) * UCOLS + tau * 16 + h0) = w; } }
    }
};
struct EpiEB { static constexpr bool PERM = false; float* EB;
    __device__ __forceinline__ void operator()(const f32x4 (&acc)[2][2][4][2], const GUnit& u, int wr, int wc, int fr, int fq) const {
        const int g = u.pm / 5, pl = u.pm - g * 5;
#pragma unroll
        for (int ai = 0; ai < 2; ++ai)
#pragma unroll
            for (int m = 0; m < 4; ++m) { float* rowp = EB + ((size_t)g * UROWS + pl * 256 + ai * 128 + wr * 64 + m * 16 + fr) * 256 + wc * 32 + 4 * fq;
#pragma unroll
                for (int bj = 0; bj < 2; ++bj)
#pragma unroll
                    for (int n = 0; n < 2; ++n) *(f32x4*)(rowp + bj * 128 + n * 16) = acc[ai][bj][m][n]; }
    }
};
struct EpiYS { static constexpr bool PERM = true; bf16* YSG; const bf16* UG; const float* s5d;
    __device__ __forceinline__ void operator()(const f32x4 (&acc)[2][2][4][2], const GUnit& u, int wr, int wc, int fr, int fq) const {
        const int g = u.pm >> 2, pl = u.pm & 3;
        float dv[2][8];
#pragma unroll
        for (int bj = 0; bj < 2; ++bj) { const int c0 = u.pn * 256 + bj * 128 + wc * 32 + 8 * fq;
#pragma unroll
            for (int j = 0; j < 8; ++j) dv[bj][j] = s5d[g * 16 + ((c0 + j) & 15)]; }
#pragma unroll
        for (int ai = 0; ai < 2; ++ai)
#pragma unroll
            for (int m = 0; m < 4; ++m) { const int crow = pl * 256 + ai * 128 + wr * 64 + m * 16 + fr;
#pragma unroll
                for (int bj = 0; bj < 2; ++bj) { const int c0 = u.pn * 256 + bj * 128 + wc * 32 + 8 * fq;
                    const u32x4 uu = *(const u32x4*)(UG + ((size_t)g * UROWS + crow) * UCOLS + c0);
                    const f32x4 v0 = acc[ai][bj][m][0], v1 = acc[ai][bj][m][1];
                    float y[8]; y[0] = v0[0] + dv[bj][0] * bflo(uu.x); y[1] = v0[1] + dv[bj][1] * bfhi(uu.x); y[2] = v0[2] + dv[bj][2] * bflo(uu.y); y[3] = v0[3] + dv[bj][3] * bfhi(uu.y);
                    y[4] = v1[0] + dv[bj][4] * bflo(uu.z); y[5] = v1[1] + dv[bj][5] * bfhi(uu.z); y[6] = v1[2] + dv[bj][6] * bflo(uu.w); y[7] = v1[3] + dv[bj][7] * bfhi(uu.w);
#pragma unroll
                    for (int j = 0; j < 8; ++j) y[j] = gelu_tanh(y[j]);
                    u32x4 w; w.x = cvt_pk_bf16(y[0], y[1]); w.y = cvt_pk_bf16(y[2], y[3]); w.z = cvt_pk_bf16(y[4], y[5]); w.w = cvt_pk_bf16(y[6], y[7]);
                    *(u32x4*)(YSG + ((size_t)g * 1024 + crow) * 512 + c0) = w; } }
    }
};
struct EpiGlu { static constexpr bool PERM = true; bf16* YCAT; const bf16* YSG; const float* glub;
    __device__ __forceinline__ void operator()(const f32x4 (&acc)[2][2][4][2], const GUnit& u, int wr, int wc, int fr, int fq) const {
#pragma unroll
        for (int bj = 0; bj < 2; ++bj) { const int n0 = u.pn * 256 + bj * 128 + wc * 32 + 8 * fq; const int g = n0 >> 4, h0 = n0 & 15;
            const f32x4 b0 = *(const f32x4*)(glub + n0), b1 = *(const f32x4*)(glub + n0 + 4);
#pragma unroll
            for (int ai = 0; ai < 2; ++ai)
#pragma unroll
                for (int m = 0; m < 4; ++m) { const int tok = u.pm * 256 + ai * 128 + wr * 64 + m * 16 + fr;
                    const u32x4 ys = *(const u32x4*)(YSG + ((size_t)g * 1024 + (tok >> 5)) * 512 + (tok & 31) * 16 + h0);
                    const f32x4 v0 = acc[ai][bj][m][0] + b0, v1 = acc[ai][bj][m][1] + b1;
                    float y[8]; y[0] = bflo(ys.x) * sigmoidf_(v0[0]); y[1] = bfhi(ys.x) * sigmoidf_(v0[1]); y[2] = bflo(ys.y) * sigmoidf_(v0[2]); y[3] = bfhi(ys.y) * sigmoidf_(v0[3]);
                    y[4] = bflo(ys.z) * sigmoidf_(v1[0]); y[5] = bfhi(ys.z) * sigmoidf_(v1[1]); y[6] = bflo(ys.w) * sigmoidf_(v1[2]); y[7] = bfhi(ys.w) * sigmoidf_(v1[3]);
                    u32x4 w; w.x = cvt_pk_bf16(y[0], y[1]); w.y = cvt_pk_bf16(y[2], y[3]); w.z = cvt_pk_bf16(y[4], y[5]); w.w = cvt_pk_bf16(y[6], y[7]);
#ifdef DBG_S5_SCALE
                    w.x = cvt_pk_bf16(y[0] * DBG_S5_SCALE, y[1] * DBG_S5_SCALE); w.y = cvt_pk_bf16(y[2] * DBG_S5_SCALE, y[3] * DBG_S5_SCALE); w.z = cvt_pk_bf16(y[4] * DBG_S5_SCALE, y[5] * DBG_S5_SCALE); w.w = cvt_pk_bf16(y[6] * DBG_S5_SCALE, y[7] * DBG_S5_SCALE);
#endif
                    *(u32x4*)(YCAT + (size_t)tok * DM + 512 + n0) = w; } }
    }
};
struct EpiXmid { static constexpr bool PERM = false; const float* x; float* xmid; const float* mod;
    __device__ __forceinline__ void operator()(const f32x4 (&acc)[2][2][4][2], const GUnit& u, int wr, int wc, int fr, int fq) const {
        const int b = u.pm >> 4;
        const int col0 = u.pn * 256 + wc * 32 + 4 * fq;
        f32x4 gv[2][2];
#pragma unroll
        for (int bj = 0; bj < 2; ++bj)
#pragma unroll
            for (int n = 0; n < 2; ++n) gv[bj][n] = *(const f32x4*)(mod + (size_t)b * (NMOD * DM) + 2 * DM + col0 + bj * 128 + n * 16);
#pragma unroll
        for (int ai = 0; ai < 2; ++ai)
#pragma unroll
            for (int m = 0; m < 4; ++m) { const size_t off = (size_t)(u.pm * 256 + ai * 128 + wr * 64 + m * 16 + fr) * DM + col0;
#pragma unroll
                for (int bj = 0; bj < 2; ++bj)
#pragma unroll
                    for (int n = 0; n < 2; ++n) { const f32x4 xv = *(const f32x4*)(x + off + bj * 128 + n * 16); *(f32x4*)(xmid + off + bj * 128 + n * 16) = xv + gv[bj][n] * acc[ai][bj][m][n]; } }
    }
};
struct EpiMoe1 { static constexpr bool PERM = true; unsigned char* HB;
    __device__ __forceinline__ void operator()(const f32x4 (&acc)[2][2][4][2], const GUnit& u, int wr, int wc, int fr, int fq) const {
        const int c0 = u.pn * 128 + wc * 32 + 8 * fq;
#pragma unroll
        for (int ai = 0; ai < 2; ++ai)
#pragma unroll
            for (int m = 0; m < 4; ++m) { const size_t row = (size_t)u.pm * 256 + ai * 128 + wr * 64 + m * 16 + fr;
                float y[8];
#pragma unroll
                for (int n = 0; n < 2; ++n)
#pragma unroll
                    for (int j = 0; j < 4; ++j) y[n * 4 + j] = fminf(fmaxf(siluf_(acc[ai][0][m][n][j]) * acc[ai][1][m][n][j], -448.0f), 448.0f);
                u32x2 w; w.x = pk4_fp8(y[0], y[1], y[2], y[3]); w.y = pk4_fp8(y[4], y[5], y[6], y[7]);
                *(u32x2*)(HB + row * FF + c0) = w; }
    }
};
struct EpiMoe2 { static constexpr bool PERM = true; bf16* Y; const float* gate;
    __device__ __forceinline__ void operator()(const f32x4 (&acc)[2][2][4][2], const GUnit& u, int wr, int wc, int fr, int fq) const {
#pragma unroll
        for (int ai = 0; ai < 2; ++ai)
#pragma unroll
            for (int m = 0; m < 4; ++m) { const size_t row = (size_t)u.pm * 256 + ai * 128 + wr * 64 + m * 16 + fr; const float gt = gate[row];
#pragma unroll
                for (int bj = 0; bj < 2; ++bj) { const int c0 = u.pn * 256 + bj * 128 + wc * 32 + 8 * fq;
                    const f32x4 v0 = acc[ai][bj][m][0] * gt, v1 = acc[ai][bj][m][1] * gt;
                    u32x4 w; w.x = cvt_pk_bf16(v0[0], v0[1]); w.y = cvt_pk_bf16(v0[2], v0[3]); w.z = cvt_pk_bf16(v1[0], v1[1]); w.w = cvt_pk_bf16(v1[2], v1[3]);
                    *(u32x4*)(Y + row * DM + c0) = w; } }
    }
};

__device__ __forceinline__ void tr_item(const float* W, int N, bf16* WT, int ldk, int k0, int n0, int drow0, LAS float* scr, int lane) {
    float tv[32];
    const float* wp = W + (size_t)(k0 + (lane >> 5)) * N + n0 + (lane & 31);
#pragma unroll
    for (int i = 0; i < 32; ++i) tv[i] = wp[(size_t)(2 * i) * N];
#pragma unroll
    for (int i = 0; i < 32; ++i) scr[(2 * i + (lane >> 5)) * 33 + (lane & 31)] = tv[i];
    LDS_WAIT(); asm volatile("" ::: "memory");
    const int c = lane & 7;
#pragma unroll
    for (int j = 0; j < 4; ++j) { const int n = (lane >> 3) + 8 * j; const LAS float* s = scr + (8 * c) * 33 + n;
        u32x4 o; o.x = pk2(s[0 * 33], s[1 * 33]); o.y = pk2(s[2 * 33], s[3 * 33]); o.z = pk2(s[4 * 33], s[5 * 33]); o.w = pk2(s[6 * 33], s[7 * 33]);
        *(u32x4*)(WT + (size_t)(drow0 + n) * ldk + k0 + 8 * c) = o; }
    LDS_WAIT(); asm volatile("" ::: "memory");
}
__device__ __forceinline__ void p0_transposes(Frame& F) {
    LAS float* scr = (LAS float*)(F.lds + F.wave * 16384);
    if (F.bid >= 192) return;
    const int gw = F.bid * NWAVES + F.wave, NGW = 192 * NWAVES;
    constexpr int I0 = 16 * 64, I1 = 16 * 32, I2 = 8 * 16, IG = 16 * 16 * 88;
    constexpr int NIT = I0 + I1 + I2;
    bf16* ws16 = (bf16*)F.ws;
    for (int it = gw; it < NIT; it += NGW) {
        int r = it;
        if (r < I0) { const int kb = r / 64, nb = r % 64; tr_item(inptr(F, I_WIN), INC, (bf16*)(F.ws + WS_WINT), DM, kb * 64, nb * 32, nb * 32, scr, F.lane); continue; } r -= I0;
        if (r < I1) { const int kb = r / 32, nb = r % 32; tr_item(inptr(F, I_WOUT), DM, (bf16*)(F.ws + WS_WOUTT), DM, kb * 64, nb * 32, nb * 32, scr, F.lane); continue; } r -= I1;
        if (r < I2) { const int kb = r / 16, nb = r % 16; tr_item(inptr(F, I_GLUW), S5W, (bf16*)(F.ws + WS_GLUT), S5W, kb * 64, nb * 32, nb * 32, scr, F.lane); continue; } r -= I2;
        if (r < 2 * IG) { const int up = r >= IG; if (up) r -= IG; const int e = r / (16 * 88), q = r % (16 * 88), kb = q / 88, nb = q % 88, n0 = nb * 32;
            const float* W = inptr(F, up ? I_WU : I_WG) + (size_t)e * DM * FF;
            tr_item(W, FF, (bf16*)(F.ws + WS_WGUT) + (size_t)e * (2 * FF) * DM, DM, kb * 64, n0, 256 * (n0 >> 7) + (n0 & 127) + (up ? 128 : 0), scr, F.lane); continue; }
    }
    (void)ws16;
}
__device__ __forceinline__ void tr_item_f8(const float* W, int N, unsigned char* WT, int ldk, int k0, int n0, int drow0, float sc, LAS float* scr, int lane) {
    float tv[32];
    const float* wp = W + (size_t)(k0 + (lane >> 5)) * N + n0 + (lane & 31);
#pragma unroll
    for (int i = 0; i < 32; ++i) tv[i] = wp[(size_t)(2 * i) * N];
#pragma unroll
    for (int i = 0; i < 32; ++i) scr[(2 * i + (lane >> 5)) * 33 + (lane & 31)] = tv[i];
    LDS_WAIT(); asm volatile("" ::: "memory");
    const int c = lane & 7;
#pragma unroll
    for (int j = 0; j < 4; ++j) { const int n = (lane >> 3) + 8 * j; const LAS float* s = scr + (8 * c) * 33 + n;
        u32x2 o; o.x = pk4_fp8(s[0 * 33] * sc, s[1 * 33] * sc, s[2 * 33] * sc, s[3 * 33] * sc); o.y = pk4_fp8(s[4 * 33] * sc, s[5 * 33] * sc, s[6 * 33] * sc, s[7 * 33] * sc);
        *(u32x2*)(WT + (size_t)(drow0 + n) * ldk + k0 + 8 * c) = o; }
    LDS_WAIT(); asm volatile("" ::: "memory");
}
__device__ __forceinline__ void p_down_items(Frame& F, int first, int count, int stride);
__device__ __forceinline__ void p_down_items(Frame& F, int first, int count, int stride) {
    LAS float* scr = (LAS float*)(F.lds + F.wave * 16384);
    for (int k = 0; k < count; ++k) { const int r = first + k * stride; if (r >= 16 * 44 * 32) break;
        const int e = r / (44 * 32), q = r % (44 * 32), kb = q / 32, nb = q % 32;
        tr_item_f8(inptr(F, I_WD) + (size_t)e * FF * DM, DM, (unsigned char*)(F.ws + WS_WDT) + (size_t)e * DM * FF, FF, kb * 64, nb * 32, nb * 32, WD_SCALE, scr, F.lane); }
}
constexpr int DN_P4 = 3 * 6 * 256, DN_P9 = 10 * 8 * 128, DN_P3 = 4 * 8 * 96, DN_P0 = 22528 - DN_P4 - DN_P9 - DN_P3;
__device__ __forceinline__ void p0_adaln_item(Frame& F, int item) {
    LAS float* sl = (LAS float*)F.lds;
    LAS float* part = sl + 9 * 1024;
    for (int i = F.tid; i < 9 * 1024; i += NTHR) { const int r = i >> 10, k = i & 1023; const float v = (r < 8) ? inptr(F, I_C)[r * DM + k] : inptr(F, I_CCTX)[k]; sl[i] = siluf_(v); }
    __syncthreads();
    const int cl = F.tid & 31, kq = F.tid >> 5, j = item * 32 + cl;
    float a[9];
#pragma unroll
    for (int r = 0; r < 9; ++r) a[r] = 0.f;
    const float* W = inptr(F, I_MODW);
#pragma unroll 16
    for (int kk = 0; kk < 64; ++kk) { const int k = kq + 16 * kk; const float w = W[(size_t)k * (NMOD * DM) + j];
#pragma unroll
        for (int r = 0; r < 9; ++r) a[r] += sl[r * 1024 + k] * w; }
#pragma unroll
    for (int r = 0; r < 9; ++r) part[(kq * 9 + r) * 32 + cl] = a[r];
    __syncthreads();
    if (F.tid < 9 * 32) { const int r = F.tid >> 5, c2 = F.tid & 31; float s = inptr(F, I_MODB)[item * 32 + c2];
#pragma unroll
        for (int q = 0; q < 16; ++q) s += part[(q * 9 + r) * 32 + c2];
        ((float*)(F.ws + WS_MOD))[(size_t)r * (NMOD * DM) + item * 32 + c2] = s; }
    __syncthreads();
}
__device__ __forceinline__ void p0_s5_tables(Frame& F, int g) {
    typedef float f32x2 __attribute__((ext_vector_type(2)));
    LAS f32x2* PW = (LAS f32x2*)F.lds;
    LAS f32x2* BB = PW + 2 * 33 * 64;
    LAS float* KT = (LAS float*)(BB + 2 * 64 * 16);
    LAS f32x2* CC = (LAS f32x2*)(KT + 2 * 32 * 256);
    const float* lre = inptr(F, I_LRE); const float* lim = inptr(F, I_LIM); const float* lst = inptr(F, I_LSTEP);
    const float* cre = inptr(F, I_CRE); const float* cim = inptr(F, I_CIM);
    for (int i = F.tid; i < 2 * 33 * 64; i += NTHR) { const int dir = i / (33 * 64), e = (i / 64) % 33, p = i & 63;
        const double lr = lre[(dir * NG + g) * NP + p], li = lim[(dir * NG + g) * NP + p], dt = exp((double)lst[dir * NG + g]);
        double ph = li * dt * e; ph -= 6.283185307179586 * floor(ph * 0.15915494309189535);
        const float m = expf((float)(lr * dt * e)); float sn, cs; sincosf((float)ph, &sn, &cs); const float cr = m * cs, ci = m * sn;
        PW[i] = (f32x2){cr, ci};
        if (e == 32) { float* LT = (float*)(F.ws + WS_LT); LT[((dir * NG + g) * NP + p) * 2] = cr; LT[((dir * NG + g) * NP + p) * 2 + 1] = ci; } }
    __syncthreads();
    for (int i = F.tid; i < 2 * 16 * 64; i += NTHR) { const int dir = i >> 10, h = (i >> 6) & 15, p = i & 63; const size_t ci = (((size_t)dir * NG + g) * GH + h) * NP + p; CC[i] = (f32x2){cre[ci], cim[ci]}; }
    for (int i = F.tid; i < 2 * 64 * 16; i += NTHR) { const int dir = i >> 10, p = (i >> 4) & 63, h = i & 15;
        const double lr = lre[(dir * NG + g) * NP + p], li = lim[(dir * NG + g) * NP + p];
        const f32x2 lb = PW[(dir * 33 + 1) * 64 + p]; const double ar = (double)lb.x - 1.0, ai = (double)lb.y, den = lr * lr + li * li;
        const double fr_ = (ar * lr + ai * li) / den, fi_ = (ai * lr - ar * li) / den;
        const size_t bi = (((size_t)dir * NG + g) * NP + p) * GH + h; const double br = inptr(F, I_BRE)[bi], bim = inptr(F, I_BIM)[bi];
        BB[i] = (f32x2){(float)(fr_ * br - fi_ * bim), (float)(fr_ * bim + fi_ * br)}; }
    __syncthreads();
    {
        const int dir = F.tid >> 8, h = (F.tid >> 4) & 15, hp = F.tid & 15;
        for (int d = 0; d < 32; ++d) KT[(dir * 32 + d) * 256 + (F.tid & 255)] = 0.f;
        for (int pc = 0; pc < 4; ++pc) { float qr[16], qi[16];
#pragma unroll
            for (int j = 0; j < 16; ++j) { const int p = pc * 16 + j; const f32x2 cc = CC[(dir * 16 + h) * 64 + p]; const float cr = cc.x, cj = cc.y; const f32x2 b = BB[(dir * 64 + p) * 16 + hp];
                qr[j] = cr * b.x - cj * b.y; qi[j] = cr * b.y + cj * b.x; }
            for (int d = 0; d < 32; ++d) { float s = 0.f;
#pragma unroll
                for (int j = 0; j < 16; ++j) { const f32x2 w = PW[(dir * 33 + d) * 64 + pc * 16 + j]; s += qr[j] * w.x - qi[j] * w.y; }
                KT[(dir * 32 + d) * 256 + (F.tid & 255)] += s; } }
    }
    __syncthreads();
    { float* TAB = (float*)(F.ws + WS_S5TAB) + (size_t)g * S5TAB_FLOATS; const LAS float* src = (const LAS float*)F.lds;
      for (int i = F.tid; i < S5TAB_FLOATS / 4; i += NTHR) ((f32x4*)TAB)[i] = ((const LAS f32x4*)src)[i]; }
    __syncthreads();
}
__device__ __forceinline__ void p1_s5_expand(Frame& F) {
    typedef float f32x2 __attribute__((ext_vector_type(2)));
    const int g = F.bid >> 3, part = F.bid & 7;
    LAS f32x2* PW = (LAS f32x2*)F.lds;
    LAS f32x2* BB = PW + 2 * 33 * 64;
    LAS float* KT = (LAS float*)(BB + 2 * 64 * 16);
    LAS f32x2* CC = (LAS f32x2*)(KT + 2 * 32 * 256);
    { const float* TAB = (const float*)(F.ws + WS_S5TAB) + (size_t)g * S5TAB_FLOATS; LAS float* dst = (LAS float*)F.lds;
      for (int i = F.tid; i < S5TAB_FLOATS / 4; i += NTHR) ((LAS f32x4*)dst)[i] = ((const f32x4*)TAB)[i]; }
    __syncthreads();
    bf16* MCT = (bf16*)(F.ws + WS_MCT) + (size_t)g * 512 * UCOLS;
    for (int pc = F.tid; pc < 64 * 64; pc += NTHR) { const int rw = part * 64 + (pc >> 6), q = pc & 63, tau = rw >> 4, h = rw & 15, s = q >> 1, h0 = (q & 1) * 8;
        float v[8];
#pragma unroll
        for (int j = 0; j < 8; ++j) { float a = 0.f; if (s <= tau) a += KT[(0 * 32 + (tau - s)) * 256 + h * 16 + h0 + j]; if (s >= tau) a += KT[(1 * 32 + (s - tau)) * 256 + h * 16 + h0 + j]; v[j] = a; }
        u32x4 w; w.x = pk2(v[0], v[1]); w.y = pk2(v[2], v[3]); w.z = pk2(v[4], v[5]); w.w = pk2(v[6], v[7]);
        *(u32x4*)(MCT + (size_t)rw * UCOLS + s * 16 + h0) = w; }
    for (int pc = F.tid; pc < 64 * 32; pc += NTHR) { const int rw = part * 64 + (pc >> 5), q = pc & 31, tau = rw >> 4, h = rw & 15, dir = q >> 4, ri = (q >> 3) & 1, p0 = (q & 7) * 8;
        const int e = dir ? (32 - tau) : (tau + 1);
        float v[8];
#pragma unroll
        for (int j = 0; j < 8; ++j) { const int p = p0 + j; const f32x2 cc = CC[(dir * 16 + h) * 64 + p]; const float cr = cc.x, cj = cc.y; const f32x2 w = PW[(dir * 33 + e) * 64 + p];
            v[j] = ri ? -(cr * w.y + cj * w.x) : (cr * w.x - cj * w.y); }
        u32x4 w; w.x = pk2(v[0], v[1]); w.y = pk2(v[2], v[3]); w.z = pk2(v[4], v[5]); w.w = pk2(v[6], v[7]);
        *(u32x4*)(MCT + (size_t)rw * UCOLS + 512 + dir * 128 + ri * 64 + p0) = w; }
    bf16* WAT = (bf16*)(F.ws + WS_WAT) + (size_t)g * 256 * 512;
    for (int pc = F.tid; pc < 32 * 64; pc += NTHR) { const int rw = part * 32 + (pc >> 6), q = pc & 63, dir = rw >> 7, ri = (rw >> 6) & 1, p = rw & 63, s = q >> 1, h0 = (q & 1) * 8;
        const f32x2 w = PW[(dir * 33 + (dir ? s : (31 - s))) * 64 + p];
        float v[8];
#pragma unroll
        for (int j = 0; j < 8; ++j) { const f32x2 b = BB[(dir * 64 + p) * 16 + h0 + j]; v[j] = ri ? (w.x * b.y + w.y * b.x) : (w.x * b.x - w.y * b.y); }
        u32x4 o; o.x = pk2(v[0], v[1]); o.y = pk2(v[2], v[3]); o.z = pk2(v[4], v[5]); o.w = pk2(v[6], v[7]);
        *(u32x4*)(WAT + (size_t)rw * 512 + s * 16 + h0) = o; }
    __syncthreads();
}
__device__ __forceinline__ void p0_filter_l12(Frame& F, int i0, int npos) {
    LAS float* sc = (LAS float*)(F.lds + F.wave * 1024);
    const int j = F.lane;
    const float* hw1 = inptr(F, I_HW1); const float* hw2 = inptr(F, I_HW2); const float* hfq = inptr(F, I_HFREQ);
    float w1c[33], w2c[64];
#pragma unroll
    for (int f = 0; f < 33; ++f) w1c[f] = hw1[f * 64 + j];
#pragma unroll
    for (int k = 0; k < 64; ++k) w2c[k] = hw2[k * 64 + j];
    const float b1 = inptr(F, I_HB1)[j], b2 = inptr(F, I_HB2)[j], f0 = hfq[j], f1 = hfq[64 + j];
    for (int q = 0; q < npos; ++q) { const int i = i0 + q;
        if (j < 33) { const double L = (double)SEQ; double v;
            if (j == 0) v = (double)i / (L - 1.0);
            else { const int k = (j - 1) & 15; const double f = 1e-4 + (double)k * ((15.0 - 1e-4) / 15.0), om = 6.283185307179586 * (double)i / L; v = (j <= 16) ? cos(f * om) : -sin(f * om); }
            sc[j] = (float)v; }
        LDS_WAIT(); asm volatile("" ::: "memory");
        float a = b1;
#pragma unroll
        for (int f = 0; f < 33; ++f) a += sc[f] * w1c[f];
        sc[64 + j] = sinf(f0 * a);
        LDS_WAIT(); asm volatile("" ::: "memory");
        float b = b2;
#pragma unroll
        for (int k = 0; k < 64; ++k) b += sc[64 + k] * w2c[k];
        ((float*)(F.ws + WS_FH2))[(size_t)j * SEQ + i] = sinf(f1 * b);
        LDS_WAIT(); asm volatile("" ::: "memory"); }
}
__device__ __forceinline__ void phase0(Frame& F) {
    if (F.bid < 192) p0_adaln_item(F, F.bid);
    else if (F.bid < 224) p0_s5_tables(F, F.bid - 192);
    else p0_filter_l12(F, (F.bid - 224) * 128 + F.wave * 16, 16);
    __syncthreads();
    p0_transposes(F);
    if (F.bid < 192) p_down_items(F, DN_P4 + DN_P9 + DN_P3 + F.bid * 8 + F.wave, 3, 192 * 8);
}

__device__ __forceinline__ void norm_mod_row(const float* xrow, const float* gam, const float* shift, const float* scale, bf16* orow, int lane) {
    const f32x4* xr = (const f32x4*)xrow + lane;
    f32x4 v[4]; float s = 0.f;
#pragma unroll
    for (int j = 0; j < 4; ++j) { v[j] = xr[64 * j]; s += (v[j].x * v[j].x + v[j].y * v[j].y) + (v[j].z * v[j].z + v[j].w * v[j].w); }
    const float rstd = 1.0f / sqrtf(wave_sum(s) * (1.0f / DM) + NORM_EPS);
    unsigned long long* o8 = (unsigned long long*)orow + lane;
#pragma unroll
    for (int j = 0; j < 4; ++j) { const f32x4 g = ((const f32x4*)gam)[lane + 64 * j], sh = ((const f32x4*)shift)[lane + 64 * j], sc = ((const f32x4*)scale)[lane + 64 * j];
        const f32x4 y = (v[j] * rstd * g) * (sc + 1.0f) + sh;
        o8[64 * j] = (unsigned long long)pk2(y.x, y.y) | ((unsigned long long)pk2(y.z, y.w) << 32); }
}
__device__ __forceinline__ void p1_norm(Frame& F) {
    const int gw = F.bid * NWAVES + F.wave, NGW = F.G * NWAVES;
    const float* mod = (const float*)(F.ws + WS_MOD);
    bf16* H1 = (bf16*)(F.ws + WS_H1);
    for (int r = gw; r < NROWS1; r += NGW) {
        const float* xrow; int mr;
        if (r < NTOK) { xrow = inptr(F, I_X) + (size_t)r * DM; mr = r >> 12; } else { xrow = inptr(F, I_CTX) + (size_t)(r - NTOK) * DM; mr = 8; }
        norm_mod_row(xrow, inptr(F, I_N1G), mod + (size_t)mr * (NMOD * DM), mod + (size_t)mr * (NMOD * DM) + DM, H1 + (size_t)r * DM, F.lane);
    }
}
__device__ __forceinline__ void p1_filter(Frame& F) {
    LAS float* w3s = (LAS float*)F.lds;
    LAS float* b3s = w3s + 512;
    LAS float* red = b3s + 8;
    LAS float* nrm = red + 32;
    const int c0 = F.bid * 2;
    for (int i = F.tid; i < 512; i += NTHR) { const int k = i >> 3, q = i & 7, ch = q >> 2, o = (q >> 1) & 1, dir = q & 1; w3s[i] = inptr(F, I_HW3)[(size_t)k * 2048 + o * 1024 + dir * 512 + c0 + ch]; }
    if (F.tid < 8) { const int q = F.tid, ch = q >> 2, o = (q >> 1) & 1, dir = q & 1; b3s[q] = inptr(F, I_HB3)[o * 1024 + dir * 512 + c0 + ch]; }
    __syncthreads();
    const float* FH2 = (const float*)(F.ws + WS_FH2);
    const double la = -4.605170185988091 / 0.3, lb = -4.605170185988091 / 1.5;
    float delta[2];
#pragma unroll
    for (int ch = 0; ch < 2; ++ch) delta[ch] = (float)fabs(la + (double)(c0 + ch) * (lb - la) / 511.0);
    unsigned char* FILT = F.ws + WS_FILT;
    float asum[4] = {0.f, 0.f, 0.f, 0.f};
    float amx[4] = {0.f, 0.f, 0.f, 0.f};
    unsigned val[8][4];
#pragma unroll
    for (int j = 0; j < 8; ++j) { const int i = F.tid + 512 * j; const float* hr = FH2 + i;
        float a[8];
#pragma unroll
        for (int q = 0; q < 8; ++q) a[q] = b3s[q];
#pragma unroll 16
        for (int k = 0; k < 64; ++k) { const float hvk = hr[(size_t)k * SEQ]; const LAS f32x4* wp = (const LAS f32x4*)(w3s + k * 8); const f32x4 wa = wp[0], wb = wp[1];
            a[0] += hvk * wa.x; a[1] += hvk * wa.y; a[2] += hvk * wa.z; a[3] += hvk * wa.w; a[4] += hvk * wb.x; a[5] += hvk * wb.y; a[6] += hvk * wb.z; a[7] += hvk * wb.w; }
        const float t = (float)i * (1.0f / 4095.0f);
#pragma unroll
        for (int q = 0; q < 8; ++q) { const int ch = q >> 2, dir = q & 1; const float v = a[q] * expf(-t * delta[ch]); a[q] = v; if (dir == 0 || i != 0) { asum[q >> 1] += fabsf(v); amx[q >> 1] = fmaxf(amx[q >> 1], fabsf(v)); } }
#pragma unroll
        for (int q = 0; q < 4; ++q) val[j][q] = pk2(a[2 * q], a[2 * q + 1]);
        asm volatile("" ::: "memory"); }
#pragma unroll
    for (int q = 0; q < 4; ++q) { const float s2 = wave_sum(asum[q]); float m2 = amx[q];
#pragma unroll
        for (int o = 32; o >= 1; o >>= 1) m2 = fmaxf(m2, __shfl_xor(m2, o));
        if (F.lane == 0) { red[F.wave * 4 + q] = s2; red[32 + 8 + F.wave * 4 + q] = m2; } }
    __syncthreads();
    if (F.tid < 4) { float s2 = 0.f, m2 = 0.f; for (int w = 0; w < 8; ++w) { s2 += red[w * 4 + F.tid]; m2 = fmaxf(m2, red[32 + 8 + w * 4 + F.tid]); }
        const float inv = 1.0f / s2; const int p = (int)((__float_as_uint(m2 * inv) >> 23) & 255u) - 127, e = 7 - p;
        nrm[F.tid] = inv * __uint_as_float((unsigned)(127 + e) << 23);
        const int ch = F.tid >> 1, o = F.tid & 1; ((int*)(F.ws + WS_FSC))[o * HYW + c0 + ch] = 127 - e; }
    __syncthreads();
#pragma unroll
    for (int j = 0; j < 8; ++j) { const int i = F.tid + 512 * j;
#pragma unroll
        for (int q = 0; q < 8; ++q) { const int ch = q >> 2, o = (q >> 1) & 1, dir = q & 1; const float sc = nrm[ch * 2 + o]; unsigned char* G = FILT + ((size_t)o * HYW + c0 + ch) * F8GS;
            const float fv = ((q & 1) ? bfhi(val[j][q >> 1]) : bflo(val[j][q >> 1])) * sc; const unsigned char hv = (unsigned char)(__builtin_amdgcn_cvt_pk_fp8_f32(fv, fv, 0, false) & 0xff);
            if (dir == 0) G[FC0 - i] = hv; else if (i != 0) G[FC0 + i] = hv; } }
    for (int i = F.tid; i < 4 * (F8LEN - 8191); i += NTHR) { const int a = i / (F8LEN - 8191), x = i % (F8LEN - 8191); const int ch = a >> 1, o = a & 1; unsigned char* G = FILT + ((size_t)o * HYW + c0 + ch) * F8GS;
        const int xx = (x < FC0 - 4095) ? x : (x - (FC0 - 4095) + FC0 + 4096); G[xx] = 0; }
    __syncthreads();
}
__device__ __forceinline__ void phase1(Frame& F) { p1_s5_expand(F); p1_filter(F); p1_norm(F); }

constexpr int HY_USTRIDE = 4368, HY_UOFF = 272, HY_G0 = 35328;
__device__ __forceinline__ i32x8 hy_ldA(const LAS unsigned char* p) { const LAS int* q = (const LAS int*)p; i32x8 v; v[0] = q[0]; v[1] = q[1]; v[2] = q[2]; v[3] = q[3]; v[4] = q[4]; v[5] = q[5]; v[6] = q[6]; v[7] = q[7]; return v; }
__device__ __forceinline__ i32x8 hy_ldB(const LAS unsigned char* p) { const u32x4 a = *(const LAS u32x4*)p, b = *(const LAS u32x4*)(p + 16); return (i32x8){(int)a.x, (int)a.y, (int)a.z, (int)a.w, (int)b.x, (int)b.y, (int)b.z, (int)b.w}; }
constexpr int HT_IG2 = 2 * 16 * 16 * 88, HT_TOTAL = 2 * HT_IG2, HT_PER_WAVE = 48, HT_SCR = 102400;
struct HyTr { const float* wg; const float* wu; bf16* wgut; LAS float* scr; int base; int lane; float tv[2][16]; };
__device__ __forceinline__ void hytr_issue(HyTr& T, int slot) {
#pragma unroll
    for (int j = 0; j < 2; ++j) { const int h = T.base + slot * 2 + j;
        if (h < HT_TOTAL) { const int up = h >= HT_IG2, r = up ? h - HT_IG2 : h, e = r / (32 * 88), q = r % (32 * 88), kb = q / 88, nb = q % 88;
            const float* wp = (up ? T.wu : T.wg) + (size_t)e * DM * FF + (size_t)(kb * 32 + (T.lane >> 5)) * FF + nb * 32 + (T.lane & 31);
#pragma unroll
            for (int i = 0; i < 16; ++i) T.tv[j][i] = wp[(size_t)(2 * i) * FF]; } }
}
__device__ __forceinline__ void hytr_finish(HyTr& T, int slot) {
#pragma unroll
    for (int j = 0; j < 2; ++j) { const int h = T.base + slot * 2 + j;
        if (h < HT_TOTAL) { const int up = h >= HT_IG2, r = up ? h - HT_IG2 : h, e = r / (32 * 88), q = r % (32 * 88), kb = q / 88, nb = q % 88, n0 = nb * 32;
            bf16* WT = (bf16*)((unsigned char*)T.wgut + (size_t)e * (2 * FF) * DM); const int drow0 = 256 * (n0 >> 7) + (n0 & 127) + (up ? 128 : 0);
#pragma unroll
            for (int i = 0; i < 16; ++i) T.scr[(2 * i + (T.lane >> 5)) * 33 + (T.lane & 31)] = T.tv[j][i];
            LDS_WAIT(); asm volatile("" ::: "memory");
            const int c = T.lane & 3;
#pragma unroll
            for (int p = 0; p < 2; ++p) { const int n = (T.lane >> 2) + 16 * p; const LAS float* sp = T.scr + (8 * c) * 33 + n;
                u32x2 o; o.x = pk4_fp8(sp[0 * 33] * WGU_SCALE, sp[1 * 33] * WGU_SCALE, sp[2 * 33] * WGU_SCALE, sp[3 * 33] * WGU_SCALE); o.y = pk4_fp8(sp[4 * 33] * WGU_SCALE, sp[5 * 33] * WGU_SCALE, sp[6 * 33] * WGU_SCALE, sp[7 * 33] * WGU_SCALE);
                *(u32x2*)((unsigned char*)WT + (size_t)(drow0 + n) * DM + kb * 32 + 8 * c) = o; }
            LDS_WAIT(); asm volatile("" ::: "memory"); } }
}
__device__ __forceinline__ void hy_conv(const LAS unsigned char* lds, int w, int lane, f32x16 (&acc)[4], HyTr& T, int slot0, int fsc_s) {
    const int r = lane & 31, hh = lane >> 5, n = lane & 31, b = n >> 2, i = n & 3;
    const LAS unsigned char* abase = lds + HY_G0 + (r & 3) * F8LEN + (FC0 - 4 * (r >> 2) + 32 * hh) - 512 * w;
    const LAS unsigned char* bbase = lds + HY_UOFF + b * HY_USTRIDE + 64 * i + 32 * hh;
    int sc1 = 127, fsc = fsc_s; asm volatile("" : "+v"(sc1), "+v"(fsc));
#pragma unroll
    for (int q = 0; q < 4; ++q)
#pragma unroll
        for (int j = 0; j < 16; ++j) acc[q][j] = 0.f;
#define HY_M1(ACC, AF, BF) asm volatile("v_mfma_scale_f32_32x32x64_f8f6f4 %0, %1, %2, %0, %3, %4 op_sel_hi:[0,0,0]" : "+v"(ACC) : "v"(AF), "v"(BF), "v"(fsc), "v"(sc1))
#define HY_MM(O0, O1, N0, N1, BB) do { HY_M1(acc[0], O0, BB); HY_M1(acc[1], O1, BB); HY_M1(acc[2], N0, BB); HY_M1(acc[3], N1, BB); } while (0)
#define HY_ST3() do { \
            Z0 = hy_ldA(pa - 512); Z1 = hy_ldA(pa - 544); Ub = hy_ldB(pb - 256); HY_MM(X0, X1, Y0, Y1, Ua); \
            X0 = hy_ldA(pa - 768); X1 = hy_ldA(pa - 800); Uc = hy_ldB(pb - 512); HY_MM(Y0, Y1, Z0, Z1, Ub); \
            Y0 = hy_ldA(pa - 1024); Y1 = hy_ldA(pa - 1056); Ua = hy_ldB(pb - 768); HY_MM(Z0, Z1, X0, X1, Uc); \
            pa -= 768; pb -= 768; } while (0)
#pragma unroll 1
    for (int rho = 0; rho < 4; ++rho) {
        const LAS unsigned char* pa = abase + 64 * (60 + rho);
        const LAS unsigned char* pb = bbase + 64 * (60 + rho);
        i32x8 X0, X1, Y0, Y1, Z0, Z1, Ua, Ub, Uc;
        if (rho < 3) hytr_issue(T, slot0 + 2 * rho);
        X0 = hy_ldA(pa); X1 = hy_ldA(pa - 32); Y0 = hy_ldA(pa - 256); Y1 = hy_ldA(pa - 288); Ua = hy_ldB(pb);
#pragma unroll 1
        for (int k = 0; k < 2; ++k) HY_ST3();
        if (rho < 3) { hytr_finish(T, slot0 + 2 * rho); hytr_issue(T, slot0 + 2 * rho + 1); }
#pragma unroll 1
        for (int k = 0; k < 3; ++k) HY_ST3();
        Z0 = hy_ldA(pa - 512); Z1 = hy_ldA(pa - 544); Ub = hy_ldB(pb - 256); HY_MM(X0, X1, Y0, Y1, Ua);
        HY_MM(Y0, Y1, Z0, Z1, Ub);
        if (rho < 3) hytr_finish(T, slot0 + 2 * rho + 1);
    }
    asm volatile("s_nop 15\n\ts_nop 15" ::: "memory");
#undef HY_ST3
#undef HY_MM
#undef HY_M1
}
__device__ __forceinline__ void hy_load_filter(Frame& F, const unsigned char* G) {
    LAS unsigned char* lds = F.lds;
#pragma unroll
    for (int k = 0; k < 2; ++k) { const int i = F.tid + k * NTHR;
        if (i < F8LEN / 16) { const u32x4 v = *(const u32x4*)(G + 16 * i); const unsigned pv = i ? *(const unsigned*)(G + 16 * i - 4) : 0u;
            *(LAS u32x4*)(lds + HY_G0 + 16 * i) = v;
            *(LAS u32x4*)(lds + HY_G0 + 1 * F8LEN + 16 * i) = (u32x4){__builtin_amdgcn_alignbyte(v.x, pv, 3), __builtin_amdgcn_alignbyte(v.y, v.x, 3), __builtin_amdgcn_alignbyte(v.z, v.y, 3), __builtin_amdgcn_alignbyte(v.w, v.z, 3)};
            *(LAS u32x4*)(lds + HY_G0 + 2 * F8LEN + 16 * i) = (u32x4){__builtin_amdgcn_alignbyte(v.x, pv, 2), __builtin_amdgcn_alignbyte(v.y, v.x, 2), __builtin_amdgcn_alignbyte(v.z, v.y, 2), __builtin_amdgcn_alignbyte(v.w, v.z, 2)};
            *(LAS u32x4*)(lds + HY_G0 + 3 * F8LEN + 16 * i) = (u32x4){__builtin_amdgcn_alignbyte(v.x, pv, 1), __builtin_amdgcn_alignbyte(v.y, v.x, 1), __builtin_amdgcn_alignbyte(v.z, v.y, 1), __builtin_amdgcn_alignbyte(v.w, v.z, 1)}; } }
}
__device__ __forceinline__ u32x4 hy_ld_piece(const bf16* p) { const unsigned* pp = (const unsigned*)(p - 2); u32x4 v; v.x = pp[0]; v.y = pp[1]; v.z = pp[2]; v.w = pp[3]; return v; }
__device__ __forceinline__ f32x4 hy_sconv4r(u32x4 z, bool lz, bool rz, float w0, float w1, float w2, float cb) {
    const float zl = lz ? 0.f : bfhi(z.x), zr = rz ? 0.f : bflo(z.w), e0 = bflo(z.y), e1 = bfhi(z.y), e2 = bflo(z.z), e3 = bfhi(z.z);
    return (f32x4){w0 * zl + w1 * e0 + w2 * e1 + cb, w0 * e0 + w1 * e1 + w2 * e2 + cb, w0 * e1 + w1 * e2 + w2 * e3 + cb, w0 * e2 + w1 * e3 + w2 * zr + cb};
}
__device__ __forceinline__ float hy_cl(float v) { return fminf(fmaxf(v, -448.f), 448.f); }
__device__ __forceinline__ void hyena_channel(Frame& F, int c, int citer) {
    LAS unsigned char* lds = F.lds;
    const int tid = F.tid, lane = F.lane, w = F.wave;
    HyTr T; T.wg = inptr(F, I_WG); T.wu = inptr(F, I_WU); T.wgut = (bf16*)(F.ws + WS_WGUT); T.scr = (LAS float*)(F.lds + HT_SCR + w * 4224); T.base = (F.bid * NWAVES + w) * HT_PER_WAVE; T.lane = lane;
    bf16* ZT = (bf16*)(F.ws + WS_ZT);
    const unsigned char* FILT = F.ws + WS_FILT; const int* FSC = (const int*)(F.ws + WS_FSC);
    bf16* VS = (bf16*)(F.ws + WS_VS) + (size_t)F.bid * (8 * SEQ);
    const float* cw = inptr(F, I_CONVW); const float* cbp = inptr(F, I_CONVB);
    const int fs0 = __builtin_amdgcn_readfirstlane(__hip_atomic_load(FSC + c, __ATOMIC_RELAXED, __HIP_MEMORY_SCOPE_AGENT)), fs1 = __builtin_amdgcn_readfirstlane(__hip_atomic_load(FSC + HYW + c, __ATOMIC_RELAXED, __HIP_MEMORY_SCOPE_AGENT));
    for (int i = tid; i < HY_G0 / 16; i += NTHR) *(LAS u32x4*)(lds + 16 * i) = (u32x4){0u, 0u, 0u, 0u};
    __syncthreads();
    {
        const float w0 = cw[c], w1 = cw[HYC + c], w2 = cw[2 * HYC + c], cb = cbp[c];
#pragma unroll 2
        for (int b = 0; b < 8; ++b) { const bf16* zr = ZT + (size_t)c * NTOK + b * SEQ + 8 * tid;
            const u32x4 z = *(const u32x4*)zr;
            const float zl = (tid & 7) ? bf2f(zr[-1]) : 0.f, zrt = ((tid & 7) != 7) ? bf2f(zr[8]) : 0.f;
            float e[10]; e[0] = zl; e[1] = bflo(z.x); e[2] = bfhi(z.x); e[3] = bflo(z.y); e[4] = bfhi(z.y); e[5] = bflo(z.z); e[6] = bfhi(z.z); e[7] = bflo(z.w); e[8] = bfhi(z.w); e[9] = zrt;
            float o[8];
#pragma unroll
            for (int j = 0; j < 8; ++j) o[j] = w0 * e[j] + w1 * e[j + 1] + w2 * e[j + 2] + cb;
            u32x4 pk; pk.x = pk2(o[0], o[1]); pk.y = pk2(o[2], o[3]); pk.z = pk2(o[4], o[5]); pk.w = pk2(o[6], o[7]);
            *(u32x4*)(VS + b * SEQ + 8 * tid) = pk;
            u32x2 p8; p8.x = pk4_fp8(hy_cl(o[0]), hy_cl(o[1]), hy_cl(o[2]), hy_cl(o[3])); p8.y = pk4_fp8(hy_cl(o[4]), hy_cl(o[5]), hy_cl(o[6]), hy_cl(o[7]));
            *(LAS u32x2*)(lds + HY_UOFF + b * HY_USTRIDE + 8 * tid) = p8; }
    }
    hy_load_filter(F, FILT + ((size_t)0 * HYW + c) * F8GS);
    __syncthreads();
    f32x16 acc[4];
    hy_conv(lds, w, lane, acc, T, (citer * 2 + 0) * 6, fs0);
#ifdef DBG_CONV_SCALE
    for (int q = 0; q < 4; ++q) for (int j = 0; j < 16; ++j) acc[q][j] *= DBG_CONV_SCALE;
#endif
    __syncthreads();
    hy_load_filter(F, FILT + ((size_t)1 * HYW + c) * F8GS);
    const int n = lane & 31, hh = lane >> 5, b = n >> 2, ii = n & 3;
    {
        const float w0 = cw[HYW + c], w1 = cw[HYC + HYW + c], w2 = cw[2 * HYC + HYW + c], cb = cbp[HYW + c], bias = inptr(F, I_HBIAS)[c];
        const int tl = 512 * w + 64 * ii + 4 * hh;
        const bf16* zrow = ZT + (size_t)(HYW + c) * NTOK + b * SEQ + tl;
        bf16* vrow = VS + b * SEQ + tl;
#pragma unroll
        for (int hq = 0; hq < 2; ++hq) {
        u32x4 zp[8]; u32x2 vp[8];
#pragma unroll
        for (int g = 0; g < 8; ++g) { const int toff = 32 * (g >> 2) + 256 * hq + 8 * (g & 3); zp[g] = hy_ld_piece(zrow + toff); vp[g] = *(const u32x2*)(vrow + toff); }
#pragma unroll
        for (int q = 2 * hq; q < 2 * hq + 2; ++q) {
#pragma unroll
            for (int rg = 0; rg < 4; ++rg) { const int toff = 32 * (q & 1) + 256 * (q >> 1) + 8 * rg;
                const f32x4 x1 = hy_sconv4r(zp[(q & 1) * 4 + rg], (q & 1) == 0 && rg == 0 && hh == 0, (q & 1) == 1 && rg == 3 && hh == 1, w0, w1, w2, cb);
                const u32x2 uv = vp[(q & 1) * 4 + rg];
                const float y0 = x1[0] * (acc[q][4 * rg + 0] + bias * bflo(uv.x)), y1 = x1[1] * (acc[q][4 * rg + 1] + bias * bfhi(uv.x));
                const float y2 = x1[2] * (acc[q][4 * rg + 2] + bias * bflo(uv.y)), y3 = x1[3] * (acc[q][4 * rg + 3] + bias * bfhi(uv.y));
                u32x2 o; o.x = pk2(y0, y1); o.y = pk2(y2, y3); *(u32x2*)(vrow + toff) = o;
                *(LAS unsigned*)(lds + HY_UOFF + b * HY_USTRIDE + tl + toff) = pk4_fp8(hy_cl(y0), hy_cl(y1), hy_cl(y2), hy_cl(y3)); }
            asm volatile("" ::: "memory"); } }
    }
    __syncthreads();
    hy_conv(lds, w, lane, acc, T, (citer * 2 + 1) * 6, fs1);
#ifdef DBG_CONV_SCALE
    for (int q = 0; q < 4; ++q) for (int j = 0; j < 16; ++j) acc[q][j] *= DBG_CONV_SCALE;
#endif
    {
        const float w0 = cw[2 * HYW + c], w1 = cw[HYC + 2 * HYW + c], w2 = cw[2 * HYC + 2 * HYW + c], cb = cbp[2 * HYW + c], bias = inptr(F, I_HBIAS)[HYW + c];
        const int tl = 512 * w + 64 * ii + 4 * hh;
        const bf16* zrow = ZT + (size_t)(2 * HYW + c) * NTOK + b * SEQ + tl;
        const bf16* vrow = VS + b * SEQ + tl;
        bf16* orow = (bf16*)(F.ws + WS_YHT) + (size_t)c * NTOK + b * SEQ + tl;
#pragma unroll
        for (int hq = 0; hq < 2; ++hq) {
        u32x4 zp[8]; u32x2 vp[8];
#pragma unroll
        for (int g = 0; g < 8; ++g) { const int toff = 32 * (g >> 2) + 256 * hq + 8 * (g & 3); zp[g] = hy_ld_piece(zrow + toff); vp[g] = *(const u32x2*)(vrow + toff); }
#pragma unroll
        for (int q = 2 * hq; q < 2 * hq + 2; ++q) {
#pragma unroll
            for (int rg = 0; rg < 4; ++rg) { const int toff = 32 * (q & 1) + 256 * (q >> 1) + 8 * rg;
                const f32x4 x2 = hy_sconv4r(zp[(q & 1) * 4 + rg], (q & 1) == 0 && rg == 0 && hh == 0, (q & 1) == 1 && rg == 3 && hh == 1, w0, w1, w2, cb);
                const u32x2 uv = vp[(q & 1) * 4 + rg];
                const float y0 = x2[0] * (acc[q][4 * rg + 0] + bias * bflo(uv.x)), y1 = x2[1] * (acc[q][4 * rg + 1] + bias * bfhi(uv.x));
                const float y2 = x2[2] * (acc[q][4 * rg + 2] + bias * bflo(uv.y)), y3 = x2[3] * (acc[q][4 * rg + 3] + bias * bfhi(uv.y));
                u32x2 o; o.x = pk2(y0, y1); o.y = pk2(y2, y3); *(u32x2*)(orow + toff) = o; }
            asm volatile("" ::: "memory"); } }
    }
    __syncthreads();
}

__device__ __forceinline__ void phase_carry(Frame& F) {
    if (F.tid >= 128) { const int wv = F.bid * 6 + (F.wave - 2); p_down_items(F, wv, 3, 6 * 256); return; }
    const int g = F.bid >> 3, b = F.bid & 7, dir = F.tid >> 6, p = F.tid & 63;
    const float* EB = (const float*)(F.ws + WS_EB) + (size_t)g * UROWS * 256 + dir * 128 + p;
    bf16* UG = (bf16*)(F.ws + WS_UG) + (size_t)g * UROWS * UCOLS + 512 + dir * 128 + p;
    const float* LT = (const float*)(F.ws + WS_LT) + ((dir * NG + g) * NP + p) * 2;
    const float lr = LT[0], li = LT[1];
    float xr = 0.f, xi = 0.f;
    {   float er[8], ei[8];
#pragma unroll
        for (int k = 0; k < 8; ++k) { const int c = dir ? (7 - k) : k; const float* e = EB + (size_t)(1024 + b * 8 + c) * 256; er[k] = e[0]; ei[k] = e[64]; }
#pragma unroll
        for (int k = 0; k < 8; ++k) { const float nr = lr * xr - li * xi + er[k], ni = lr * xi + li * xr + ei[k]; xr = nr; xi = ni; }
    }
#pragma unroll 1
    for (int c8 = 0; c8 < 4; ++c8) { float er[32], ei[32];
#pragma unroll
        for (int k = 0; k < 32; ++k) { const int c = dir ? (127 - (c8 * 32 + k)) : (c8 * 32 + k); const float* e = EB + (size_t)(b * 128 + c) * 256; er[k] = e[0]; ei[k] = e[64]; }
#pragma unroll
        for (int k = 0; k < 32; ++k) { const int c = dir ? (127 - (c8 * 32 + k)) : (c8 * 32 + k); bf16* u = UG + (size_t)(b * 128 + c) * UCOLS; u[0] = (bf16)f2bf(xr); u[64] = (bf16)f2bf(xi);
            const float nr = lr * xr - li * xi + er[k], ni = lr * xi + li * xr + ei[k]; xr = nr; xi = ni; }
    }
}

__device__ __forceinline__ void phase_tr_hy(Frame& F) {
    LAS unsigned char* lds = F.lds;
    const bf16* ZT = (const bf16*)(F.ws + WS_YHT); bf16* YCAT = (bf16*)(F.ws + WS_YCAT);
    constexpr int S = 132;
    for (int pass = 0; pass < 2; ++pass) { const int tok0 = F.bid * 128 + pass * 64;
        for (int pc = F.tid; pc < 4096; pc += NTHR) { const int ch = pc >> 3, gq = pc & 7; const u32x4 v = *(const u32x4*)(ZT + (size_t)ch * NTOK + tok0 + 8 * gq);
            LAS unsigned* d = (LAS unsigned*)(lds + ch * S + 16 * gq); d[0] = v.x; d[1] = v.y; d[2] = v.z; d[3] = v.w; }
        __syncthreads();
        for (int it = 0; it < 8; ++it) { const int tok = it * 8 + (F.lane & 7), cg = F.wave * 8 + (F.lane >> 3);
            const LAS unsigned short* s = (const LAS unsigned short*)(lds + (8 * cg) * S + 2 * tok);
            unsigned e[8];
#pragma unroll
            for (int j = 0; j < 8; ++j) e[j] = s[j * (S / 2)];
            u32x4 o; o.x = e[0] | (e[1] << 16); o.y = e[2] | (e[3] << 16); o.z = e[4] | (e[5] << 16); o.w = e[6] | (e[7] << 16);
#ifdef DBG_HY_SCALE
            for (int j = 0; j < 8; ++j) e[j] = f2bf(bf2f(e[j]) * DBG_HY_SCALE);
            o.x = e[0] | (e[1] << 16); o.y = e[2] | (e[3] << 16); o.z = e[4] | (e[5] << 16); o.w = e[6] | (e[7] << 16);
#endif
            *(u32x4*)(YCAT + (size_t)(tok0 + tok) * DM + 8 * cg) = o; }
        __syncthreads();
    }
}

__device__ __forceinline__ void phase_norm2(Frame& F) {
    LAS float* rwT = (LAS float*)F.lds;
    for (int i = F.tid; i < 16 * 1024; i += NTHR) { const int e = i >> 10, k = i & 1023; rwT[i] = inptr(F, I_RW)[k * NE + e]; }
    __syncthreads();
    const int gw = F.bid * NWAVES + F.wave, NGW = F.G * NWAVES, lane = F.lane;
    const float* mod = (const float*)(F.ws + WS_MOD); const float* xm = F.out;
    bf16* H2 = (bf16*)(F.ws + WS_H2); float* AFF = (float*)(F.ws + WS_AFF);
    for (int r = gw; r < NTOK; r += NGW) { const int b = r >> 12, t = r & 4095;
        const f32x4* xr = (const f32x4*)(xm + (size_t)r * DM) + lane;
        f32x4 v[4]; float s = 0.f;
#pragma unroll
        for (int j = 0; j < 4; ++j) { v[j] = xr[64 * j]; s += (v[j].x * v[j].x + v[j].y * v[j].y) + (v[j].z * v[j].z + v[j].w * v[j].w); }
        const float rstd = 1.0f / sqrtf(wave_sum(s) * (1.0f / DM) + NORM_EPS);
        const float* mb = mod + (size_t)b * (NMOD * DM);
        unsigned* o4 = (unsigned*)((unsigned char*)H2 + (size_t)r * DM) + lane;
#pragma unroll
        for (int j = 0; j < 4; ++j) { const f32x4 g = ((const f32x4*)inptr(F, I_N2G))[lane + 64 * j], sh = ((const f32x4*)(mb + 3 * DM))[lane + 64 * j], sc = ((const f32x4*)(mb + 4 * DM))[lane + 64 * j];
            v[j] = (v[j] * rstd * g) * (sc + 1.0f) + sh;
            o4[64 * j] = pk4_fp8(v[j].x, v[j].y, v[j].z, v[j].w); }
        float a16[16];
#pragma unroll
        for (int e = 0; e < 16; ++e) { float a = 0.f;
#pragma unroll
            for (int j = 0; j < 4; ++j) { const f32x4 wv = *(const LAS f32x4*)(rwT + e * 1024 + 4 * lane + 256 * j); a += (v[j].x * wv.x + v[j].y * wv.y) + (v[j].z * wv.z + v[j].w * wv.w); }
            a16[e] = a; if ((e & 1) == 1) asm volatile("" ::: "memory"); }
        float a8[8], a4[4], a2[2], mine;
        { const bool up = (lane & 32) != 0;
#pragma unroll
          for (int e = 0; e < 8; ++e) { const float keep = up ? a16[e + 8] : a16[e], send = up ? a16[e] : a16[e + 8]; a8[e] = keep + __shfl_xor(send, 32); } }
        { const bool up = (lane & 16) != 0;
#pragma unroll
          for (int e = 0; e < 4; ++e) { const float keep = up ? a8[e + 4] : a8[e], send = up ? a8[e] : a8[e + 4]; a4[e] = keep + __shfl_xor(send, 16); } }
        { const bool up = (lane & 8) != 0;
#pragma unroll
          for (int e = 0; e < 2; ++e) { const float keep = up ? a4[e + 2] : a4[e], send = up ? a4[e] : a4[e + 2]; a2[e] = keep + __shfl_xor(send, 8); } }
        { const bool up = (lane & 4) != 0; const float keep = up ? a2[1] : a2[0], send = up ? a2[0] : a2[1]; mine = keep + __shfl_xor(send, 4); }
        mine += __shfl_xor(mine, 2); mine += __shfl_xor(mine, 1);
        float mx = mine;
#pragma unroll
        for (int o = 4; o < 64; o <<= 1) mx = fmaxf(mx, __shfl_xor(mx, o));
        mine = expf(mine - mx);
        float den = mine;
#pragma unroll
        for (int o = 4; o < 64; o <<= 1) den += __shfl_xor(den, o);
        if ((lane & 3) == 0) { const int ex = (lane >> 2) & 15; AFF[((size_t)b * NE + ex) * SEQ + t] = mine / den; }
    }
    __syncthreads();
}

__device__ __forceinline__ int block_sum_i(LAS int* red, int v, int wave, int lane, int slot) {
#pragma unroll
    for (int o = 1; o < 64; o <<= 1) v += __shfl_xor(v, o);
    if (lane == 0) red[slot * 8 + wave] = v;
    __syncthreads();
    int s = 0;
#pragma unroll
    for (int w = 0; w < 8; ++w) s += red[slot * 8 + w];
    return s;
}
__device__ __forceinline__ void phase_topk(Frame& F) {
    if (F.bid >= NB * NE) { const int wv = (F.bid - 128) * 8 + F.wave; p_down_items(F, DN_P4 + wv, 10, 8 * 128); return; }
    const int b = F.bid >> 4, e = F.bid & 15, tid = F.tid, lane = F.lane, wave = F.wave;
    LAS int* red = (LAS int*)F.lds;
    LAS int* wtot = red + 16;
    const float* aff = (const float*)(F.ws + WS_AFF) + ((size_t)b * NE + e) * SEQ + 8 * tid;
    unsigned key[8];
#ifndef DBG_PLAIN_AFF
#pragma unroll
    for (int j = 0; j < 8; ++j) key[j] = __hip_atomic_load((const unsigned*)aff + j, __ATOMIC_RELAXED, __HIP_MEMORY_SCOPE_AGENT);
#else
    { const f32x4 a0 = *(const f32x4*)aff, a1 = *(const f32x4*)(aff + 4);
    key[0] = __builtin_bit_cast(unsigned, a0.x); key[1] = __builtin_bit_cast(unsigned, a0.y); key[2] = __builtin_bit_cast(unsigned, a0.z); key[3] = __builtin_bit_cast(unsigned, a0.w);
    key[4] = __builtin_bit_cast(unsigned, a1.x); key[5] = __builtin_bit_cast(unsigned, a1.y); key[6] = __builtin_bit_cast(unsigned, a1.z); key[7] = __builtin_bit_cast(unsigned, a1.w); }
#endif
    unsigned prefix = 0u; int it = 0;
    for (int bit = 30; bit >= 0; --bit, ++it) { const unsigned cand = prefix | (1u << bit); int c = 0;
#pragma unroll
        for (int j = 0; j < 8; ++j) c += __builtin_popcountll(__ballot(key[j] >= cand));
        if (lane == 0) red[(it & 1) * 8 + wave] = c;
        __syncthreads();
        int tot = 0;
#pragma unroll
        for (int w2 = 0; w2 < 8; ++w2) tot += red[(it & 1) * 8 + w2];
        if (tot >= CAP) prefix = cand; }
    const unsigned thr = prefix;
    int cgt = 0, ceq = 0;
#pragma unroll
    for (int j = 0; j < 8; ++j) { cgt += (key[j] > thr) ? 1 : 0; ceq += (key[j] == thr) ? 1 : 0; }
    int sg = cgt, se = ceq;
#pragma unroll
    for (int o = 1; o < 64; o <<= 1) { const int tg = __shfl_up(sg, o), te = __shfl_up(se, o); if (lane >= o) { sg += tg; se += te; } }
    __syncthreads();
    if (lane == 63) { wtot[wave] = sg; wtot[8 + wave] = se; }
    __syncthreads();
    int bg = 0, be = 0, totg = 0;
#pragma unroll
    for (int w2 = 0; w2 < 8; ++w2) { const int g2 = wtot[w2], e2 = wtot[8 + w2]; if (w2 < wave) { bg += g2; be += e2; } totg += g2; }
    int rg = bg + sg - cgt, re = be + se - ceq;
    const int need_eq = CAP - totg;
    int* IDX = (int*)(F.ws + WS_IDX); float* GATE = (float*)(F.ws + WS_GATE); int* INV = (int*)(F.ws + WS_INV);
    const size_t rowbase = ((size_t)e * NB + b) * CAP;
#pragma unroll
    for (int j = 0; j < 8; ++j) { const int t = 8 * tid + j; int slot = -1;
        if (key[j] > thr) { slot = rg; ++rg; } else if (key[j] == thr) { if (re < need_eq) slot = totg + re; ++re; }
        if (slot >= 0) { IDX[rowbase + slot] = b * SEQ + t; GATE[rowbase + slot] = __builtin_bit_cast(float, key[j]); }
        INV[((size_t)b * SEQ + t) * NE + e] = slot; }
}

__device__ __forceinline__ void final_accum(const bf16* Y, int b, unsigned long long mask, int myinv, int lane, f32x4 (&mo)[4]) {
    while (mask) { const int e = __builtin_ctzll(mask); mask &= mask - 1; const int s = __shfl(myinv, e);
        const unsigned long long* yr = (const unsigned long long*)(Y + (((size_t)e * NB + b) * CAP + s) * DM) + lane;
        unsigned long long w[4];
#pragma unroll
        for (int j = 0; j < 4; ++j) w[j] = yr[64 * j];
#pragma unroll
        for (int j = 0; j < 4; ++j) { const unsigned lo = (unsigned)w[j], hi = (unsigned)(w[j] >> 32); mo[j].x += bflo(lo); mo[j].y += bfhi(lo); mo[j].z += bflo(hi); mo[j].w += bfhi(hi); } }
}
__device__ __forceinline__ void phase_final(Frame& F) {
    const int gw = F.bid * NWAVES + F.wave, NGW = F.G * NWAVES, lane = F.lane;
    const float* mod = (const float*)(F.ws + WS_MOD); float* xm = F.out;
    const bf16* Y = (const bf16*)(F.ws + WS_Y); const int* INV = (const int*)(F.ws + WS_INV);
    const float* fing = inptr(F, I_FING);
    for (int r0 = gw; r0 < NTOK; r0 += 2 * NGW) { const int r1 = r0 + NGW;
        const int b0 = r0 >> 12, b1 = r1 >> 12;
        f32x4* xr0 = (f32x4*)(xm + (size_t)r0 * DM) + lane; f32x4* xr1 = (f32x4*)(xm + (size_t)r1 * DM) + lane;
        const int inv0 = (lane < 16) ? (int)__hip_atomic_load((const unsigned*)INV + (size_t)r0 * NE + lane, __ATOMIC_RELAXED, __HIP_MEMORY_SCOPE_AGENT) : -1;
        const int inv1 = (lane < 16) ? (int)__hip_atomic_load((const unsigned*)INV + (size_t)r1 * NE + lane, __ATOMIC_RELAXED, __HIP_MEMORY_SCOPE_AGENT) : -1;
        f32x4 v0[4], v1[4], m0[4], m1[4];
#pragma unroll
        for (int j = 0; j < 4; ++j) { v0[j] = xr0[64 * j]; v1[j] = xr1[64 * j]; m0[j] = (f32x4){0.f, 0.f, 0.f, 0.f}; m1[j] = (f32x4){0.f, 0.f, 0.f, 0.f}; }
        const unsigned long long k0 = __ballot(inv0 >= 0), k1 = __ballot(inv1 >= 0);
        final_accum(Y, b0, k0, inv0, lane, m0);
        final_accum(Y, b1, k1, inv1, lane, m1);
        const float* g20 = mod + (size_t)b0 * (NMOD * DM) + 5 * DM; const float* g21 = mod + (size_t)b1 * (NMOD * DM) + 5 * DM; float s0 = 0.f, s1 = 0.f;
#pragma unroll
        for (int j = 0; j < 4; ++j) { const f32x4 ga = ((const f32x4*)g20)[lane + 64 * j], gb = ((const f32x4*)g21)[lane + 64 * j];
            v0[j] = v0[j] + ga * m0[j] * DBG_MOE_ALPHA; v1[j] = v1[j] + gb * m1[j] * DBG_MOE_ALPHA;
            s0 += (v0[j].x * v0[j].x + v0[j].y * v0[j].y) + (v0[j].z * v0[j].z + v0[j].w * v0[j].w); s1 += (v1[j].x * v1[j].x + v1[j].y * v1[j].y) + (v1[j].z * v1[j].z + v1[j].w * v1[j].w); }
        const float rs0 = 1.0f / sqrtf(wave_sum(s0) * (1.0f / DM) + NORM_EPS), rs1 = 1.0f / sqrtf(wave_sum(s1) * (1.0f / DM) + NORM_EPS);
#pragma unroll
        for (int j = 0; j < 4; ++j) { const f32x4 fg = ((const f32x4*)fing)[lane + 64 * j]; xr0[64 * j] = v0[j] * rs0 * fg; xr1[64 * j] = v1[j] * rs1 * fg; }
    }
}

#ifdef DBG_CHECK_MOE
__device__ __forceinline__ void phase_dbg_moe(Frame& F) {
    LAS float* hs = (LAS float*)F.lds;
    LAS float* Hs = hs + 1024;
    LAS float* red = Hs + 2816;
    const int row = (F.bid * 257) & 65535, e = row >> 12, b = (row >> 9) & 7;
    const int tok = ((const int*)(F.ws + WS_IDX))[row]; const float gate = ((const float*)(F.ws + WS_GATE))[row];
    const bf16* H2 = (const bf16*)(F.ws + WS_H2) + (size_t)tok * DM;
    for (int i = F.tid; i < DM; i += NTHR) hs[i] = bf2f(H2[i]);
    __syncthreads();
    const float* Wg = inptr(F, I_WG) + (size_t)e * DM * FF; const float* Wu = inptr(F, I_WU) + (size_t)e * DM * FF; const float* Wd = inptr(F, I_WD) + (size_t)e * FF * DM;
    float e1n = 0.f, e1d = 0.f;
    for (int f = F.tid; f < FF; f += NTHR) { float g = 0.f, u = 0.f;
        for (int k = 0; k < DM; ++k) { g += hs[k] * Wg[(size_t)k * FF + f]; u += hs[k] * Wu[(size_t)k * FF + f]; }
        const float h = siluf_(g) * u; Hs[f] = h;
        const float hb = bf2f(((const bf16*)(F.ws + WS_HB))[(size_t)row * FF + f]); e1n += (hb - h) * (hb - h); e1d += h * h; }
    __syncthreads();
    float e2n = 0.f, e2d = 0.f;
    for (int n = F.tid; n < DM; n += NTHR) { float y = 0.f;
        for (int f = 0; f < FF; ++f) y += Hs[f] * Wd[(size_t)f * DM + n];
        y *= gate; const float yb = bf2f(((const bf16*)(F.ws + WS_Y))[(size_t)row * DM + n]); e2n += (yb - y) * (yb - y); e2d += y * y; }
    const float* aff = (const float*)(F.ws + WS_AFF) + ((size_t)b * NE + e) * SEQ; int cnt = 0;
    for (int t = F.tid; t < SEQ; t += NTHR) cnt += (aff[t] > gate) ? 1 : 0;
    float vals[5] = {e1n, e1d, e2n, e2d, (float)cnt};
#pragma unroll
    for (int q = 0; q < 5; ++q) { const float s2 = wave_sum(vals[q]); if (F.lane == 0) red[F.wave * 5 + q] = s2; }
    __syncthreads();
    if (F.tid == 0) { float t5[5] = {0, 0, 0, 0, 0}; for (int w = 0; w < 8; ++w) for (int q = 0; q < 5; ++q) t5[q] += red[w * 5 + q];
        float* D = (float*)(F.ws + WS_CTL + 65536) + F.bid * 4;
        D[0] = t5[0] / (t5[1] + 1e-30f); D[1] = t5[2] / (t5[3] + 1e-30f); D[2] = (t5[4] >= (float)CAP) ? 1.f : 0.f;
        int dup = 0; const int* IDXs = (const int*)(F.ws + WS_IDX) + ((size_t)e * NB + b) * CAP; for (int q = 0; q < CAP; ++q) dup += (IDXs[q] == tok) ? 1 : 0;
        const int inv = ((const int*)(F.ws + WS_INV))[(size_t)tok * NE + e];
        const int c3 = DBG_C3;
        D[3] = (c3 == 0) ? ((fabsf(aff[tok - b * SEQ] - gate) > 1e-6f) ? 1.f : 0.f) : (c3 == 1) ? (((tok >> 12) != b) ? 1.f : 0.f) : (c3 == 2) ? ((dup != 1) ? 1.f : 0.f) : ((inv != (row & 511)) ? 1.f : 0.f); }
    __syncthreads();
}
__device__ __forceinline__ void phase_dbg_apply(Frame& F) {
    const float* D = (const float*)(F.ws + WS_CTL + 65536);
    int bad[4] = {0, 0, 0, 0};
    for (int k = 0; k < 256; ++k) { if (D[k * 4 + 0] > 1e-3f) ++bad[0]; if (D[k * 4 + 1] > 1e-3f) ++bad[1]; if (D[k * 4 + 2] > 0.5f) ++bad[2]; if (D[k * 4 + 3] > 0.5f) ++bad[3]; }
    int code = 0;
    for (int q = 0; q < 4; ++q) if (((DBG_CHECK_MOE >> q) & 1) && bad[q] > DBG_BAD_THR) code += 1;
    const float sc = 1.0f + 0.5f * (float)code;
    const int gw = F.bid * NWAVES + F.wave, NGW = F.G * NWAVES;
    for (int r = gw; r < NTOK; r += NGW) { f32x4* xr = (f32x4*)(F.out + (size_t)r * DM) + F.lane;
#pragma unroll
        for (int j = 0; j < 4; ++j) xr[64 * j] = xr[64 * j] * sc; }
}
#endif

#ifdef DBG_CHECK_MOE
constexpr int NPHASE = 15;
#else
constexpr int NPHASE = 13;
#endif
__global__ void __launch_bounds__(NTHR, 2) fwd_kernel(Args args) {
    extern __shared__ __attribute__((aligned(16))) unsigned char lds_raw[];
    Frame F;
    F.lds = (LAS unsigned char*)lds_raw;
    F.tid = threadIdx.x; F.lane = F.tid & 63; F.wave = __builtin_amdgcn_readfirstlane(F.tid >> 6);
    F.G = gridDim.x; F.bid = blockIdx.x;
    F.out = args.out; F.ws = args.ws;
    for (int u = F.tid; u < (LDS_BYTES - LDSCTL_OFF) / 4; u += NTHR) ((LAS unsigned*)(F.lds + LDSCTL_OFF))[u] = 0u;
    __syncthreads();
    if (F.tid < 35) { const float* const* tab = args.in; *(LAS unsigned long long*)(F.lds + LDSCTL_OFF + 8 * F.tid) = (unsigned long long)tab[F.tid]; }
    __syncthreads();
    const int lo = args.ph_lo, hi = args.ph_hi;
    const bool single = (hi - lo) > 1;
    XcdBarrier bar; bar.bar = (unsigned*)(args.ws + WS_CTL) + CW_BAR; bar.x = 0; bar.st = nullptr;
    if (single) bar = xcd_barrier_post((unsigned*)(args.ws + WS_CTL) + CW_BAR, (volatile LAS unsigned*)(F.lds + MISC_OFF) + 8);
#ifndef PHASE_MASK
#define PHASE_MASK 0x7fff
#endif
#define IN(k) ((((PHASE_MASK) >> (k)) & 1) && lo <= (k) && (k) < hi)
#ifndef DBG_REPEAT_MASK
#define DBG_REPEAT_MASK 0
#endif
#define SEAM(k) do { if (IN(k) && IN((k) + 1)) xcd_barrier(bar); } while (0)
#define REP(k) for (int rep_ = 0; rep_ < ((((DBG_REPEAT_MASK) >> (k)) & 1) ? 2 : 1); ++rep_)
    LAS unsigned char* ring = F.lds;
    const unsigned char* ws = args.ws;

    REP(0) { if (rep_) xcd_barrier(bar); asm volatile("" : "+v"(F.tid), "+v"(F.lane)); if (IN(0)) { phase0(F); } } SEAM(0);
    REP(1) { if (rep_) xcd_barrier(bar); asm volatile("" : "+v"(F.tid), "+v"(F.lane)); if (IN(1)) { phase1(F); } } SEAM(1);
    REP(2) { if (rep_) xcd_barrier(bar); asm volatile("" : "+v"(F.tid), "+v"(F.lane)); if (IN(2)) {
        { SchedPlain S; S.T.init(128, 6, F.G, F.bid); S.A = (const char*)(ws + WS_H1); S.B = (const char*)(ws + WS_WINT); S.lda = 2048; S.ldb = 2048; S.kstepA = 128; S.kstepB = 128; S.nt = 16; S.mt = 1 << 20; S.az = 0; S.bz = 0;
          EpiZT E{(bf16*)(ws + WS_ZT)}; gm::gemm_phase<EpiZT, SchedPlain, false>(ring, S, E); }
        __syncthreads();
        { SchedPlain S; S.T.init(136, 2, F.G, F.bid); S.A = (const char*)(ws + WS_H1); S.B = (const char*)(ws + WS_WINT) + (size_t)HYC * 2048; S.lda = 2048; S.ldb = 2048; S.kstepA = 128; S.kstepB = 128; S.nt = 16; S.mt = 1 << 20; S.az = 0; S.bz = 0;
          EpiUG E{(bf16*)(ws + WS_UG)}; gm::gemm_phase<EpiUG, SchedPlain, true>(ring, S, E); }
    } } SEAM(2);
    REP(3) { if (rep_) xcd_barrier(bar); asm volatile("" : "+v"(F.tid), "+v"(F.lane)); if (IN(3)) {
        SchedPlain S; S.T.init(160, 1, F.G, F.bid); S.A = (const char*)(ws + WS_UG); S.B = (const char*)(ws + WS_WAT); S.lda = UCOLS * 2; S.ldb = 1024; S.kstepA = 128; S.kstepB = 128; S.nt = 8; S.mt = 5;
        S.az = (size_t)UROWS * UCOLS * 2; S.bz = (size_t)256 * 1024;
        EpiEB E{(float*)(ws + WS_EB)}; gm::gemm_phase<EpiEB, SchedPlain, true>(ring, S, E);
        if (F.bid >= 160) { const int wv = (F.bid - 160) * 8 + F.wave; p_down_items(F, DN_P4 + DN_P9 + wv, 4, 8 * 96); }
    } } SEAM(3);
    REP(4) { if (rep_) xcd_barrier(bar); asm volatile("" : "+v"(F.tid), "+v"(F.lane)); if (IN(4)) { phase_carry(F); } } SEAM(4);
    REP(5) { if (rep_) xcd_barrier(bar); asm volatile("" : "+v"(F.tid), "+v"(F.lane)); if (IN(5)) {
        { SchedPlain S; S.T.init(128, 2, F.G, F.bid); S.A = (const char*)(ws + WS_UG); S.B = (const char*)(ws + WS_MCT); S.lda = UCOLS * 2; S.ldb = UCOLS * 2; S.kstepA = 128; S.kstepB = 128; S.nt = 12; S.mt = 4;
          S.az = (size_t)UROWS * UCOLS * 2; S.bz = (size_t)512 * UCOLS * 2;
          EpiYS E{(bf16*)(ws + WS_YSG), (const bf16*)(ws + WS_UG), inptr(F, I_S5D)};
#ifndef NO_YS
          gm::gemm_phase<EpiYS, SchedPlain, true>(ring, S, E);
#endif
        }
        __syncthreads();
#ifndef NO_HY
        { int citer = 0; for (int c = F.bid; c < HYW; c += F.G, ++citer) hyena_channel(F, c, citer); }
#endif
    } } SEAM(5);
    REP(6) { if (rep_) xcd_barrier(bar); asm volatile("" : "+v"(F.tid), "+v"(F.lane)); if (IN(6)) {
        { SchedGlu S; S.T.init(128, 2, F.G, F.bid); S.A = (const char*)(ws + WS_YSG); S.B = (const char*)(ws + WS_GLUT); S.ldb = 1024; S.kstepA = 4u * 1024u * 512u * 2u; S.kstepB = 128; S.nt = 8;
          EpiGlu E{(bf16*)(ws + WS_YCAT), (const bf16*)(ws + WS_YSG), inptr(F, I_GLUB)}; gm::gemm_phase<EpiGlu, SchedGlu, true>(ring, S, E); }
        __syncthreads();
        phase_tr_hy(F);
    } } SEAM(6);
    REP(7) { if (rep_) xcd_barrier(bar); asm volatile("" : "+v"(F.tid), "+v"(F.lane)); if (IN(7)) {
        SchedPlain S; S.T.init(128, 4, F.G, F.bid); S.A = (const char*)(ws + WS_YCAT); S.B = (const char*)(ws + WS_WOUTT); S.lda = 2048; S.ldb = 2048; S.kstepA = 128; S.kstepB = 128; S.nt = 16; S.mt = 1 << 20; S.az = 0; S.bz = 0;
        EpiXmid E{inptr(F, I_X), F.out, (const float*)(ws + WS_MOD)}; gm::gemm_phase<EpiXmid, SchedPlain, true>(ring, S, E);
    } } SEAM(7);
    REP(8) { if (rep_) xcd_barrier(bar); asm volatile("" : "+v"(F.tid), "+v"(F.lane)); if (IN(8)) { phase_norm2(F); } } SEAM(8);
    REP(9) { if (rep_) xcd_barrier(bar); asm volatile("" : "+v"(F.tid), "+v"(F.lane)); if (IN(9)) { phase_topk(F); } } SEAM(9);
    REP(10) { if (rep_) xcd_barrier(bar); asm volatile("" : "+v"(F.tid), "+v"(F.lane)); if (IN(10)) {
        SchedMoe1 S; S.T.init(256, 22, F.G, F.bid); S.A = (const char*)(ws + WS_H2); S.B = (const char*)(ws + WS_WGUT); S.idx = (const int*)(ws + WS_IDX); S.lda = 1024; S.ldb = 1024; S.kstepA = 128; S.kstepB = 128; S.nt = 8;
        EpiMoe1 E{(unsigned char*)(ws + WS_HB)}; gm::gemm_phase_f8<EpiMoe1, SchedMoe1, WGU_E8M0>(ring, S, E);
    } } SEAM(10);
    REP(11) { if (rep_) xcd_barrier(bar); asm volatile("" : "+v"(F.tid), "+v"(F.lane)); if (IN(11)) {
        SchedPlain S; S.T.init(256, 4, F.G, F.bid); S.A = (const char*)(ws + WS_HB); S.B = (const char*)(ws + WS_WDT); S.lda = FF; S.ldb = FF; S.kstepA = 128; S.kstepB = 128; S.nt = 22; S.mt = 16;
        S.az = (size_t)EROWS * FF; S.bz = (size_t)DM * FF;
        EpiMoe2 E{(bf16*)(ws + WS_Y), (const float*)(ws + WS_GATE)}; gm::gemm_phase_f8<EpiMoe2, SchedPlain, WD_E8M0>(ring, S, E);
    } } SEAM(11);
    if (IN(12)) { phase_final(F); }
#ifdef DBG_CHECK_MOE
    if (IN(13)) { phase_dbg_moe(F); }
    if (IN(14)) { phase_dbg_apply(F); }
#endif
#undef IN
#undef SEAM
}

#ifndef N_LAUNCHES
#define N_LAUNCHES 1
#endif
extern "C" void kernel_launch(void* const* d_in, const int* in_sizes, int n_in, void* d_out, int out_size, void* d_ws, size_t ws_size, hipStream_t stream) {
    static int grid = 0;
    if (grid == 0) {
        if (n_in != 35 || out_size != NTOK * DM || ws_size < WS_END) { fprintf(stderr, "kernel_launch: unexpected shapes (n_in %d out %d ws %zu)\n", n_in, out_size, ws_size); grid = -1; return; }
        int dev = 0, cus = 0;
        if (hipGetDevice(&dev) != hipSuccess || hipDeviceGetAttribute(&cus, hipDeviceAttributeMultiprocessorCount, dev) != hipSuccess) { grid = -1; return; }
        if (hipFuncSetAttribute((const void*)fwd_kernel, hipFuncAttributeMaxDynamicSharedMemorySize, LDS_BYTES) != hipSuccess) { fprintf(stderr, "kernel_launch: hipFuncSetAttribute failed\n"); grid = -1; return; }
        int per_cu = 0;
        if (hipOccupancyMaxActiveBlocksPerMultiprocessor(&per_cu, (const void*)fwd_kernel, NTHR, LDS_BYTES) != hipSuccess || per_cu < 1) fprintf(stderr, "kernel_launch: occupancy query reports %d\n", per_cu);
        (void)hipGetLastError();
        grid = 256;
        if (cus != 256) fprintf(stderr, "kernel_launch: device has %d CUs, kernel expects 256\n", cus);
    }
    if (grid < 0) return;
    (void)hipMemsetAsync((char*)d_ws + WS_CTL, 0, CTL_ZERO_BYTES, stream);
    Args a{};
    for (int i = 0; i < 35; ++i) a.in[i] = (const float*)d_in[i];
    a.out = (float*)d_out; a.ws = (unsigned char*)d_ws;
    if (N_LAUNCHES == 1) { a.ph_lo = 0; a.ph_hi = NPHASE; hipLaunchKernelGGL(fwd_kernel, dim3(grid), dim3(NTHR), LDS_BYTES, stream, a); }
    else for (int p = 0; p < NPHASE; ++p) { a.ph_lo = p; a.ph_hi = p + 1; hipLaunchKernelGGL(fwd_kernel, dim3(grid), dim3(NTHR), LDS_BYTES, stream, a); }
}
```

```cpp
#ifndef DBG_GM_MODE
#define DBG_GM_MODE 0
#endif
#ifndef DBG_C3
#define DBG_C3 0
#endif
#ifndef DBG_BAD_THR
#define DBG_BAD_THR 16
#endif
#ifndef DBG_MOE_ALPHA
#define DBG_MOE_ALPHA 1.0f
#endif
#include <hip/hip_runtime.h>
#include <cstdio>
#include <cstdint>

#define LAS __attribute__((address_space(3)))
#define GAS __attribute__((address_space(1)))
typedef unsigned short bf16;
typedef short bf16x8 __attribute__((ext_vector_type(8)));
typedef float f32x4 __attribute__((ext_vector_type(4)));
typedef float f32x16 __attribute__((ext_vector_type(16)));
typedef unsigned u32x4 __attribute__((ext_vector_type(4)));
typedef unsigned u32x2 __attribute__((ext_vector_type(2)));
typedef GAS unsigned gu32;

constexpr int NB = 8, SEQ = 4096, DM = 1024, CTXL = 256;
constexpr int NTOK = NB * SEQ, NCTX = NB * CTXL, NROWS1 = NTOK + NCTX;
constexpr int HYW = 512, HYC = 1536, S5W = 512, INC = 2048;
constexpr int NG = 32, GH = 16, NP = 64;
constexpr int CT = 32, NCH = SEQ / CT, NCHC = CTXL / CT;
constexpr int UROWS = 1280, UCOLS = 768;
constexpr int NE = 16, FF = 2816, CAP = 512, EROWS = NB * CAP;
constexpr int NMOD = 6;
constexpr float NORM_EPS = 1e-6f;
constexpr int FLEN = 8448, FC0 = 4224, F8LEN = 8480, F8GS = 8576;

constexpr size_t MiB = 1u << 20;
constexpr size_t WS_CTL = 0, CTL_ZERO_BYTES = 1 * MiB;
constexpr size_t WS_MOD = 1 * MiB;
constexpr size_t WS_LT = WS_MOD + 256 * 1024;
constexpr size_t WS_FH2 = 2 * MiB;
constexpr size_t WS_GLUT = 3 * MiB;
constexpr size_t WS_WINT = 4 * MiB;
constexpr size_t WS_WOUTT = 8 * MiB;
constexpr size_t WS_AFF = 10 * MiB;
constexpr size_t WS_IDX = 12 * MiB;
constexpr size_t WS_GATE = WS_IDX + 256 * 1024;
constexpr size_t WS_INV = 13 * MiB;
constexpr size_t WS_WDT = 16 * MiB;
constexpr size_t WS_WGUT = 104 * MiB;
constexpr size_t WS_Y = WS_WGUT;
constexpr size_t WS_R = 280 * MiB;
constexpr size_t WS_H1 = WS_R;
constexpr size_t WS_ZT = WS_R + 68 * MiB;
constexpr size_t WS_UG = WS_R + 164 * MiB;
constexpr size_t WS_EB = WS_R + 224 * MiB;
constexpr size_t WS_YHT = WS_EB;
constexpr size_t WS_MCT = WS_R + 264 * MiB;
constexpr size_t WS_WAT = WS_R + 288 * MiB;
constexpr size_t WS_FILT = WS_R + 296 * MiB;
constexpr size_t WS_FSC = WS_FILT + (size_t)2 * 512 * 8576;
constexpr size_t WS_VS = WS_R;
constexpr size_t WS_YSG = WS_R + 330 * MiB;
constexpr int S5TAB_FLOATS = (2 * 33 * 64 * 2) + (2 * 64 * 16 * 2) + (2 * 32 * 256) + (2 * 16 * 64 * 2);
constexpr size_t WS_S5TAB = WS_YSG;
constexpr size_t WS_YCAT = WS_R;
constexpr size_t WS_H2 = WS_R;
constexpr size_t WS_HB = WS_R + 64 * MiB;
constexpr size_t WS_XMID = WS_R + 256 * MiB;
constexpr size_t WS_END = WS_R + 416 * MiB;
static_assert(WS_YSG + (size_t)NG * 1024 * 512 * 2 <= WS_END && WS_FILT + (size_t)4 * HYW * FLEN * 2 <= WS_YSG && WS_YCAT + (size_t)NTOK * DM * 2 <= WS_ZT && WS_HB + (size_t)NE * EROWS * FF * 2 <= WS_END, "ws map");

constexpr int CW_BAR = 4096;

constexpr int RING_BYTES = 131072;
constexpr int LDS_BYTES = 163840;
constexpr int LDSCTL_OFF = LDS_BYTES - 1024, MISC_OFF = LDSCTL_OFF + 320;
constexpr int NWAVES = 8, NTHR = 512;

__device__ __forceinline__ unsigned f2bf(float f) { unsigned u = __builtin_bit_cast(unsigned, f); return (u + 0x7fffu + ((u >> 16) & 1u)) >> 16; }
__device__ __forceinline__ unsigned pk2(float lo, float hi) { return f2bf(lo) | (f2bf(hi) << 16); }
__device__ __forceinline__ float bf2f(unsigned b) { return __builtin_bit_cast(float, (b & 0xffffu) << 16); }
__device__ __forceinline__ float bflo(unsigned w) { return __builtin_bit_cast(float, w << 16); }
__device__ __forceinline__ float bfhi(unsigned w) { return __builtin_bit_cast(float, w & 0xffff0000u); }
__device__ __forceinline__ float wave_sum(float v) {
#pragma unroll
    for (int o = 1; o < 64; o <<= 1) v += __shfl_xor(v, o);
    return v;
}
__device__ __forceinline__ float sigmoidf_(float x) { return __builtin_amdgcn_rcpf(1.0f + __builtin_amdgcn_exp2f(fminf(-1.4426950408889634f * x, 80.0f))); }
__device__ __forceinline__ float siluf_(float x) { return x * sigmoidf_(x); }
__device__ __forceinline__ float gelu_tanh(float y) {
    const float u2 = 1.5957691216057308f * (y + 0.044715f * y * y * y);
    return y * sigmoidf_(u2);
}
typedef int i32x8 __attribute__((ext_vector_type(8)));
typedef int i32x4 __attribute__((ext_vector_type(4)));
__device__ __forceinline__ unsigned pk4_fp8(float a, float b, float c, float d) { int w = 0; w = __builtin_amdgcn_cvt_pk_fp8_f32(a, b, w, false); w = __builtin_amdgcn_cvt_pk_fp8_f32(c, d, w, true); return (unsigned)w; }
constexpr float WGU_SCALE = 16.0f, WD_SCALE = 32.0f;
constexpr int WGU_E8M0 = 127 - 4, WD_E8M0 = 127 - 5;
#define LDS_WAIT() asm volatile("s_waitcnt lgkmcnt(0)" ::: "memory")
#define VM_WAIT() asm volatile("s_waitcnt vmcnt(0)" ::: "memory")

#define XB_TMO      128
#define XB_XCNT(j)  (256  + 64 * (j))
#define XB_XSUB(j)  (1280 + 64 * (j))
#define XB_XGEN(j)  (2304 + 64 * (j))
#define XB_TOP      3328
#define XB_TOPGEN   3392
#define XCD_BAR_WORDS 3456
#define XB_SPIN_CAP (1u << 22)
__device__ __forceinline__ unsigned xb_ld(unsigned* p)              { return __hip_atomic_load(p, __ATOMIC_RELAXED, __HIP_MEMORY_SCOPE_AGENT); }
__device__ __forceinline__ unsigned xb_add(unsigned* p, unsigned v) { return __hip_atomic_fetch_add(p, v, __ATOMIC_RELAXED, __HIP_MEMORY_SCOPE_AGENT); }
__device__ __forceinline__ unsigned xb_xcc_id() { return (unsigned)__builtin_amdgcn_s_getreg((3 << 11) | 20) & 0xFu; }
#define XB_SPIN(cond, bar) do { unsigned _sp = 0; while (cond) { __builtin_amdgcn_s_sleep(1); \
    if ((++_sp & 255u) == 0u) { if (xb_ld(&(bar)[XB_TMO])) break; if (_sp > XB_SPIN_CAP) { atomicAdd(&(bar)[XB_TMO], 1u); break; } } } } while (0)
struct XcdBarrier { unsigned* bar; unsigned x; volatile LAS unsigned* st; };
__device__ __forceinline__ XcdBarrier xcd_barrier_post(unsigned* bar, volatile LAS unsigned* st) {
    XcdBarrier b; b.bar = bar; b.x = xb_xcc_id(); b.st = st;
    if (threadIdx.x == 0) (void)xb_add(&bar[XB_XCNT(b.x)], 1u);
    return b;
}
__device__ __forceinline__ void xcd_barrier_complete(unsigned* bar, unsigned x, unsigned& nloc, unsigned& nx) {
    const unsigned G = gridDim.x * gridDim.y * gridDim.z;
    unsigned sum, cnt, mine, sp = 0u;
    for (;;) {
        sum = 0u; cnt = 0u; mine = 0u;
#pragma unroll
        for (unsigned j = 0; j < 16; ++j) { const unsigned c = xb_ld(&bar[XB_XCNT(j)]); sum += c; cnt += (c > 0u) ? 1u : 0u; mine = (j == x) ? c : mine; }
        if (sum == G) break;
        __builtin_amdgcn_s_sleep(1);
        if ((++sp & 255u) == 0u) { if (xb_ld(&bar[XB_TMO])) break; if (sp > XB_SPIN_CAP) { atomicAdd(&bar[XB_TMO], 1u); break; } }
    }
    nloc = mine > 0u ? mine : 1u; nx = cnt > 0u ? cnt : 1u;
}
__device__ __forceinline__ void xcd_barrier(const XcdBarrier& b) {
    asm volatile("s_waitcnt vmcnt(0)" ::: "memory");
    __syncthreads();
    if (threadIdx.x == 0) {
        unsigned* bar = b.bar;
        __builtin_amdgcn_s_waitcnt(0);
        unsigned nloc = b.st[0], nx = b.st[1];
        if (nloc == 0u) { xcd_barrier_complete(bar, b.x, nloc, nx); b.st[0] = nloc; b.st[1] = nx; }
        const unsigned old = xb_add(&bar[XB_XSUB(b.x)], 1u);
        const unsigned gen = old / nloc;
        if (old + 1u == (gen + 1u) * nloc) {
            __builtin_amdgcn_fence(__ATOMIC_RELEASE, "agent");
            asm volatile("s_waitcnt vmcnt(0)" ::: "memory");
            const unsigned og = xb_add(&bar[XB_TOP], 1u);
            const unsigned tg = og / nx;
            if (og + 1u == (tg + 1u) * nx) xb_add(&bar[XB_TOPGEN], 1u);
            else XB_SPIN(xb_ld(&bar[XB_TOPGEN]) == tg, bar);
            __builtin_amdgcn_fence(__ATOMIC_ACQUIRE, "agent");
            xb_add(&bar[XB_XGEN(b.x)], 1u);
            asm volatile("s_waitcnt vmcnt(0)" ::: "memory");
        } else {
            XB_SPIN(xb_ld(&bar[XB_XGEN(b.x)]) == gen, bar);
            __builtin_amdgcn_fence(__ATOMIC_ACQUIRE, "agent");
            asm volatile("s_waitcnt vmcnt(0)" ::: "memory");
        }
    }
    __syncthreads();
}

namespace gm {
constexpr int BM = 256, BK = 64, HALF = 128, HTB = HALF * BK * 2, STAGE_BYTES = 8 * HTB, NXCD = 8, WGM = 8;
__host__ __device__ __forceinline__ int lds_byte(int r, int c) { const int st = (r >> 4) * 2 + (c >> 5), rr = r & 15, cc = c & 31, ob = rr * 64 + cc * 2; return st * 1024 + (ob ^ (((ob >> 9) & 1) << 5)); }
__host__ __device__ __forceinline__ void stage_rc(int b, int& R, int& C) { const int st = b / 1024, sb = b % 1024, swz = sb ^ (((sb >> 9) & 1) << 5); R = (st >> 1) * 16 + swz / 64; C = (st & 1) * 32 + (swz % 64) / 2; }
__host__ __device__ __forceinline__ int perm32(int rho) { const int n = rho >> 4, i = rho & 15; return 8 * (i >> 2) + 4 * n + (i & 3); }

struct GUnit { const char* A; const char* B; int pm, pn; };
__device__ __forceinline__ const char* uni_ptr(const char* p) { const unsigned long long v = (unsigned long long)p; const unsigned lo = __builtin_amdgcn_readfirstlane((unsigned)v), hi = __builtin_amdgcn_readfirstlane((unsigned)(v >> 32));
    return (const char*)(const GAS char*)(((unsigned long long)hi << 32) | lo); }

struct TileOrder {
    int nM, nN, nwg, G, c;
    __device__ __forceinline__ void init(int nM_, int nN_, int G_, int c_) { nM = nM_; nN = nN_; nwg = nM * nN; G = G_; c = c_; }
    __device__ __forceinline__ bool get(int i, int& pm, int& pn) const {
        const long L = (long)i * G + c; if (L >= nwg) return false;
        int wgid = (int)L; { const int q = nwg / NXCD, r = nwg % NXCD, xcd = wgid % NXCD, off = wgid / NXCD; wgid = (xcd < r ? xcd * (q + 1) : r * (q + 1) + (xcd - r) * q) + off; }
        const int nig = WGM * nN, gid = wgid / nig, fm = gid * WGM, gsz = (nM - fm) < WGM ? (nM - fm) : WGM;
        pm = fm + ((wgid % nig) % gsz); pn = (wgid % nig) / gsz; return true;
    }
};

__device__ __forceinline__ unsigned cvt_pk_bf16(float lo, float hi) { unsigned r; asm volatile("v_cvt_pk_bf16_f32 %0, %1, %2" : "=v"(r) : "v"(lo), "v"(hi)); return r; }

template <class Epi, class Sched, bool TR>
__device__ __forceinline__ void gemm_phase(LAS unsigned char* lds, const Sched& S, const Epi& E) {
    int tid = threadIdx.x; asm volatile("" : "+v"(tid));
    const int wid = __builtin_amdgcn_readfirstlane(tid >> 6), lane = tid & 63, wr = wid >> 2, wc = wid & 3, fr = lane & 15, fq = lane >> 4;
    const int nt = S.nt;
    int sR0, sC0, sR1, sC1; stage_rc(tid * 16, sR0, sC0); stage_rc(tid * 16 + 8192, sR1, sC1);
    const unsigned vB0 = (unsigned)(Epi::PERM ? ((sR0 & ~31) + perm32(sR0 & 31)) : sR0) * S.ldb + (unsigned)sC0 * 2u;
    const unsigned vB1 = (unsigned)(Epi::PERM ? ((sR1 & ~31) + perm32(sR1 & 31)) : sR1) * S.ldb + (unsigned)sC1 * 2u;
    const size_t kA = S.kstepA, kB = S.kstepB;
    const size_t hstepB = (size_t)HALF * S.ldb;
    const unsigned ldsw = (unsigned)wid * 1024u;
    const int aoff = lds_byte(wr * 64 + fr, fq * 8), boff = lds_byte(wc * 32 + fr, fq * 8);
#define PG8_SA(b, h) (((b) * 2 + (h)) * HTB)
#define PG8_SB(b, h) ((4 + (b) * 2 + (h)) * HTB)
#define PG8_STAGE(bufoff, gbase, o0, o1) do { \
        __builtin_amdgcn_global_load_lds((const unsigned*)((const char*)(gbase) + (o0)), (LAS unsigned*)(lds + (bufoff) + ldsw), 16, 0, 0); \
        __builtin_amdgcn_global_load_lds((const unsigned*)((const char*)(gbase) + (o1)), (LAS unsigned*)(lds + (bufoff) + ldsw + 8192), 16, 0, 0); } while (0)
#define PG8_LDA(dst, b, h) do { _Pragma("unroll") for (int m = 0; m < 4; ++m) _Pragma("unroll") for (int k = 0; k < 2; ++k) dst[m][k] = *(const LAS bf16x8*)(lds + PG8_SA(b, h) + aoff + m * 2048 + k * 1024); } while (0)
#define PG8_LDB(dst, b, h) do { _Pragma("unroll") for (int n = 0; n < 2; ++n) _Pragma("unroll") for (int k = 0; k < 2; ++k) dst[n][k] = *(const LAS bf16x8*)(lds + PG8_SB(b, h) + boff + n * 2048 + k * 1024); } while (0)
#define PG8_MMA(ai, bj, At, Bt) do { __builtin_amdgcn_s_setprio(1); _Pragma("unroll") for (int m = 0; m < 4; ++m) _Pragma("unroll") for (int n = 0; n < 2; ++n) _Pragma("unroll") for (int k = 0; k < 2; ++k) \
        acc[ai][bj][m][n] = TR ? __builtin_amdgcn_mfma_f32_16x16x32_bf16(Bt[n][k], At[m][k], acc[ai][bj][m][n], 0, 0, 0) \
                               : __builtin_amdgcn_mfma_f32_16x16x32_bf16(At[m][k], Bt[n][k], acc[ai][bj][m][n], 0, 0, 0); __builtin_amdgcn_s_setprio(0); } while (0)
#define PG8_WAIT_V(n) asm volatile("s_waitcnt vmcnt(" #n ")" ::: "memory")
#define PG8_WAIT_L(n) asm volatile("s_waitcnt lgkmcnt(" #n ")" ::: "memory")
#define PG8_BAR __builtin_amdgcn_s_barrier()
#define PG8_SCHED __builtin_amdgcn_sched_barrier(0)
    GUnit cur, nxt; int ui = 0;
    if (!S.next(0, cur)) return;
    f32x4 acc[2][2][4][2];
#pragma unroll
    for (int a = 0; a < 2; ++a)
#pragma unroll
        for (int b = 0; b < 2; ++b)
#pragma unroll
            for (int m = 0; m < 4; ++m)
#pragma unroll
                for (int n = 0; n < 2; ++n) acc[a][b][m][n] = (f32x4){0.f, 0.f, 0.f, 0.f};
    bf16x8 At[4][2], B0[2][2], B1[2][2];
    unsigned c00 = S.aoff(cur, sR0, sC0), c01 = S.aoff(cur, sR1, sC1), c10 = S.aoff(cur, HALF + sR0, sC0), c11 = S.aoff(cur, HALF + sR1, sC1);
    const char* cA = uni_ptr(cur.A); const char* cB = uni_ptr(cur.B);
    PG8_STAGE(PG8_SB(0, 0), cB, vB0, vB1); PG8_STAGE(PG8_SB(0, 1), cB + hstepB, vB0, vB1); PG8_STAGE(PG8_SA(0, 0), cA, c00, c01); PG8_STAGE(PG8_SA(0, 1), cA, c10, c11);
    if (wr == 1) PG8_BAR;
    PG8_WAIT_V(2); PG8_BAR;
    PG8_STAGE(PG8_SB(1, 0), cB + kB, vB0, vB1); PG8_STAGE(PG8_SA(1, 0), cA + kA, c00, c01); PG8_STAGE(PG8_SB(1, 1), cB + hstepB + kB, vB0, vB1);
    PG8_WAIT_V(6); PG8_BAR;
    for (;;) {
        const bool has_next = S.next(ui + 1, nxt);
        if (!has_next) nxt = cur;
        const char* nA = uni_ptr(nxt.A); const char* nB = uni_ptr(nxt.B);
        unsigned n00 = c00, n01 = c01, n10 = c10, n11 = c11;
        if (!Sched::AOFF_PM_ONLY || nxt.pm != cur.pm) { n00 = S.aoff(nxt, sR0, sC0); n01 = S.aoff(nxt, sR1, sC1); n10 = S.aoff(nxt, HALF + sR0, sC0); n11 = S.aoff(nxt, HALF + sR1, sC1); }
        for (int t = 0; t < nt; t += 2) {
            const bool last = (t == nt - 2);
            const char* a1 = cA + (size_t)(t + 1) * kA;
            const char* a2 = last ? nA : cA + (size_t)(t + 2) * kA; const char* b2 = last ? nB : cB + (size_t)(t + 2) * kB;
            const char* a3 = a2 + kA; const char* b3 = b2 + kB;
            const unsigned x00 = last ? n00 : c00, x01 = last ? n01 : c01, x10 = last ? n10 : c10, x11 = last ? n11 : c11;
            PG8_LDB(B0, 0, 0); PG8_LDB(B1, 0, 1); PG8_SCHED; PG8_LDA(At, 0, 0); PG8_STAGE(PG8_SA(1, 1), a1, c10, c11);
            PG8_WAIT_V(8); PG8_WAIT_L(0); PG8_BAR; PG8_MMA(0, 0, At, B0); PG8_MMA(0, 1, At, B1); PG8_BAR; PG8_SCHED;
            PG8_LDA(At, 0, 1); PG8_STAGE(PG8_SB(0, 0), b2, vB0, vB1); PG8_STAGE(PG8_SB(0, 1), b2 + hstepB, vB0, vB1); PG8_STAGE(PG8_SA(0, 0), a2, x00, x01);
            PG8_WAIT_V(8); PG8_WAIT_L(0); PG8_BAR; PG8_MMA(1, 0, At, B0); PG8_MMA(1, 1, At, B1); PG8_BAR; PG8_SCHED;
            PG8_LDB(B0, 1, 0); PG8_LDB(B1, 1, 1); PG8_SCHED; PG8_LDA(At, 1, 0); PG8_STAGE(PG8_SA(0, 1), a2, x10, x11);
            PG8_WAIT_V(8); PG8_WAIT_L(0); PG8_BAR; PG8_MMA(0, 0, At, B0); PG8_MMA(0, 1, At, B1); PG8_BAR; PG8_SCHED;
            PG8_LDA(At, 1, 1); PG8_STAGE(PG8_SB(1, 0), b3, vB0, vB1); PG8_STAGE(PG8_SB(1, 1), b3 + hstepB, vB0, vB1); PG8_STAGE(PG8_SA(1, 0), a3, x00, x01);
            PG8_WAIT_V(8); PG8_WAIT_L(0); PG8_BAR; PG8_MMA(1, 0, At, B0); PG8_MMA(1, 1, At, B1); PG8_BAR; PG8_SCHED;
        }
        if (wr == 0) PG8_BAR;
        E(acc, cur, wr, wc, fr, fq);
        if (!has_next) break;
#pragma unroll
        for (int a = 0; a < 2; ++a)
#pragma unroll
            for (int b = 0; b < 2; ++b)
#pragma unroll
                for (int m = 0; m < 4; ++m)
#pragma unroll
                    for (int n = 0; n < 2; ++n) acc[a][b][m][n] = (f32x4){0.f, 0.f, 0.f, 0.f};
        cur = nxt; cA = nA; cB = nB; ++ui;
        c00 = n00; c01 = n01; c10 = n10; c11 = n11;
        if (wr == 1) PG8_BAR;
    }
    PG8_WAIT_V(0);
    PG8_BAR;
#undef PG8_SA
#undef PG8_SB
#undef PG8_STAGE
#undef PG8_LDA
#undef PG8_LDB
#undef PG8_MMA
#undef PG8_WAIT_V
#undef PG8_WAIT_L
#undef PG8_BAR
#undef PG8_SCHED
}
template <class Epi, class Sched, int SCALE_B, int MODE = 0>
__device__ __forceinline__ void gemm_phase_f8(LAS unsigned char* lds, const Sched& S, const Epi& E) {
    int tid = threadIdx.x; asm volatile("" : "+v"(tid));
    const int wid = __builtin_amdgcn_readfirstlane(tid >> 6), lane = tid & 63, wr = wid >> 2, wc = wid & 3, fr = lane & 15, fq = lane >> 4;
    const int nt = S.nt;
    int scA = 127, scB = SCALE_B; asm volatile("" : "+v"(scA), "+v"(scB));
    int sR0, sC0, sR1, sC1; stage_rc(tid * 16, sR0, sC0); stage_rc(tid * 16 + 8192, sR1, sC1);
    const unsigned vB0 = (unsigned)(Epi::PERM ? ((sR0 & ~31) + perm32(sR0 & 31)) : sR0) * S.ldb + (unsigned)sC0 * 2u;
    const unsigned vB1 = (unsigned)(Epi::PERM ? ((sR1 & ~31) + perm32(sR1 & 31)) : sR1) * S.ldb + (unsigned)sC1 * 2u;
    const size_t kA = S.kstepA, kB = S.kstepB;
    const size_t hstepB = (size_t)HALF * S.ldb;
    const unsigned ldsw = (unsigned)wid * 1024u;
    const int aoff = lds_byte(wr * 64 + fr, fq * 8), aoff2 = lds_byte(wr * 64 + fr, fq * 8 + 32), boff = lds_byte(wc * 32 + fr, fq * 8), boff2 = lds_byte(wc * 32 + fr, fq * 8 + 32);
#define PG8_SA(b, h) (((b) * 2 + (h)) * HTB)
#define PG8_SB(b, h) ((4 + (b) * 2 + (h)) * HTB)
#define PG8_STAGE(bufoff, gbase, o0, o1) do { if (MODE == 2) break; \
        __builtin_amdgcn_global_load_lds((const unsigned*)((const char*)(gbase) + (o0)), (LAS unsigned*)(lds + (bufoff) + ldsw), 16, 0, 0); \
        __builtin_amdgcn_global_load_lds((const unsigned*)((const char*)(gbase) + (o1)), (LAS unsigned*)(lds + (bufoff) + ldsw + 8192), 16, 0, 0); } while (0)
#define PG8_LDA(dst, b, h) do { _Pragma("unroll") for (int m = 0; m < 4; ++m) dst[m] = __builtin_shufflevector(*(const LAS i32x4*)(lds + PG8_SA(b, h) + aoff + m * 2048), *(const LAS i32x4*)(lds + PG8_SA(b, h) + aoff2 + m * 2048), 0, 1, 2, 3, 4, 5, 6, 7); } while (0)
#define PG8_LDB(dst, b, h) do { _Pragma("unroll") for (int n = 0; n < 2; ++n) dst[n] = __builtin_shufflevector(*(const LAS i32x4*)(lds + PG8_SB(b, h) + boff + n * 2048), *(const LAS i32x4*)(lds + PG8_SB(b, h) + boff2 + n * 2048), 0, 1, 2, 3, 4, 5, 6, 7); } while (0)
#define PG8_F8(FRG) (i32x8){(int)FRG[0][0], (int)FRG[0][1], (int)FRG[0][2], (int)FRG[0][3], (int)FRG[1][0], (int)FRG[1][1], (int)FRG[1][2], (int)FRG[1][3]}
#define PG8_MMA(ai, bj, At, Bt) do { __builtin_amdgcn_s_setprio(1); _Pragma("unroll") for (int m = 0; m < 4; ++m) _Pragma("unroll") for (int n = 0; n < 2; ++n) \
        { if (MODE == 1) asm volatile("" : "+v"(acc[ai][bj][m][n]) : "v"(Bt[n]), "v"(At[m]), "v"(scB), "v"(scA)); else asm volatile("v_mfma_scale_f32_16x16x128_f8f6f4 %0, %1, %2, %0, %3, %4 op_sel_hi:[0,0,0]" : "+v"(acc[ai][bj][m][n]) : "v"(Bt[n]), "v"(At[m]), "v"(scB), "v"(scA)); } __builtin_amdgcn_s_setprio(0); } while (0)
#define PG8_WAIT_V(n) asm volatile("s_waitcnt vmcnt(" #n ")" ::: "memory")
#define PG8_WAIT_L(n) asm volatile("s_waitcnt lgkmcnt(" #n ")" ::: "memory")
#define PG8_BAR __builtin_amdgcn_s_barrier()
#define PG8_SCHED __builtin_amdgcn_sched_barrier(0)
    GUnit cur, nxt; int ui = 0;
    if (!S.next(0, cur)) return;
    f32x4 acc[2][2][4][2];
#pragma unroll
    for (int a = 0; a < 2; ++a)
#pragma unroll
        for (int b = 0; b < 2; ++b)
#pragma unroll
            for (int m = 0; m < 4; ++m)
#pragma unroll
                for (int n = 0; n < 2; ++n) acc[a][b][m][n] = (f32x4){0.f, 0.f, 0.f, 0.f};
    i32x8 At[4], B0[2], B1[2];
    unsigned c00 = S.aoff(cur, sR0, sC0), c01 = S.aoff(cur, sR1, sC1), c10 = S.aoff(cur, HALF + sR0, sC0), c11 = S.aoff(cur, HALF + sR1, sC1);
    const char* cA = uni_ptr(cur.A); const char* cB = uni_ptr(cur.B);
    PG8_STAGE(PG8_SB(0, 0), cB, vB0, vB1); PG8_STAGE(PG8_SB(0, 1), cB + hstepB, vB0, vB1); PG8_STAGE(PG8_SA(0, 0), cA, c00, c01); PG8_STAGE(PG8_SA(0, 1), cA, c10, c11);
    if (wr == 1) PG8_BAR;
    PG8_WAIT_V(2); PG8_BAR;
    PG8_STAGE(PG8_SB(1, 0), cB + kB, vB0, vB1); PG8_STAGE(PG8_SA(1, 0), cA + kA, c00, c01); PG8_STAGE(PG8_SB(1, 1), cB + hstepB + kB, vB0, vB1);
    PG8_WAIT_V(6); PG8_BAR;
    for (;;) {
        const bool has_next = S.next(ui + 1, nxt);
        if (!has_next) nxt = cur;
        const char* nA = uni_ptr(nxt.A); const char* nB = uni_ptr(nxt.B);
        unsigned n00 = c00, n01 = c01, n10 = c10, n11 = c11;
        if constexpr (!Sched::AOFF_CONST) { if (!Sched::AOFF_PM_ONLY || nxt.pm != cur.pm) { n00 = S.aoff(nxt, sR0, sC0); n01 = S.aoff(nxt, sR1, sC1); n10 = S.aoff(nxt, HALF + sR0, sC0); n11 = S.aoff(nxt, HALF + sR1, sC1); } }
        for (int t = 0; t < nt; t += 2) {
            const bool last = (t == nt - 2);
            const char* a1 = cA + (size_t)(t + 1) * kA;
            const char* a2 = last ? nA : cA + (size_t)(t + 2) * kA; const char* b2 = last ? nB : cB + (size_t)(t + 2) * kB;
            const char* a3 = a2 + kA; const char* b3 = b2 + kB;
            const unsigned x00 = (!Sched::AOFF_CONST && last) ? n00 : c00, x01 = (!Sched::AOFF_CONST && last) ? n01 : c01, x10 = (!Sched::AOFF_CONST && last) ? n10 : c10, x11 = (!Sched::AOFF_CONST && last) ? n11 : c11;
            PG8_LDB(B0, 0, 0); PG8_LDB(B1, 0, 1); PG8_SCHED; PG8_LDA(At, 0, 0); PG8_STAGE(PG8_SA(1, 1), a1, c10, c11);
            PG8_WAIT_V(8); PG8_WAIT_L(0); PG8_BAR; PG8_MMA(0, 0, At, B0); PG8_MMA(0, 1, At, B1); PG8_BAR; PG8_SCHED;
            PG8_LDA(At, 0, 1); PG8_STAGE(PG8_SB(0, 0), b2, vB0, vB1); PG8_STAGE(PG8_SB(0, 1), b2 + hstepB, vB0, vB1); PG8_STAGE(PG8_SA(0, 0), a2, x00, x01);
            PG8_WAIT_V(8); PG8_WAIT_L(0); PG8_BAR; PG8_MMA(1, 0, At, B0); PG8_MMA(1, 1, At, B1); PG8_BAR; PG8_SCHED;
            PG8_LDB(B0, 1, 0); PG8_LDB(B1, 1, 1); PG8_SCHED; PG8_LDA(At, 1, 0); PG8_STAGE(PG8_SA(0, 1), a2, x10, x11);
            PG8_WAIT_V(8); PG8_WAIT_L(0); PG8_BAR; PG8_MMA(0, 0, At, B0); PG8_MMA(0, 1, At, B1); PG8_BAR; PG8_SCHED;
            PG8_LDA(At, 1, 1); PG8_STAGE(PG8_SB(1, 0), b3, vB0, vB1); PG8_STAGE(PG8_SB(1, 1), b3 + hstepB, vB0, vB1); PG8_STAGE(PG8_SA(1, 0), a3, x00, x01);
            PG8_WAIT_V(8); PG8_WAIT_L(0); PG8_BAR; PG8_MMA(1, 0, At, B0); PG8_MMA(1, 1, At, B1); PG8_BAR; PG8_SCHED;
        }
        if (wr == 0) PG8_BAR;
        asm volatile("s_nop 15\n\ts_nop 15" ::: "memory");
        if (MODE == 0) E(acc, cur, wr, wc, fr, fq); else asm volatile("" :: "v"(acc[0][0][0][0]), "v"(acc[1][1][3][1]));
        if (!has_next) break;
#pragma unroll
        for (int a = 0; a < 2; ++a)
#pragma unroll
            for (int b = 0; b < 2; ++b)
#pragma unroll
                for (int m = 0; m < 4; ++m)
#pragma unroll
                    for (int n = 0; n < 2; ++n) acc[a][b][m][n] = (f32x4){0.f, 0.f, 0.f, 0.f};
        cur = nxt; cA = nA; cB = nB; ++ui;
        c00 = n00; c01 = n01; c10 = n10; c11 = n11;
        if (wr == 1) PG8_BAR;
    }
    PG8_WAIT_V(0);
    PG8_BAR;
#undef PG8_SA
#undef PG8_SB
#undef PG8_STAGE
#undef PG8_LDA
#undef PG8_LDB
#undef PG8_MMA
#undef PG8_F8
#undef PG8_WAIT_V
#undef PG8_WAIT_L
#undef PG8_BAR
#undef PG8_SCHED
}
}

struct Args { const float* in[35]; float* out; unsigned char* ws; int ph_lo, ph_hi; };
struct Frame {
    LAS unsigned char* lds;
    int tid, lane, wave, G, bid;
    float* out; unsigned char* ws;
};
__device__ __forceinline__ const float* inptr(const Frame& F, int i) {
    const LAS unsigned* t = (const LAS unsigned*)(F.lds + LDSCTL_OFF) + 2 * i;
    const unsigned lo = __builtin_amdgcn_readfirstlane(t[0]), hi = __builtin_amdgcn_readfirstlane(t[1]);
    const GAS float* g = (const GAS float*)(((unsigned long long)hi << 32) | lo);
    return (const float*)g;
}
enum { I_X = 0, I_C, I_CTX, I_CCTX, I_MODW, I_MODB, I_N1G, I_N2G, I_WIN, I_WOUT, I_CONVW, I_CONVB, I_HW1, I_HB1, I_HFREQ, I_HW2, I_HB2, I_HW3, I_HB3, I_HBIAS,
       I_LRE, I_LIM, I_LSTEP, I_BRE, I_BIM, I_CRE, I_CIM, I_S5D, I_GLUW, I_GLUB, I_RW, I_WG, I_WU, I_WD, I_FING };

struct SchedPlain {
    static constexpr bool AOFF_PM_ONLY = true, AOFF_CONST = true;
    gm::TileOrder T; const char* A; const char* B; unsigned lda, ldb, kstepA, kstepB; int nt; int mt; size_t az, bz;
    __device__ __forceinline__ bool next(int i, gm::GUnit& u) const {
        int pm, pn; if (!T.get(i, pm, pn)) return false; const int z = pm / mt, pl = pm - z * mt;
        u.pm = pm; u.pn = pn; u.A = A + (size_t)z * az + (size_t)pl * 256 * lda; u.B = B + (size_t)z * bz + (size_t)pn * 256 * ldb; return true; }
    __device__ __forceinline__ unsigned aoff(const gm::GUnit&, int row, int col) const { return (unsigned)row * lda + (unsigned)col * 2u; }
};
struct SchedMoe1 {
    static constexpr bool AOFF_PM_ONLY = true, AOFF_CONST = false;
    gm::TileOrder T; const char* A; const char* B; const int* idx; unsigned lda, ldb, kstepA, kstepB; int nt;
    __device__ __forceinline__ bool next(int i, gm::GUnit& u) const {
        int pm, pn; if (!T.get(i, pm, pn)) return false; const int e = pm >> 4;
        u.pm = pm; u.pn = pn; u.A = A; u.B = B + ((size_t)e * (2 * FF) + (size_t)pn * 256) * ldb; return true; }
    __device__ __forceinline__ unsigned aoff(const gm::GUnit& u, int row, int col) const { const int tok = idx[u.pm * 256 + row]; return (unsigned)tok * lda + (unsigned)col * 2u; }
};
struct SchedGlu {
    static constexpr bool AOFF_PM_ONLY = true;
    gm::TileOrder T; const char* A; const char* B; unsigned ldb, kstepA, kstepB; int nt;
    __device__ __forceinline__ bool next(int i, gm::GUnit& u) const {
        int pm, pn; if (!T.get(i, pm, pn)) return false;
        u.pm = pm; u.pn = pn; u.A = A + (size_t)pm * 256 * 32; u.B = B + (size_t)pn * 256 * ldb; return true; }
    __device__ __forceinline__ unsigned aoff(const gm::GUnit&, int row, int col) const { return (unsigned)(col >> 4) * (unsigned)(1024 * 512 * 2) + (unsigned)row * 32u + (unsigned)(col & 15) * 2u; }
};

using gm::GUnit; using gm::cvt_pk_bf16;
struct EpiZT { static constexpr bool PERM = false; bf16* ZT;
    __device__ __forceinline__ void operator()(const f32x4 (&acc)[2][2][4][2], const GUnit& u, int wr, int wc, int fr, int fq) const {
#pragma unroll
        for (int bj = 0; bj < 2; ++bj)
#pragma unroll
            for (int n = 0; n < 2; ++n) { const int ch = u.pn * 256 + bj * 128 + wc * 32 + n * 16 + fr; bf16* rowp = ZT + (size_t)ch * NTOK + u.pm * 256 + wr * 64 + 4 * fq;
#pragma unroll
                for (int ai = 0; ai < 2; ++ai)
#pragma unroll
                    for (int m = 0; m < 4; ++m) { const f32x4 v = acc[ai][bj][m][n]; u32x2 w; w.x = cvt_pk_bf16(v[0], v[1]); w.y = cvt_pk_bf16(v[2], v[3]); *(u32x2*)(rowp + ai * 128 + m * 16) = w; } }
    }
};
struct EpiUG { static constexpr bool PERM = true; bf16* UG;
    __device__ __forceinline__ void operator()(const f32x4 (&acc)[2][2][4][2], const GUnit& u, int wr, int wc, int fr, int fq) const {
#pragma unroll
        for (int ai = 0; ai < 2; ++ai)
#pragma unroll
            for (int m = 0; m < 4; ++m) { const int r = u.pm * 256 + ai * 128 + wr * 64 + m * 16 + fr; int crow, tau;
                if (r < NTOK) { crow = r >> 5; tau = r & 31; } else { const int rc = r - NTOK; crow = 1024 + (rc >> 5); tau = rc & 31; }
#pragma unroll
                for (int bj = 0; bj < 2; ++bj) { const int c0 = u.pn * 256 + bj * 128 + wc * 32 + 8 * fq; const int g = c0 >> 4, h0 = c0 & 15;
                    const f32x4 v0 = acc[ai][bj][m][0], v1 = acc[ai][bj][m][1]; u32x4 w; w.x = cvt_pk_bf16(v0[0], v0[1]); w.y = cvt_pk_bf16(v0[2], v0[3]); w.z = cvt_pk_bf16(v1[0], v1[1]); w.w = cvt_pk_bf16(v1[2], v1[3]);
                    *(u32x4*)(UG + ((size_t)g * UROWS + crow) * UCOLS + tau * 16 + h0) = w; } }
    }
};
struct EpiEB { static constexpr bool PERM = false; float* EB;
    __device__ __forceinline__ void operator()(const f32x4 (&acc)[2][2][4][2], const GUnit& u, int wr, int wc, int fr, int fq) const {
        const int g = u.pm / 5, pl = u.pm - g * 5;
#pragma unroll
        for (int ai = 0; ai < 2; ++ai)
#pragma unroll
            for (int m = 0; m < 4; ++m) { float* rowp = EB + ((size_t)g * UROWS + pl * 256 + ai * 128 + wr * 64 + m * 16 + fr) * 256 + wc * 32 + 4 * fq;
#pragma unroll
                for (int bj = 0; bj < 2; ++bj)
#pragma unroll
                    for (int n = 0; n < 2; ++n) *(f32x4*)(rowp + bj * 128 + n * 16) = acc[ai][bj][m][n]; }
    }
};
struct EpiYS { static constexpr bool PERM = true; bf16* YSG; const bf16* UG; const float* s5d;
    __device__ __forceinline__ void operator()(const f32x4 (&acc)[2][2][4][2], const GUnit& u, int wr, int wc, int fr, int fq) const {
        const int g = u.pm >> 2, pl = u.pm & 3;
        float dv[2][8];
#pragma unroll
        for (int bj = 0; bj < 2; ++bj) { const int c0 = u.pn * 256 + bj * 128 + wc * 32 + 8 * fq;
#pragma unroll
            for (int j = 0; j < 8; ++j) dv[bj][j] = s5d[g * 16 + ((c0 + j) & 15)]; }
#pragma unroll
        for (int ai = 0; ai < 2; ++ai)
#pragma unroll
            for (int m = 0; m < 4; ++m) { const int crow = pl * 256 + ai * 128 + wr * 64 + m * 16 + fr;
#pragma unroll
                for (int bj = 0; bj < 2; ++bj) { const int c0 = u.pn * 256 + bj * 128 + wc * 32 + 8 * fq;
                    const u32x4 uu = *(const u32x4*)(UG + ((size_t)g * UROWS + crow) * UCOLS + c0);
                    const f32x4 v0 = acc[ai][bj][m][0], v1 = acc[ai][bj][m][1];
                    float y[8]; y[0] = v0[0] + dv[bj][0] * bflo(uu.x); y[1] = v0[1] + dv[bj][1] * bfhi(uu.x); y[2] = v0[2] + dv[bj][2] * bflo(uu.y); y[3] = v0[3] + dv[bj][3] * bfhi(uu.y);
                    y[4] = v1[0] + dv[bj][4] * bflo(uu.z); y[5] = v1[1] + dv[bj][5] * bfhi(uu.z); y[6] = v1[2] + dv[bj][6] * bflo(uu.w); y[7] = v1[3] + dv[bj][7] * bfhi(uu.w);
#pragma unroll
                    for (int j = 0; j < 8; ++j) y[j] = gelu_tanh(y[j]);
                    u32x4 w; w.x = cvt_pk_bf16(y[0], y[1]); w.y = cvt_pk_bf16(y[2], y[3]); w.z = cvt_pk_bf16(y[4], y[5]); w.w = cvt_pk_bf16(y[6], y[7]);
                    *(u32x4*)(YSG + ((size_t)g * 1024 + crow) * 512 + c0) = w; } }
    }
};
struct EpiGlu { static constexpr bool PERM = true; bf16* YCAT; const bf16* YSG; const float* glub;
    __device__ __forceinline__ void operator()(const f32x4 (&acc)[2][2][4][2], const GUnit& u, int wr, int wc, int fr, int fq) const {
#pragma unroll
        for (int bj = 0; bj < 2; ++bj) { const int n0 = u.pn * 256 + bj * 128 + wc * 32 + 8 * fq; const int g = n0 >> 4, h0 = n0 & 15;
            const f32x4 b0 = *(const f32x4*)(glub + n0), b1 = *(const f32x4*)(glub + n0 + 4);
#pragma unroll
            for (int ai = 0; ai < 2; ++ai)
#pragma unroll
                for (int m = 0; m < 4; ++m) { const int tok = u.pm * 256 + ai * 128 + wr * 64 + m * 16 + fr;
                    const u32x4 ys = *(const u32x4*)(YSG + ((size_t)g * 1024 + (tok >> 5)) * 512 + (tok & 31) * 16 + h0);
                    const f32x4 v0 = acc[ai][bj][m][0] + b0, v1 = acc[ai][bj][m][1] + b1;
                    float y[8]; y[0] = bflo(ys.x) * sigmoidf_(v0[0]); y[1] = bfhi(ys.x) * sigmoidf_(v0[1]); y[2] = bflo(ys.y) * sigmoidf_(v0[2]); y[3] = bfhi(ys.y) * sigmoidf_(v0[3]);
                    y[4] = bflo(ys.z) * sigmoidf_(v1[0]); y[5] = bfhi(ys.z) * sigmoidf_(v1[1]); y[6] = bflo(ys.w) * sigmoidf_(v1[2]); y[7] = bfhi(ys.w) * sigmoidf_(v1[3]);
                    u32x4 w; w.x = cvt_pk_bf16(y[0], y[1]); w.y = cvt_pk_bf16(y[2], y[3]); w.z = cvt_pk_bf16(y[4], y[5]); w.w = cvt_pk_bf16(y[6], y[7]);
#ifdef DBG_S5_SCALE
                    w.x = cvt_pk_bf16(y[0] * DBG_S5_SCALE, y[1] * DBG_S5_SCALE); w.y = cvt_pk_bf16(y[2] * DBG_S5_SCALE, y[3] * DBG_S5_SCALE); w.z = cvt_pk_bf16(y[4] * DBG_S5_SCALE, y[5] * DBG_S5_SCALE); w.w = cvt_pk_bf16(y[6] * DBG_S5_SCALE, y[7] * DBG_S5_SCALE);
#endif
                    *(u32x4*)(YCAT + (size_t)tok * DM + 512 + n0) = w; } }
    }
};
struct EpiXmid { static constexpr bool PERM = false; const float* x; bf16* xmid; const float* mod;
    __device__ __forceinline__ void operator()(const f32x4 (&acc)[2][2][4][2], const GUnit& u, int wr, int wc, int fr, int fq) const {
        const int b = u.pm >> 4;
        const int col0 = u.pn * 256 + wc * 32 + 4 * fq;
        f32x4 gv[2][2];
#pragma unroll
        for (int bj = 0; bj < 2; ++bj)
#pragma unroll
            for (int n = 0; n < 2; ++n) gv[bj][n] = *(const f32x4*)(mod + (size_t)b * (NMOD * DM) + 2 * DM + col0 + bj * 128 + n * 16);
#pragma unroll
        for (int ai = 0; ai < 2; ++ai)
#pragma unroll
            for (int m = 0; m < 4; ++m) { const size_t off = (size_t)(u.pm * 256 + ai * 128 + wr * 64 + m * 16 + fr) * DM + col0;
#pragma unroll
                for (int bj = 0; bj < 2; ++bj)
#pragma unroll
                    for (int n = 0; n < 2; ++n) { const f32x4 xv = *(const f32x4*)(x + off + bj * 128 + n * 16); const f32x4 rv = xv + gv[bj][n] * acc[ai][bj][m][n]; u32x2 o; o.x = pk2(rv.x, rv.y); o.y = pk2(rv.z, rv.w); *(u32x2*)(xmid + off + bj * 128 + n * 16) = o; } }
    }
};
struct EpiMoe1 { static constexpr bool PERM = true; unsigned char* HB;
    __device__ __forceinline__ void operator()(const f32x4 (&acc)[2][2][4][2], const GUnit& u, int wr, int wc, int fr, int fq) const {
        const int c0 = u.pn * 128 + wc * 32 + 8 * fq;
#pragma unroll
        for (int ai = 0; ai < 2; ++ai)
#pragma unroll
            for (int m = 0; m < 4; ++m) { const size_t row = (size_t)u.pm * 256 + ai * 128 + wr * 64 + m * 16 + fr;
                float y[8];
#pragma unroll
                for (int n = 0; n < 2; ++n)
#pragma unroll
                    for (int j = 0; j < 4; ++j) y[n * 4 + j] = fminf(fmaxf(siluf_(acc[ai][0][m][n][j]) * acc[ai][1][m][n][j], -448.0f), 448.0f);
                u32x2 w; w.x = pk4_fp8(y[0], y[1], y[2], y[3]); w.y = pk4_fp8(y[4], y[5], y[6], y[7]);
                *(u32x2*)(HB + row * FF + c0) = w; }
    }
};
struct EpiMoe2 { static constexpr bool PERM = true; bf16* Y; const float* gate;
    __device__ __forceinline__ void operator()(const f32x4 (&acc)[2][2][4][2], const GUnit& u, int wr, int wc, int fr, int fq) const {
#pragma unroll
        for (int ai = 0; ai < 2; ++ai)
#pragma unroll
            for (int m = 0; m < 4; ++m) { const size_t row = (size_t)u.pm * 256 + ai * 128 + wr * 64 + m * 16 + fr; const float gt = gate[row];
#pragma unroll
                for (int bj = 0; bj < 2; ++bj) { const int c0 = u.pn * 256 + bj * 128 + wc * 32 + 8 * fq;
                    const f32x4 v0 = acc[ai][bj][m][0] * gt, v1 = acc[ai][bj][m][1] * gt;
                    u32x4 w; w.x = cvt_pk_bf16(v0[0], v0[1]); w.y = cvt_pk_bf16(v0[2], v0[3]); w.z = cvt_pk_bf16(v1[0], v1[1]); w.w = cvt_pk_bf16(v1[2], v1[3]);
                    *(u32x4*)(Y + row * DM + c0) = w; } }
    }
};

__device__ __forceinline__ void tr_item(const float* W, int N, bf16* WT, int ldk, int k0, int n0, int drow0, LAS float* scr, int lane) {
    float tv[32];
    const float* wp = W + (size_t)(k0 + (lane >> 5)) * N + n0 + (lane & 31);
#pragma unroll
    for (int i = 0; i < 32; ++i) tv[i] = wp[(size_t)(2 * i) * N];
#pragma unroll
    for (int i = 0; i < 32; ++i) scr[(2 * i + (lane >> 5)) * 33 + (lane & 31)] = tv[i];
    LDS_WAIT(); asm volatile("" ::: "memory");
    const int c = lane & 7;
#pragma unroll
    for (int j = 0; j < 4; ++j) { const int n = (lane >> 3) + 8 * j; const LAS float* s = scr + (8 * c) * 33 + n;
        u32x4 o; o.x = pk2(s[0 * 33], s[1 * 33]); o.y = pk2(s[2 * 33], s[3 * 33]); o.z = pk2(s[4 * 33], s[5 * 33]); o.w = pk2(s[6 * 33], s[7 * 33]);
        *(u32x4*)(WT + (size_t)(drow0 + n) * ldk + k0 + 8 * c) = o; }
    LDS_WAIT(); asm volatile("" ::: "memory");
}
__device__ __forceinline__ void p0_transposes(Frame& F) {
    LAS float* scr = (LAS float*)(F.lds + F.wave * 16384);
    if (F.bid >= 192) return;
    const int gw = F.bid * NWAVES + F.wave, NGW = 192 * NWAVES;
    constexpr int I0 = 16 * 64, I1 = 16 * 32, I2 = 8 * 16, IG = 16 * 16 * 88;
    constexpr int NIT = I0 + I1 + I2;
    bf16* ws16 = (bf16*)F.ws;
    for (int it = gw; it < NIT; it += NGW) {
        int r = it;
        if (r < I0) { const int kb = r / 64, nb = r % 64; tr_item(inptr(F, I_WIN), INC, (bf16*)(F.ws + WS_WINT), DM, kb * 64, nb * 32, nb * 32, scr, F.lane); continue; } r -= I0;
        if (r < I1) { const int kb = r / 32, nb = r % 32; tr_item(inptr(F, I_WOUT), DM, (bf16*)(F.ws + WS_WOUTT), DM, kb * 64, nb * 32, nb * 32, scr, F.lane); continue; } r -= I1;
        if (r < I2) { const int kb = r / 16, nb = r % 16; tr_item(inptr(F, I_GLUW), S5W, (bf16*)(F.ws + WS_GLUT), S5W, kb * 64, nb * 32, nb * 32, scr, F.lane); continue; } r -= I2;
        if (r < 2 * IG) { const int up = r >= IG; if (up) r -= IG; const int e = r / (16 * 88), q = r % (16 * 88), kb = q / 88, nb = q % 88, n0 = nb * 32;
            const float* W = inptr(F, up ? I_WU : I_WG) + (size_t)e * DM * FF;
            tr_item(W, FF, (bf16*)(F.ws + WS_WGUT) + (size_t)e * (2 * FF) * DM, DM, kb * 64, n0, 256 * (n0 >> 7) + (n0 & 127) + (up ? 128 : 0), scr, F.lane); continue; }
    }
    (void)ws16;
}
__device__ __forceinline__ void tr_item_f8(const float* W, int N, unsigned char* WT, int ldk, int k0, int n0, int drow0, float sc, LAS float* scr, int lane) {
    float tv[32];
    const float* wp = W + (size_t)(k0 + (lane >> 5)) * N + n0 + (lane & 31);
#pragma unroll
    for (int i = 0; i < 32; ++i) tv[i] = wp[(size_t)(2 * i) * N];
#pragma unroll
    for (int i = 0; i < 32; ++i) scr[(2 * i + (lane >> 5)) * 33 + (lane & 31)] = tv[i];
    LDS_WAIT(); asm volatile("" ::: "memory");
    const int c = lane & 7;
#pragma unroll
    for (int j = 0; j < 4; ++j) { const int n = (lane >> 3) + 8 * j; const LAS float* s = scr + (8 * c) * 33 + n;
        u32x2 o; o.x = pk4_fp8(s[0 * 33] * sc, s[1 * 33] * sc, s[2 * 33] * sc, s[3 * 33] * sc); o.y = pk4_fp8(s[4 * 33] * sc, s[5 * 33] * sc, s[6 * 33] * sc, s[7 * 33] * sc);
        *(u32x2*)(WT + (size_t)(drow0 + n) * ldk + k0 + 8 * c) = o; }
    LDS_WAIT(); asm volatile("" ::: "memory");
}
__device__ __forceinline__ void dn_issue(Frame& F, int r, float (&tv)[32]) {
    if (r >= 16 * 44 * 32) return;
    const int e = r / (44 * 32), q = r % (44 * 32), kb = q / 32, nb = q % 32;
    const float* wp = inptr(F, I_WD) + (size_t)e * FF * DM + (size_t)(kb * 64 + (F.lane >> 5)) * DM + nb * 32 + (F.lane & 31);
#pragma unroll
    for (int i = 0; i < 32; ++i) tv[i] = wp[(size_t)(2 * i) * DM];
}
__device__ __forceinline__ void dn_finish(Frame& F, int r, const float (&tv)[32], LAS float* scr) {
    if (r >= 16 * 44 * 32) return;
    const int e = r / (44 * 32), q = r % (44 * 32), kb = q / 32, nb = q % 32, lane = F.lane;
    unsigned char* WT = (unsigned char*)(F.ws + WS_WDT) + (size_t)e * DM * FF;
#pragma unroll
    for (int i = 0; i < 32; ++i) scr[(2 * i + (lane >> 5)) * 33 + (lane & 31)] = tv[i];
    LDS_WAIT(); asm volatile("" ::: "memory");
    const int c = lane & 7;
#pragma unroll
    for (int j = 0; j < 4; ++j) { const int n = (lane >> 3) + 8 * j; const LAS float* s = scr + (8 * c) * 33 + n;
        u32x2 o; o.x = pk4_fp8(s[0 * 33] * WD_SCALE, s[1 * 33] * WD_SCALE, s[2 * 33] * WD_SCALE, s[3 * 33] * WD_SCALE); o.y = pk4_fp8(s[4 * 33] * WD_SCALE, s[5 * 33] * WD_SCALE, s[6 * 33] * WD_SCALE, s[7 * 33] * WD_SCALE);
        *(u32x2*)(WT + (size_t)(nb * 32 + n) * FF + kb * 64 + 8 * c) = o; }
    LDS_WAIT(); asm volatile("" ::: "memory");
}
__device__ __forceinline__ void p_down_items(Frame& F, int first, int count, int stride) {
    LAS float* scr = (LAS float*)(F.lds + F.wave * 16384);
    float ta[32], tb[32];
    dn_issue(F, first, ta);
#pragma unroll 1
    for (int k = 0; k < count; k += 2) {
        if (k + 1 < count) dn_issue(F, first + (k + 1) * stride, tb);
        dn_finish(F, first + k * stride, ta, scr);
        if (k + 2 < count) dn_issue(F, first + (k + 2) * stride, ta);
        if (k + 1 < count) dn_finish(F, first + (k + 1) * stride, tb, scr);
    }
}
constexpr int DN_P4 = 3 * 6 * 256, DN_P9 = 10 * 8 * 128, DN_P3 = 4 * 8 * 96, DN_P0 = 22528 - DN_P4 - DN_P9 - DN_P3;
__device__ __forceinline__ void p0_adaln_item(Frame& F, int item) {
    LAS float* sl = (LAS float*)F.lds;
    LAS float* part = sl + 9 * 1024;
    for (int i = F.tid; i < 9 * 1024; i += NTHR) { const int r = i >> 10, k = i & 1023; const float v = (r < 8) ? inptr(F, I_C)[r * DM + k] : inptr(F, I_CCTX)[k]; sl[i] = siluf_(v); }
    __syncthreads();
    const int cl = F.tid & 31, kq = F.tid >> 5, j = item * 32 + cl;
    float a[9];
#pragma unroll
    for (int r = 0; r < 9; ++r) a[r] = 0.f;
    const float* W = inptr(F, I_MODW);
#pragma unroll 16
    for (int kk = 0; kk < 64; ++kk) { const int k = kq + 16 * kk; const float w = W[(size_t)k * (NMOD * DM) + j];
#pragma unroll
        for (int r = 0; r < 9; ++r) a[r] += sl[r * 1024 + k] * w; }
#pragma unroll
    for (int r = 0; r < 9; ++r) part[(kq * 9 + r) * 32 + cl] = a[r];
    __syncthreads();
    if (F.tid < 9 * 32) { const int r = F.tid >> 5, c2 = F.tid & 31; float s = inptr(F, I_MODB)[item * 32 + c2];
#pragma unroll
        for (int q = 0; q < 16; ++q) s += part[(q * 9 + r) * 32 + c2];
        ((float*)(F.ws + WS_MOD))[(size_t)r * (NMOD * DM) + item * 32 + c2] = s; }
    __syncthreads();
}
__device__ __forceinline__ void p0_s5_tables(Frame& F, int g) {
    typedef float f32x2 __attribute__((ext_vector_type(2)));
    LAS f32x2* PW = (LAS f32x2*)F.lds;
    LAS f32x2* BB = PW + 2 * 33 * 64;
    LAS float* KT = (LAS float*)(BB + 2 * 64 * 16);
    LAS f32x2* CC = (LAS f32x2*)(KT + 2 * 32 * 256);
    const float* lre = inptr(F, I_LRE); const float* lim = inptr(F, I_LIM); const float* lst = inptr(F, I_LSTEP);
    const float* cre = inptr(F, I_CRE); const float* cim = inptr(F, I_CIM);
    for (int i = F.tid; i < 2 * 33 * 64; i += NTHR) { const int dir = i / (33 * 64), e = (i / 64) % 33, p = i & 63;
        const double lr = lre[(dir * NG + g) * NP + p], li = lim[(dir * NG + g) * NP + p], dt = exp((double)lst[dir * NG + g]);
        double ph = li * dt * e; ph -= 6.283185307179586 * floor(ph * 0.15915494309189535);
        const float m = expf((float)(lr * dt * e)); float sn, cs; sincosf((float)ph, &sn, &cs); const float cr = m * cs, ci = m * sn;
        PW[i] = (f32x2){cr, ci};
        if (e == 32) { float* LT = (float*)(F.ws + WS_LT); LT[((dir * NG + g) * NP + p) * 2] = cr; LT[((dir * NG + g) * NP + p) * 2 + 1] = ci; } }
    __syncthreads();
    for (int i = F.tid; i < 2 * 16 * 64; i += NTHR) { const int dir = i >> 10, h = (i >> 6) & 15, p = i & 63; const size_t ci = (((size_t)dir * NG + g) * GH + h) * NP + p; CC[i] = (f32x2){cre[ci], cim[ci]}; }
    for (int i = F.tid; i < 2 * 64 * 16; i += NTHR) { const int dir = i >> 10, p = (i >> 4) & 63, h = i & 15;
        const double lr = lre[(dir * NG + g) * NP + p], li = lim[(dir * NG + g) * NP + p];
        const f32x2 lb = PW[(dir * 33 + 1) * 64 + p]; const double ar = (double)lb.x - 1.0, ai = (double)lb.y, den = lr * lr + li * li;
        const double fr_ = (ar * lr + ai * li) / den, fi_ = (ai * lr - ar * li) / den;
        const size_t bi = (((size_t)dir * NG + g) * NP + p) * GH + h; const double br = inptr(F, I_BRE)[bi], bim = inptr(F, I_BIM)[bi];
        BB[i] = (f32x2){(float)(fr_ * br - fi_ * bim), (float)(fr_ * bim + fi_ * br)}; }
    __syncthreads();
    {
        const int dir = F.tid >> 8, h = (F.tid >> 4) & 15, hp = F.tid & 15;
        for (int d = 0; d < 32; ++d) KT[(dir * 32 + d) * 256 + (F.tid & 255)] = 0.f;
        for (int pc = 0; pc < 4; ++pc) { float qr[16], qi[16];
#pragma unroll
            for (int j = 0; j < 16; ++j) { const int p = pc * 16 + j; const f32x2 cc = CC[(dir * 16 + h) * 64 + p]; const float cr = cc.x, cj = cc.y; const f32x2 b = BB[(dir * 64 + p) * 16 + hp];
                qr[j] = cr * b.x - cj * b.y; qi[j] = cr * b.y + cj * b.x; }
            for (int d = 0; d < 32; ++d) { float s = 0.f;
#pragma unroll
                for (int j = 0; j < 16; ++j) { const f32x2 w = PW[(dir * 33 + d) * 64 + pc * 16 + j]; s += qr[j] * w.x - qi[j] * w.y; }
                KT[(dir * 32 + d) * 256 + (F.tid & 255)] += s; } }
    }
    __syncthreads();
    { float* TAB = (float*)(F.ws + WS_S5TAB) + (size_t)g * S5TAB_FLOATS; const LAS float* src = (const LAS float*)F.lds;
      for (int i = F.tid; i < S5TAB_FLOATS / 4; i += NTHR) ((f32x4*)TAB)[i] = ((const LAS f32x4*)src)[i]; }
    __syncthreads();
}
__device__ __forceinline__ void p1_s5_expand(Frame& F) {
    typedef float f32x2 __attribute__((ext_vector_type(2)));
    const int g = F.bid >> 3, part = F.bid & 7;
    LAS f32x2* PW = (LAS f32x2*)F.lds;
    LAS f32x2* BB = PW + 2 * 33 * 64;
    LAS float* KT = (LAS float*)(BB + 2 * 64 * 16);
    LAS f32x2* CC = (LAS f32x2*)(KT + 2 * 32 * 256);
    { const float* TAB = (const float*)(F.ws + WS_S5TAB) + (size_t)g * S5TAB_FLOATS; LAS float* dst = (LAS float*)F.lds;
      for (int i = F.tid; i < S5TAB_FLOATS / 4; i += NTHR) ((LAS f32x4*)dst)[i] = ((const f32x4*)TAB)[i]; }
    __syncthreads();
    bf16* MCT = (bf16*)(F.ws + WS_MCT) + (size_t)g * 512 * UCOLS;
    for (int pc = F.tid; pc < 64 * 64; pc += NTHR) { const int rw = part * 64 + (pc >> 6), q = pc & 63, tau = rw >> 4, h = rw & 15, s = q >> 1, h0 = (q & 1) * 8;
        float v[8];
#pragma unroll
        for (int j = 0; j < 8; ++j) { float a = 0.f; if (s <= tau) a += KT[(0 * 32 + (tau - s)) * 256 + h * 16 + h0 + j]; if (s >= tau) a += KT[(1 * 32 + (s - tau)) * 256 + h * 16 + h0 + j]; v[j] = a; }
        u32x4 w; w.x = pk2(v[0], v[1]); w.y = pk2(v[2], v[3]); w.z = pk2(v[4], v[5]); w.w = pk2(v[6], v[7]);
        *(u32x4*)(MCT + (size_t)rw * UCOLS + s * 16 + h0) = w; }
    for (int pc = F.tid; pc < 64 * 32; pc += NTHR) { const int rw = part * 64 + (pc >> 5), q = pc & 31, tau = rw >> 4, h = rw & 15, dir = q >> 4, ri = (q >> 3) & 1, p0 = (q & 7) * 8;
        const int e = dir ? (32 - tau) : (tau + 1);
        float v[8];
#pragma unroll
        for (int j = 0; j < 8; ++j) { const int p = p0 + j; const f32x2 cc = CC[(dir * 16 + h) * 64 + p]; const float cr = cc.x, cj = cc.y; const f32x2 w = PW[(dir * 33 + e) * 64 + p];
            v[j] = ri ? -(cr * w.y + cj * w.x) : (cr * w.x - cj * w.y); }
        u32x4 w; w.x = pk2(v[0], v[1]); w.y = pk2(v[2], v[3]); w.z = pk2(v[4], v[5]); w.w = pk2(v[6], v[7]);
        *(u32x4*)(MCT + (size_t)rw * UCOLS + 512 + dir * 128 + ri * 64 + p0) = w; }
    bf16* WAT = (bf16*)(F.ws + WS_WAT) + (size_t)g * 256 * 512;
    for (int pc = F.tid; pc < 32 * 64; pc += NTHR) { const int rw = part * 32 + (pc >> 6), q = pc & 63, dir = rw >> 7, ri = (rw >> 6) & 1, p = rw & 63, s = q >> 1, h0 = (q & 1) * 8;
        const f32x2 w = PW[(dir * 33 + (dir ? s : (31 - s))) * 64 + p];
        float v[8];
#pragma unroll
        for (int j = 0; j < 8; ++j) { const f32x2 b = BB[(dir * 64 + p) * 16 + h0 + j]; v[j] = ri ? (w.x * b.y + w.y * b.x) : (w.x * b.x - w.y * b.y); }
        u32x4 o; o.x = pk2(v[0], v[1]); o.y = pk2(v[2], v[3]); o.z = pk2(v[4], v[5]); o.w = pk2(v[6], v[7]);
        *(u32x4*)(WAT + (size_t)rw * 512 + s * 16 + h0) = o; }
    __syncthreads();
}
__device__ __forceinline__ void p0_filter_l12(Frame& F, int i0, int npos) {
    LAS float* sc = (LAS float*)(F.lds + F.wave * 1024);
    const int j = F.lane;
    const float* hw1 = inptr(F, I_HW1); const float* hw2 = inptr(F, I_HW2); const float* hfq = inptr(F, I_HFREQ);
    float w1c[33], w2c[64];
#pragma unroll
    for (int f = 0; f < 33; ++f) w1c[f] = hw1[f * 64 + j];
#pragma unroll
    for (int k = 0; k < 64; ++k) w2c[k] = hw2[k * 64 + j];
    const float b1 = inptr(F, I_HB1)[j], b2 = inptr(F, I_HB2)[j], f0 = hfq[j], f1 = hfq[64 + j];
    for (int q = 0; q < npos; ++q) { const int i = i0 + q;
        if (j < 33) { const double L = (double)SEQ; double v;
            if (j == 0) v = (double)i / (L - 1.0);
            else { const int k = (j - 1) & 15; const double f = 1e-4 + (double)k * ((15.0 - 1e-4) / 15.0), om = 6.283185307179586 * (double)i / L; v = (j <= 16) ? cos(f * om) : -sin(f * om); }
            sc[j] = (float)v; }
        LDS_WAIT(); asm volatile("" ::: "memory");
        float a = b1;
#pragma unroll
        for (int f = 0; f < 33; ++f) a += sc[f] * w1c[f];
        sc[64 + j] = sinf(f0 * a);
        LDS_WAIT(); asm volatile("" ::: "memory");
        float b = b2;
#pragma unroll
        for (int k = 0; k < 64; ++k) b += sc[64 + k] * w2c[k];
        ((float*)(F.ws + WS_FH2))[(size_t)j * SEQ + i] = sinf(f1 * b);
        LDS_WAIT(); asm volatile("" ::: "memory"); }
}
__device__ __forceinline__ void phase0(Frame& F) {
    if (F.bid < 192) p0_adaln_item(F, F.bid);
    else if (F.bid < 224) p0_s5_tables(F, F.bid - 192);
    else p0_filter_l12(F, (F.bid - 224) * 128 + F.wave * 16, 16);
    __syncthreads();
    p0_transposes(F);
    if (F.bid < 192) p_down_items(F, DN_P4 + DN_P9 + DN_P3 + F.bid * 8 + F.wave, 3, 192 * 8);
}

__device__ __forceinline__ void norm_mod_row(const float* xrow, const float* gam, const float* shift, const float* scale, bf16* orow, int lane) {
    const f32x4* xr = (const f32x4*)xrow + lane;
    f32x4 v[4]; float s = 0.f;
#pragma unroll
    for (int j = 0; j < 4; ++j) { v[j] = xr[64 * j]; s += (v[j].x * v[j].x + v[j].y * v[j].y) + (v[j].z * v[j].z + v[j].w * v[j].w); }
    const float rstd = 1.0f / sqrtf(wave_sum(s) * (1.0f / DM) + NORM_EPS);
    unsigned long long* o8 = (unsigned long long*)orow + lane;
#pragma unroll
    for (int j = 0; j < 4; ++j) { const f32x4 g = ((const f32x4*)gam)[lane + 64 * j], sh = ((const f32x4*)shift)[lane + 64 * j], sc = ((const f32x4*)scale)[lane + 64 * j];
        const f32x4 y = (v[j] * rstd * g) * (sc + 1.0f) + sh;
        o8[64 * j] = (unsigned long long)pk2(y.x, y.y) | ((unsigned long long)pk2(y.z, y.w) << 32); }
}
__device__ __forceinline__ void p1_norm_rows(const float* xbase, bf16* obase, int nrows, const float* gam, const float* shift, const float* scale, int lane) {
    f32x4 GM[4], SH[4];
#pragma unroll
    for (int j = 0; j < 4; ++j) { const f32x4 g = ((const f32x4*)gam)[lane + 64 * j], sc = ((const f32x4*)scale)[lane + 64 * j]; GM[j] = g * (sc + 1.0f); SH[j] = ((const f32x4*)shift)[lane + 64 * j]; }
    for (int r = 0; r < nrows; r += 4) {
        f32x4 v[4][4];
#pragma unroll
        for (int q = 0; q < 4; ++q) if (r + q < nrows) { const f32x4* xr = (const f32x4*)(xbase + (size_t)(r + q) * DM) + lane;
#pragma unroll
            for (int j = 0; j < 4; ++j) v[q][j] = xr[64 * j]; }
#pragma unroll
        for (int q = 0; q < 4; ++q) if (r + q < nrows) { float s = 0.f;
#pragma unroll
            for (int j = 0; j < 4; ++j) s += (v[q][j].x * v[q][j].x + v[q][j].y * v[q][j].y) + (v[q][j].z * v[q][j].z + v[q][j].w * v[q][j].w);
            const float rstd = 1.0f / sqrtf(wave_sum(s) * (1.0f / DM) + NORM_EPS);
            unsigned long long* o8 = (unsigned long long*)(obase + (size_t)(r + q) * DM) + lane;
#pragma unroll
            for (int j = 0; j < 4; ++j) { const f32x4 y = (v[q][j] * rstd) * GM[j] + SH[j];
                o8[64 * j] = (unsigned long long)pk2(y.x, y.y) | ((unsigned long long)pk2(y.z, y.w) << 32); } }
    }
}
__device__ __forceinline__ void p1_norm(Frame& F) {
    const int gw = F.bid * NWAVES + F.wave, lane = F.lane;
    const float* mod = (const float*)(F.ws + WS_MOD);
    bf16* H1 = (bf16*)(F.ws + WS_H1);
    const float* gam = inptr(F, I_N1G);
    { const int mr = gw >> 8; const float* shift = mod + (size_t)mr * (NMOD * DM);
      p1_norm_rows(inptr(F, I_X) + (size_t)gw * 16 * DM, H1 + (size_t)gw * 16 * DM, 16, gam, shift, shift + DM, lane); }
    { const float* shift = mod + (size_t)8 * (NMOD * DM);
      p1_norm_rows(inptr(F, I_CTX) + (size_t)gw * DM, H1 + (size_t)(NTOK + gw) * DM, 1, gam, shift, shift + DM, lane); }
}
__device__ __forceinline__ void p1_filter(Frame& F) {
    LAS float* w3s = (LAS float*)F.lds;
    LAS float* b3s = w3s + 512;
    LAS float* red = b3s + 8;
    LAS float* nrm = red + 32;
    const int c0 = F.bid * 2;
    for (int i = F.tid; i < 512; i += NTHR) { const int k = i >> 3, q = i & 7, ch = q >> 2, o = (q >> 1) & 1, dir = q & 1; w3s[i] = inptr(F, I_HW3)[(size_t)k * 2048 + o * 1024 + dir * 512 + c0 + ch]; }
    if (F.tid < 8) { const int q = F.tid, ch = q >> 2, o = (q >> 1) & 1, dir = q & 1; b3s[q] = inptr(F, I_HB3)[o * 1024 + dir * 512 + c0 + ch]; }
    __syncthreads();
    const float* FH2 = (const float*)(F.ws + WS_FH2);
    const double la = -4.605170185988091 / 0.3, lb = -4.605170185988091 / 1.5;
    float delta[2];
#pragma unroll
    for (int ch = 0; ch < 2; ++ch) delta[ch] = (float)fabs(la + (double)(c0 + ch) * (lb - la) / 511.0);
    unsigned char* FILT = F.ws + WS_FILT;
    float asum[4] = {0.f, 0.f, 0.f, 0.f};
    float amx[4] = {0.f, 0.f, 0.f, 0.f};
    unsigned val[8][4];
#pragma unroll
    for (int j = 0; j < 8; ++j) { const int i = F.tid + 512 * j; const float* hr = FH2 + i;
        float a[8];
#pragma unroll
        for (int q = 0; q < 8; ++q) a[q] = b3s[q];
#pragma unroll 16
        for (int k = 0; k < 64; ++k) { const float hvk = hr[(size_t)k * SEQ]; const LAS f32x4* wp = (const LAS f32x4*)(w3s + k * 8); const f32x4 wa = wp[0], wb = wp[1];
            a[0] += hvk * wa.x; a[1] += hvk * wa.y; a[2] += hvk * wa.z; a[3] += hvk * wa.w; a[4] += hvk * wb.x; a[5] += hvk * wb.y; a[6] += hvk * wb.z; a[7] += hvk * wb.w; }
        const float t = (float)i * (1.0f / 4095.0f);
#pragma unroll
        for (int q = 0; q < 8; ++q) { const int ch = q >> 2, dir = q & 1; const float v = a[q] * expf(-t * delta[ch]); a[q] = v; if (dir == 0 || i != 0) { asum[q >> 1] += fabsf(v); amx[q >> 1] = fmaxf(amx[q >> 1], fabsf(v)); } }
#pragma unroll
        for (int q = 0; q < 4; ++q) val[j][q] = pk2(a[2 * q], a[2 * q + 1]);
        asm volatile("" ::: "memory"); }
#pragma unroll
    for (int q = 0; q < 4; ++q) { const float s2 = wave_sum(asum[q]); float m2 = amx[q];
#pragma unroll
        for (int o = 32; o >= 1; o >>= 1) m2 = fmaxf(m2, __shfl_xor(m2, o));
        if (F.lane == 0) { red[F.wave * 4 + q] = s2; red[32 + 8 + F.wave * 4 + q] = m2; } }
    __syncthreads();
    if (F.tid < 4) { float s2 = 0.f, m2 = 0.f; for (int w = 0; w < 8; ++w) { s2 += red[w * 4 + F.tid]; m2 = fmaxf(m2, red[32 + 8 + w * 4 + F.tid]); }
        const float inv = 1.0f / s2; const int p = (int)((__float_as_uint(m2 * inv) >> 23) & 255u) - 127, e = 7 - p;
        nrm[F.tid] = inv * __uint_as_float((unsigned)(127 + e) << 23);
        const int ch = F.tid >> 1, o = F.tid & 1; ((int*)(F.ws + WS_FSC))[o * HYW + c0 + ch] = 127 - e; }
    __syncthreads();
#pragma unroll
    for (int j = 0; j < 8; ++j) { const int i = F.tid + 512 * j;
#pragma unroll
        for (int q = 0; q < 8; ++q) { const int ch = q >> 2, o = (q >> 1) & 1, dir = q & 1; const float sc = nrm[ch * 2 + o]; unsigned char* G = FILT + ((size_t)o * HYW + c0 + ch) * F8GS;
            const float fv = ((q & 1) ? bfhi(val[j][q >> 1]) : bflo(val[j][q >> 1])) * sc; const unsigned char hv = (unsigned char)(__builtin_amdgcn_cvt_pk_fp8_f32(fv, fv, 0, false) & 0xff);
            if (dir == 0) G[FC0 - i] = hv; else if (i != 0) G[FC0 + i] = hv; } }
    for (int i = F.tid; i < 4 * (F8LEN - 8191); i += NTHR) { const int a = i / (F8LEN - 8191), x = i % (F8LEN - 8191); const int ch = a >> 1, o = a & 1; unsigned char* G = FILT + ((size_t)o * HYW + c0 + ch) * F8GS;
        const int xx = (x < FC0 - 4095) ? x : (x - (FC0 - 4095) + FC0 + 4096); G[xx] = 0; }
    __syncthreads();
}
__device__ __forceinline__ void phase1(Frame& F) { p1_s5_expand(F); p1_filter(F); p1_norm(F); }

#ifndef DBG_AMPX
#define DBG_AMPX 0
#endif
#define AMPB(k) unsigned long long amp_t0_ = 0; if (DBG_AMPX == (k)) amp_t0_ = __builtin_amdgcn_s_memrealtime();
#define AMPE(k) if (DBG_AMPX == (k)) { __syncthreads(); const unsigned long long t1_ = __builtin_amdgcn_s_memrealtime(); const unsigned long long d_ = t1_ - amp_t0_; while (__builtin_amdgcn_s_memrealtime() - t1_ < d_) __builtin_amdgcn_s_sleep(8); }
constexpr int HY_USTRIDE = 4368, HY_UOFF = 272, HY_G0 = 35328;
__device__ __forceinline__ i32x8 hy_ldA(const LAS unsigned char* p) { const LAS u32x2* q = (const LAS u32x2*)p; const u32x2 a = q[0], b = q[1], c = q[2], d = q[3]; return (i32x8){(int)a.x, (int)a.y, (int)b.x, (int)b.y, (int)c.x, (int)c.y, (int)d.x, (int)d.y}; }
__device__ __forceinline__ i32x8 hy_ldB(const LAS unsigned char* p) { const u32x4 a = *(const LAS u32x4*)p, b = *(const LAS u32x4*)(p + 16); return (i32x8){(int)a.x, (int)a.y, (int)a.z, (int)a.w, (int)b.x, (int)b.y, (int)b.z, (int)b.w}; }
constexpr int HT_IG2 = 2 * 16 * 16 * 88, HT_TOTAL = 2 * HT_IG2, HT_PER_WAVE = 48, HT_SCR = 35328 + 8 * 8480;
struct HyTr { const float* wg; const float* wu; bf16* wgut; LAS float* scr; int base; int lane; float tv[2][16]; };
__device__ __forceinline__ void hytr_issue(HyTr& T, int slot) {
#pragma unroll
    for (int j = 0; j < 2; ++j) { const int h = T.base + slot * 2 + j;
        if (h < HT_TOTAL) { const int up = h >= HT_IG2, r = up ? h - HT_IG2 : h, e = r / (32 * 88), q = r % (32 * 88), kb = q / 88, nb = q % 88;
            const float* wp = (up ? T.wu : T.wg) + (size_t)e * DM * FF + (size_t)(kb * 32 + (T.lane >> 5)) * FF + nb * 32 + (T.lane & 31);
#pragma unroll
            for (int i = 0; i < 16; ++i) T.tv[j][i] = wp[(size_t)(2 * i) * FF]; } }
}
__device__ __forceinline__ void hytr_finish(HyTr& T, int slot) {
#pragma unroll
    for (int j = 0; j < 2; ++j) { const int h = T.base + slot * 2 + j;
        if (h < HT_TOTAL) { const int up = h >= HT_IG2, r = up ? h - HT_IG2 : h, e = r / (32 * 88), q = r % (32 * 88), kb = q / 88, nb = q % 88, n0 = nb * 32;
            bf16* WT = (bf16*)((unsigned char*)T.wgut + (size_t)e * (2 * FF) * DM); const int drow0 = 256 * (n0 >> 7) + (n0 & 127) + (up ? 128 : 0);
#pragma unroll
            for (int i = 0; i < 16; ++i) T.scr[(2 * i + (T.lane >> 5)) * 33 + (T.lane & 31)] = T.tv[j][i];
            LDS_WAIT(); asm volatile("" ::: "memory");
            const int c = T.lane & 3;
#pragma unroll
            for (int p = 0; p < 2; ++p) { const int n = (T.lane >> 2) + 16 * p; const LAS float* sp = T.scr + (8 * c) * 33 + n;
                u32x2 o; o.x = pk4_fp8(sp[0 * 33] * WGU_SCALE, sp[1 * 33] * WGU_SCALE, sp[2 * 33] * WGU_SCALE, sp[3 * 33] * WGU_SCALE); o.y = pk4_fp8(sp[4 * 33] * WGU_SCALE, sp[5 * 33] * WGU_SCALE, sp[6 * 33] * WGU_SCALE, sp[7 * 33] * WGU_SCALE);
                *(u32x2*)((unsigned char*)WT + (size_t)(drow0 + n) * DM + kb * 32 + 8 * c) = o; }
            LDS_WAIT(); asm volatile("" ::: "memory"); } }
}
__device__ __forceinline__ void hy_conv(const LAS unsigned char* lds, int w, int lane, f32x16 (&acc)[4], HyTr& T, int slot0, int fsc_s) {
    const int r = lane & 31, hh = lane >> 5, n = lane & 31, b = n >> 2, i = n & 3;
    const LAS unsigned char* abase = lds + HY_G0 + (r & 7) * F8LEN + (FC0 - 8 * (r >> 3) + 32 * hh) - 512 * w;
    const LAS unsigned char* bbase = lds + HY_UOFF + b * HY_USTRIDE + 64 * i + 32 * hh;
    int sc1 = 127, fsc = fsc_s; asm volatile("" : "+v"(sc1), "+v"(fsc));
#pragma unroll
    for (int q = 0; q < 4; ++q)
#pragma unroll
        for (int j = 0; j < 16; ++j) acc[q][j] = 0.f;
#define HY_M1(ACC, AF, BF) asm volatile("v_mfma_scale_f32_32x32x64_f8f6f4 %0, %1, %2, %0, %3, %4 op_sel_hi:[0,0,0]" : "+v"(ACC) : "v"(AF), "v"(BF), "v"(fsc), "v"(sc1))
#define HY_MM(O0, O1, N0, N1, BB) do { HY_M1(acc[0], O0, BB); HY_M1(acc[1], O1, BB); HY_M1(acc[2], N0, BB); HY_M1(acc[3], N1, BB); } while (0)
#define HY_ST3() do { \
            Z0 = hy_ldA(pa - 512); Z1 = hy_ldA(pa - 544); Ub = hy_ldB(pb - 256); HY_MM(X0, X1, Y0, Y1, Ua); \
            X0 = hy_ldA(pa - 768); X1 = hy_ldA(pa - 800); Uc = hy_ldB(pb - 512); HY_MM(Y0, Y1, Z0, Z1, Ub); \
            Y0 = hy_ldA(pa - 1024); Y1 = hy_ldA(pa - 1056); Ua = hy_ldB(pb - 768); HY_MM(Z0, Z1, X0, X1, Uc); \
            pa -= 768; pb -= 768; } while (0)
#pragma unroll 1
    for (int rho = 0; rho < 4; ++rho) {
        const LAS unsigned char* pa = abase + 64 * (60 + rho);
        const LAS unsigned char* pb = bbase + 64 * (60 + rho);
        i32x8 X0, X1, Y0, Y1, Z0, Z1, Ua, Ub, Uc;
        if (rho < 3) hytr_issue(T, slot0 + 2 * rho);
        X0 = hy_ldA(pa); X1 = hy_ldA(pa - 32); Y0 = hy_ldA(pa - 256); Y1 = hy_ldA(pa - 288); Ua = hy_ldB(pb);
#pragma unroll 1
        for (int k = 0; k < 2; ++k) HY_ST3();
        if (rho < 3) { hytr_finish(T, slot0 + 2 * rho); hytr_issue(T, slot0 + 2 * rho + 1); }
#pragma unroll 1
        for (int k = 0; k < 3; ++k) HY_ST3();
        Z0 = hy_ldA(pa - 512); Z1 = hy_ldA(pa - 544); Ub = hy_ldB(pb - 256); HY_MM(X0, X1, Y0, Y1, Ua);
        HY_MM(Y0, Y1, Z0, Z1, Ub);
        if (rho < 3) hytr_finish(T, slot0 + 2 * rho + 1);
    }
    asm volatile("s_nop 15\n\ts_nop 15" ::: "memory");
#undef HY_ST3
#undef HY_MM
#undef HY_M1
}
__device__ __forceinline__ void hy_load_filter(Frame& F, const unsigned char* G) {
    LAS unsigned char* lds = F.lds;
#define AB(H, L, N) __builtin_amdgcn_alignbyte(H, L, N)
#pragma unroll
    for (int k = 0; k < 2; ++k) { const int i = F.tid + k * NTHR;
        if (i < F8LEN / 16) { const u32x4 v = *(const u32x4*)(G + 16 * i); u32x2 pv = (u32x2){0u, 0u}; if (i) pv = *(const u32x2*)(G + 16 * i - 8);
            LAS unsigned char* d = lds + HY_G0 + 16 * i;
            *(LAS u32x4*)(d) = v;
            *(LAS u32x4*)(d + 1 * F8LEN) = (u32x4){AB(v.x, pv.y, 3), AB(v.y, v.x, 3), AB(v.z, v.y, 3), AB(v.w, v.z, 3)};
            *(LAS u32x4*)(d + 2 * F8LEN) = (u32x4){AB(v.x, pv.y, 2), AB(v.y, v.x, 2), AB(v.z, v.y, 2), AB(v.w, v.z, 2)};
            *(LAS u32x4*)(d + 3 * F8LEN) = (u32x4){AB(v.x, pv.y, 1), AB(v.y, v.x, 1), AB(v.z, v.y, 1), AB(v.w, v.z, 1)};
            *(LAS u32x4*)(d + 4 * F8LEN) = (u32x4){pv.y, v.x, v.y, v.z};
            *(LAS u32x4*)(d + 5 * F8LEN) = (u32x4){AB(pv.y, pv.x, 3), AB(v.x, pv.y, 3), AB(v.y, v.x, 3), AB(v.z, v.y, 3)};
            *(LAS u32x4*)(d + 6 * F8LEN) = (u32x4){AB(pv.y, pv.x, 2), AB(v.x, pv.y, 2), AB(v.y, v.x, 2), AB(v.z, v.y, 2)};
            *(LAS u32x4*)(d + 7 * F8LEN) = (u32x4){AB(pv.y, pv.x, 1), AB(v.x, pv.y, 1), AB(v.y, v.x, 1), AB(v.z, v.y, 1)}; } }
#undef AB
}
__device__ __forceinline__ u32x4 hy_ld_piece(const bf16* p) { const unsigned* pp = (const unsigned*)(p - 2); u32x4 v; v.x = pp[0]; v.y = pp[1]; v.z = pp[2]; v.w = pp[3]; return v; }
__device__ __forceinline__ f32x4 hy_sconv4r(u32x4 z, bool lz, bool rz, float w0, float w1, float w2, float cb) {
    const float zl = lz ? 0.f : bfhi(z.x), zr = rz ? 0.f : bflo(z.w), e0 = bflo(z.y), e1 = bfhi(z.y), e2 = bflo(z.z), e3 = bfhi(z.z);
    return (f32x4){w0 * zl + w1 * e0 + w2 * e1 + cb, w0 * e0 + w1 * e1 + w2 * e2 + cb, w0 * e1 + w1 * e2 + w2 * e3 + cb, w0 * e2 + w1 * e3 + w2 * zr + cb};
}
__device__ __forceinline__ float hy_cl(float v) { return fminf(fmaxf(v, -448.f), 448.f); }
__device__ __forceinline__ void hyena_channel(Frame& F, int c, int citer) {
    LAS unsigned char* lds = F.lds;
    const int tid = F.tid, lane = F.lane, w = F.wave;
    HyTr T; T.wg = inptr(F, I_WG); T.wu = inptr(F, I_WU); T.wgut = (bf16*)(F.ws + WS_WGUT); T.scr = (LAS float*)(F.lds + HT_SCR + w * 4224); T.base = (F.bid * NWAVES + w) * HT_PER_WAVE; T.lane = lane;
    bf16* ZT = (bf16*)(F.ws + WS_ZT);
    const unsigned char* FILT = F.ws + WS_FILT; const int* FSC = (const int*)(F.ws + WS_FSC);
    bf16* VS = (bf16*)(F.ws + WS_VS) + (size_t)F.bid * (8 * SEQ);
    const float* cw = inptr(F, I_CONVW); const float* cbp = inptr(F, I_CONVB);
    const int fs0 = __builtin_amdgcn_readfirstlane(__hip_atomic_load(FSC + c, __ATOMIC_RELAXED, __HIP_MEMORY_SCOPE_AGENT)), fs1 = __builtin_amdgcn_readfirstlane(__hip_atomic_load(FSC + HYW + c, __ATOMIC_RELAXED, __HIP_MEMORY_SCOPE_AGENT));
    for (int i = tid; i < HY_G0 / 16; i += NTHR) *(LAS u32x4*)(lds + 16 * i) = (u32x4){0u, 0u, 0u, 0u};
    __syncthreads();
    {
        const float w0 = cw[c], w1 = cw[HYC + c], w2 = cw[2 * HYC + c], cb = cbp[c];
        u32x4 zz[8]; float zls[8], zrs[8];
#pragma unroll
        for (int b = 0; b < 8; ++b) { const bf16* zr = ZT + (size_t)c * NTOK + b * SEQ + 8 * tid; zz[b] = *(const u32x4*)zr; zls[b] = (tid & 7) ? bf2f(zr[-1]) : 0.f; zrs[b] = ((tid & 7) != 7) ? bf2f(zr[8]) : 0.f; }
#pragma unroll
        for (int b = 0; b < 8; ++b) { const u32x4 z = zz[b];
            const float zl = zls[b], zrt = zrs[b];
            float e[10]; e[0] = zl; e[1] = bflo(z.x); e[2] = bfhi(z.x); e[3] = bflo(z.y); e[4] = bfhi(z.y); e[5] = bflo(z.z); e[6] = bfhi(z.z); e[7] = bflo(z.w); e[8] = bfhi(z.w); e[9] = zrt;
            float o[8];
#pragma unroll
            for (int j = 0; j < 8; ++j) o[j] = w0 * e[j] + w1 * e[j + 1] + w2 * e[j + 2] + cb;
            u32x4 pk; pk.x = pk2(o[0], o[1]); pk.y = pk2(o[2], o[3]); pk.z = pk2(o[4], o[5]); pk.w = pk2(o[6], o[7]);
            *(u32x4*)(VS + b * SEQ + 8 * tid) = pk;
            u32x2 p8; p8.x = pk4_fp8(hy_cl(o[0]), hy_cl(o[1]), hy_cl(o[2]), hy_cl(o[3])); p8.y = pk4_fp8(hy_cl(o[4]), hy_cl(o[5]), hy_cl(o[6]), hy_cl(o[7]));
            *(LAS u32x2*)(lds + HY_UOFF + b * HY_USTRIDE + 8 * tid) = p8; }
    }
    hy_load_filter(F, FILT + ((size_t)0 * HYW + c) * F8GS);
    __syncthreads();
    f32x16 acc[4];
    { AMPB(1) hy_conv(lds, w, lane, acc, T, (citer * 2 + 0) * 6, fs0); AMPE(1) }
#ifdef DBG_CONV_SCALE
    for (int q = 0; q < 4; ++q) for (int j = 0; j < 16; ++j) acc[q][j] *= DBG_CONV_SCALE;
#endif
    __syncthreads();
    hy_load_filter(F, FILT + ((size_t)1 * HYW + c) * F8GS);
    const int n = lane & 31, hh = lane >> 5, b = n >> 2, ii = n & 3;
    {
        const float w0 = cw[HYW + c], w1 = cw[HYC + HYW + c], w2 = cw[2 * HYC + HYW + c], cb = cbp[HYW + c], bias = inptr(F, I_HBIAS)[c];
        const int tl = 512 * w + 64 * ii + 4 * hh;
        const bf16* zrow = ZT + (size_t)(HYW + c) * NTOK + b * SEQ + tl;
        bf16* vrow = VS + b * SEQ + tl;
#pragma unroll
        for (int hq = 0; hq < 2; ++hq) {
        u32x4 zp[8]; u32x2 vp[8];
#pragma unroll
        for (int g = 0; g < 8; ++g) { const int toff = 32 * (g >> 2) + 256 * hq + 8 * (g & 3); zp[g] = hy_ld_piece(zrow + toff); vp[g] = *(const u32x2*)(vrow + toff); }
#pragma unroll
        for (int q = 2 * hq; q < 2 * hq + 2; ++q) {
#pragma unroll
            for (int rg = 0; rg < 4; ++rg) { const int toff = 32 * (q & 1) + 256 * (q >> 1) + 8 * rg;
                const f32x4 x1 = hy_sconv4r(zp[(q & 1) * 4 + rg], (q & 1) == 0 && rg == 0 && hh == 0, (q & 1) == 1 && rg == 3 && hh == 1, w0, w1, w2, cb);
                const u32x2 uv = vp[(q & 1) * 4 + rg];
                const float y0 = x1[0] * (acc[q][4 * rg + 0] + bias * bflo(uv.x)), y1 = x1[1] * (acc[q][4 * rg + 1] + bias * bfhi(uv.x));
                const float y2 = x1[2] * (acc[q][4 * rg + 2] + bias * bflo(uv.y)), y3 = x1[3] * (acc[q][4 * rg + 3] + bias * bfhi(uv.y));
                u32x2 o; o.x = pk2(y0, y1); o.y = pk2(y2, y3); *(u32x2*)(vrow + toff) = o;
                *(LAS unsigned*)(lds + HY_UOFF + b * HY_USTRIDE + tl + toff) = pk4_fp8(hy_cl(y0), hy_cl(y1), hy_cl(y2), hy_cl(y3)); }
            asm volatile("" ::: "memory"); } }
    }
    __syncthreads();
    { AMPB(1) hy_conv(lds, w, lane, acc, T, (citer * 2 + 1) * 6, fs1); AMPE(1) }
#ifdef DBG_CONV_SCALE
    for (int q = 0; q < 4; ++q) for (int j = 0; j < 16; ++j) acc[q][j] *= DBG_CONV_SCALE;
#endif
    {
        const float w0 = cw[2 * HYW + c], w1 = cw[HYC + 2 * HYW + c], w2 = cw[2 * HYC + 2 * HYW + c], cb = cbp[2 * HYW + c], bias = inptr(F, I_HBIAS)[HYW + c];
        const int tl = 512 * w + 64 * ii + 4 * hh;
        const bf16* zrow = ZT + (size_t)(2 * HYW + c) * NTOK + b * SEQ + tl;
        const bf16* vrow = VS + b * SEQ + tl;
        bf16* orow = (bf16*)(F.ws + WS_YHT) + (size_t)c * NTOK + b * SEQ + tl;
#pragma unroll
        for (int hq = 0; hq < 2; ++hq) {
        u32x4 zp[8]; u32x2 vp[8];
#pragma unroll
        for (int g = 0; g < 8; ++g) { const int toff = 32 * (g >> 2) + 256 * hq + 8 * (g & 3); zp[g] = hy_ld_piece(zrow + toff); vp[g] = *(const u32x2*)(vrow + toff); }
#pragma unroll
        for (int q = 2 * hq; q < 2 * hq + 2; ++q) {
#pragma unroll
            for (int rg = 0; rg < 4; ++rg) { const int toff = 32 * (q & 1) + 256 * (q >> 1) + 8 * rg;
                const f32x4 x2 = hy_sconv4r(zp[(q & 1) * 4 + rg], (q & 1) == 0 && rg == 0 && hh == 0, (q & 1) == 1 && rg == 3 && hh == 1, w0, w1, w2, cb);
                const u32x2 uv = vp[(q & 1) * 4 + rg];
                const float y0 = x2[0] * (acc[q][4 * rg + 0] + bias * bflo(uv.x)), y1 = x2[1] * (acc[q][4 * rg + 1] + bias * bfhi(uv.x));
                const float y2 = x2[2] * (acc[q][4 * rg + 2] + bias * bflo(uv.y)), y3 = x2[3] * (acc[q][4 * rg + 3] + bias * bfhi(uv.y));
                u32x2 o; o.x = pk2(y0, y1); o.y = pk2(y2, y3); *(u32x2*)(orow + toff) = o; }
            asm volatile("" ::: "memory"); } }
    }
    __syncthreads();
}

__device__ __forceinline__ void phase_carry(Frame& F) {
    if (F.tid >= 128) { const int wv = F.bid * 6 + (F.wave - 2); p_down_items(F, wv, 3, 6 * 256); return; }
    const int g = F.bid >> 3, b = F.bid & 7, dir = F.tid >> 6, p = F.tid & 63;
    const float* EB = (const float*)(F.ws + WS_EB) + (size_t)g * UROWS * 256 + dir * 128 + p;
    bf16* UG = (bf16*)(F.ws + WS_UG) + (size_t)g * UROWS * UCOLS + 512 + dir * 128 + p;
    const float* LT = (const float*)(F.ws + WS_LT) + ((dir * NG + g) * NP + p) * 2;
    const float lr = LT[0], li = LT[1];
    float xr = 0.f, xi = 0.f;
    {   float er[8], ei[8];
#pragma unroll
        for (int k = 0; k < 8; ++k) { const int c = dir ? (7 - k) : k; const float* e = EB + (size_t)(1024 + b * 8 + c) * 256; er[k] = e[0]; ei[k] = e[64]; }
#pragma unroll
        for (int k = 0; k < 8; ++k) { const float nr = lr * xr - li * xi + er[k], ni = lr * xi + li * xr + ei[k]; xr = nr; xi = ni; }
    }
#pragma unroll 1
    for (int c8 = 0; c8 < 4; ++c8) { float er[32], ei[32];
#pragma unroll
        for (int k = 0; k < 32; ++k) { const int c = dir ? (127 - (c8 * 32 + k)) : (c8 * 32 + k); const float* e = EB + (size_t)(b * 128 + c) * 256; er[k] = e[0]; ei[k] = e[64]; }
#pragma unroll
        for (int k = 0; k < 32; ++k) { const int c = dir ? (127 - (c8 * 32 + k)) : (c8 * 32 + k); bf16* u = UG + (size_t)(b * 128 + c) * UCOLS; u[0] = (bf16)f2bf(xr); u[64] = (bf16)f2bf(xi);
            const float nr = lr * xr - li * xi + er[k], ni = lr * xi + li * xr + ei[k]; xr = nr; xi = ni; }
    }
}

__device__ __forceinline__ void phase_tr_hy(Frame& F) {
    LAS unsigned char* lds = F.lds;
    const bf16* ZT = (const bf16*)(F.ws + WS_YHT); bf16* YCAT = (bf16*)(F.ws + WS_YCAT);
    constexpr int S = 132;
    for (int pass = 0; pass < 2; ++pass) { const int tok0 = F.bid * 128 + pass * 64;
        for (int pc = F.tid; pc < 4096; pc += NTHR) { const int ch = pc >> 3, gq = pc & 7; const u32x4 v = *(const u32x4*)(ZT + (size_t)ch * NTOK + tok0 + 8 * gq);
            LAS unsigned* d = (LAS unsigned*)(lds + ch * S + 16 * gq); d[0] = v.x; d[1] = v.y; d[2] = v.z; d[3] = v.w; }
        __syncthreads();
        for (int it = 0; it < 8; ++it) { const int tok = it * 8 + (F.lane & 7), cg = F.wave * 8 + (F.lane >> 3);
            const LAS unsigned short* s = (const LAS unsigned short*)(lds + (8 * cg) * S + 2 * tok);
            unsigned e[8];
#pragma unroll
            for (int j = 0; j < 8; ++j) e[j] = s[j * (S / 2)];
            u32x4 o; o.x = e[0] | (e[1] << 16); o.y = e[2] | (e[3] << 16); o.z = e[4] | (e[5] << 16); o.w = e[6] | (e[7] << 16);
#ifdef DBG_HY_SCALE
            for (int j = 0; j < 8; ++j) e[j] = f2bf(bf2f(e[j]) * DBG_HY_SCALE);
            o.x = e[0] | (e[1] << 16); o.y = e[2] | (e[3] << 16); o.z = e[4] | (e[5] << 16); o.w = e[6] | (e[7] << 16);
#endif
            *(u32x4*)(YCAT + (size_t)(tok0 + tok) * DM + 8 * cg) = o; }
        __syncthreads();
    }
}

__device__ __forceinline__ void phase_norm2(Frame& F) {
    LAS unsigned char* lds = F.lds;
    LAS unsigned short* WH = (LAS unsigned short*)lds;
    LAS unsigned short* WL = WH + 16384;
    LAS float* GM = (LAS float*)(lds + 65536);
    LAS float* SH = GM + 1024;
    LAS float* red = SH + 1024;
    LAS float* cbs = red + 128;
    const int tid = F.tid, lane = F.lane, wave = F.wave;
    const int b = F.bid >> 5;
    const float* mb = (const float*)(F.ws + WS_MOD) + (size_t)b * (NMOD * DM);
    const float* rw = inptr(F, I_RW); const float* n2g = inptr(F, I_N2G);
    for (int i = tid; i < DM; i += NTHR) { GM[i] = n2g[i] * (mb[4 * DM + i] + 1.0f); SH[i] = mb[3 * DM + i]; }
    __syncthreads();
    float cpart = 0.f;
#pragma unroll 4
    for (int i = 0; i < 32; ++i) { const int idx = tid + 512 * i, k = idx >> 4, e = idx & 15; const float r = rw[idx]; const float w = GM[k] * r; cpart += SH[k] * r;
        const unsigned hi = f2bf(w); const float lo = w - bf2f(hi);
        const int s = k >> 5, kq = (k >> 3) & 3, j = k & 7, o = ((s * 4 + kq) * 16 + e) * 8 + j; WH[o] = (unsigned short)hi; WL[o] = (unsigned short)f2bf(lo); }
    cpart += __shfl_xor(cpart, 16); cpart += __shfl_xor(cpart, 32);
    if (lane < 16) red[wave * 16 + lane] = cpart;
    __syncthreads();
    if (tid < 16) { float c = 0.f; for (int w = 0; w < 8; ++w) c += red[w * 16 + tid]; cbs[tid] = c; }
    __syncthreads();
    const int rr = lane & 15, kq = lane >> 4;
    const int row = F.bid * 128 + wave * 16 + rr;
    const bf16* xrow = (const bf16*)(F.ws + WS_XMID) + (size_t)row * DM + 8 * kq;
    f32x4 acc = (f32x4){0.f, 0.f, 0.f, 0.f}; float ss = 0.f;
#pragma unroll 1
    for (int hb = 0; hb < 2; ++hb) { u32x4 xv[16];
#pragma unroll
        for (int s = 0; s < 16; ++s) xv[s] = *(const u32x4*)(xrow + 32 * (16 * hb + s));
#pragma unroll
        for (int s = 0; s < 16; ++s) { const u32x4 q = xv[s]; const int sg = 16 * hb + s;
            const float e0 = bflo(q.x), e1 = bfhi(q.x), e2 = bflo(q.y), e3 = bfhi(q.y), e4 = bflo(q.z), e5 = bfhi(q.z), e6 = bflo(q.w), e7 = bfhi(q.w);
            ss += ((e0 * e0 + e1 * e1) + (e2 * e2 + e3 * e3)) + ((e4 * e4 + e5 * e5) + (e6 * e6 + e7 * e7));
            const bf16x8 a = __builtin_bit_cast(bf16x8, q);
            const bf16x8 bh = *(const LAS bf16x8*)(WH + ((sg * 4 + kq) * 16 + rr) * 8), bl = *(const LAS bf16x8*)(WL + ((sg * 4 + kq) * 16 + rr) * 8);
            acc = __builtin_amdgcn_mfma_f32_16x16x32_bf16(a, bh, acc, 0, 0, 0); acc = __builtin_amdgcn_mfma_f32_16x16x32_bf16(a, bl, acc, 0, 0, 0);
            if ((s & 3) == 3) asm volatile("" ::: "memory"); } }
    ss += __shfl_xor(ss, 16); ss += __shfl_xor(ss, 32);
    const float rstd = 1.0f / sqrtf(ss * (1.0f / DM) + NORM_EPS);
    {
        const float cb = cbs[rr]; f32x4 p;
#pragma unroll
        for (int i = 0; i < 4; ++i) { const float rs = __shfl(rstd, 4 * kq + i); const float lg = acc[i] * rs + cb; float mx = lg;
#pragma unroll
            for (int o = 1; o < 16; o <<= 1) mx = fmaxf(mx, __shfl_xor(mx, o));
            const float ex = expf(lg - mx); float den = ex;
#pragma unroll
            for (int o = 1; o < 16; o <<= 1) den += __shfl_xor(den, o);
            p[i] = ex / den; }
        float* AFF = (float*)(F.ws + WS_AFF);
        *(f32x4*)(AFF + ((size_t)b * NE + rr) * SEQ + (F.bid & 31) * 128 + wave * 16 + 4 * kq) = p; }
    unsigned char* h2row = F.ws + WS_H2 + (size_t)row * DM + 8 * kq;
#pragma unroll 1
    for (int hb = 0; hb < 2; ++hb) { u32x4 xv[16];
#pragma unroll
        for (int s = 0; s < 16; ++s) xv[s] = *(const u32x4*)(xrow + 32 * (16 * hb + s));
#pragma unroll
        for (int s = 0; s < 16; ++s) { const u32x4 q = xv[s]; const int sg = 16 * hb + s; const LAS f32x4* gp = (const LAS f32x4*)(GM + 32 * sg + 8 * kq); const LAS f32x4* sp = (const LAS f32x4*)(SH + 32 * sg + 8 * kq);
            const f32x4 g0 = gp[0], g1 = gp[1], s0 = sp[0], s1 = sp[1];
            u32x2 o; o.x = pk4_fp8(bflo(q.x) * rstd * g0.x + s0.x, bfhi(q.x) * rstd * g0.y + s0.y, bflo(q.y) * rstd * g0.z + s0.z, bfhi(q.y) * rstd * g0.w + s0.w);
            o.y = pk4_fp8(bflo(q.z) * rstd * g1.x + s1.x, bfhi(q.z) * rstd * g1.y + s1.y, bflo(q.w) * rstd * g1.z + s1.z, bfhi(q.w) * rstd * g1.w + s1.w);
            *(u32x2*)(h2row + 32 * sg) = o; if ((s & 3) == 3) asm volatile("" ::: "memory"); } }
    __syncthreads();
}

__device__ __forceinline__ int block_sum_i(LAS int* red, int v, int wave, int lane, int slot) {
#pragma unroll
    for (int o = 1; o < 64; o <<= 1) v += __shfl_xor(v, o);
    if (lane == 0) red[slot * 8 + wave] = v;
    __syncthreads();
    int s = 0;
#pragma unroll
    for (int w = 0; w < 8; ++w) s += red[slot * 8 + w];
    return s;
}
__device__ __forceinline__ void phase_topk(Frame& F) {
    if (F.bid >= NB * NE) { const int wv = (F.bid - 128) * 8 + F.wave; p_down_items(F, DN_P4 + wv, 10, 8 * 128); return; }
    const int b = F.bid >> 4, e = F.bid & 15, tid = F.tid, lane = F.lane, wave = F.wave;
    LAS int* red = (LAS int*)F.lds;
    LAS int* wtot = red + 16;
    const float* aff = (const float*)(F.ws + WS_AFF) + ((size_t)b * NE + e) * SEQ + 8 * tid;
    unsigned key[8];
#ifndef DBG_PLAIN_AFF
#pragma unroll
    for (int j = 0; j < 8; ++j) key[j] = __hip_atomic_load((const unsigned*)aff + j, __ATOMIC_RELAXED, __HIP_MEMORY_SCOPE_AGENT);
#else
    { const f32x4 a0 = *(const f32x4*)aff, a1 = *(const f32x4*)(aff + 4);
    key[0] = __builtin_bit_cast(unsigned, a0.x); key[1] = __builtin_bit_cast(unsigned, a0.y); key[2] = __builtin_bit_cast(unsigned, a0.z); key[3] = __builtin_bit_cast(unsigned, a0.w);
    key[4] = __builtin_bit_cast(unsigned, a1.x); key[5] = __builtin_bit_cast(unsigned, a1.y); key[6] = __builtin_bit_cast(unsigned, a1.z); key[7] = __builtin_bit_cast(unsigned, a1.w); }
#endif
    unsigned prefix = 0u; int it = 0;
    LAS int* red3 = (LAS int*)F.lds + 64;
    { const unsigned cand = 1u << 30; int c = 0;
#pragma unroll
      for (int j = 0; j < 8; ++j) c += __builtin_popcountll(__ballot(key[j] >= cand));
      if (lane == 0) red[wave] = c;
      __syncthreads();
      int tot = 0;
#pragma unroll
      for (int w2 = 0; w2 < 8; ++w2) tot += red[w2];
      if (tot >= CAP) prefix = cand; }
    for (int bit = 28; bit >= 0; bit -= 2, ++it) { const unsigned c1 = prefix | (1u << bit), c2 = prefix | (2u << bit), c3 = prefix | (3u << bit); int n1 = 0, n2 = 0, n3 = 0;
#pragma unroll
        for (int j = 0; j < 8; ++j) { n1 += __builtin_popcountll(__ballot(key[j] >= c1)); n2 += __builtin_popcountll(__ballot(key[j] >= c2)); n3 += __builtin_popcountll(__ballot(key[j] >= c3)); }
        LAS int* rr = red3 + (it & 1) * 24;
        if (lane == 0) { rr[wave] = n1; rr[8 + wave] = n2; rr[16 + wave] = n3; }
        __syncthreads();
        int t1 = 0, t2 = 0, t3 = 0;
#pragma unroll
        for (int w2 = 0; w2 < 8; ++w2) { t1 += rr[w2]; t2 += rr[8 + w2]; t3 += rr[16 + w2]; }
        prefix = (t3 >= CAP) ? c3 : (t2 >= CAP) ? c2 : (t1 >= CAP) ? c1 : prefix; }
    const unsigned thr = prefix;
    int cgt = 0, ceq = 0;
#pragma unroll
    for (int j = 0; j < 8; ++j) { cgt += (key[j] > thr) ? 1 : 0; ceq += (key[j] == thr) ? 1 : 0; }
    int sg = cgt, se = ceq;
#pragma unroll
    for (int o = 1; o < 64; o <<= 1) { const int tg = __shfl_up(sg, o), te = __shfl_up(se, o); if (lane >= o) { sg += tg; se += te; } }
    __syncthreads();
    if (lane == 63) { wtot[wave] = sg; wtot[8 + wave] = se; }
    __syncthreads();
    int bg = 0, be = 0, totg = 0;
#pragma unroll
    for (int w2 = 0; w2 < 8; ++w2) { const int g2 = wtot[w2], e2 = wtot[8 + w2]; if (w2 < wave) { bg += g2; be += e2; } totg += g2; }
    int rg = bg + sg - cgt, re = be + se - ceq;
    const int need_eq = CAP - totg;
    int* IDX = (int*)(F.ws + WS_IDX); float* GATE = (float*)(F.ws + WS_GATE); int* INV = (int*)(F.ws + WS_INV);
    const size_t rowbase = ((size_t)e * NB + b) * CAP;
    int sl[8];
#pragma unroll
    for (int j = 0; j < 8; ++j) { const int t = 8 * tid + j; int slot = -1;
        if (key[j] > thr) { slot = rg; ++rg; } else if (key[j] == thr) { if (re < need_eq) slot = totg + re; ++re; }
        if (slot >= 0) { IDX[rowbase + slot] = b * SEQ + t; GATE[rowbase + slot] = __builtin_bit_cast(float, key[j]); }
        sl[j] = slot; }
    u32x4* ip = (u32x4*)(INV + ((size_t)b * NE + e) * SEQ + 8 * tid);
    ip[0] = (u32x4){(unsigned)sl[0], (unsigned)sl[1], (unsigned)sl[2], (unsigned)sl[3]}; ip[1] = (u32x4){(unsigned)sl[4], (unsigned)sl[5], (unsigned)sl[6], (unsigned)sl[7]};
}

__device__ __forceinline__ void final_issue(const bf16* Y, int b, unsigned& mask, int myinv, int lo, int lane, unsigned long long (&w)[4][4], float (&fl)[4]) {
#pragma unroll
    for (int q = 0; q < 4; ++q) { int e = 0, s = 0; fl[q] = 0.f;
        if (mask) { e = __builtin_ctz(mask); mask &= mask - 1; s = __shfl(myinv, lo + e); fl[q] = 1.f; }
        const unsigned long long* yr = (const unsigned long long*)(Y + (((size_t)e * NB + b) * CAP + s) * DM) + lane;
#pragma unroll
        for (int j = 0; j < 4; ++j) w[q][j] = yr[64 * j]; }
}
__device__ __forceinline__ void final_add(const unsigned long long (&w)[4][4], const float (&fl)[4], f32x4 (&mo)[4]) {
#pragma unroll
    for (int q = 0; q < 4; ++q)
#pragma unroll
        for (int j = 0; j < 4; ++j) { const unsigned lo = (unsigned)w[q][j], hi = (unsigned)(w[q][j] >> 32); mo[j].x += fl[q] * bflo(lo); mo[j].y += fl[q] * bfhi(lo); mo[j].z += fl[q] * bflo(hi); mo[j].w += fl[q] * bfhi(hi); }
}
__device__ __forceinline__ void final_pair(Frame& F, const bf16* Y, int b, int ra, int inva, int invb, int lo, const f32x4 (&G2)[4], const f32x4 (&FG)[4]) {
    const int lane = F.lane; const int rb = ra + 1;
    const bf16* xm16 = (const bf16*)(F.ws + WS_XMID);
    unsigned k0 = (unsigned)((__ballot(inva >= 0) >> lo) & 0xffffull), k1 = (unsigned)((__ballot(invb >= 0) >> lo) & 0xffffull);
    unsigned long long w0[4][4], w1[4][4]; float f0[4], f1[4];
    final_issue(Y, b, k0, inva, lo, lane, w0, f0);
    final_issue(Y, b, k1, invb, lo, lane, w1, f1);
    f32x4 v0[4], v1[4], m0[4], m1[4];
#pragma unroll
    for (int j = 0; j < 4; ++j) { const u32x2 q0 = ((const u32x2*)(xm16 + (size_t)ra * DM) + lane)[64 * j], q1 = ((const u32x2*)(xm16 + (size_t)rb * DM) + lane)[64 * j];
        v0[j] = (f32x4){bflo(q0.x), bfhi(q0.x), bflo(q0.y), bfhi(q0.y)}; v1[j] = (f32x4){bflo(q1.x), bfhi(q1.x), bflo(q1.y), bfhi(q1.y)}; m0[j] = (f32x4){0.f, 0.f, 0.f, 0.f}; m1[j] = (f32x4){0.f, 0.f, 0.f, 0.f}; }
    final_add(w0, f0, m0); final_add(w1, f1, m1);
    while (k0 | k1) { final_issue(Y, b, k0, inva, lo, lane, w0, f0); final_issue(Y, b, k1, invb, lo, lane, w1, f1); final_add(w0, f0, m0); final_add(w1, f1, m1); }
    float s0 = 0.f, s1 = 0.f;
#pragma unroll
    for (int j = 0; j < 4; ++j) { v0[j] = v0[j] + G2[j] * m0[j] * DBG_MOE_ALPHA; v1[j] = v1[j] + G2[j] * m1[j] * DBG_MOE_ALPHA;
        s0 += (v0[j].x * v0[j].x + v0[j].y * v0[j].y) + (v0[j].z * v0[j].z + v0[j].w * v0[j].w); s1 += (v1[j].x * v1[j].x + v1[j].y * v1[j].y) + (v1[j].z * v1[j].z + v1[j].w * v1[j].w); }
    const float rs0 = 1.0f / sqrtf(wave_sum(s0) * (1.0f / DM) + NORM_EPS), rs1 = 1.0f / sqrtf(wave_sum(s1) * (1.0f / DM) + NORM_EPS);
    f32x4* xr0 = (f32x4*)(F.out + (size_t)ra * DM) + lane; f32x4* xr1 = (f32x4*)(F.out + (size_t)rb * DM) + lane;
#pragma unroll
    for (int j = 0; j < 4; ++j) { xr0[64 * j] = v0[j] * rs0 * FG[j]; xr1[64 * j] = v1[j] * rs1 * FG[j]; }
}
__device__ __forceinline__ void phase_final(Frame& F) {
    const int gw = F.bid * NWAVES + F.wave, lane = F.lane;
    const int b = gw >> 8, t0 = (gw & 255) * 16, row0 = gw * 16;
    const float* mod = (const float*)(F.ws + WS_MOD);
    const bf16* Y = (const bf16*)(F.ws + WS_Y); const int* INV = (const int*)(F.ws + WS_INV);
    const float* fing = inptr(F, I_FING); const float* g2 = mod + (size_t)b * (NMOD * DM) + 5 * DM;
    int val[4];
#pragma unroll
    for (int c = 0; c < 4; ++c) val[c] = (int)__hip_atomic_load((const unsigned*)INV + ((size_t)b * NE + (lane & 15)) * SEQ + t0 + 4 * (lane >> 4) + c, __ATOMIC_RELAXED, __HIP_MEMORY_SCOPE_AGENT);
    f32x4 G2[4], FG[4];
#pragma unroll
    for (int j = 0; j < 4; ++j) { G2[j] = ((const f32x4*)g2)[lane + 64 * j]; FG[j] = ((const f32x4*)fing)[lane + 64 * j]; }
#pragma unroll 1
    for (int q = 0; q < 4; ++q) {
        final_pair(F, Y, b, row0 + 4 * q, val[0], val[1], 16 * q, G2, FG);
        final_pair(F, Y, b, row0 + 4 * q + 2, val[2], val[3], 16 * q, G2, FG);
    }
}

#ifdef DBG_CHECK_MOE
__device__ __forceinline__ void phase_dbg_moe(Frame& F) {
    LAS float* hs = (LAS float*)F.lds;
    LAS float* Hs = hs + 1024;
    LAS float* red = Hs + 2816;
    const int row = (F.bid * 257) & 65535, e = row >> 12, b = (row >> 9) & 7;
    const int tok = ((const int*)(F.ws + WS_IDX))[row]; const float gate = ((const float*)(F.ws + WS_GATE))[row];
    const bf16* H2 = (const bf16*)(F.ws + WS_H2) + (size_t)tok * DM;
    for (int i = F.tid; i < DM; i += NTHR) hs[i] = bf2f(H2[i]);
    __syncthreads();
    const float* Wg = inptr(F, I_WG) + (size_t)e * DM * FF; const float* Wu = inptr(F, I_WU) + (size_t)e * DM * FF; const float* Wd = inptr(F, I_WD) + (size_t)e * FF * DM;
    float e1n = 0.f, e1d = 0.f;
    for (int f = F.tid; f < FF; f += NTHR) { float g = 0.f, u = 0.f;
        for (int k = 0; k < DM; ++k) { g += hs[k] * Wg[(size_t)k * FF + f]; u += hs[k] * Wu[(size_t)k * FF + f]; }
        const float h = siluf_(g) * u; Hs[f] = h;
        const float hb = bf2f(((const bf16*)(F.ws + WS_HB))[(size_t)row * FF + f]); e1n += (hb - h) * (hb - h); e1d += h * h; }
    __syncthreads();
    float e2n = 0.f, e2d = 0.f;
    for (int n = F.tid; n < DM; n += NTHR) { float y = 0.f;
        for (int f = 0; f < FF; ++f) y += Hs[f] * Wd[(size_t)f * DM + n];
        y *= gate; const float yb = bf2f(((const bf16*)(F.ws + WS_Y))[(size_t)row * DM + n]); e2n += (yb - y) * (yb - y); e2d += y * y; }
    const float* aff = (const float*)(F.ws + WS_AFF) + ((size_t)b * NE + e) * SEQ; int cnt = 0;
    for (int t = F.tid; t < SEQ; t += NTHR) cnt += (aff[t] > gate) ? 1 : 0;
    float vals[5] = {e1n, e1d, e2n, e2d, (float)cnt};
#pragma unroll
    for (int q = 0; q < 5; ++q) { const float s2 = wave_sum(vals[q]); if (F.lane == 0) red[F.wave * 5 + q] = s2; }
    __syncthreads();
    if (F.tid == 0) { float t5[5] = {0, 0, 0, 0, 0}; for (int w = 0; w < 8; ++w) for (int q = 0; q < 5; ++q) t5[q] += red[w * 5 + q];
        float* D = (float*)(F.ws + WS_CTL + 65536) + F.bid * 4;
        D[0] = t5[0] / (t5[1] + 1e-30f); D[1] = t5[2] / (t5[3] + 1e-30f); D[2] = (t5[4] >= (float)CAP) ? 1.f : 0.f;
        int dup = 0; const int* IDXs = (const int*)(F.ws + WS_IDX) + ((size_t)e * NB + b) * CAP; for (int q = 0; q < CAP; ++q) dup += (IDXs[q] == tok) ? 1 : 0;
        const int inv = ((const int*)(F.ws + WS_INV))[((size_t)(tok >> 12) * NE + e) * SEQ + (tok & 4095)];
        const int c3 = DBG_C3;
        D[3] = (c3 == 0) ? ((fabsf(aff[tok - b * SEQ] - gate) > 1e-6f) ? 1.f : 0.f) : (c3 == 1) ? (((tok >> 12) != b) ? 1.f : 0.f) : (c3 == 2) ? ((dup != 1) ? 1.f : 0.f) : ((inv != (row & 511)) ? 1.f : 0.f); }
    __syncthreads();
}
__device__ __forceinline__ void phase_dbg_apply(Frame& F) {
    const float* D = (const float*)(F.ws + WS_CTL + 65536);
    int bad[4] = {0, 0, 0, 0};
    for (int k = 0; k < 256; ++k) { if (D[k * 4 + 0] > 1e-3f) ++bad[0]; if (D[k * 4 + 1] > 1e-3f) ++bad[1]; if (D[k * 4 + 2] > 0.5f) ++bad[2]; if (D[k * 4 + 3] > 0.5f) ++bad[3]; }
    int code = 0;
    for (int q = 0; q < 4; ++q) if (((DBG_CHECK_MOE >> q) & 1) && bad[q] > DBG_BAD_THR) code += 1;
    const float sc = 1.0f + 0.5f * (float)code;
    const int gw = F.bid * NWAVES + F.wave, NGW = F.G * NWAVES;
    for (int r = gw; r < NTOK; r += NGW) { f32x4* xr = (f32x4*)(F.out + (size_t)r * DM) + F.lane;
#pragma unroll
        for (int j = 0; j < 4; ++j) xr[64 * j] = xr[64 * j] * sc; }
}
#endif

#ifdef DBG_CHECK_MOE
constexpr int NPHASE = 15;
#else
constexpr int NPHASE = 13;
#endif
__global__ void __launch_bounds__(NTHR, 2) fwd_kernel(Args args) {
    extern __shared__ __attribute__((aligned(16))) unsigned char lds_raw[];
    Frame F;
    F.lds = (LAS unsigned char*)lds_raw;
    F.tid = threadIdx.x; F.lane = F.tid & 63; F.wave = __builtin_amdgcn_readfirstlane(F.tid >> 6);
    F.G = gridDim.x; F.bid = blockIdx.x;
    F.out = args.out; F.ws = args.ws;
    for (int u = F.tid; u < (LDS_BYTES - LDSCTL_OFF) / 4; u += NTHR) ((LAS unsigned*)(F.lds + LDSCTL_OFF))[u] = 0u;
    __syncthreads();
    if (F.tid < 35) { const float* const* tab = args.in; *(LAS unsigned long long*)(F.lds + LDSCTL_OFF + 8 * F.tid) = (unsigned long long)tab[F.tid]; }
    __syncthreads();
    const int lo = args.ph_lo, hi = args.ph_hi;
    const bool single = (hi - lo) > 1;
    XcdBarrier bar; bar.bar = (unsigned*)(args.ws + WS_CTL) + CW_BAR; bar.x = 0; bar.st = nullptr;
    if (single) bar = xcd_barrier_post((unsigned*)(args.ws + WS_CTL) + CW_BAR, (volatile LAS unsigned*)(F.lds + MISC_OFF) + 8);
#ifndef PHASE_MASK
#define PHASE_MASK 0x7fff
#endif
#define IN(k) ((((PHASE_MASK) >> (k)) & 1) && lo <= (k) && (k) < hi)
#ifndef DBG_REPEAT_MASK
#define DBG_REPEAT_MASK 0
#endif
#define SEAM(k) do { if (IN(k) && IN((k) + 1)) xcd_barrier(bar); } while (0)
#define REP(k) for (int rep_ = 0; rep_ < ((((DBG_REPEAT_MASK) >> (k)) & 1) ? 2 : 1); ++rep_)
    LAS unsigned char* ring = F.lds;
    const unsigned char* ws = args.ws;

    REP(0) { if (rep_) xcd_barrier(bar); asm volatile("" : "+v"(F.tid), "+v"(F.lane)); if (IN(0)) { AMPB(10) phase0(F); AMPE(10) } } SEAM(0);
    REP(1) { if (rep_) xcd_barrier(bar); asm volatile("" : "+v"(F.tid), "+v"(F.lane)); if (IN(1)) { AMPB(11) phase1(F); AMPE(11) } } SEAM(1);
    REP(2) { if (rep_) xcd_barrier(bar); asm volatile("" : "+v"(F.tid), "+v"(F.lane)); if (IN(2)) {
        { SchedPlain S; S.T.init(128, 6, F.G, F.bid); S.A = (const char*)(ws + WS_H1); S.B = (const char*)(ws + WS_WINT); S.lda = 2048; S.ldb = 2048; S.kstepA = 128; S.kstepB = 128; S.nt = 16; S.mt = 1 << 20; S.az = 0; S.bz = 0;
          EpiZT E{(bf16*)(ws + WS_ZT)}; gm::gemm_phase<EpiZT, SchedPlain, false>(ring, S, E); }
        __syncthreads();
        { SchedPlain S; S.T.init(136, 2, F.G, F.bid); S.A = (const char*)(ws + WS_H1); S.B = (const char*)(ws + WS_WINT) + (size_t)HYC * 2048; S.lda = 2048; S.ldb = 2048; S.kstepA = 128; S.kstepB = 128; S.nt = 16; S.mt = 1 << 20; S.az = 0; S.bz = 0;
          EpiUG E{(bf16*)(ws + WS_UG)}; gm::gemm_phase<EpiUG, SchedPlain, true>(ring, S, E); }
    } } SEAM(2);
    REP(3) { if (rep_) xcd_barrier(bar); asm volatile("" : "+v"(F.tid), "+v"(F.lane)); if (IN(3)) {
        SchedPlain S; S.T.init(160, 1, F.G, F.bid); S.A = (const char*)(ws + WS_UG); S.B = (const char*)(ws + WS_WAT); S.lda = UCOLS * 2; S.ldb = 1024; S.kstepA = 128; S.kstepB = 128; S.nt = 8; S.mt = 5;
        S.az = (size_t)UROWS * UCOLS * 2; S.bz = (size_t)256 * 1024;
        EpiEB E{(float*)(ws + WS_EB)}; gm::gemm_phase<EpiEB, SchedPlain, true>(ring, S, E);
        if (F.bid >= 160) { const int wv = (F.bid - 160) * 8 + F.wave; p_down_items(F, DN_P4 + DN_P9 + wv, 4, 8 * 96); }
    } } SEAM(3);
    REP(4) { if (rep_) xcd_barrier(bar); asm volatile("" : "+v"(F.tid), "+v"(F.lane)); if (IN(4)) { phase_carry(F); } } SEAM(4);
    REP(5) { if (rep_) xcd_barrier(bar); asm volatile("" : "+v"(F.tid), "+v"(F.lane)); if (IN(5)) {
        { SchedPlain S; S.T.init(128, 2, F.G, F.bid); S.A = (const char*)(ws + WS_UG); S.B = (const char*)(ws + WS_MCT); S.lda = UCOLS * 2; S.ldb = UCOLS * 2; S.kstepA = 128; S.kstepB = 128; S.nt = 12; S.mt = 4;
          S.az = (size_t)UROWS * UCOLS * 2; S.bz = (size_t)512 * UCOLS * 2;
          EpiYS E{(bf16*)(ws + WS_YSG), (const bf16*)(ws + WS_UG), inptr(F, I_S5D)};
#ifndef NO_YS
          gm::gemm_phase<EpiYS, SchedPlain, true>(ring, S, E);
#endif
        }
        __syncthreads();
#ifndef NO_HY
        { AMPB(2) int citer = 0; for (int c = F.bid; c < HYW; c += F.G, ++citer) hyena_channel(F, c, citer); AMPE(2) }
#endif
    } } SEAM(5);
    REP(6) { if (rep_) xcd_barrier(bar); asm volatile("" : "+v"(F.tid), "+v"(F.lane)); if (IN(6)) {
        { SchedGlu S; S.T.init(128, 2, F.G, F.bid); S.A = (const char*)(ws + WS_YSG); S.B = (const char*)(ws + WS_GLUT); S.ldb = 1024; S.kstepA = 4u * 1024u * 512u * 2u; S.kstepB = 128; S.nt = 8;
          EpiGlu E{(bf16*)(ws + WS_YCAT), (const bf16*)(ws + WS_YSG), inptr(F, I_GLUB)}; gm::gemm_phase<EpiGlu, SchedGlu, true>(ring, S, E); }
        __syncthreads();
        phase_tr_hy(F);
    } } SEAM(6);
    REP(7) { if (rep_) xcd_barrier(bar); asm volatile("" : "+v"(F.tid), "+v"(F.lane)); if (IN(7)) {
        SchedPlain S; S.T.init(128, 4, F.G, F.bid); S.A = (const char*)(ws + WS_YCAT); S.B = (const char*)(ws + WS_WOUTT); S.lda = 2048; S.ldb = 2048; S.kstepA = 128; S.kstepB = 128; S.nt = 16; S.mt = 1 << 20; S.az = 0; S.bz = 0;
        EpiXmid E{inptr(F, I_X), (bf16*)(ws + WS_XMID), (const float*)(ws + WS_MOD)}; gm::gemm_phase<EpiXmid, SchedPlain, true>(ring, S, E);
    } } SEAM(7);
    REP(8) { if (rep_) xcd_barrier(bar); asm volatile("" : "+v"(F.tid), "+v"(F.lane)); if (IN(8)) { AMPB(18) phase_norm2(F); AMPE(18) } } SEAM(8);
    REP(9) { if (rep_) xcd_barrier(bar); asm volatile("" : "+v"(F.tid), "+v"(F.lane)); if (IN(9)) { AMPB(19) phase_topk(F); AMPE(19) } } SEAM(9);
    REP(10) { if (rep_) xcd_barrier(bar); asm volatile("" : "+v"(F.tid), "+v"(F.lane)); if (IN(10)) {
        SchedMoe1 S; S.T.init(256, 22, F.G, F.bid); S.A = (const char*)(ws + WS_H2); S.B = (const char*)(ws + WS_WGUT); S.idx = (const int*)(ws + WS_IDX); S.lda = 1024; S.ldb = 1024; S.kstepA = 128; S.kstepB = 128; S.nt = 8;
        EpiMoe1 E{(unsigned char*)(ws + WS_HB)}; gm::gemm_phase_f8<EpiMoe1, SchedMoe1, WGU_E8M0>(ring, S, E);
#if DBG_GM_MODE
        __syncthreads(); gm::gemm_phase_f8<EpiMoe1, SchedMoe1, WGU_E8M0, DBG_GM_MODE>(ring, S, E);
#endif
    } } SEAM(10);
    REP(11) { if (rep_) xcd_barrier(bar); asm volatile("" : "+v"(F.tid), "+v"(F.lane)); if (IN(11)) {
        SchedPlain S; S.T.init(256, 4, F.G, F.bid); S.A = (const char*)(ws + WS_HB); S.B = (const char*)(ws + WS_WDT); S.lda = FF; S.ldb = FF; S.kstepA = 128; S.kstepB = 128; S.nt = 22; S.mt = 16;
        S.az = (size_t)EROWS * FF; S.bz = (size_t)DM * FF;
        EpiMoe2 E{(bf16*)(ws + WS_Y), (const float*)(ws + WS_GATE)}; gm::gemm_phase_f8<EpiMoe2, SchedPlain, WD_E8M0>(ring, S, E);
    } } SEAM(11);
    if (IN(12)) { AMPB(22) phase_final(F); AMPE(22) }
#ifdef DBG_CHECK_MOE
    if (IN(13)) { phase_dbg_moe(F); }
    if (IN(14)) { phase_dbg_apply(F); }
#endif
#undef IN
#undef SEAM
}

#ifndef N_LAUNCHES
#define N_LAUNCHES 1
#endif
extern "C" void kernel_launch(void* const* d_in, const int* in_sizes, int n_in, void* d_out, int out_size, void* d_ws, size_t ws_size, hipStream_t stream) {
    static int grid = 0;
    if (grid == 0) {
        if (n_in != 35 || out_size != NTOK * DM || ws_size < WS_END) { fprintf(stderr, "kernel_launch: unexpected shapes (n_in %d out %d ws %zu)\n", n_in, out_size, ws_size); grid = -1; return; }
        int dev = 0, cus = 0;
        if (hipGetDevice(&dev) != hipSuccess || hipDeviceGetAttribute(&cus, hipDeviceAttributeMultiprocessorCount, dev) != hipSuccess) { grid = -1; return; }
        if (hipFuncSetAttribute((const void*)fwd_kernel, hipFuncAttributeMaxDynamicSharedMemorySize, LDS_BYTES) != hipSuccess) { fprintf(stderr, "kernel_launch: hipFuncSetAttribute failed\n"); grid = -1; return; }
        int per_cu = 0;
        if (hipOccupancyMaxActiveBlocksPerMultiprocessor(&per_cu, (const void*)fwd_kernel, NTHR, LDS_BYTES) != hipSuccess || per_cu < 1) fprintf(stderr, "kernel_launch: occupancy query reports %d\n", per_cu);
        (void)hipGetLastError();
        grid = 256;
        if (cus != 256) fprintf(stderr, "kernel_launch: device has %d CUs, kernel expects 256\n", cus);
    }
    if (grid < 0) return;
    (void)hipMemsetAsync((char*)d_ws + WS_CTL, 0, CTL_ZERO_BYTES, stream);
    Args a{};
    for (int i = 0; i < 35; ++i) a.in[i] = (const float*)d_in[i];
    a.out = (float*)d_out; a.ws = (unsigned char*)d_ws;
    if (N_LAUNCHES == 1) { a.ph_lo = 0; a.ph_hi = NPHASE; hipLaunchKernelGGL(fwd_kernel, dim3(grid), dim3(NTHR), LDS_BYTES, stream, a); }
    else for (int p = 0; p < NPHASE; ++p) { a.ph_lo = p; a.ph_hi = p + 1; hipLaunchKernelGGL(fwd_kernel, dim3(grid), dim3(NTHR), LDS_BYTES, stream, a); }
}
```

```cpp
#ifndef DBG_GM_MODE
#define DBG_GM_MODE 0
#endif
#ifndef DBG_C3
#define DBG_C3 0
#endif
#ifndef DBG_BAD_THR
#define DBG_BAD_THR 16
#endif
#ifndef DBG_MOE_ALPHA
#define DBG_MOE_ALPHA 1.0f
#endif
#include <hip/hip_runtime.h>
#include <cstdio>
#include <cstdint>

#define LAS __attribute__((address_space(3)))
#define GAS __attribute__((address_space(1)))
typedef unsigned short bf16;
typedef short bf16x8 __attribute__((ext_vector_type(8)));
typedef float f32x4 __attribute__((ext_vector_type(4)));
typedef float f32x16 __attribute__((ext_vector_type(16)));
typedef unsigned u32x4 __attribute__((ext_vector_type(4)));
typedef unsigned u32x2 __attribute__((ext_vector_type(2)));
typedef GAS unsigned gu32;

constexpr int NB = 8, SEQ = 4096, DM = 1024, CTXL = 256;
constexpr int NTOK = NB * SEQ, NCTX = NB * CTXL, NROWS1 = NTOK + NCTX;
constexpr int HYW = 512, HYC = 1536, S5W = 512, INC = 2048;
constexpr int NG = 32, GH = 16, NP = 64;
constexpr int CT = 32, NCH = SEQ / CT, NCHC = CTXL / CT;
constexpr int UROWS = 1280, UCOLS = 768;
constexpr int NE = 16, FF = 2816, CAP = 512, EROWS = NB * CAP;
constexpr int NMOD = 6;
constexpr float NORM_EPS = 1e-6f;
constexpr int FLEN = 8448, FC0 = 4224, F8LEN = 8480, F8GS = 8576;

constexpr size_t MiB = 1u << 20;
constexpr size_t WS_CTL = 0, CTL_ZERO_BYTES = 1 * MiB;
constexpr size_t WS_MOD = 1 * MiB;
constexpr size_t WS_LT = WS_MOD + 256 * 1024;
constexpr size_t WS_FH2 = 2 * MiB;
constexpr size_t WS_GLUT = 3 * MiB;
constexpr size_t WS_WINT = 4 * MiB;
constexpr size_t WS_WOUTT = 8 * MiB;
constexpr size_t WS_AFF = 10 * MiB;
constexpr size_t WS_IDX = 12 * MiB;
constexpr size_t WS_GATE = WS_IDX + 256 * 1024;
constexpr size_t WS_INV = 13 * MiB;
constexpr size_t WS_WDT = 16 * MiB;
constexpr size_t WS_WGUT = 104 * MiB;
constexpr size_t WS_Y = WS_WGUT;
constexpr size_t WS_R = 280 * MiB;
constexpr size_t WS_H1 = WS_R;
constexpr size_t WS_ZT = WS_R + 68 * MiB;
constexpr size_t WS_UG = WS_R + 164 * MiB;
constexpr size_t WS_EB = WS_R + 224 * MiB;
constexpr size_t WS_YHT = WS_EB;
constexpr size_t WS_MCT = WS_R + 264 * MiB;
constexpr size_t WS_WAT = WS_R + 288 * MiB;
constexpr size_t WS_FILT = WS_R + 296 * MiB;
constexpr size_t WS_FSC = WS_FILT + (size_t)2 * 512 * 8576;
constexpr size_t WS_VS = WS_R;
constexpr size_t WS_YSG = WS_R + 330 * MiB;
constexpr int S5TAB_FLOATS = (2 * 33 * 64 * 2) + (2 * 64 * 16 * 2) + (2 * 32 * 256) + (2 * 16 * 64 * 2);
constexpr size_t WS_S5TAB = WS_YSG;
constexpr size_t WS_YCAT = WS_R;
constexpr size_t WS_H2 = WS_R;
constexpr size_t WS_HB = WS_R + 64 * MiB;
constexpr size_t WS_XMID = WS_R + 256 * MiB;
constexpr size_t WS_END = WS_R + 416 * MiB;
static_assert(WS_YSG + (size_t)NG * 1024 * 512 * 2 <= WS_END && WS_FILT + (size_t)4 * HYW * FLEN * 2 <= WS_YSG && WS_YCAT + (size_t)NTOK * DM * 2 <= WS_ZT && WS_HB + (size_t)NE * EROWS * FF * 2 <= WS_END, "ws map");

constexpr int CW_BAR = 4096;

constexpr int RING_BYTES = 131072;
constexpr int LDS_BYTES = 163840;
constexpr int LDSCTL_OFF = LDS_BYTES - 1024, MISC_OFF = LDSCTL_OFF + 320;
constexpr int NWAVES = 8, NTHR = 512;

__device__ __forceinline__ unsigned f2bf(float f) { unsigned u = __builtin_bit_cast(unsigned, f); return (u + 0x7fffu + ((u >> 16) & 1u)) >> 16; }
__device__ __forceinline__ unsigned pk2(float lo, float hi) { return f2bf(lo) | (f2bf(hi) << 16); }
__device__ __forceinline__ float bf2f(unsigned b) { return __builtin_bit_cast(float, (b & 0xffffu) << 16); }
__device__ __forceinline__ float bflo(unsigned w) { return __builtin_bit_cast(float, w << 16); }
__device__ __forceinline__ float bfhi(unsigned w) { return __builtin_bit_cast(float, w & 0xffff0000u); }
__device__ __forceinline__ float wave_sum(float v) {
#pragma unroll
    for (int o = 1; o < 64; o <<= 1) v += __shfl_xor(v, o);
    return v;
}
__device__ __forceinline__ float sigmoidf_(float x) { return __builtin_amdgcn_rcpf(1.0f + __builtin_amdgcn_exp2f(fminf(-1.4426950408889634f * x, 80.0f))); }
__device__ __forceinline__ float siluf_(float x) { return x * sigmoidf_(x); }
__device__ __forceinline__ float gelu_tanh(float y) {
    const float u2 = 1.5957691216057308f * (y + 0.044715f * y * y * y);
    return y * sigmoidf_(u2);
}
typedef int i32x8 __attribute__((ext_vector_type(8)));
typedef int i32x4 __attribute__((ext_vector_type(4)));
__device__ __forceinline__ unsigned pk4_fp8(float a, float b, float c, float d) { int w = 0; w = __builtin_amdgcn_cvt_pk_fp8_f32(a, b, w, false); w = __builtin_amdgcn_cvt_pk_fp8_f32(c, d, w, true); return (unsigned)w; }
constexpr float WGU_SCALE = 16.0f, WD_SCALE = 32.0f;
constexpr int WGU_E8M0 = 127 - 4, WD_E8M0 = 127 - 5;
#define LDS_WAIT() asm volatile("s_waitcnt lgkmcnt(0)" ::: "memory")
#define VM_WAIT() asm volatile("s_waitcnt vmcnt(0)" ::: "memory")

#define XB_TMO      128
#define XB_XCNT(j)  (256  + 64 * (j))
#define XB_XSUB(j)  (1280 + 64 * (j))
#define XB_XGEN(j)  (2304 + 64 * (j))
#define XB_TOP      3328
#define XB_TOPGEN   3392
#define XCD_BAR_WORDS 3456
#define XB_SPIN_CAP (1u << 22)
__device__ __forceinline__ unsigned xb_ld(unsigned* p)              { return __hip_atomic_load(p, __ATOMIC_RELAXED, __HIP_MEMORY_SCOPE_AGENT); }
__device__ __forceinline__ unsigned xb_add(unsigned* p, unsigned v) { return __hip_atomic_fetch_add(p, v, __ATOMIC_RELAXED, __HIP_MEMORY_SCOPE_AGENT); }
__device__ __forceinline__ unsigned xb_xcc_id() { return (unsigned)__builtin_amdgcn_s_getreg((3 << 11) | 20) & 0xFu; }
#define XB_SPIN(cond, bar) do { unsigned _sp = 0; while (cond) { __builtin_amdgcn_s_sleep(1); \
    if ((++_sp & 255u) == 0u) { if (xb_ld(&(bar)[XB_TMO])) break; if (_sp > XB_SPIN_CAP) { atomicAdd(&(bar)[XB_TMO], 1u); break; } } } } while (0)
struct XcdBarrier { unsigned* bar; unsigned x; volatile LAS unsigned* st; };
__device__ __forceinline__ XcdBarrier xcd_barrier_post(unsigned* bar, volatile LAS unsigned* st) {
    XcdBarrier b; b.bar = bar; b.x = xb_xcc_id(); b.st = st;
    if (threadIdx.x == 0) (void)xb_add(&bar[XB_XCNT(b.x)], 1u);
    return b;
}
__device__ __forceinline__ void xcd_barrier_complete(unsigned* bar, unsigned x, unsigned& nloc, unsigned& nx) {
    const unsigned G = gridDim.x * gridDim.y * gridDim.z;
    unsigned sum, cnt, mine, sp = 0u;
    for (;;) {
        sum = 0u; cnt = 0u; mine = 0u;
#pragma unroll
        for (unsigned j = 0; j < 16; ++j) { const unsigned c = xb_ld(&bar[XB_XCNT(j)]); sum += c; cnt += (c > 0u) ? 1u : 0u; mine = (j == x) ? c : mine; }
        if (sum == G) break;
        __builtin_amdgcn_s_sleep(1);
        if ((++sp & 255u) == 0u) { if (xb_ld(&bar[XB_TMO])) break; if (sp > XB_SPIN_CAP) { atomicAdd(&bar[XB_TMO], 1u); break; } }
    }
    nloc = mine > 0u ? mine : 1u; nx = cnt > 0u ? cnt : 1u;
}
__device__ __forceinline__ void xcd_barrier(const XcdBarrier& b) {
    asm volatile("s_waitcnt vmcnt(0)" ::: "memory");
    __syncthreads();
    if (threadIdx.x == 0) {
        unsigned* bar = b.bar;
        __builtin_amdgcn_s_waitcnt(0);
        unsigned nloc = b.st[0], nx = b.st[1];
        if (nloc == 0u) { xcd_barrier_complete(bar, b.x, nloc, nx); b.st[0] = nloc; b.st[1] = nx; }
        const unsigned old = xb_add(&bar[XB_XSUB(b.x)], 1u);
        const unsigned gen = old / nloc;
        if (old + 1u == (gen + 1u) * nloc) {
            __builtin_amdgcn_fence(__ATOMIC_RELEASE, "agent");
            asm volatile("s_waitcnt vmcnt(0)" ::: "memory");
            const unsigned og = xb_add(&bar[XB_TOP], 1u);
            const unsigned tg = og / nx;
            if (og + 1u == (tg + 1u) * nx) xb_add(&bar[XB_TOPGEN], 1u);
            else XB_SPIN(xb_ld(&bar[XB_TOPGEN]) == tg, bar);
            __builtin_amdgcn_fence(__ATOMIC_ACQUIRE, "agent");
            xb_add(&bar[XB_XGEN(b.x)], 1u);
            asm volatile("s_waitcnt vmcnt(0)" ::: "memory");
        } else {
            XB_SPIN(xb_ld(&bar[XB_XGEN(b.x)]) == gen, bar);
            __builtin_amdgcn_fence(__ATOMIC_ACQUIRE, "agent");
            asm volatile("s_waitcnt vmcnt(0)" ::: "memory");
        }
    }
    __syncthreads();
}

namespace gm {
constexpr int BM = 256, BK = 64, HALF = 128, HTB = HALF * BK * 2, STAGE_BYTES = 8 * HTB, NXCD = 8, WGM = 8;
__host__ __device__ __forceinline__ int lds_byte(int r, int c) { const int st = (r >> 4) * 2 + (c >> 5), rr = r & 15, cc = c & 31, ob = rr * 64 + cc * 2; return st * 1024 + (ob ^ (((ob >> 9) & 1) << 5)); }
__host__ __device__ __forceinline__ void stage_rc(int b, int& R, int& C) { const int st = b / 1024, sb = b % 1024, swz = sb ^ (((sb >> 9) & 1) << 5); R = (st >> 1) * 16 + swz / 64; C = (st & 1) * 32 + (swz % 64) / 2; }
__host__ __device__ __forceinline__ int perm32(int rho) { const int n = rho >> 4, i = rho & 15; return 8 * (i >> 2) + 4 * n + (i & 3); }

struct GUnit { const char* A; const char* B; int pm, pn; };
__device__ __forceinline__ const char* uni_ptr(const char* p) { const unsigned long long v = (unsigned long long)p; const unsigned lo = __builtin_amdgcn_readfirstlane((unsigned)v), hi = __builtin_amdgcn_readfirstlane((unsigned)(v >> 32));
    return (const char*)(const GAS char*)(((unsigned long long)hi << 32) | lo); }

struct TileOrder {
    int nM, nN, nwg, G, c;
    __device__ __forceinline__ void init(int nM_, int nN_, int G_, int c_) { nM = nM_; nN = nN_; nwg = nM * nN; G = G_; c = c_; }
    __device__ __forceinline__ bool get(int i, int& pm, int& pn) const {
        const long L = (long)i * G + c; if (L >= nwg) return false;
        int wgid = (int)L; { const int q = nwg / NXCD, r = nwg % NXCD, xcd = wgid % NXCD, off = wgid / NXCD; wgid = (xcd < r ? xcd * (q + 1) : r * (q + 1) + (xcd - r) * q) + off; }
        const int nig = WGM * nN, gid = wgid / nig, fm = gid * WGM, gsz = (nM - fm) < WGM ? (nM - fm) : WGM;
        pm = fm + ((wgid % nig) % gsz); pn = (wgid % nig) / gsz; return true;
    }
};

__device__ __forceinline__ unsigned cvt_pk_bf16(float lo, float hi) { unsigned r; asm volatile("v_cvt_pk_bf16_f32 %0, %1, %2" : "=v"(r) : "v"(lo), "v"(hi)); return r; }

template <class Epi, class Sched, bool TR>
__device__ __forceinline__ void gemm_phase(LAS unsigned char* lds, const Sched& S, const Epi& E) {
    int tid = threadIdx.x; asm volatile("" : "+v"(tid));
    const int wid = __builtin_amdgcn_readfirstlane(tid >> 6), lane = tid & 63, wr = wid >> 2, wc = wid & 3, fr = lane & 15, fq = lane >> 4;
    const int nt = S.nt;
    int sR0, sC0, sR1, sC1; stage_rc(tid * 16, sR0, sC0); stage_rc(tid * 16 + 8192, sR1, sC1);
    const unsigned vB0 = (unsigned)(Epi::PERM ? ((sR0 & ~31) + perm32(sR0 & 31)) : sR0) * S.ldb + (unsigned)sC0 * 2u;
    const unsigned vB1 = (unsigned)(Epi::PERM ? ((sR1 & ~31) + perm32(sR1 & 31)) : sR1) * S.ldb + (unsigned)sC1 * 2u;
    const size_t kA = S.kstepA, kB = S.kstepB;
    const size_t hstepB = (size_t)HALF * S.ldb;
    const unsigned ldsw = (unsigned)wid * 1024u;
    const int aoff = lds_byte(wr * 64 + fr, fq * 8), boff = lds_byte(wc * 32 + fr, fq * 8);
#define PG8_SA(b, h) (((b) * 2 + (h)) * HTB)
#define PG8_SB(b, h) ((4 + (b) * 2 + (h)) * HTB)
#define PG8_STAGE(bufoff, gbase, o0, o1) do { \
        __builtin_amdgcn_global_load_lds((const unsigned*)((const char*)(gbase) + (o0)), (LAS unsigned*)(lds + (bufoff) + ldsw), 16, 0, 0); \
        __builtin_amdgcn_global_load_lds((const unsigned*)((const char*)(gbase) + (o1)), (LAS unsigned*)(lds + (bufoff) + ldsw + 8192), 16, 0, 0); } while (0)
#define PG8_LDA(dst, b, h) do { _Pragma("unroll") for (int m = 0; m < 4; ++m) _Pragma("unroll") for (int k = 0; k < 2; ++k) dst[m][k] = *(const LAS bf16x8*)(lds + PG8_SA(b, h) + aoff + m * 2048 + k * 1024); } while (0)
#define PG8_LDB(dst, b, h) do { _Pragma("unroll") for (int n = 0; n < 2; ++n) _Pragma("unroll") for (int k = 0; k < 2; ++k) dst[n][k] = *(const LAS bf16x8*)(lds + PG8_SB(b, h) + boff + n * 2048 + k * 1024); } while (0)
#define PG8_MMA(ai, bj, At, Bt) do { __builtin_amdgcn_s_setprio(1); _Pragma("unroll") for (int m = 0; m < 4; ++m) _Pragma("unroll") for (int n = 0; n < 2; ++n) _Pragma("unroll") for (int k = 0; k < 2; ++k) \
        acc[ai][bj][m][n] = TR ? __builtin_amdgcn_mfma_f32_16x16x32_bf16(Bt[n][k], At[m][k], acc[ai][bj][m][n], 0, 0, 0) \
                               : __builtin_amdgcn_mfma_f32_16x16x32_bf16(At[m][k], Bt[n][k], acc[ai][bj][m][n], 0, 0, 0); __builtin_amdgcn_s_setprio(0); } while (0)
#define PG8_WAIT_V(n) asm volatile("s_waitcnt vmcnt(" #n ")" ::: "memory")
#define PG8_WAIT_L(n) asm volatile("s_waitcnt lgkmcnt(" #n ")" ::: "memory")
#define PG8_BAR __builtin_amdgcn_s_barrier()
#define PG8_SCHED __builtin_amdgcn_sched_barrier(0)
    GUnit cur, nxt; int ui = 0;
    if (!S.next(0, cur)) return;
    f32x4 acc[2][2][4][2];
#pragma unroll
    for (int a = 0; a < 2; ++a)
#pragma unroll
        for (int b = 0; b < 2; ++b)
#pragma unroll
            for (int m = 0; m < 4; ++m)
#pragma unroll
                for (int n = 0; n < 2; ++n) acc[a][b][m][n] = (f32x4){0.f, 0.f, 0.f, 0.f};
    bf16x8 At[4][2], B0[2][2], B1[2][2];
    unsigned c00 = S.aoff(cur, sR0, sC0), c01 = S.aoff(cur, sR1, sC1), c10 = S.aoff(cur, HALF + sR0, sC0), c11 = S.aoff(cur, HALF + sR1, sC1);
    const char* cA = uni_ptr(cur.A); const char* cB = uni_ptr(cur.B);
    PG8_STAGE(PG8_SB(0, 0), cB, vB0, vB1); PG8_STAGE(PG8_SB(0, 1), cB + hstepB, vB0, vB1); PG8_STAGE(PG8_SA(0, 0), cA, c00, c01); PG8_STAGE(PG8_SA(0, 1), cA, c10, c11);
    if (wr == 1) PG8_BAR;
    PG8_WAIT_V(2); PG8_BAR;
    PG8_STAGE(PG8_SB(1, 0), cB + kB, vB0, vB1); PG8_STAGE(PG8_SA(1, 0), cA + kA, c00, c01); PG8_STAGE(PG8_SB(1, 1), cB + hstepB + kB, vB0, vB1);
    PG8_WAIT_V(6); PG8_BAR;
    for (;;) {
        const bool has_next = S.next(ui + 1, nxt);
        if (!has_next) nxt = cur;
        const char* nA = uni_ptr(nxt.A); const char* nB = uni_ptr(nxt.B);
        unsigned n00 = c00, n01 = c01, n10 = c10, n11 = c11;
        if (!Sched::AOFF_PM_ONLY || nxt.pm != cur.pm) { n00 = S.aoff(nxt, sR0, sC0); n01 = S.aoff(nxt, sR1, sC1); n10 = S.aoff(nxt, HALF + sR0, sC0); n11 = S.aoff(nxt, HALF + sR1, sC1); }
        for (int t = 0; t < nt; t += 2) {
            const bool last = (t == nt - 2);
            const char* a1 = cA + (size_t)(t + 1) * kA;
            const char* a2 = last ? nA : cA + (size_t)(t + 2) * kA; const char* b2 = last ? nB : cB + (size_t)(t + 2) * kB;
            const char* a3 = a2 + kA; const char* b3 = b2 + kB;
            const unsigned x00 = last ? n00 : c00, x01 = last ? n01 : c01, x10 = last ? n10 : c10, x11 = last ? n11 : c11;
            PG8_LDB(B0, 0, 0); PG8_LDB(B1, 0, 1); PG8_SCHED; PG8_LDA(At, 0, 0); PG8_STAGE(PG8_SA(1, 1), a1, c10, c11);
            PG8_WAIT_V(8); PG8_WAIT_L(0); PG8_BAR; PG8_MMA(0, 0, At, B0); PG8_MMA(0, 1, At, B1); PG8_BAR; PG8_SCHED;
            PG8_LDA(At, 0, 1); PG8_STAGE(PG8_SB(0, 0), b2, vB0, vB1); PG8_STAGE(PG8_SB(0, 1), b2 + hstepB, vB0, vB1); PG8_STAGE(PG8_SA(0, 0), a2, x00, x01);
            PG8_WAIT_V(8); PG8_WAIT_L(0); PG8_BAR; PG8_MMA(1, 0, At, B0); PG8_MMA(1, 1, At, B1); PG8_BAR; PG8_SCHED;
            PG8_LDB(B0, 1, 0); PG8_LDB(B1, 1, 1); PG8_SCHED; PG8_LDA(At, 1, 0); PG8_STAGE(PG8_SA(0, 1), a2, x10, x11);
            PG8_WAIT_V(8); PG8_WAIT_L(0); PG8_BAR; PG8_MMA(0, 0, At, B0); PG8_MMA(0, 1, At, B1); PG8_BAR; PG8_SCHED;
            PG8_LDA(At, 1, 1); PG8_STAGE(PG8_SB(1, 0), b3, vB0, vB1); PG8_STAGE(PG8_SB(1, 1), b3 + hstepB, vB0, vB1); PG8_STAGE(PG8_SA(1, 0), a3, x00, x01);
            PG8_WAIT_V(8); PG8_WAIT_L(0); PG8_BAR; PG8_MMA(1, 0, At, B0); PG8_MMA(1, 1, At, B1); PG8_BAR; PG8_SCHED;
        }
        if (wr == 0) PG8_BAR;
        E(acc, cur, wr, wc, fr, fq);
        if (!has_next) break;
#pragma unroll
        for (int a = 0; a < 2; ++a)
#pragma unroll
            for (int b = 0; b < 2; ++b)
#pragma unroll
                for (int m = 0; m < 4; ++m)
#pragma unroll
                    for (int n = 0; n < 2; ++n) acc[a][b][m][n] = (f32x4){0.f, 0.f, 0.f, 0.f};
        cur = nxt; cA = nA; cB = nB; ++ui;
        c00 = n00; c01 = n01; c10 = n10; c11 = n11;
        if (wr == 1) PG8_BAR;
    }
    PG8_WAIT_V(0);
    PG8_BAR;
#undef PG8_SA
#undef PG8_SB
#undef PG8_STAGE
#undef PG8_LDA
#undef PG8_LDB
#undef PG8_MMA
#undef PG8_WAIT_V
#undef PG8_WAIT_L
#undef PG8_BAR
#undef PG8_SCHED
}
template <class Epi, class Sched, int SCALE_B, int MODE = 0>
__device__ __forceinline__ void gemm_phase_f8(LAS unsigned char* lds, const Sched& S, const Epi& E) {
    int tid = threadIdx.x; asm volatile("" : "+v"(tid));
    const int wid = __builtin_amdgcn_readfirstlane(tid >> 6), lane = tid & 63, wr = wid >> 2, wc = wid & 3, fr = lane & 15, fq = lane >> 4;
    const int nt = S.nt;
    int scA = 127, scB = SCALE_B; asm volatile("" : "+v"(scA), "+v"(scB));
    int sR0, sC0, sR1, sC1; stage_rc(tid * 16, sR0, sC0); stage_rc(tid * 16 + 8192, sR1, sC1);
    const unsigned vB0 = (unsigned)(Epi::PERM ? ((sR0 & ~31) + perm32(sR0 & 31)) : sR0) * S.ldb + (unsigned)sC0 * 2u;
    const unsigned vB1 = (unsigned)(Epi::PERM ? ((sR1 & ~31) + perm32(sR1 & 31)) : sR1) * S.ldb + (unsigned)sC1 * 2u;
    const size_t kA = S.kstepA, kB = S.kstepB;
    const size_t hstepB = (size_t)HALF * S.ldb;
    const unsigned ldsw = (unsigned)wid * 1024u;
    const int aoff = lds_byte(wr * 64 + fr, fq * 8), aoff2 = lds_byte(wr * 64 + fr, fq * 8 + 32), boff = lds_byte(wc * 32 + fr, fq * 8), boff2 = lds_byte(wc * 32 + fr, fq * 8 + 32);
#define PG8_SA(b, h) (((b) * 2 + (h)) * HTB)
#define PG8_SB(b, h) ((4 + (b) * 2 + (h)) * HTB)
#define PG8_STAGE(bufoff, gbase, o0, o1) do { if (MODE == 2) break; \
        __builtin_amdgcn_global_load_lds((const unsigned*)((const char*)(gbase) + (o0)), (LAS unsigned*)(lds + (bufoff) + ldsw), 16, 0, 0); \
        __builtin_amdgcn_global_load_lds((const unsigned*)((const char*)(gbase) + (o1)), (LAS unsigned*)(lds + (bufoff) + ldsw + 8192), 16, 0, 0); } while (0)
#define PG8_LDA(dst, b, h) do { _Pragma("unroll") for (int m = 0; m < 4; ++m) dst[m] = __builtin_shufflevector(*(const LAS i32x4*)(lds + PG8_SA(b, h) + aoff + m * 2048), *(const LAS i32x4*)(lds + PG8_SA(b, h) + aoff2 + m * 2048), 0, 1, 2, 3, 4, 5, 6, 7); } while (0)
#define PG8_LDB(dst, b, h) do { _Pragma("unroll") for (int n = 0; n < 2; ++n) dst[n] = __builtin_shufflevector(*(const LAS i32x4*)(lds + PG8_SB(b, h) + boff + n * 2048), *(const LAS i32x4*)(lds + PG8_SB(b, h) + boff2 + n * 2048), 0, 1, 2, 3, 4, 5, 6, 7); } while (0)
#define PG8_F8(FRG) (i32x8){(int)FRG[0][0], (int)FRG[0][1], (int)FRG[0][2], (int)FRG[0][3], (int)FRG[1][0], (int)FRG[1][1], (int)FRG[1][2], (int)FRG[1][3]}
#define PG8_MMA(ai, bj, At, Bt) do { __builtin_amdgcn_s_setprio(1); _Pragma("unroll") for (int m = 0; m < 4; ++m) _Pragma("unroll") for (int n = 0; n < 2; ++n) \
        { if (MODE == 1) asm volatile("" : "+v"(acc[ai][bj][m][n]) : "v"(Bt[n]), "v"(At[m]), "v"(scB), "v"(scA)); else asm volatile("v_mfma_scale_f32_16x16x128_f8f6f4 %0, %1, %2, %0, %3, %4 op_sel_hi:[0,0,0]" : "+v"(acc[ai][bj][m][n]) : "v"(Bt[n]), "v"(At[m]), "v"(scB), "v"(scA)); } __builtin_amdgcn_s_setprio(0); } while (0)
#define PG8_WAIT_V(n) asm volatile("s_waitcnt vmcnt(" #n ")" ::: "memory")
#define PG8_WAIT_L(n) asm volatile("s_waitcnt lgkmcnt(" #n ")" ::: "memory")
#define PG8_BAR __builtin_amdgcn_s_barrier()
#define PG8_SCHED __builtin_amdgcn_sched_barrier(0)
    GUnit cur, nxt; int ui = 0;
    if (!S.next(0, cur)) return;
    f32x4 acc[2][2][4][2];
#pragma unroll
    for (int a = 0; a < 2; ++a)
#pragma unroll
        for (int b = 0; b < 2; ++b)
#pragma unroll
            for (int m = 0; m < 4; ++m)
#pragma unroll
                for (int n = 0; n < 2; ++n) acc[a][b][m][n] = (f32x4){0.f, 0.f, 0.f, 0.f};
    i32x8 At[4], B0[2], B1[2];
    unsigned c00 = S.aoff(cur, sR0, sC0), c01 = S.aoff(cur, sR1, sC1), c10 = S.aoff(cur, HALF + sR0, sC0), c11 = S.aoff(cur, HALF + sR1, sC1);
    const char* cA = uni_ptr(cur.A); const char* cB = uni_ptr(cur.B);
    PG8_STAGE(PG8_SB(0, 0), cB, vB0, vB1); PG8_STAGE(PG8_SB(0, 1), cB + hstepB, vB0, vB1); PG8_STAGE(PG8_SA(0, 0), cA, c00, c01); PG8_STAGE(PG8_SA(0, 1), cA, c10, c11);
    if (wr == 1) PG8_BAR;
    PG8_WAIT_V(2); PG8_BAR;
    PG8_STAGE(PG8_SB(1, 0), cB + kB, vB0, vB1); PG8_STAGE(PG8_SA(1, 0), cA + kA, c00, c01); PG8_STAGE(PG8_SB(1, 1), cB + hstepB + kB, vB0, vB1);
    PG8_WAIT_V(6); PG8_BAR;
    for (;;) {
        const bool has_next = S.next(ui + 1, nxt);
        if (!has_next) nxt = cur;
        const char* nA = uni_ptr(nxt.A); const char* nB = uni_ptr(nxt.B);
        unsigned n00 = c00, n01 = c01, n10 = c10, n11 = c11;
        if constexpr (!Sched::AOFF_CONST) { if (!Sched::AOFF_PM_ONLY || nxt.pm != cur.pm) { n00 = S.aoff(nxt, sR0, sC0); n01 = S.aoff(nxt, sR1, sC1); n10 = S.aoff(nxt, HALF + sR0, sC0); n11 = S.aoff(nxt, HALF + sR1, sC1); } }
        for (int t = 0; t < nt; t += 2) {
            const bool last = (t == nt - 2);
            const char* a1 = cA + (size_t)(t + 1) * kA;
            const char* a2 = last ? nA : cA + (size_t)(t + 2) * kA; const char* b2 = last ? nB : cB + (size_t)(t + 2) * kB;
            const char* a3 = a2 + kA; const char* b3 = b2 + kB;
            const unsigned x00 = (!Sched::AOFF_CONST && last) ? n00 : c00, x01 = (!Sched::AOFF_CONST && last) ? n01 : c01, x10 = (!Sched::AOFF_CONST && last) ? n10 : c10, x11 = (!Sched::AOFF_CONST && last) ? n11 : c11;
            PG8_LDB(B0, 0, 0); PG8_LDB(B1, 0, 1); PG8_SCHED; PG8_LDA(At, 0, 0); PG8_STAGE(PG8_SA(1, 1), a1, c10, c11);
            PG8_WAIT_V(8); PG8_WAIT_L(0); PG8_BAR; PG8_MMA(0, 0, At, B0); PG8_MMA(0, 1, At, B1); PG8_BAR; PG8_SCHED;
            PG8_LDA(At, 0, 1); PG8_STAGE(PG8_SB(0, 0), b2, vB0, vB1); PG8_STAGE(PG8_SB(0, 1), b2 + hstepB, vB0, vB1); PG8_STAGE(PG8_SA(0, 0), a2, x00, x01);
            PG8_WAIT_V(8); PG8_WAIT_L(0); PG8_BAR; PG8_MMA(1, 0, At, B0); PG8_MMA(1, 1, At, B1); PG8_BAR; PG8_SCHED;
            PG8_LDB(B0, 1, 0); PG8_LDB(B1, 1, 1); PG8_SCHED; PG8_LDA(At, 1, 0); PG8_STAGE(PG8_SA(0, 1), a2, x10, x11);
            PG8_WAIT_V(8); PG8_WAIT_L(0); PG8_BAR; PG8_MMA(0, 0, At, B0); PG8_MMA(0, 1, At, B1); PG8_BAR; PG8_SCHED;
            PG8_LDA(At, 1, 1); PG8_STAGE(PG8_SB(1, 0), b3, vB0, vB1); PG8_STAGE(PG8_SB(1, 1), b3 + hstepB, vB0, vB1); PG8_STAGE(PG8_SA(1, 0), a3, x00, x01);
            PG8_WAIT_V(8); PG8_WAIT_L(0); PG8_BAR; PG8_MMA(1, 0, At, B0); PG8_MMA(1, 1, At, B1); PG8_BAR; PG8_SCHED;
        }
        if (wr == 0) PG8_BAR;
        asm volatile("s_nop 15\n\ts_nop 15" ::: "memory");
        if (MODE == 0) E(acc, cur, wr, wc, fr, fq); else asm volatile("" :: "v"(acc[0][0][0][0]), "v"(acc[1][1][3][1]));
        if (!has_next) break;
#pragma unroll
        for (int a = 0; a < 2; ++a)
#pragma unroll
            for (int b = 0; b < 2; ++b)
#pragma unroll
                for (int m = 0; m < 4; ++m)
#pragma unroll
                    for (int n = 0; n < 2; ++n) acc[a][b][m][n] = (f32x4){0.f, 0.f, 0.f, 0.f};
        cur = nxt; cA = nA; cB = nB; ++ui;
        c00 = n00; c01 = n01; c10 = n10; c11 = n11;
        if (wr == 1) PG8_BAR;
    }
    PG8_WAIT_V(0);
    PG8_BAR;
#undef PG8_SA
#undef PG8_SB
#undef PG8_STAGE
#undef PG8_LDA
#undef PG8_LDB
#undef PG8_MMA
#undef PG8_F8
#undef PG8_WAIT_V
#undef PG8_WAIT_L
#undef PG8_BAR
#undef PG8_SCHED
}
}

struct Args { const float* in[35]; float* out; unsigned char* ws; int ph_lo, ph_hi; };
struct Frame {
    LAS unsigned char* lds;
    int tid, lane, wave, G, bid;
    float* out; unsigned char* ws;
};
__device__ __forceinline__ const float* inptr(const Frame& F, int i) {
    const LAS unsigned* t = (const LAS unsigned*)(F.lds + LDSCTL_OFF) + 2 * i;
    const unsigned lo = __builtin_amdgcn_readfirstlane(t[0]), hi = __builtin_amdgcn_readfirstlane(t[1]);
    const GAS float* g = (const GAS float*)(((unsigned long long)hi << 32) | lo);
    return (const float*)g;
}
enum { I_X = 0, I_C, I_CTX, I_CCTX, I_MODW, I_MODB, I_N1G, I_N2G, I_WIN, I_WOUT, I_CONVW, I_CONVB, I_HW1, I_HB1, I_HFREQ, I_HW2, I_HB2, I_HW3, I_HB3, I_HBIAS,
       I_LRE, I_LIM, I_LSTEP, I_BRE, I_BIM, I_CRE, I_CIM, I_S5D, I_GLUW, I_GLUB, I_RW, I_WG, I_WU, I_WD, I_FING };

struct SchedPlain {
    static constexpr bool AOFF_PM_ONLY = true, AOFF_CONST = true;
    gm::TileOrder T; const char* A; const char* B; unsigned lda, ldb, kstepA, kstepB; int nt; int mt; size_t az, bz;
    __device__ __forceinline__ bool next(int i, gm::GUnit& u) const {
        int pm, pn; if (!T.get(i, pm, pn)) return false; const int z = pm / mt, pl = pm - z * mt;
        u.pm = pm; u.pn = pn; u.A = A + (size_t)z * az + (size_t)pl * 256 * lda; u.B = B + (size_t)z * bz + (size_t)pn * 256 * ldb; return true; }
    __device__ __forceinline__ unsigned aoff(const gm::GUnit&, int row, int col) const { return (unsigned)row * lda + (unsigned)col * 2u; }
};
struct SchedMoe1 {
    static constexpr bool AOFF_PM_ONLY = true, AOFF_CONST = false;
    gm::TileOrder T; const char* A; const char* B; const int* idx; unsigned lda, ldb, kstepA, kstepB; int nt;
    __device__ __forceinline__ bool next(int i, gm::GUnit& u) const {
        int pm, pn; if (!T.get(i, pm, pn)) return false; const int e = pm >> 4;
        u.pm = pm; u.pn = pn; u.A = A; u.B = B + ((size_t)e * (2 * FF) + (size_t)pn * 256) * ldb; return true; }
    __device__ __forceinline__ unsigned aoff(const gm::GUnit& u, int row, int col) const { const int tok = idx[u.pm * 256 + row]; return (unsigned)tok * lda + (unsigned)col * 2u; }
};
struct SchedGlu {
    static constexpr bool AOFF_PM_ONLY = true;
    gm::TileOrder T; const char* A; const char* B; unsigned ldb, kstepA, kstepB; int nt;
    __device__ __forceinline__ bool next(int i, gm::GUnit& u) const {
        int pm, pn; if (!T.get(i, pm, pn)) return false;
        u.pm = pm; u.pn = pn; u.A = A + (size_t)pm * 256 * 32; u.B = B + (size_t)pn * 256 * ldb; return true; }
    __device__ __forceinline__ unsigned aoff(const gm::GUnit&, int row, int col) const { return (unsigned)(col >> 4) * (unsigned)(1024 * 512 * 2) + (unsigned)row * 32u + (unsigned)(col & 15) * 2u; }
};

using gm::GUnit; using gm::cvt_pk_bf16;
struct EpiZT { static constexpr bool PERM = false; bf16* ZT;
    __device__ __forceinline__ void operator()(const f32x4 (&acc)[2][2][4][2], const GUnit& u, int wr, int wc, int fr, int fq) const {
#pragma unroll
        for (int bj = 0; bj < 2; ++bj)
#pragma unroll
            for (int n = 0; n < 2; ++n) { const int ch = u.pn * 256 + bj * 128 + wc * 32 + n * 16 + fr; bf16* rowp = ZT + (size_t)ch * NTOK + u.pm * 256 + wr * 64 + 4 * fq;
#pragma unroll
                for (int ai = 0; ai < 2; ++ai)
#pragma unroll
                    for (int m = 0; m < 4; ++m) { const f32x4 v = acc[ai][bj][m][n]; u32x2 w; w.x = cvt_pk_bf16(v[0], v[1]); w.y = cvt_pk_bf16(v[2], v[3]); *(u32x2*)(rowp + ai * 128 + m * 16) = w; } }
    }
};
struct EpiUG { static constexpr bool PERM = true; bf16* UG;
    __device__ __forceinline__ void operator()(const f32x4 (&acc)[2][2][4][2], const GUnit& u, int wr, int wc, int fr, int fq) const {
#pragma unroll
        for (int ai = 0; ai < 2; ++ai)
#pragma unroll
            for (int m = 0; m < 4; ++m) { const int r = u.pm * 256 + ai * 128 + wr * 64 + m * 16 + fr; int crow, tau;
                if (r < NTOK) { crow = r >> 5; tau = r & 31; } else { const int rc = r - NTOK; crow = 1024 + (rc >> 5); tau = rc & 31; }
#pragma unroll
                for (int bj = 0; bj < 2; ++bj) { const int c0 = u.pn * 256 + bj * 128 + wc * 32 + 8 * fq; const int g = c0 >> 4, h0 = c0 & 15;
                    const f32x4 v0 = acc[ai][bj][m][0], v1 = acc[ai][bj][m][1]; u32x4 w; w.x = cvt_pk_bf16(v0[0], v0[1]); w.y = cvt_pk_bf16(v0[2], v0[3]); w.z = cvt_pk_bf16(v1[0], v1[1]); w.w = cvt_pk_bf16(v1[2], v1[3]);
                    *(u32x4*)(UG + ((size_t)g * UROWS + crow) * UCOLS + tau * 16 + h0) = w; } }
    }
};
struct EpiEB { static constexpr bool PERM = false; float* EB;
    __device__ __forceinline__ void operator()(const f32x4 (&acc)[2][2][4][2], const GUnit& u, int wr, int wc, int fr, int fq) const {
        const int g = u.pm / 5, pl = u.pm - g * 5;
#pragma unroll
        for (int ai = 0; ai < 2; ++ai)
#pragma unroll
            for (int m = 0; m < 4; ++m) { float* rowp = EB + ((size_t)g * UROWS + pl * 256 + ai * 128 + wr * 64 + m * 16 + fr) * 256 + wc * 32 + 4 * fq;
#pragma unroll
                for (int bj = 0; bj < 2; ++bj)
#pragma unroll
                    for (int n = 0; n < 2; ++n) *(f32x4*)(rowp + bj * 128 + n * 16) = acc[ai][bj][m][n]; }
    }
};
struct EpiYS { static constexpr bool PERM = true; bf16* YSG; const bf16* UG; const float* s5d;
    __device__ __forceinline__ void operator()(const f32x4 (&acc)[2][2][4][2], const GUnit& u, int wr, int wc, int fr, int fq) const {
        const int g = u.pm >> 2, pl = u.pm & 3;
        float dv[2][8];
#pragma unroll
        for (int bj = 0; bj < 2; ++bj) { const int c0 = u.pn * 256 + bj * 128 + wc * 32 + 8 * fq;
#pragma unroll
            for (int j = 0; j < 8; ++j) dv[bj][j] = s5d[g * 16 + ((c0 + j) & 15)]; }
        u32x4 uq[2][4][2];
#pragma unroll
        for (int ai = 0; ai < 2; ++ai)
#pragma unroll
            for (int m = 0; m < 4; ++m) { const int crow = pl * 256 + ai * 128 + wr * 64 + m * 16 + fr;
#pragma unroll
                for (int bj = 0; bj < 2; ++bj) uq[ai][m][bj] = *(const u32x4*)(UG + ((size_t)g * UROWS + crow) * UCOLS + u.pn * 256 + bj * 128 + wc * 32 + 8 * fq); }
#pragma unroll
        for (int ai = 0; ai < 2; ++ai)
#pragma unroll
            for (int m = 0; m < 4; ++m) { const int crow = pl * 256 + ai * 128 + wr * 64 + m * 16 + fr;
#pragma unroll
                for (int bj = 0; bj < 2; ++bj) { const int c0 = u.pn * 256 + bj * 128 + wc * 32 + 8 * fq;
                    const u32x4 uu = uq[ai][m][bj];
                    const f32x4 v0 = acc[ai][bj][m][0], v1 = acc[ai][bj][m][1];
                    float y[8]; y[0] = v0[0] + dv[bj][0] * bflo(uu.x); y[1] = v0[1] + dv[bj][1] * bfhi(uu.x); y[2] = v0[2] + dv[bj][2] * bflo(uu.y); y[3] = v0[3] + dv[bj][3] * bfhi(uu.y);
                    y[4] = v1[0] + dv[bj][4] * bflo(uu.z); y[5] = v1[1] + dv[bj][5] * bfhi(uu.z); y[6] = v1[2] + dv[bj][6] * bflo(uu.w); y[7] = v1[3] + dv[bj][7] * bfhi(uu.w);
#pragma unroll
                    for (int j = 0; j < 8; ++j) y[j] = gelu_tanh(y[j]);
                    u32x4 w; w.x = cvt_pk_bf16(y[0], y[1]); w.y = cvt_pk_bf16(y[2], y[3]); w.z = cvt_pk_bf16(y[4], y[5]); w.w = cvt_pk_bf16(y[6], y[7]);
                    *(u32x4*)(YSG + ((size_t)g * 1024 + crow) * 512 + c0) = w; } }
    }
};
struct EpiGlu { static constexpr bool PERM = true; bf16* YCAT; const bf16* YSG; const float* glub;
    __device__ __forceinline__ void operator()(const f32x4 (&acc)[2][2][4][2], const GUnit& u, int wr, int wc, int fr, int fq) const {
#pragma unroll
        for (int bj = 0; bj < 2; ++bj) { const int n0 = u.pn * 256 + bj * 128 + wc * 32 + 8 * fq; const int g = n0 >> 4, h0 = n0 & 15;
            const f32x4 b0 = *(const f32x4*)(glub + n0), b1 = *(const f32x4*)(glub + n0 + 4);
            u32x4 yq[2][4];
#pragma unroll
            for (int ai = 0; ai < 2; ++ai)
#pragma unroll
                for (int m = 0; m < 4; ++m) { const int tok = u.pm * 256 + ai * 128 + wr * 64 + m * 16 + fr; yq[ai][m] = *(const u32x4*)(YSG + ((size_t)g * 1024 + (tok >> 5)) * 512 + (tok & 31) * 16 + h0); }
#pragma unroll
            for (int ai = 0; ai < 2; ++ai)
#pragma unroll
                for (int m = 0; m < 4; ++m) { const int tok = u.pm * 256 + ai * 128 + wr * 64 + m * 16 + fr;
                    const u32x4 ys = yq[ai][m];
                    const f32x4 v0 = acc[ai][bj][m][0] + b0, v1 = acc[ai][bj][m][1] + b1;
                    float y[8]; y[0] = bflo(ys.x) * sigmoidf_(v0[0]); y[1] = bfhi(ys.x) * sigmoidf_(v0[1]); y[2] = bflo(ys.y) * sigmoidf_(v0[2]); y[3] = bfhi(ys.y) * sigmoidf_(v0[3]);
                    y[4] = bflo(ys.z) * sigmoidf_(v1[0]); y[5] = bfhi(ys.z) * sigmoidf_(v1[1]); y[6] = bflo(ys.w) * sigmoidf_(v1[2]); y[7] = bfhi(ys.w) * sigmoidf_(v1[3]);
                    u32x4 w; w.x = cvt_pk_bf16(y[0], y[1]); w.y = cvt_pk_bf16(y[2], y[3]); w.z = cvt_pk_bf16(y[4], y[5]); w.w = cvt_pk_bf16(y[6], y[7]);
#ifdef DBG_S5_SCALE
                    w.x = cvt_pk_bf16(y[0] * DBG_S5_SCALE, y[1] * DBG_S5_SCALE); w.y = cvt_pk_bf16(y[2] * DBG_S5_SCALE, y[3] * DBG_S5_SCALE); w.z = cvt_pk_bf16(y[4] * DBG_S5_SCALE, y[5] * DBG_S5_SCALE); w.w = cvt_pk_bf16(y[6] * DBG_S5_SCALE, y[7] * DBG_S5_SCALE);
#endif
                    *(u32x4*)(YCAT + (size_t)tok * DM + 512 + n0) = w; } }
    }
};
struct EpiXmid { static constexpr bool PERM = false; const float* x; bf16* xmid; const float* mod;
    __device__ __forceinline__ void operator()(const f32x4 (&acc)[2][2][4][2], const GUnit& u, int wr, int wc, int fr, int fq) const {
        const int b = u.pm >> 4;
        const int col0 = u.pn * 256 + wc * 32 + 4 * fq;
        f32x4 gv[2][2];
#pragma unroll
        for (int bj = 0; bj < 2; ++bj)
#pragma unroll
            for (int n = 0; n < 2; ++n) gv[bj][n] = *(const f32x4*)(mod + (size_t)b * (NMOD * DM) + 2 * DM + col0 + bj * 128 + n * 16);
#pragma unroll
        for (int ai = 0; ai < 2; ++ai) { f32x4 xv[4][2][2];
#pragma unroll
            for (int m = 0; m < 4; ++m) { const size_t off = (size_t)(u.pm * 256 + ai * 128 + wr * 64 + m * 16 + fr) * DM + col0;
#pragma unroll
                for (int bj = 0; bj < 2; ++bj)
#pragma unroll
                    for (int n = 0; n < 2; ++n) xv[m][bj][n] = *(const f32x4*)(x + off + bj * 128 + n * 16); }
#pragma unroll
            for (int m = 0; m < 4; ++m) { const size_t off = (size_t)(u.pm * 256 + ai * 128 + wr * 64 + m * 16 + fr) * DM + col0;
#pragma unroll
                for (int bj = 0; bj < 2; ++bj)
#pragma unroll
                    for (int n = 0; n < 2; ++n) { const f32x4 rv = xv[m][bj][n] + gv[bj][n] * acc[ai][bj][m][n]; u32x2 o; o.x = pk2(rv.x, rv.y); o.y = pk2(rv.z, rv.w); *(u32x2*)(xmid + off + bj * 128 + n * 16) = o; } }
            asm volatile("" ::: "memory"); }
    }
};
struct EpiMoe1 { static constexpr bool PERM = true; unsigned char* HB;
    __device__ __forceinline__ void operator()(const f32x4 (&acc)[2][2][4][2], const GUnit& u, int wr, int wc, int fr, int fq) const {
        const int c0 = u.pn * 128 + wc * 32 + 8 * fq;
#pragma unroll
        for (int ai = 0; ai < 2; ++ai)
#pragma unroll
            for (int m = 0; m < 4; ++m) { const size_t row = (size_t)u.pm * 256 + ai * 128 + wr * 64 + m * 16 + fr;
                float y[8];
#pragma unroll
                for (int n = 0; n < 2; ++n)
#pragma unroll
                    for (int j = 0; j < 4; ++j) y[n * 4 + j] = fminf(fmaxf(siluf_(acc[ai][0][m][n][j]) * acc[ai][1][m][n][j], -448.0f), 448.0f);
                u32x2 w; w.x = pk4_fp8(y[0], y[1], y[2], y[3]); w.y = pk4_fp8(y[4], y[5], y[6], y[7]);
                *(u32x2*)(HB + row * FF + c0) = w; }
    }
};
struct EpiMoe2 { static constexpr bool PERM = true; bf16* Y; const float* gate;
    __device__ __forceinline__ void operator()(const f32x4 (&acc)[2][2][4][2], const GUnit& u, int wr, int wc, int fr, int fq) const {
#pragma unroll
        for (int ai = 0; ai < 2; ++ai)
#pragma unroll
            for (int m = 0; m < 4; ++m) { const size_t row = (size_t)u.pm * 256 + ai * 128 + wr * 64 + m * 16 + fr; const float gt = gate[row];
#pragma unroll
                for (int bj = 0; bj < 2; ++bj) { const int c0 = u.pn * 256 + bj * 128 + wc * 32 + 8 * fq;
                    const f32x4 v0 = acc[ai][bj][m][0] * gt, v1 = acc[ai][bj][m][1] * gt;
                    u32x4 w; w.x = cvt_pk_bf16(v0[0], v0[1]); w.y = cvt_pk_bf16(v0[2], v0[3]); w.z = cvt_pk_bf16(v1[0], v1[1]); w.w = cvt_pk_bf16(v1[2], v1[3]);
                    *(u32x4*)(Y + row * DM + c0) = w; } }
    }
};

__device__ __forceinline__ void tr_item(const float* W, int N, bf16* WT, int ldk, int k0, int n0, int drow0, LAS float* scr, int lane) {
    float tv[32];
    const float* wp = W + (size_t)(k0 + (lane >> 5)) * N + n0 + (lane & 31);
#pragma unroll
    for (int i = 0; i < 32; ++i) tv[i] = wp[(size_t)(2 * i) * N];
#pragma unroll
    for (int i = 0; i < 32; ++i) scr[(2 * i + (lane >> 5)) * 33 + (lane & 31)] = tv[i];
    LDS_WAIT(); asm volatile("" ::: "memory");
    const int c = lane & 7;
#pragma unroll
    for (int j = 0; j < 4; ++j) { const int n = (lane >> 3) + 8 * j; const LAS float* s = scr + (8 * c) * 33 + n;
        u32x4 o; o.x = pk2(s[0 * 33], s[1 * 33]); o.y = pk2(s[2 * 33], s[3 * 33]); o.z = pk2(s[4 * 33], s[5 * 33]); o.w = pk2(s[6 * 33], s[7 * 33]);
        *(u32x4*)(WT + (size_t)(drow0 + n) * ldk + k0 + 8 * c) = o; }
    LDS_WAIT(); asm volatile("" ::: "memory");
}
__device__ __forceinline__ void p0_transposes(Frame& F) {
    LAS float* scr = (LAS float*)(F.lds + F.wave * 16384);
    if (F.bid >= 192) return;
    const int gw = F.bid * NWAVES + F.wave, NGW = 192 * NWAVES;
    constexpr int I0 = 16 * 64, I1 = 16 * 32, I2 = 8 * 16, IG = 16 * 16 * 88;
    constexpr int NIT = I0 + I1 + I2;
    bf16* ws16 = (bf16*)F.ws;
    for (int it = gw; it < NIT; it += NGW) {
        int r = it;
        if (r < I0) { const int kb = r / 64, nb = r % 64; tr_item(inptr(F, I_WIN), INC, (bf16*)(F.ws + WS_WINT), DM, kb * 64, nb * 32, nb * 32, scr, F.lane); continue; } r -= I0;
        if (r < I1) { const int kb = r / 32, nb = r % 32; tr_item(inptr(F, I_WOUT), DM, (bf16*)(F.ws + WS_WOUTT), DM, kb * 64, nb * 32, nb * 32, scr, F.lane); continue; } r -= I1;
        if (r < I2) { const int kb = r / 16, nb = r % 16; tr_item(inptr(F, I_GLUW), S5W, (bf16*)(F.ws + WS_GLUT), S5W, kb * 64, nb * 32, nb * 32, scr, F.lane); continue; } r -= I2;
        if (r < 2 * IG) { const int up = r >= IG; if (up) r -= IG; const int e = r / (16 * 88), q = r % (16 * 88), kb = q / 88, nb = q % 88, n0 = nb * 32;
            const float* W = inptr(F, up ? I_WU : I_WG) + (size_t)e * DM * FF;
            tr_item(W, FF, (bf16*)(F.ws + WS_WGUT) + (size_t)e * (2 * FF) * DM, DM, kb * 64, n0, 256 * (n0 >> 7) + (n0 & 127) + (up ? 128 : 0), scr, F.lane); continue; }
    }
    (void)ws16;
}
__device__ __forceinline__ void tr_item_f8(const float* W, int N, unsigned char* WT, int ldk, int k0, int n0, int drow0, float sc, LAS float* scr, int lane) {
    float tv[32];
    const float* wp = W + (size_t)(k0 + (lane >> 5)) * N + n0 + (lane & 31);
#pragma unroll
    for (int i = 0; i < 32; ++i) tv[i] = wp[(size_t)(2 * i) * N];
#pragma unroll
    for (int i = 0; i < 32; ++i) scr[(2 * i + (lane >> 5)) * 33 + (lane & 31)] = tv[i];
    LDS_WAIT(); asm volatile("" ::: "memory");
    const int c = lane & 7;
#pragma unroll
    for (int j = 0; j < 4; ++j) { const int n = (lane >> 3) + 8 * j; const LAS float* s = scr + (8 * c) * 33 + n;
        u32x2 o; o.x = pk4_fp8(s[0 * 33] * sc, s[1 * 33] * sc, s[2 * 33] * sc, s[3 * 33] * sc); o.y = pk4_fp8(s[4 * 33] * sc, s[5 * 33] * sc, s[6 * 33] * sc, s[7 * 33] * sc);
        *(u32x2*)(WT + (size_t)(drow0 + n) * ldk + k0 + 8 * c) = o; }
    LDS_WAIT(); asm volatile("" ::: "memory");
}
__device__ __forceinline__ void dn_issue(Frame& F, int r, float (&tv)[32]) {
    if (r >= 16 * 44 * 32) return;
    const int e = r / (44 * 32), q = r % (44 * 32), kb = q / 32, nb = q % 32;
    const float* wp = inptr(F, I_WD) + (size_t)e * FF * DM + (size_t)(kb * 64 + (F.lane >> 5)) * DM + nb * 32 + (F.lane & 31);
#pragma unroll
    for (int i = 0; i < 32; ++i) tv[i] = wp[(size_t)(2 * i) * DM];
}
__device__ __forceinline__ void dn_finish(Frame& F, int r, const float (&tv)[32], LAS float* scr) {
    if (r >= 16 * 44 * 32) return;
    const int e = r / (44 * 32), q = r % (44 * 32), kb = q / 32, nb = q % 32, lane = F.lane;
    unsigned char* WT = (unsigned char*)(F.ws + WS_WDT) + (size_t)e * DM * FF;
#pragma unroll
    for (int i = 0; i < 32; ++i) scr[(2 * i + (lane >> 5)) * 33 + (lane & 31)] = tv[i];
    LDS_WAIT(); asm volatile("" ::: "memory");
    const int c = lane & 7;
#pragma unroll
    for (int j = 0; j < 4; ++j) { const int n = (lane >> 3) + 8 * j; const LAS float* s = scr + (8 * c) * 33 + n;
        u32x2 o; o.x = pk4_fp8(s[0 * 33] * WD_SCALE, s[1 * 33] * WD_SCALE, s[2 * 33] * WD_SCALE, s[3 * 33] * WD_SCALE); o.y = pk4_fp8(s[4 * 33] * WD_SCALE, s[5 * 33] * WD_SCALE, s[6 * 33] * WD_SCALE, s[7 * 33] * WD_SCALE);
        *(u32x2*)(WT + (size_t)(nb * 32 + n) * FF + kb * 64 + 8 * c) = o; }
    LDS_WAIT(); asm volatile("" ::: "memory");
}
__device__ __forceinline__ void p_down_items(Frame& F, int first, int count, int stride) {
    LAS float* scr = (LAS float*)(F.lds + F.wave * 16384);
    float ta[32], tb[32];
    dn_issue(F, first, ta);
#pragma unroll 1
    for (int k = 0; k < count; k += 2) {
        if (k + 1 < count) dn_issue(F, first + (k + 1) * stride, tb);
        dn_finish(F, first + k * stride, ta, scr);
        if (k + 2 < count) dn_issue(F, first + (k + 2) * stride, ta);
        if (k + 1 < count) dn_finish(F, first + (k + 1) * stride, tb, scr);
    }
}
constexpr int DN_P4 = 3 * 6 * 256, DN_P9 = 10 * 8 * 128, DN_P3 = 4 * 8 * 96, DN_P0 = 22528 - DN_P4 - DN_P9 - DN_P3;
__device__ __forceinline__ void p0_adaln_item(Frame& F, int item) {
    LAS float* sl = (LAS float*)F.lds;
    LAS float* part = sl + 9 * 1024;
    for (int i = F.tid; i < 9 * 1024; i += NTHR) { const int r = i >> 10, k = i & 1023; const float v = (r < 8) ? inptr(F, I_C)[r * DM + k] : inptr(F, I_CCTX)[k]; sl[i] = siluf_(v); }
    __syncthreads();
    const int cl = F.tid & 31, kq = F.tid >> 5, j = item * 32 + cl;
    float a[9];
#pragma unroll
    for (int r = 0; r < 9; ++r) a[r] = 0.f;
    const float* W = inptr(F, I_MODW);
#pragma unroll 16
    for (int kk = 0; kk < 64; ++kk) { const int k = kq + 16 * kk; const float w = W[(size_t)k * (NMOD * DM) + j];
#pragma unroll
        for (int r = 0; r < 9; ++r) a[r] += sl[r * 1024 + k] * w; }
#pragma unroll
    for (int r = 0; r < 9; ++r) part[(kq * 9 + r) * 32 + cl] = a[r];
    __syncthreads();
    if (F.tid < 9 * 32) { const int r = F.tid >> 5, c2 = F.tid & 31; float s = inptr(F, I_MODB)[item * 32 + c2];
#pragma unroll
        for (int q = 0; q < 16; ++q) s += part[(q * 9 + r) * 32 + c2];
        ((float*)(F.ws + WS_MOD))[(size_t)r * (NMOD * DM) + item * 32 + c2] = s; }
    __syncthreads();
}
__device__ __forceinline__ void p0_s5_tables(Frame& F, int g) {
    typedef float f32x2 __attribute__((ext_vector_type(2)));
    LAS f32x2* PW = (LAS f32x2*)F.lds;
    LAS f32x2* BB = PW + 2 * 33 * 64;
    LAS float* KT = (LAS float*)(BB + 2 * 64 * 16);
    LAS f32x2* CC = (LAS f32x2*)(KT + 2 * 32 * 256);
    const float* lre = inptr(F, I_LRE); const float* lim = inptr(F, I_LIM); const float* lst = inptr(F, I_LSTEP);
    const float* cre = inptr(F, I_CRE); const float* cim = inptr(F, I_CIM);
    for (int i = F.tid; i < 2 * 33 * 64; i += NTHR) { const int dir = i / (33 * 64), e = (i / 64) % 33, p = i & 63;
        const double lr = lre[(dir * NG + g) * NP + p], li = lim[(dir * NG + g) * NP + p], dt = exp((double)lst[dir * NG + g]);
        double ph = li * dt * e; ph -= 6.283185307179586 * floor(ph * 0.15915494309189535);
        const float m = expf((float)(lr * dt * e)); float sn, cs; sincosf((float)ph, &sn, &cs); const float cr = m * cs, ci = m * sn;
        PW[i] = (f32x2){cr, ci};
        if (e == 32) { float* LT = (float*)(F.ws + WS_LT); LT[((dir * NG + g) * NP + p) * 2] = cr; LT[((dir * NG + g) * NP + p) * 2 + 1] = ci; } }
    __syncthreads();
    for (int i = F.tid; i < 2 * 16 * 64; i += NTHR) { const int dir = i >> 10, h = (i >> 6) & 15, p = i & 63; const size_t ci = (((size_t)dir * NG + g) * GH + h) * NP + p; CC[i] = (f32x2){cre[ci], cim[ci]}; }
    for (int i = F.tid; i < 2 * 64 * 16; i += NTHR) { const int dir = i >> 10, p = (i >> 4) & 63, h = i & 15;
        const double lr = lre[(dir * NG + g) * NP + p], li = lim[(dir * NG + g) * NP + p];
        const f32x2 lb = PW[(dir * 33 + 1) * 64 + p]; const double ar = (double)lb.x - 1.0, ai = (double)lb.y, den = lr * lr + li * li;
        const double fr_ = (ar * lr + ai * li) / den, fi_ = (ai * lr - ar * li) / den;
        const size_t bi = (((size_t)dir * NG + g) * NP + p) * GH + h; const double br = inptr(F, I_BRE)[bi], bim = inptr(F, I_BIM)[bi];
        BB[i] = (f32x2){(float)(fr_ * br - fi_ * bim), (float)(fr_ * bim + fi_ * br)}; }
    __syncthreads();
    {
        const int dir = F.tid >> 8, h = (F.tid >> 4) & 15, hp = F.tid & 15;
        for (int d = 0; d < 32; ++d) KT[(dir * 32 + d) * 256 + (F.tid & 255)] = 0.f;
        for (int pc = 0; pc < 4; ++pc) { float qr[16], qi[16];
#pragma unroll
            for (int j = 0; j < 16; ++j) { const int p = pc * 16 + j; const f32x2 cc = CC[(dir * 16 + h) * 64 + p]; const float cr = cc.x, cj = cc.y; const f32x2 b = BB[(dir * 64 + p) * 16 + hp];
                qr[j] = cr * b.x - cj * b.y; qi[j] = cr * b.y + cj * b.x; }
            for (int d = 0; d < 32; ++d) { float s = 0.f;
#pragma unroll
                for (int j = 0; j < 16; ++j) { const f32x2 w = PW[(dir * 33 + d) * 64 + pc * 16 + j]; s += qr[j] * w.x - qi[j] * w.y; }
                KT[(dir * 32 + d) * 256 + (F.tid & 255)] += s; } }
    }
    __syncthreads();
    { float* TAB = (float*)(F.ws + WS_S5TAB) + (size_t)g * S5TAB_FLOATS; const LAS float* src = (const LAS float*)F.lds;
      for (int i = F.tid; i < S5TAB_FLOATS / 4; i += NTHR) ((f32x4*)TAB)[i] = ((const LAS f32x4*)src)[i]; }
    __syncthreads();
}
__device__ __forceinline__ void p1_s5_expand(Frame& F) {
    typedef float f32x2 __attribute__((ext_vector_type(2)));
    const int g = F.bid >> 3, part = F.bid & 7;
    LAS f32x2* PW = (LAS f32x2*)F.lds;
    LAS f32x2* BB = PW + 2 * 33 * 64;
    constexpr int KTS = 260;
    LAS float* KT = (LAS float*)(BB + 2 * 64 * 16);
    LAS f32x2* CC = (LAS f32x2*)(KT + 2 * 32 * KTS);
    { const float* TAB = (const float*)(F.ws + WS_S5TAB) + (size_t)g * S5TAB_FLOATS; LAS float* dst = (LAS float*)F.lds;
      constexpr int KT0 = (2 * 33 * 64 * 2) + (2 * 64 * 16 * 2), KT1 = KT0 + 2 * 32 * 256;
      for (int i = F.tid; i < S5TAB_FLOATS / 4; i += NTHR) { const int f = 4 * i; int d = f;
          if (f >= KT1) d = f + 64 * (KTS - 256); else if (f >= KT0) { const int o = f - KT0; d = KT0 + (o >> 8) * KTS + (o & 255); }
          *(LAS f32x4*)(dst + d) = ((const f32x4*)TAB)[i]; } }
    __syncthreads();
    bf16* MCT = (bf16*)(F.ws + WS_MCT) + (size_t)g * 512 * UCOLS;
    for (int pc = F.tid; pc < 64 * 64; pc += NTHR) { const int rw = part * 64 + (pc >> 6), q = pc & 63, tau = rw >> 4, h = rw & 15, s = q >> 1, h0 = (q & 1) * 8;
        float v[8];
        {   const int d0 = tau - s; const float m0 = (d0 >= 0) ? 1.f : 0.f, m1 = (d0 <= 0) ? 1.f : 0.f;
            const LAS f32x4* k0 = (const LAS f32x4*)(KT + (0 * 32 + (d0 >= 0 ? d0 : 0)) * KTS + h * 16 + h0); const LAS f32x4* k1 = (const LAS f32x4*)(KT + (1 * 32 + (d0 <= 0 ? -d0 : 0)) * KTS + h * 16 + h0);
            const f32x4 a0 = k0[0], a1 = k0[1], b0 = k1[0], b1 = k1[1];
#pragma unroll
            for (int j = 0; j < 4; ++j) { v[j] = m0 * a0[j] + m1 * b0[j]; v[4 + j] = m0 * a1[j] + m1 * b1[j]; } }
        u32x4 w; w.x = pk2(v[0], v[1]); w.y = pk2(v[2], v[3]); w.z = pk2(v[4], v[5]); w.w = pk2(v[6], v[7]);
        *(u32x4*)(MCT + (size_t)rw * UCOLS + s * 16 + h0) = w; }
    for (int pc = F.tid; pc < 64 * 32; pc += NTHR) { const int rw = part * 64 + (pc >> 5), q = pc & 31, tau = rw >> 4, h = rw & 15, dir = q >> 4, ri = (q >> 3) & 1, p0 = (q & 7) * 8;
        const int e = dir ? (32 - tau) : (tau + 1);
        float v[8];
#pragma unroll
        for (int j = 0; j < 8; ++j) { const int p = p0 + j; const f32x2 cc = CC[(dir * 16 + h) * 64 + p]; const float cr = cc.x, cj = cc.y; const f32x2 w = PW[(dir * 33 + e) * 64 + p];
            v[j] = ri ? -(cr * w.y + cj * w.x) : (cr * w.x - cj * w.y); }
        u32x4 w; w.x = pk2(v[0], v[1]); w.y = pk2(v[2], v[3]); w.z = pk2(v[4], v[5]); w.w = pk2(v[6], v[7]);
        *(u32x4*)(MCT + (size_t)rw * UCOLS + 512 + dir * 128 + ri * 64 + p0) = w; }
    bf16* WAT = (bf16*)(F.ws + WS_WAT) + (size_t)g * 256 * 512;
    for (int pc = F.tid; pc < 32 * 64; pc += NTHR) { const int rw = part * 32 + (pc >> 6), q = pc & 63, dir = rw >> 7, ri = (rw >> 6) & 1, p = rw & 63, s = q >> 1, h0 = (q & 1) * 8;
        const f32x2 w = PW[(dir * 33 + (dir ? s : (31 - s))) * 64 + p];
        float v[8];
#pragma unroll
        for (int j = 0; j < 8; ++j) { const f32x2 b = BB[(dir * 64 + p) * 16 + h0 + j]; v[j] = ri ? (w.x * b.y + w.y * b.x) : (w.x * b.x - w.y * b.y); }
        u32x4 o; o.x = pk2(v[0], v[1]); o.y = pk2(v[2], v[3]); o.z = pk2(v[4], v[5]); o.w = pk2(v[6], v[7]);
        *(u32x4*)(WAT + (size_t)rw * 512 + s * 16 + h0) = o; }
    __syncthreads();
}
__device__ __forceinline__ void p0_filter_l12(Frame& F, int i0, int npos) {
    LAS float* sc = (LAS float*)(F.lds + F.wave * 1024);
    const int j = F.lane;
    const float* hw1 = inptr(F, I_HW1); const float* hw2 = inptr(F, I_HW2); const float* hfq = inptr(F, I_HFREQ);
    float w1c[33], w2c[64];
#pragma unroll
    for (int f = 0; f < 33; ++f) w1c[f] = hw1[f * 64 + j];
#pragma unroll
    for (int k = 0; k < 64; ++k) w2c[k] = hw2[k * 64 + j];
    const float b1 = inptr(F, I_HB1)[j], b2 = inptr(F, I_HB2)[j], f0 = hfq[j], f1 = hfq[64 + j];
    for (int q = 0; q < npos; ++q) { const int i = i0 + q;
        if (j < 33) { const double L = (double)SEQ; double v;
            if (j == 0) v = (double)i / (L - 1.0);
            else { const int k = (j - 1) & 15; const double f = 1e-4 + (double)k * ((15.0 - 1e-4) / 15.0), om = 6.283185307179586 * (double)i / L; v = (j <= 16) ? cos(f * om) : -sin(f * om); }
            sc[j] = (float)v; }
        LDS_WAIT(); asm volatile("" ::: "memory");
        float a = b1;
#pragma unroll
        for (int f = 0; f < 33; ++f) a += sc[f] * w1c[f];
        sc[64 + j] = sinf(f0 * a);
        LDS_WAIT(); asm volatile("" ::: "memory");
        float b = b2;
#pragma unroll
        for (int k = 0; k < 64; ++k) b += sc[64 + k] * w2c[k];
        ((float*)(F.ws + WS_FH2))[(size_t)j * SEQ + i] = sinf(f1 * b);
        LDS_WAIT(); asm volatile("" ::: "memory"); }
}
__device__ __forceinline__ void phase0(Frame& F) {
    if (F.bid < 192) p0_adaln_item(F, F.bid);
    else if (F.bid < 224) p0_s5_tables(F, F.bid - 192);
    else p0_filter_l12(F, (F.bid - 224) * 128 + F.wave * 16, 16);
    __syncthreads();
    p0_transposes(F);
    if (F.bid < 192) p_down_items(F, DN_P4 + DN_P9 + DN_P3 + F.bid * 8 + F.wave, 3, 192 * 8);
}

__device__ __forceinline__ void norm_mod_row(const float* xrow, const float* gam, const float* shift, const float* scale, bf16* orow, int lane) {
    const f32x4* xr = (const f32x4*)xrow + lane;
    f32x4 v[4]; float s = 0.f;
#pragma unroll
    for (int j = 0; j < 4; ++j) { v[j] = xr[64 * j]; s += (v[j].x * v[j].x + v[j].y * v[j].y) + (v[j].z * v[j].z + v[j].w * v[j].w); }
    const float rstd = 1.0f / sqrtf(wave_sum(s) * (1.0f / DM) + NORM_EPS);
    unsigned long long* o8 = (unsigned long long*)orow + lane;
#pragma unroll
    for (int j = 0; j < 4; ++j) { const f32x4 g = ((const f32x4*)gam)[lane + 64 * j], sh = ((const f32x4*)shift)[lane + 64 * j], sc = ((const f32x4*)scale)[lane + 64 * j];
        const f32x4 y = (v[j] * rstd * g) * (sc + 1.0f) + sh;
        o8[64 * j] = (unsigned long long)pk2(y.x, y.y) | ((unsigned long long)pk2(y.z, y.w) << 32); }
}
__device__ __forceinline__ void p1_norm_rows(const float* xbase, bf16* obase, int nrows, const float* gam, const float* shift, const float* scale, int lane) {
    f32x4 GM[4], SH[4];
#pragma unroll
    for (int j = 0; j < 4; ++j) { const f32x4 g = ((const f32x4*)gam)[lane + 64 * j], sc = ((const f32x4*)scale)[lane + 64 * j]; GM[j] = g * (sc + 1.0f); SH[j] = ((const f32x4*)shift)[lane + 64 * j]; }
    for (int r = 0; r < nrows; r += 4) {
        f32x4 v[4][4];
#pragma unroll
        for (int q = 0; q < 4; ++q) if (r + q < nrows) { const f32x4* xr = (const f32x4*)(xbase + (size_t)(r + q) * DM) + lane;
#pragma unroll
            for (int j = 0; j < 4; ++j) v[q][j] = xr[64 * j]; }
#pragma unroll
        for (int q = 0; q < 4; ++q) if (r + q < nrows) { float s = 0.f;
#pragma unroll
            for (int j = 0; j < 4; ++j) s += (v[q][j].x * v[q][j].x + v[q][j].y * v[q][j].y) + (v[q][j].z * v[q][j].z + v[q][j].w * v[q][j].w);
            const float rstd = 1.0f / sqrtf(wave_sum(s) * (1.0f / DM) + NORM_EPS);
            unsigned long long* o8 = (unsigned long long*)(obase + (size_t)(r + q) * DM) + lane;
#pragma unroll
            for (int j = 0; j < 4; ++j) { const f32x4 y = (v[q][j] * rstd) * GM[j] + SH[j];
                o8[64 * j] = (unsigned long long)pk2(y.x, y.y) | ((unsigned long long)pk2(y.z, y.w) << 32); } }
    }
}
__device__ __forceinline__ void p1_norm(Frame& F) {
    const int gw = F.bid * NWAVES + F.wave, lane = F.lane;
    const float* mod = (const float*)(F.ws + WS_MOD);
    bf16* H1 = (bf16*)(F.ws + WS_H1);
    const float* gam = inptr(F, I_N1G);
    { const int mr = gw >> 8; const float* shift = mod + (size_t)mr * (NMOD * DM);
      p1_norm_rows(inptr(F, I_X) + (size_t)gw * 16 * DM, H1 + (size_t)gw * 16 * DM, 16, gam, shift, shift + DM, lane); }
    { const float* shift = mod + (size_t)8 * (NMOD * DM);
      p1_norm_rows(inptr(F, I_CTX) + (size_t)gw * DM, H1 + (size_t)(NTOK + gw) * DM, 1, gam, shift, shift + DM, lane); }
}
__device__ __forceinline__ void p1_filter(Frame& F) {
    LAS float* w3s = (LAS float*)F.lds;
    LAS float* b3s = w3s + 512;
    LAS float* red = b3s + 8;
    LAS float* nrm = red + 32;
    const int c0 = F.bid * 2;
    for (int i = F.tid; i < 512; i += NTHR) { const int k = i >> 3, q = i & 7, ch = q >> 2, o = (q >> 1) & 1, dir = q & 1; w3s[i] = inptr(F, I_HW3)[(size_t)k * 2048 + o * 1024 + dir * 512 + c0 + ch]; }
    if (F.tid < 8) { const int q = F.tid, ch = q >> 2, o = (q >> 1) & 1, dir = q & 1; b3s[q] = inptr(F, I_HB3)[o * 1024 + dir * 512 + c0 + ch]; }
    __syncthreads();
    const float* FH2 = (const float*)(F.ws + WS_FH2);
    const double la = -4.605170185988091 / 0.3, lb = -4.605170185988091 / 1.5;
    float delta[2];
#pragma unroll
    for (int ch = 0; ch < 2; ++ch) delta[ch] = (float)fabs(la + (double)(c0 + ch) * (lb - la) / 511.0);
    unsigned char* FILT = F.ws + WS_FILT;
    float asum[4] = {0.f, 0.f, 0.f, 0.f};
    float amx[4] = {0.f, 0.f, 0.f, 0.f};
    unsigned val[8][4];
#pragma unroll
    for (int j = 0; j < 8; ++j) { const int i = F.tid + 512 * j; const float* hr = FH2 + i;
        float a[8];
#pragma unroll
        for (int q = 0; q < 8; ++q) a[q] = b3s[q];
#pragma unroll 16
        for (int k = 0; k < 64; ++k) { const float hvk = hr[(size_t)k * SEQ]; const LAS f32x4* wp = (const LAS f32x4*)(w3s + k * 8); const f32x4 wa = wp[0], wb = wp[1];
            a[0] += hvk * wa.x; a[1] += hvk * wa.y; a[2] += hvk * wa.z; a[3] += hvk * wa.w; a[4] += hvk * wb.x; a[5] += hvk * wb.y; a[6] += hvk * wb.z; a[7] += hvk * wb.w; }
        const float t = (float)i * (1.0f / 4095.0f);
#pragma unroll
        for (int q = 0; q < 8; ++q) { const int ch = q >> 2, dir = q & 1; const float v = a[q] * expf(-t * delta[ch]); a[q] = v; if (dir == 0 || i != 0) { asum[q >> 1] += fabsf(v); amx[q >> 1] = fmaxf(amx[q >> 1], fabsf(v)); } }
#pragma unroll
        for (int q = 0; q < 4; ++q) val[j][q] = pk2(a[2 * q], a[2 * q + 1]);
        asm volatile("" ::: "memory"); }
#pragma unroll
    for (int q = 0; q < 4; ++q) { const float s2 = wave_sum(asum[q]); float m2 = amx[q];
#pragma unroll
        for (int o = 32; o >= 1; o >>= 1) m2 = fmaxf(m2, __shfl_xor(m2, o));
        if (F.lane == 0) { red[F.wave * 4 + q] = s2; red[32 + 8 + F.wave * 4 + q] = m2; } }
    __syncthreads();
    if (F.tid < 4) { float s2 = 0.f, m2 = 0.f; for (int w = 0; w < 8; ++w) { s2 += red[w * 4 + F.tid]; m2 = fmaxf(m2, red[32 + 8 + w * 4 + F.tid]); }
        const float inv = 1.0f / s2; const int p = (int)((__float_as_uint(m2 * inv) >> 23) & 255u) - 127, e = 7 - p;
        nrm[F.tid] = inv * __uint_as_float((unsigned)(127 + e) << 23);
        const int ch = F.tid >> 1, o = F.tid & 1; ((int*)(F.ws + WS_FSC))[o * HYW + c0 + ch] = 127 - e; }
    __syncthreads();
#pragma unroll
    for (int j = 0; j < 8; ++j) { const int i = F.tid + 512 * j;
#pragma unroll
        for (int q = 0; q < 8; ++q) { const int ch = q >> 2, o = (q >> 1) & 1, dir = q & 1; const float sc = nrm[ch * 2 + o]; unsigned char* G = FILT + ((size_t)o * HYW + c0 + ch) * F8GS;
            const float fv = ((q & 1) ? bfhi(val[j][q >> 1]) : bflo(val[j][q >> 1])) * sc; const unsigned char hv = (unsigned char)(__builtin_amdgcn_cvt_pk_fp8_f32(fv, fv, 0, false) & 0xff);
            if (dir == 0) G[FC0 - i] = hv; else if (i != 0) G[FC0 + i] = hv; } }
    for (int i = F.tid; i < 4 * (F8LEN - 8191); i += NTHR) { const int a = i / (F8LEN - 8191), x = i % (F8LEN - 8191); const int ch = a >> 1, o = a & 1; unsigned char* G = FILT + ((size_t)o * HYW + c0 + ch) * F8GS;
        const int xx = (x < FC0 - 4095) ? x : (x - (FC0 - 4095) + FC0 + 4096); G[xx] = 0; }
    __syncthreads();
}
__device__ __forceinline__ void phase1(Frame& F) { p1_s5_expand(F); p1_filter(F); p1_norm(F); }

#ifndef DBG_AMPX
#define DBG_AMPX 0
#endif
#define AMPB(k) unsigned long long amp_t0_ = 0; if (DBG_AMPX == (k)) amp_t0_ = __builtin_amdgcn_s_memrealtime();
#define AMPE(k) if (DBG_AMPX == (k)) { __syncthreads(); const unsigned long long t1_ = __builtin_amdgcn_s_memrealtime(); const unsigned long long d_ = t1_ - amp_t0_; while (__builtin_amdgcn_s_memrealtime() - t1_ < d_) __builtin_amdgcn_s_sleep(8); }
constexpr int HY_USTRIDE = 4368, HY_UOFF = 272, HY_G0 = 35328;
__device__ __forceinline__ i32x8 hy_ldA(const LAS unsigned char* p) { const LAS u32x2* q = (const LAS u32x2*)p; const u32x2 a = q[0], b = q[1], c = q[2], d = q[3]; return (i32x8){(int)a.x, (int)a.y, (int)b.x, (int)b.y, (int)c.x, (int)c.y, (int)d.x, (int)d.y}; }
__device__ __forceinline__ i32x8 hy_ldB(const LAS unsigned char* p) { const u32x4 a = *(const LAS u32x4*)p, b = *(const LAS u32x4*)(p + 16); return (i32x8){(int)a.x, (int)a.y, (int)a.z, (int)a.w, (int)b.x, (int)b.y, (int)b.z, (int)b.w}; }
constexpr int HT_IG2 = 2 * 16 * 16 * 88, HT_TOTAL = 2 * HT_IG2, HT_PER_WAVE = 48, HT_SCR = 35328 + 8 * 8480;
struct HyTr { const float* wg; const float* wu; bf16* wgut; LAS float* scr; int base; int lane; float tv[2][16]; };
__device__ __forceinline__ void hytr_issue(HyTr& T, int slot) {
#pragma unroll
    for (int j = 0; j < 2; ++j) { const int h = T.base + slot * 2 + j;
        if (h < HT_TOTAL) { const int up = h >= HT_IG2, r = up ? h - HT_IG2 : h, e = r / (32 * 88), q = r % (32 * 88), kb = q / 88, nb = q % 88;
            const float* wp = (up ? T.wu : T.wg) + (size_t)e * DM * FF + (size_t)(kb * 32 + (T.lane >> 5)) * FF + nb * 32 + (T.lane & 31);
#pragma unroll
            for (int i = 0; i < 16; ++i) T.tv[j][i] = wp[(size_t)(2 * i) * FF]; } }
}
__device__ __forceinline__ void hytr_finish(HyTr& T, int slot) {
#pragma unroll
    for (int j = 0; j < 2; ++j) { const int h = T.base + slot * 2 + j;
        if (h < HT_TOTAL) { const int up = h >= HT_IG2, r = up ? h - HT_IG2 : h, e = r / (32 * 88), q = r % (32 * 88), kb = q / 88, nb = q % 88, n0 = nb * 32;
            bf16* WT = (bf16*)((unsigned char*)T.wgut + (size_t)e * (2 * FF) * DM); const int drow0 = 256 * (n0 >> 7) + (n0 & 127) + (up ? 128 : 0);
#pragma unroll
            for (int i = 0; i < 16; ++i) T.scr[(2 * i + (T.lane >> 5)) * 33 + (T.lane & 31)] = T.tv[j][i];
            LDS_WAIT(); asm volatile("" ::: "memory");
            const int c = T.lane & 3;
#pragma unroll
            for (int p = 0; p < 2; ++p) { const int n = (T.lane >> 2) + 16 * p; const LAS float* sp = T.scr + (8 * c) * 33 + n;
                u32x2 o; o.x = pk4_fp8(sp[0 * 33] * WGU_SCALE, sp[1 * 33] * WGU_SCALE, sp[2 * 33] * WGU_SCALE, sp[3 * 33] * WGU_SCALE); o.y = pk4_fp8(sp[4 * 33] * WGU_SCALE, sp[5 * 33] * WGU_SCALE, sp[6 * 33] * WGU_SCALE, sp[7 * 33] * WGU_SCALE);
                *(u32x2*)((unsigned char*)WT + (size_t)(drow0 + n) * DM + kb * 32 + 8 * c) = o; }
            LDS_WAIT(); asm volatile("" ::: "memory"); } }
}
__device__ __forceinline__ void hy_conv(const LAS unsigned char* lds, int w, int lane, f32x16 (&acc)[4], HyTr& T, int slot0, int fsc_s) {
    const int r = lane & 31, hh = lane >> 5, n = lane & 31, b = n >> 2, i = n & 3;
    const LAS unsigned char* abase = lds + HY_G0 + (r & 7) * F8LEN + (FC0 - 8 * (r >> 3) + 32 * hh) - 512 * w;
    const LAS unsigned char* bbase = lds + HY_UOFF + b * HY_USTRIDE + 64 * i + 32 * hh;
    int sc1 = 127, fsc = fsc_s; asm volatile("" : "+v"(sc1), "+v"(fsc));
#pragma unroll
    for (int q = 0; q < 4; ++q)
#pragma unroll
        for (int j = 0; j < 16; ++j) acc[q][j] = 0.f;
#define HY_M1(ACC, AF, BF) asm volatile("v_mfma_scale_f32_32x32x64_f8f6f4 %0, %1, %2, %0, %3, %4 op_sel_hi:[0,0,0]" : "+v"(ACC) : "v"(AF), "v"(BF), "v"(fsc), "v"(sc1))
#define HY_MM(O0, O1, N0, N1, BB) do { HY_M1(acc[0], O0, BB); HY_M1(acc[1], O1, BB); HY_M1(acc[2], N0, BB); HY_M1(acc[3], N1, BB); } while (0)
#define HY_ST3() do { \
            Z0 = hy_ldA(pa - 512); Z1 = hy_ldA(pa - 544); Ub = hy_ldB(pb - 256); HY_MM(X0, X1, Y0, Y1, Ua); \
            X0 = hy_ldA(pa - 768); X1 = hy_ldA(pa - 800); Uc = hy_ldB(pb - 512); HY_MM(Y0, Y1, Z0, Z1, Ub); \
            Y0 = hy_ldA(pa - 1024); Y1 = hy_ldA(pa - 1056); Ua = hy_ldB(pb - 768); HY_MM(Z0, Z1, X0, X1, Uc); \
            pa -= 768; pb -= 768; } while (0)
#pragma unroll 1
    for (int rho = 0; rho < 4; ++rho) {
        const LAS unsigned char* pa = abase + 64 * (60 + rho);
        const LAS unsigned char* pb = bbase + 64 * (60 + rho);
        i32x8 X0, X1, Y0, Y1, Z0, Z1, Ua, Ub, Uc;
        if (rho < 3) hytr_issue(T, slot0 + 2 * rho);
        X0 = hy_ldA(pa); X1 = hy_ldA(pa - 32); Y0 = hy_ldA(pa - 256); Y1 = hy_ldA(pa - 288); Ua = hy_ldB(pb);
#pragma unroll 1
        for (int k = 0; k < 2; ++k) HY_ST3();
        if (rho < 3) { hytr_finish(T, slot0 + 2 * rho); hytr_issue(T, slot0 + 2 * rho + 1); }
#pragma unroll 1
        for (int k = 0; k < 3; ++k) HY_ST3();
        Z0 = hy_ldA(pa - 512); Z1 = hy_ldA(pa - 544); Ub = hy_ldB(pb - 256); HY_MM(X0, X1, Y0, Y1, Ua);
        HY_MM(Y0, Y1, Z0, Z1, Ub);
        if (rho < 3) hytr_finish(T, slot0 + 2 * rho + 1);
    }
    asm volatile("s_nop 15\n\ts_nop 15" ::: "memory");
#undef HY_ST3
#undef HY_MM
#undef HY_M1
}
__device__ __forceinline__ void hy_load_filter(Frame& F, const unsigned char* G) {
    LAS unsigned char* lds = F.lds;
#define AB(H, L, N) __builtin_amdgcn_alignbyte(H, L, N)
#pragma unroll
    for (int k = 0; k < 2; ++k) { const int i = F.tid + k * NTHR;
        if (i < F8LEN / 16) { const u32x4 v = *(const u32x4*)(G + 16 * i); u32x2 pv = (u32x2){0u, 0u}; if (i) pv = *(const u32x2*)(G + 16 * i - 8);
            LAS unsigned char* d = lds + HY_G0 + 16 * i;
            *(LAS u32x4*)(d) = v;
            *(LAS u32x4*)(d + 1 * F8LEN) = (u32x4){AB(v.x, pv.y, 3), AB(v.y, v.x, 3), AB(v.z, v.y, 3), AB(v.w, v.z, 3)};
            *(LAS u32x4*)(d + 2 * F8LEN) = (u32x4){AB(v.x, pv.y, 2), AB(v.y, v.x, 2), AB(v.z, v.y, 2), AB(v.w, v.z, 2)};
            *(LAS u32x4*)(d + 3 * F8LEN) = (u32x4){AB(v.x, pv.y, 1), AB(v.y, v.x, 1), AB(v.z, v.y, 1), AB(v.w, v.z, 1)};
            *(LAS u32x4*)(d + 4 * F8LEN) = (u32x4){pv.y, v.x, v.y, v.z};
            *(LAS u32x4*)(d + 5 * F8LEN) = (u32x4){AB(pv.y, pv.x, 3), AB(v.x, pv.y, 3), AB(v.y, v.x, 3), AB(v.z, v.y, 3)};
            *(LAS u32x4*)(d + 6 * F8LEN) = (u32x4){AB(pv.y, pv.x, 2), AB(v.x, pv.y, 2), AB(v.y, v.x, 2), AB(v.z, v.y, 2)};
            *(LAS u32x4*)(d + 7 * F8LEN) = (u32x4){AB(pv.y, pv.x, 1), AB(v.x, pv.y, 1), AB(v.y, v.x, 1), AB(v.z, v.y, 1)}; } }
#undef AB
}
__device__ __forceinline__ u32x4 hy_ld_piece(const bf16* p) { const unsigned* pp = (const unsigned*)(p - 2); u32x4 v; v.x = pp[0]; v.y = pp[1]; v.z = pp[2]; v.w = pp[3]; return v; }
__device__ __forceinline__ f32x4 hy_sconv4r(u32x4 z, bool lz, bool rz, float w0, float w1, float w2, float cb) {
    const float zl = lz ? 0.f : bfhi(z.x), zr = rz ? 0.f : bflo(z.w), e0 = bflo(z.y), e1 = bfhi(z.y), e2 = bflo(z.z), e3 = bfhi(z.z);
    return (f32x4){w0 * zl + w1 * e0 + w2 * e1 + cb, w0 * e0 + w1 * e1 + w2 * e2 + cb, w0 * e1 + w1 * e2 + w2 * e3 + cb, w0 * e2 + w1 * e3 + w2 * zr + cb};
}
__device__ __forceinline__ float hy_cl(float v) { return fminf(fmaxf(v, -448.f), 448.f); }
__device__ __forceinline__ void hyena_channel(Frame& F, int c, int citer) {
    LAS unsigned char* lds = F.lds;
    const int tid = F.tid, lane = F.lane, w = F.wave;
    HyTr T; T.wg = inptr(F, I_WG); T.wu = inptr(F, I_WU); T.wgut = (bf16*)(F.ws + WS_WGUT); T.scr = (LAS float*)(F.lds + HT_SCR + w * 4224); T.base = (F.bid * NWAVES + w) * HT_PER_WAVE; T.lane = lane;
    bf16* ZT = (bf16*)(F.ws + WS_ZT);
    const unsigned char* FILT = F.ws + WS_FILT; const int* FSC = (const int*)(F.ws + WS_FSC);
    bf16* VS = (bf16*)(F.ws + WS_VS) + (size_t)F.bid * (8 * SEQ);
    const float* cw = inptr(F, I_CONVW); const float* cbp = inptr(F, I_CONVB);
    const int fs0 = __builtin_amdgcn_readfirstlane(__hip_atomic_load(FSC + c, __ATOMIC_RELAXED, __HIP_MEMORY_SCOPE_AGENT)), fs1 = __builtin_amdgcn_readfirstlane(__hip_atomic_load(FSC + HYW + c, __ATOMIC_RELAXED, __HIP_MEMORY_SCOPE_AGENT));
    for (int i = tid; i < HY_G0 / 16; i += NTHR) *(LAS u32x4*)(lds + 16 * i) = (u32x4){0u, 0u, 0u, 0u};
    __syncthreads();
    {
        const float w0 = cw[c], w1 = cw[HYC + c], w2 = cw[2 * HYC + c], cb = cbp[c];
        u32x4 zz[8]; float zls[8], zrs[8];
#pragma unroll
        for (int b = 0; b < 8; ++b) { const bf16* zr = ZT + (size_t)c * NTOK + b * SEQ + 8 * tid; zz[b] = *(const u32x4*)zr; zls[b] = (tid & 7) ? bf2f(zr[-1]) : 0.f; zrs[b] = ((tid & 7) != 7) ? bf2f(zr[8]) : 0.f; }
#pragma unroll
        for (int b = 0; b < 8; ++b) { const u32x4 z = zz[b];
            const float zl = zls[b], zrt = zrs[b];
            float e[10]; e[0] = zl; e[1] = bflo(z.x); e[2] = bfhi(z.x); e[3] = bflo(z.y); e[4] = bfhi(z.y); e[5] = bflo(z.z); e[6] = bfhi(z.z); e[7] = bflo(z.w); e[8] = bfhi(z.w); e[9] = zrt;
            float o[8];
#pragma unroll
            for (int j = 0; j < 8; ++j) o[j] = w0 * e[j] + w1 * e[j + 1] + w2 * e[j + 2] + cb;
            u32x4 pk; pk.x = pk2(o[0], o[1]); pk.y = pk2(o[2], o[3]); pk.z = pk2(o[4], o[5]); pk.w = pk2(o[6], o[7]);
            *(u32x4*)(VS + b * SEQ + 8 * tid) = pk;
            u32x2 p8; p8.x = pk4_fp8(hy_cl(o[0]), hy_cl(o[1]), hy_cl(o[2]), hy_cl(o[3])); p8.y = pk4_fp8(hy_cl(o[4]), hy_cl(o[5]), hy_cl(o[6]), hy_cl(o[7]));
            *(LAS u32x2*)(lds + HY_UOFF + b * HY_USTRIDE + 8 * tid) = p8; }
    }
    hy_load_filter(F, FILT + ((size_t)0 * HYW + c) * F8GS);
    __syncthreads();
    f32x16 acc[4];
    { AMPB(1) hy_conv(lds, w, lane, acc, T, (citer * 2 + 0) * 6, fs0); AMPE(1) }
#ifdef DBG_CONV_SCALE
    for (int q = 0; q < 4; ++q) for (int j = 0; j < 16; ++j) acc[q][j] *= DBG_CONV_SCALE;
#endif
    __syncthreads();
    hy_load_filter(F, FILT + ((size_t)1 * HYW + c) * F8GS);
    const int n = lane & 31, hh = lane >> 5, b = n >> 2, ii = n & 3;
    {
        const float w0 = cw[HYW + c], w1 = cw[HYC + HYW + c], w2 = cw[2 * HYC + HYW + c], cb = cbp[HYW + c], bias = inptr(F, I_HBIAS)[c];
        const int tl = 512 * w + 64 * ii + 4 * hh;
        const bf16* zrow = ZT + (size_t)(HYW + c) * NTOK + b * SEQ + tl;
        bf16* vrow = VS + b * SEQ + tl;
#pragma unroll
        for (int hq = 0; hq < 2; ++hq) {
        u32x4 zp[8]; u32x2 vp[8];
#pragma unroll
        for (int g = 0; g < 8; ++g) { const int toff = 32 * (g >> 2) + 256 * hq + 8 * (g & 3); zp[g] = hy_ld_piece(zrow + toff); vp[g] = *(const u32x2*)(vrow + toff); }
#pragma unroll
        for (int q = 2 * hq; q < 2 * hq + 2; ++q) {
#pragma unroll
            for (int rg = 0; rg < 4; ++rg) { const int toff = 32 * (q & 1) + 256 * (q >> 1) + 8 * rg;
                const f32x4 x1 = hy_sconv4r(zp[(q & 1) * 4 + rg], (q & 1) == 0 && rg == 0 && hh == 0, (q & 1) == 1 && rg == 3 && hh == 1, w0, w1, w2, cb);
                const u32x2 uv = vp[(q & 1) * 4 + rg];
                const float y0 = x1[0] * (acc[q][4 * rg + 0] + bias * bflo(uv.x)), y1 = x1[1] * (acc[q][4 * rg + 1] + bias * bfhi(uv.x));
                const float y2 = x1[2] * (acc[q][4 * rg + 2] + bias * bflo(uv.y)), y3 = x1[3] * (acc[q][4 * rg + 3] + bias * bfhi(uv.y));
                u32x2 o; o.x = pk2(y0, y1); o.y = pk2(y2, y3); *(u32x2*)(vrow + toff) = o;
                *(LAS unsigned*)(lds + HY_UOFF + b * HY_USTRIDE + tl + toff) = pk4_fp8(hy_cl(y0), hy_cl(y1), hy_cl(y2), hy_cl(y3)); }
            asm volatile("" ::: "memory"); } }
    }
    __syncthreads();
    { AMPB(1) hy_conv(lds, w, lane, acc, T, (citer * 2 + 1) * 6, fs1); AMPE(1) }
#ifdef DBG_CONV_SCALE
    for (int q = 0; q < 4; ++q) for (int j = 0; j < 16; ++j) acc[q][j] *= DBG_CONV_SCALE;
#endif
    {
        const float w0 = cw[2 * HYW + c], w1 = cw[HYC + 2 * HYW + c], w2 = cw[2 * HYC + 2 * HYW + c], cb = cbp[2 * HYW + c], bias = inptr(F, I_HBIAS)[HYW + c];
        const int tl = 512 * w + 64 * ii + 4 * hh;
        const bf16* zrow = ZT + (size_t)(2 * HYW + c) * NTOK + b * SEQ + tl;
        const bf16* vrow = VS + b * SEQ + tl;
        bf16* orow = (bf16*)(F.ws + WS_YHT) + (size_t)c * NTOK + b * SEQ + tl;
#pragma unroll
        for (int hq = 0; hq < 2; ++hq) {
        u32x4 zp[8]; u32x2 vp[8];
#pragma unroll
        for (int g = 0; g < 8; ++g) { const int toff = 32 * (g >> 2) + 256 * hq + 8 * (g & 3); zp[g] = hy_ld_piece(zrow + toff); vp[g] = *(const u32x2*)(vrow + toff); }
#pragma unroll
        for (int q = 2 * hq; q < 2 * hq + 2; ++q) {
#pragma unroll
            for (int rg = 0; rg < 4; ++rg) { const int toff = 32 * (q & 1) + 256 * (q >> 1) + 8 * rg;
                const f32x4 x2 = hy_sconv4r(zp[(q & 1) * 4 + rg], (q & 1) == 0 && rg == 0 && hh == 0, (q & 1) == 1 && rg == 3 && hh == 1, w0, w1, w2, cb);
                const u32x2 uv = vp[(q & 1) * 4 + rg];
                const float y0 = x2[0] * (acc[q][4 * rg + 0] + bias * bflo(uv.x)), y1 = x2[1] * (acc[q][4 * rg + 1] + bias * bfhi(uv.x));
                const float y2 = x2[2] * (acc[q][4 * rg + 2] + bias * bflo(uv.y)), y3 = x2[3] * (acc[q][4 * rg + 3] + bias * bfhi(uv.y));
                u32x2 o; o.x = pk2(y0, y1); o.y = pk2(y2, y3); *(u32x2*)(orow + toff) = o; }
            asm volatile("" ::: "memory"); } }
    }
    __syncthreads();
}

__device__ __forceinline__ void phase_carry(Frame& F) {
    if (F.tid >= 128) { const int wv = F.bid * 6 + (F.wave - 2); p_down_items(F, wv, 3, 6 * 256); return; }
    const int g = F.bid >> 3, b = F.bid & 7, dir = F.tid >> 6, p = F.tid & 63;
    const float* EB = (const float*)(F.ws + WS_EB) + (size_t)g * UROWS * 256 + dir * 128 + p;
    bf16* UG = (bf16*)(F.ws + WS_UG) + (size_t)g * UROWS * UCOLS + 512 + dir * 128 + p;
    const float* LT = (const float*)(F.ws + WS_LT) + ((dir * NG + g) * NP + p) * 2;
    const float lr = LT[0], li = LT[1];
    float xr = 0.f, xi = 0.f;
    {   float er[8], ei[8];
#pragma unroll
        for (int k = 0; k < 8; ++k) { const int c = dir ? (7 - k) : k; const float* e = EB + (size_t)(1024 + b * 8 + c) * 256; er[k] = e[0]; ei[k] = e[64]; }
#pragma unroll
        for (int k = 0; k < 8; ++k) { const float nr = lr * xr - li * xi + er[k], ni = lr * xi + li * xr + ei[k]; xr = nr; xi = ni; }
    }
#pragma unroll 1
    for (int c8 = 0; c8 < 4; ++c8) { float er[32], ei[32];
#pragma unroll
        for (int k = 0; k < 32; ++k) { const int c = dir ? (127 - (c8 * 32 + k)) : (c8 * 32 + k); const float* e = EB + (size_t)(b * 128 + c) * 256; er[k] = e[0]; ei[k] = e[64]; }
#pragma unroll
        for (int k = 0; k < 32; ++k) { const int c = dir ? (127 - (c8 * 32 + k)) : (c8 * 32 + k); bf16* u = UG + (size_t)(b * 128 + c) * UCOLS; u[0] = (bf16)f2bf(xr); u[64] = (bf16)f2bf(xi);
            const float nr = lr * xr - li * xi + er[k], ni = lr * xi + li * xr + ei[k]; xr = nr; xi = ni; }
    }
}

__device__ __forceinline__ void phase_tr_hy(Frame& F) {
    LAS unsigned char* lds = F.lds;
    const bf16* ZT = (const bf16*)(F.ws + WS_YHT); bf16* YCAT = (bf16*)(F.ws + WS_YCAT);
    constexpr int S = 132;
    for (int pass = 0; pass < 2; ++pass) { const int tok0 = F.bid * 128 + pass * 64;
        for (int pc = F.tid; pc < 4096; pc += NTHR) { const int ch = pc >> 3, gq = pc & 7; const u32x4 v = *(const u32x4*)(ZT + (size_t)ch * NTOK + tok0 + 8 * gq);
            LAS unsigned* d = (LAS unsigned*)(lds + ch * S + 16 * gq); d[0] = v.x; d[1] = v.y; d[2] = v.z; d[3] = v.w; }
        __syncthreads();
        for (int it = 0; it < 8; ++it) { const int tok = it * 8 + (F.lane & 7), cg = F.wave * 8 + (F.lane >> 3);
            const LAS unsigned short* s = (const LAS unsigned short*)(lds + (8 * cg) * S + 2 * tok);
            unsigned e[8];
#pragma unroll
            for (int j = 0; j < 8; ++j) e[j] = s[j * (S / 2)];
            u32x4 o; o.x = e[0] | (e[1] << 16); o.y = e[2] | (e[3] << 16); o.z = e[4] | (e[5] << 16); o.w = e[6] | (e[7] << 16);
#ifdef DBG_HY_SCALE
            for (int j = 0; j < 8; ++j) e[j] = f2bf(bf2f(e[j]) * DBG_HY_SCALE);
            o.x = e[0] | (e[1] << 16); o.y = e[2] | (e[3] << 16); o.z = e[4] | (e[5] << 16); o.w = e[6] | (e[7] << 16);
#endif
            *(u32x4*)(YCAT + (size_t)(tok0 + tok) * DM + 8 * cg) = o; }
        __syncthreads();
    }
}

__device__ __forceinline__ void phase_norm2(Frame& F) {
    LAS unsigned char* lds = F.lds;
    LAS unsigned short* WH = (LAS unsigned short*)lds;
    LAS unsigned short* WL = WH + 16384;
    LAS float* GM = (LAS float*)(lds + 65536);
    LAS float* SH = GM + 1024;
    LAS float* red = SH + 1024;
    LAS float* cbs = red + 128;
    const int tid = F.tid, lane = F.lane, wave = F.wave;
    const int b = F.bid >> 5;
    const float* mb = (const float*)(F.ws + WS_MOD) + (size_t)b * (NMOD * DM);
    const float* rw = inptr(F, I_RW); const float* n2g = inptr(F, I_N2G);
    for (int i = tid; i < DM; i += NTHR) { GM[i] = n2g[i] * (mb[4 * DM + i] + 1.0f); SH[i] = mb[3 * DM + i]; }
    __syncthreads();
    float cpart = 0.f;
#pragma unroll 4
    for (int i = 0; i < 32; ++i) { const int idx = tid + 512 * i, k = idx >> 4, e = idx & 15; const float r = rw[idx]; const float w = GM[k] * r; cpart += SH[k] * r;
        const unsigned hi = f2bf(w); const float lo = w - bf2f(hi);
        const int s = k >> 5, kq = (k >> 3) & 3, j = k & 7, o = ((s * 4 + kq) * 16 + e) * 8 + j; WH[o] = (unsigned short)hi; WL[o] = (unsigned short)f2bf(lo); }
    cpart += __shfl_xor(cpart, 16); cpart += __shfl_xor(cpart, 32);
    if (lane < 16) red[wave * 16 + lane] = cpart;
    __syncthreads();
    if (tid < 16) { float c = 0.f; for (int w = 0; w < 8; ++w) c += red[w * 16 + tid]; cbs[tid] = c; }
    __syncthreads();
    const int rr = lane & 15, kq = lane >> 4;
    const int row = F.bid * 128 + wave * 16 + rr;
    const bf16* xrow = (const bf16*)(F.ws + WS_XMID) + (size_t)row * DM + 8 * kq;
    f32x4 acc = (f32x4){0.f, 0.f, 0.f, 0.f}; float ss = 0.f;
#pragma unroll 1
    for (int hb = 0; hb < 2; ++hb) { u32x4 xv[16];
#pragma unroll
        for (int s = 0; s < 16; ++s) xv[s] = *(const u32x4*)(xrow + 32 * (16 * hb + s));
#pragma unroll
        for (int s = 0; s < 16; ++s) { const u32x4 q = xv[s]; const int sg = 16 * hb + s;
            const float e0 = bflo(q.x), e1 = bfhi(q.x), e2 = bflo(q.y), e3 = bfhi(q.y), e4 = bflo(q.z), e5 = bfhi(q.z), e6 = bflo(q.w), e7 = bfhi(q.w);
            ss += ((e0 * e0 + e1 * e1) + (e2 * e2 + e3 * e3)) + ((e4 * e4 + e5 * e5) + (e6 * e6 + e7 * e7));
            const bf16x8 a = __builtin_bit_cast(bf16x8, q);
            const bf16x8 bh = *(const LAS bf16x8*)(WH + ((sg * 4 + kq) * 16 + rr) * 8), bl = *(const LAS bf16x8*)(WL + ((sg * 4 + kq) * 16 + rr) * 8);
            acc = __builtin_amdgcn_mfma_f32_16x16x32_bf16(a, bh, acc, 0, 0, 0); acc = __builtin_amdgcn_mfma_f32_16x16x32_bf16(a, bl, acc, 0, 0, 0);
            if ((s & 3) == 3) asm volatile("" ::: "memory"); } }
    ss += __shfl_xor(ss, 16); ss += __shfl_xor(ss, 32);
    const float rstd = 1.0f / sqrtf(ss * (1.0f / DM) + NORM_EPS);
    {
        const float cb = cbs[rr]; f32x4 p;
#pragma unroll
        for (int i = 0; i < 4; ++i) { const float rs = __shfl(rstd, 4 * kq + i); const float lg = acc[i] * rs + cb; float mx = lg;
#pragma unroll
            for (int o = 1; o < 16; o <<= 1) mx = fmaxf(mx, __shfl_xor(mx, o));
            const float ex = expf(lg - mx); float den = ex;
#pragma unroll
            for (int o = 1; o < 16; o <<= 1) den += __shfl_xor(den, o);
            p[i] = ex / den; }
        float* AFF = (float*)(F.ws + WS_AFF);
        *(f32x4*)(AFF + ((size_t)b * NE + rr) * SEQ + (F.bid & 31) * 128 + wave * 16 + 4 * kq) = p; }
    unsigned char* h2row = F.ws + WS_H2 + (size_t)row * DM + 8 * kq;
#pragma unroll 1
    for (int hb = 0; hb < 2; ++hb) { u32x4 xv[16];
#pragma unroll
        for (int s = 0; s < 16; ++s) xv[s] = *(const u32x4*)(xrow + 32 * (16 * hb + s));
#pragma unroll
        for (int s = 0; s < 16; ++s) { const u32x4 q = xv[s]; const int sg = 16 * hb + s; const LAS f32x4* gp = (const LAS f32x4*)(GM + 32 * sg + 8 * kq); const LAS f32x4* sp = (const LAS f32x4*)(SH + 32 * sg + 8 * kq);
            const f32x4 g0 = gp[0], g1 = gp[1], s0 = sp[0], s1 = sp[1];
            u32x2 o; o.x = pk4_fp8(bflo(q.x) * rstd * g0.x + s0.x, bfhi(q.x) * rstd * g0.y + s0.y, bflo(q.y) * rstd * g0.z + s0.z, bfhi(q.y) * rstd * g0.w + s0.w);
            o.y = pk4_fp8(bflo(q.z) * rstd * g1.x + s1.x, bfhi(q.z) * rstd * g1.y + s1.y, bflo(q.w) * rstd * g1.z + s1.z, bfhi(q.w) * rstd * g1.w + s1.w);
            *(u32x2*)(h2row + 32 * sg) = o; if ((s & 3) == 3) asm volatile("" ::: "memory"); } }
    __syncthreads();
}

__device__ __forceinline__ int block_sum_i(LAS int* red, int v, int wave, int lane, int slot) {
#pragma unroll
    for (int o = 1; o < 64; o <<= 1) v += __shfl_xor(v, o);
    if (lane == 0) red[slot * 8 + wave] = v;
    __syncthreads();
    int s = 0;
#pragma unroll
    for (int w = 0; w < 8; ++w) s += red[slot * 8 + w];
    return s;
}
__device__ __forceinline__ void phase_topk(Frame& F) {
    if (F.bid >= NB * NE) { const int wv = (F.bid - 128) * 8 + F.wave; p_down_items(F, DN_P4 + wv, 10, 8 * 128); return; }
    const int b = F.bid >> 4, e = F.bid & 15, tid = F.tid, lane = F.lane, wave = F.wave;
    LAS int* red = (LAS int*)F.lds;
    LAS int* wtot = red + 16;
    const float* aff = (const float*)(F.ws + WS_AFF) + ((size_t)b * NE + e) * SEQ + 8 * tid;
    unsigned key[8];
#ifndef DBG_PLAIN_AFF
#pragma unroll
    for (int j = 0; j < 8; ++j) key[j] = __hip_atomic_load((const unsigned*)aff + j, __ATOMIC_RELAXED, __HIP_MEMORY_SCOPE_AGENT);
#else
    { const f32x4 a0 = *(const f32x4*)aff, a1 = *(const f32x4*)(aff + 4);
    key[0] = __builtin_bit_cast(unsigned, a0.x); key[1] = __builtin_bit_cast(unsigned, a0.y); key[2] = __builtin_bit_cast(unsigned, a0.z); key[3] = __builtin_bit_cast(unsigned, a0.w);
    key[4] = __builtin_bit_cast(unsigned, a1.x); key[5] = __builtin_bit_cast(unsigned, a1.y); key[6] = __builtin_bit_cast(unsigned, a1.z); key[7] = __builtin_bit_cast(unsigned, a1.w); }
#endif
    unsigned prefix = 0u; int it = 0;
    LAS int* red3 = (LAS int*)F.lds + 64;
    { const unsigned cand = 1u << 30; int c = 0;
#pragma unroll
      for (int j = 0; j < 8; ++j) c += __builtin_popcountll(__ballot(key[j] >= cand));
      if (lane == 0) red[wave] = c;
      __syncthreads();
      int tot = 0;
#pragma unroll
      for (int w2 = 0; w2 < 8; ++w2) tot += red[w2];
      if (tot >= CAP) prefix = cand; }
    for (int bit = 28; bit >= 0; bit -= 2, ++it) { const unsigned c1 = prefix | (1u << bit), c2 = prefix | (2u << bit), c3 = prefix | (3u << bit); int n1 = 0, n2 = 0, n3 = 0;
#pragma unroll
        for (int j = 0; j < 8; ++j) { n1 += __builtin_popcountll(__ballot(key[j] >= c1)); n2 += __builtin_popcountll(__ballot(key[j] >= c2)); n3 += __builtin_popcountll(__ballot(key[j] >= c3)); }
        LAS int* rr = red3 + (it & 1) * 24;
        if (lane == 0) { rr[wave] = n1; rr[8 + wave] = n2; rr[16 + wave] = n3; }
        __syncthreads();
        int t1 = 0, t2 = 0, t3 = 0;
#pragma unroll
        for (int w2 = 0; w2 < 8; ++w2) { t1 += rr[w2]; t2 += rr[8 + w2]; t3 += rr[16 + w2]; }
        prefix = (t3 >= CAP) ? c3 : (t2 >= CAP) ? c2 : (t1 >= CAP) ? c1 : prefix; }
    const unsigned thr = prefix;
    int cgt = 0, ceq = 0;
#pragma unroll
    for (int j = 0; j < 8; ++j) { cgt += (key[j] > thr) ? 1 : 0; ceq += (key[j] == thr) ? 1 : 0; }
    int sg = cgt, se = ceq;
#pragma unroll
    for (int o = 1; o < 64; o <<= 1) { const int tg = __shfl_up(sg, o), te = __shfl_up(se, o); if (lane >= o) { sg += tg; se += te; } }
    __syncthreads();
    if (lane == 63) { wtot[wave] = sg; wtot[8 + wave] = se; }
    __syncthreads();
    int bg = 0, be = 0, totg = 0;
#pragma unroll
    for (int w2 = 0; w2 < 8; ++w2) { const int g2 = wtot[w2], e2 = wtot[8 + w2]; if (w2 < wave) { bg += g2; be += e2; } totg += g2; }
    int rg = bg + sg - cgt, re = be + se - ceq;
    const int need_eq = CAP - totg;
    int* IDX = (int*)(F.ws + WS_IDX); float* GATE = (float*)(F.ws + WS_GATE); int* INV = (int*)(F.ws + WS_INV);
    const size_t rowbase = ((size_t)e * NB + b) * CAP;
    int sl[8];
#pragma unroll
    for (int j = 0; j < 8; ++j) { const int t = 8 * tid + j; int slot = -1;
        if (key[j] > thr) { slot = rg; ++rg; } else if (key[j] == thr) { if (re < need_eq) slot = totg + re; ++re; }
        if (slot >= 0) { IDX[rowbase + slot] = b * SEQ + t; GATE[rowbase + slot] = __builtin_bit_cast(float, key[j]); }
        sl[j] = slot; }
    u32x4* ip = (u32x4*)(INV + ((size_t)b * NE + e) * SEQ + 8 * tid);
    ip[0] = (u32x4){(unsigned)sl[0], (unsigned)sl[1], (unsigned)sl[2], (unsigned)sl[3]}; ip[1] = (u32x4){(unsigned)sl[4], (unsigned)sl[5], (unsigned)sl[6], (unsigned)sl[7]};
}

__device__ __forceinline__ void final_issue(const bf16* Y, int b, unsigned& mask, int myinv, int lo, int lane, unsigned long long (&w)[4][4], float (&fl)[4]) {
#pragma unroll
    for (int q = 0; q < 4; ++q) { int e = 0, s = 0; fl[q] = 0.f;
        if (mask) { e = __builtin_ctz(mask); mask &= mask - 1; s = __shfl(myinv, lo + e); fl[q] = 1.f; }
        const unsigned long long* yr = (const unsigned long long*)(Y + (((size_t)e * NB + b) * CAP + s) * DM) + lane;
#pragma unroll
        for (int j = 0; j < 4; ++j) w[q][j] = yr[64 * j]; }
}
__device__ __forceinline__ void final_add(const unsigned long long (&w)[4][4], const float (&fl)[4], f32x4 (&mo)[4]) {
#pragma unroll
    for (int q = 0; q < 4; ++q)
#pragma unroll
        for (int j = 0; j < 4; ++j) { const unsigned lo = (unsigned)w[q][j], hi = (unsigned)(w[q][j] >> 32); mo[j].x += fl[q] * bflo(lo); mo[j].y += fl[q] * bfhi(lo); mo[j].z += fl[q] * bflo(hi); mo[j].w += fl[q] * bfhi(hi); }
}
__device__ __forceinline__ void final_pair(Frame& F, const bf16* Y, int b, int ra, int inva, int invb, int lo, const f32x4 (&G2)[4], const f32x4 (&FG)[4]) {
    const int lane = F.lane; const int rb = ra + 1;
    const bf16* xm16 = (const bf16*)(F.ws + WS_XMID);
    unsigned k0 = (unsigned)((__ballot(inva >= 0) >> lo) & 0xffffull), k1 = (unsigned)((__ballot(invb >= 0) >> lo) & 0xffffull);
    unsigned long long w0[4][4], w1[4][4]; float f0[4], f1[4];
    final_issue(Y, b, k0, inva, lo, lane, w0, f0);
    final_issue(Y, b, k1, invb, lo, lane, w1, f1);
    f32x4 v0[4], v1[4], m0[4], m1[4];
#pragma unroll
    for (int j = 0; j < 4; ++j) { const u32x2 q0 = ((const u32x2*)(xm16 + (size_t)ra * DM) + lane)[64 * j], q1 = ((const u32x2*)(xm16 + (size_t)rb * DM) + lane)[64 * j];
        v0[j] = (f32x4){bflo(q0.x), bfhi(q0.x), bflo(q0.y), bfhi(q0.y)}; v1[j] = (f32x4){bflo(q1.x), bfhi(q1.x), bflo(q1.y), bfhi(q1.y)}; m0[j] = (f32x4){0.f, 0.f, 0.f, 0.f}; m1[j] = (f32x4){0.f, 0.f, 0.f, 0.f}; }
    final_add(w0, f0, m0); final_add(w1, f1, m1);
    while (k0 | k1) { final_issue(Y, b, k0, inva, lo, lane, w0, f0); final_issue(Y, b, k1, invb, lo, lane, w1, f1); final_add(w0, f0, m0); final_add(w1, f1, m1); }
    float s0 = 0.f, s1 = 0.f;
#pragma unroll
    for (int j = 0; j < 4; ++j) { v0[j] = v0[j] + G2[j] * m0[j] * DBG_MOE_ALPHA; v1[j] = v1[j] + G2[j] * m1[j] * DBG_MOE_ALPHA;
        s0 += (v0[j].x * v0[j].x + v0[j].y * v0[j].y) + (v0[j].z * v0[j].z + v0[j].w * v0[j].w); s1 += (v1[j].x * v1[j].x + v1[j].y * v1[j].y) + (v1[j].z * v1[j].z + v1[j].w * v1[j].w); }
    const float rs0 = 1.0f / sqrtf(wave_sum(s0) * (1.0f / DM) + NORM_EPS), rs1 = 1.0f / sqrtf(wave_sum(s1) * (1.0f / DM) + NORM_EPS);
    f32x4* xr0 = (f32x4*)(F.out + (size_t)ra * DM) + lane; f32x4* xr1 = (f32x4*)(F.out + (size_t)rb * DM) + lane;
#pragma unroll
    for (int j = 0; j < 4; ++j) { xr0[64 * j] = v0[j] * rs0 * FG[j]; xr1[64 * j] = v1[j] * rs1 * FG[j]; }
}
__device__ __forceinline__ void phase_final(Frame& F) {
    const int gw = F.bid * NWAVES + F.wave, lane = F.lane;
    const int b = gw >> 8, t0 = (gw & 255) * 16, row0 = gw * 16;
    const float* mod = (const float*)(F.ws + WS_MOD);
    const bf16* Y = (const bf16*)(F.ws + WS_Y); const int* INV = (const int*)(F.ws + WS_INV);
    const float* fing = inptr(F, I_FING); const float* g2 = mod + (size_t)b * (NMOD * DM) + 5 * DM;
    int val[4];
#pragma unroll
    for (int c = 0; c < 4; ++c) val[c] = (int)__hip_atomic_load((const unsigned*)INV + ((size_t)b * NE + (lane & 15)) * SEQ + t0 + 4 * (lane >> 4) + c, __ATOMIC_RELAXED, __HIP_MEMORY_SCOPE_AGENT);
    f32x4 G2[4], FG[4];
#pragma unroll
    for (int j = 0; j < 4; ++j) { G2[j] = ((const f32x4*)g2)[lane + 64 * j]; FG[j] = ((const f32x4*)fing)[lane + 64 * j]; }
#pragma unroll 1
    for (int q = 0; q < 4; ++q) {
        final_pair(F, Y, b, row0 + 4 * q, val[0], val[1], 16 * q, G2, FG);
        final_pair(F, Y, b, row0 + 4 * q + 2, val[2], val[3], 16 * q, G2, FG);
    }
}

#ifdef DBG_CHECK_MOE
__device__ __forceinline__ void phase_dbg_moe(Frame& F) {
    LAS float* hs = (LAS float*)F.lds;
    LAS float* Hs = hs + 1024;
    LAS float* red = Hs + 2816;
    const int row = (F.bid * 257) & 65535, e = row >> 12, b = (row >> 9) & 7;
    const int tok = ((const int*)(F.ws + WS_IDX))[row]; const float gate = ((const float*)(F.ws + WS_GATE))[row];
    const bf16* H2 = (const bf16*)(F.ws + WS_H2) + (size_t)tok * DM;
    for (int i = F.tid; i < DM; i += NTHR) hs[i] = bf2f(H2[i]);
    __syncthreads();
    const float* Wg = inptr(F, I_WG) + (size_t)e * DM * FF; const float* Wu = inptr(F, I_WU) + (size_t)e * DM * FF; const float* Wd = inptr(F, I_WD) + (size_t)e * FF * DM;
    float e1n = 0.f, e1d = 0.f;
    for (int f = F.tid; f < FF; f += NTHR) { float g = 0.f, u = 0.f;
        for (int k = 0; k < DM; ++k) { g += hs[k] * Wg[(size_t)k * FF + f]; u += hs[k] * Wu[(size_t)k * FF + f]; }
        const float h = siluf_(g) * u; Hs[f] = h;
        const float hb = bf2f(((const bf16*)(F.ws + WS_HB))[(size_t)row * FF + f]); e1n += (hb - h) * (hb - h); e1d += h * h; }
    __syncthreads();
    float e2n = 0.f, e2d = 0.f;
    for (int n = F.tid; n < DM; n += NTHR) { float y = 0.f;
        for (int f = 0; f < FF; ++f) y += Hs[f] * Wd[(size_t)f * DM + n];
        y *= gate; const float yb = bf2f(((const bf16*)(F.ws + WS_Y))[(size_t)row * DM + n]); e2n += (yb - y) * (yb - y); e2d += y * y; }
    const float* aff = (const float*)(F.ws + WS_AFF) + ((size_t)b * NE + e) * SEQ; int cnt = 0;
    for (int t = F.tid; t < SEQ; t += NTHR) cnt += (aff[t] > gate) ? 1 : 0;
    float vals[5] = {e1n, e1d, e2n, e2d, (float)cnt};
#pragma unroll
    for (int q = 0; q < 5; ++q) { const float s2 = wave_sum(vals[q]); if (F.lane == 0) red[F.wave * 5 + q] = s2; }
    __syncthreads();
    if (F.tid == 0) { float t5[5] = {0, 0, 0, 0, 0}; for (int w = 0; w < 8; ++w) for (int q = 0; q < 5; ++q) t5[q] += red[w * 5 + q];
        float* D = (float*)(F.ws + WS_CTL + 65536) + F.bid * 4;
        D[0] = t5[0] / (t5[1] + 1e-30f); D[1] = t5[2] / (t5[3] + 1e-30f); D[2] = (t5[4] >= (float)CAP) ? 1.f : 0.f;
        int dup = 0; const int* IDXs = (const int*)(F.ws + WS_IDX) + ((size_t)e * NB + b) * CAP; for (int q = 0; q < CAP; ++q) dup += (IDXs[q] == tok) ? 1 : 0;
        const int inv = ((const int*)(F.ws + WS_INV))[((size_t)(tok >> 12) * NE + e) * SEQ + (tok & 4095)];
        const int c3 = DBG_C3;
        D[3] = (c3 == 0) ? ((fabsf(aff[tok - b * SEQ] - gate) > 1e-6f) ? 1.f : 0.f) : (c3 == 1) ? (((tok >> 12) != b) ? 1.f : 0.f) : (c3 == 2) ? ((dup != 1) ? 1.f : 0.f) : ((inv != (row & 511)) ? 1.f : 0.f); }
    __syncthreads();
}
__device__ __forceinline__ void phase_dbg_apply(Frame& F) {
    const float* D = (const float*)(F.ws + WS_CTL + 65536);
    int bad[4] = {0, 0, 0, 0};
    for (int k = 0; k < 256; ++k) { if (D[k * 4 + 0] > 1e-3f) ++bad[0]; if (D[k * 4 + 1] > 1e-3f) ++bad[1]; if (D[k * 4 + 2] > 0.5f) ++bad[2]; if (D[k * 4 + 3] > 0.5f) ++bad[3]; }
    int code = 0;
    for (int q = 0; q < 4; ++q) if (((DBG_CHECK_MOE >> q) & 1) && bad[q] > DBG_BAD_THR) code += 1;
    const float sc = 1.0f + 0.5f * (float)code;
    const int gw = F.bid * NWAVES + F.wave, NGW = F.G * NWAVES;
    for (int r = gw; r < NTOK; r += NGW) { f32x4* xr = (f32x4*)(F.out + (size_t)r * DM) + F.lane;
#pragma unroll
        for (int j = 0; j < 4; ++j) xr[64 * j] = xr[64 * j] * sc; }
}
#endif

#ifdef DBG_CHECK_MOE
constexpr int NPHASE = 15;
#else
constexpr int NPHASE = 13;
#endif
__global__ void __launch_bounds__(NTHR, 2) fwd_kernel(Args args) {
    extern __shared__ __attribute__((aligned(16))) unsigned char lds_raw[];
    Frame F;
    F.lds = (LAS unsigned char*)lds_raw;
    F.tid = threadIdx.x; F.lane = F.tid & 63; F.wave = __builtin_amdgcn_readfirstlane(F.tid >> 6);
    F.G = gridDim.x; F.bid = blockIdx.x;
    F.out = args.out; F.ws = args.ws;
    for (int u = F.tid; u < (LDS_BYTES - LDSCTL_OFF) / 4; u += NTHR) ((LAS unsigned*)(F.lds + LDSCTL_OFF))[u] = 0u;
    __syncthreads();
    if (F.tid < 35) { const float* const* tab = args.in; *(LAS unsigned long long*)(F.lds + LDSCTL_OFF + 8 * F.tid) = (unsigned long long)tab[F.tid]; }
    __syncthreads();
    const int lo = args.ph_lo, hi = args.ph_hi;
    const bool single = (hi - lo) > 1;
    XcdBarrier bar; bar.bar = (unsigned*)(args.ws + WS_CTL) + CW_BAR; bar.x = 0; bar.st = nullptr;
    if (single) bar = xcd_barrier_post((unsigned*)(args.ws + WS_CTL) + CW_BAR, (volatile LAS unsigned*)(F.lds + MISC_OFF) + 8);
#ifndef PHASE_MASK
#define PHASE_MASK 0x7fff
#endif
#define IN(k) ((((PHASE_MASK) >> (k)) & 1) && lo <= (k) && (k) < hi)
#ifndef DBG_REPEAT_MASK
#define DBG_REPEAT_MASK 0
#endif
#define SEAM(k) do { if (IN(k) && IN((k) + 1)) xcd_barrier(bar); } while (0)
#define REP(k) for (int rep_ = 0; rep_ < ((((DBG_REPEAT_MASK) >> (k)) & 1) ? 2 : 1); ++rep_)
    LAS unsigned char* ring = F.lds;
    const unsigned char* ws = args.ws;

    REP(0) { if (rep_) xcd_barrier(bar); asm volatile("" : "+v"(F.tid), "+v"(F.lane)); if (IN(0)) { AMPB(10) phase0(F); AMPE(10) } } SEAM(0);
    REP(1) { if (rep_) xcd_barrier(bar); asm volatile("" : "+v"(F.tid), "+v"(F.lane)); if (IN(1)) { AMPB(11) phase1(F); AMPE(11) } } SEAM(1);
    REP(2) { if (rep_) xcd_barrier(bar); asm volatile("" : "+v"(F.tid), "+v"(F.lane)); if (IN(2)) {
        { SchedPlain S; S.T.init(128, 6, F.G, F.bid); S.A = (const char*)(ws + WS_H1); S.B = (const char*)(ws + WS_WINT); S.lda = 2048; S.ldb = 2048; S.kstepA = 128; S.kstepB = 128; S.nt = 16; S.mt = 1 << 20; S.az = 0; S.bz = 0;
          EpiZT E{(bf16*)(ws + WS_ZT)}; gm::gemm_phase<EpiZT, SchedPlain, false>(ring, S, E); }
        __syncthreads();
        { SchedPlain S; S.T.init(136, 2, F.G, F.bid); S.A = (const char*)(ws + WS_H1); S.B = (const char*)(ws + WS_WINT) + (size_t)HYC * 2048; S.lda = 2048; S.ldb = 2048; S.kstepA = 128; S.kstepB = 128; S.nt = 16; S.mt = 1 << 20; S.az = 0; S.bz = 0;
          EpiUG E{(bf16*)(ws + WS_UG)}; gm::gemm_phase<EpiUG, SchedPlain, true>(ring, S, E); }
    } } SEAM(2);
    REP(3) { if (rep_) xcd_barrier(bar); asm volatile("" : "+v"(F.tid), "+v"(F.lane)); if (IN(3)) {
        SchedPlain S; S.T.init(160, 1, F.G, F.bid); S.A = (const char*)(ws + WS_UG); S.B = (const char*)(ws + WS_WAT); S.lda = UCOLS * 2; S.ldb = 1024; S.kstepA = 128; S.kstepB = 128; S.nt = 8; S.mt = 5;
        S.az = (size_t)UROWS * UCOLS * 2; S.bz = (size_t)256 * 1024;
        EpiEB E{(float*)(ws + WS_EB)}; gm::gemm_phase<EpiEB, SchedPlain, true>(ring, S, E);
        if (F.bid >= 160) { const int wv = (F.bid - 160) * 8 + F.wave; p_down_items(F, DN_P4 + DN_P9 + wv, 4, 8 * 96); }
    } } SEAM(3);
    REP(4) { if (rep_) xcd_barrier(bar); asm volatile("" : "+v"(F.tid), "+v"(F.lane)); if (IN(4)) { phase_carry(F); } } SEAM(4);
    REP(5) { if (rep_) xcd_barrier(bar); asm volatile("" : "+v"(F.tid), "+v"(F.lane)); if (IN(5)) {
        { SchedPlain S; S.T.init(128, 2, F.G, F.bid); S.A = (const char*)(ws + WS_UG); S.B = (const char*)(ws + WS_MCT); S.lda = UCOLS * 2; S.ldb = UCOLS * 2; S.kstepA = 128; S.kstepB = 128; S.nt = 12; S.mt = 4;
          S.az = (size_t)UROWS * UCOLS * 2; S.bz = (size_t)512 * UCOLS * 2;
          EpiYS E{(bf16*)(ws + WS_YSG), (const bf16*)(ws + WS_UG), inptr(F, I_S5D)};
#ifndef NO_YS
          gm::gemm_phase<EpiYS, SchedPlain, true>(ring, S, E);
#endif
        }
        __syncthreads();
#ifndef NO_HY
        { AMPB(2) int citer = 0; for (int c = F.bid; c < HYW; c += F.G, ++citer) hyena_channel(F, c, citer); AMPE(2) }
#endif
    } } SEAM(5);
    REP(6) { if (rep_) xcd_barrier(bar); asm volatile("" : "+v"(F.tid), "+v"(F.lane)); if (IN(6)) {
        { SchedGlu S; S.T.init(128, 2, F.G, F.bid); S.A = (const char*)(ws + WS_YSG); S.B = (const char*)(ws + WS_GLUT); S.ldb = 1024; S.kstepA = 4u * 1024u * 512u * 2u; S.kstepB = 128; S.nt = 8;
          EpiGlu E{(bf16*)(ws + WS_YCAT), (const bf16*)(ws + WS_YSG), inptr(F, I_GLUB)}; gm::gemm_phase<EpiGlu, SchedGlu, true>(ring, S, E); }
        __syncthreads();
        phase_tr_hy(F);
    } } SEAM(6);
    REP(7) { if (rep_) xcd_barrier(bar); asm volatile("" : "+v"(F.tid), "+v"(F.lane)); if (IN(7)) {
        SchedPlain S; S.T.init(128, 4, F.G, F.bid); S.A = (const char*)(ws + WS_YCAT); S.B = (const char*)(ws + WS_WOUTT); S.lda = 2048; S.ldb = 2048; S.kstepA = 128; S.kstepB = 128; S.nt = 16; S.mt = 1 << 20; S.az = 0; S.bz = 0;
        EpiXmid E{inptr(F, I_X), (bf16*)(ws + WS_XMID), (const float*)(ws + WS_MOD)}; gm::gemm_phase<EpiXmid, SchedPlain, true>(ring, S, E);
    } } SEAM(7);
    REP(8) { if (rep_) xcd_barrier(bar); asm volatile("" : "+v"(F.tid), "+v"(F.lane)); if (IN(8)) { AMPB(18) phase_norm2(F); AMPE(18) } } SEAM(8);
    REP(9) { if (rep_) xcd_barrier(bar); asm volatile("" : "+v"(F.tid), "+v"(F.lane)); if (IN(9)) { AMPB(19) phase_topk(F); AMPE(19) } } SEAM(9);
    REP(10) { if (rep_) xcd_barrier(bar); asm volatile("" : "+v"(F.tid), "+v"(F.lane)); if (IN(10)) {
        SchedMoe1 S; S.T.init(256, 22, F.G, F.bid); S.A = (const char*)(ws + WS_H2); S.B = (const char*)(ws + WS_WGUT); S.idx = (const int*)(ws + WS_IDX); S.lda = 1024; S.ldb = 1024; S.kstepA = 128; S.kstepB = 128; S.nt = 8;
        EpiMoe1 E{(unsigned char*)(ws + WS_HB)}; gm::gemm_phase_f8<EpiMoe1, SchedMoe1, WGU_E8M0>(ring, S, E);
#if DBG_GM_MODE
        __syncthreads(); gm::gemm_phase_f8<EpiMoe1, SchedMoe1, WGU_E8M0, DBG_GM_MODE>(ring, S, E);
#endif
    } } SEAM(10);
    REP(11) { if (rep_) xcd_barrier(bar); asm volatile("" : "+v"(F.tid), "+v"(F.lane)); if (IN(11)) {
        SchedPlain S; S.T.init(256, 4, F.G, F.bid); S.A = (const char*)(ws + WS_HB); S.B = (const char*)(ws + WS_WDT); S.lda = FF; S.ldb = FF; S.kstepA = 128; S.kstepB = 128; S.nt = 22; S.mt = 16;
        S.az = (size_t)EROWS * FF; S.bz = (size_t)DM * FF;
        EpiMoe2 E{(bf16*)(ws + WS_Y), (const float*)(ws + WS_GATE)}; gm::gemm_phase_f8<EpiMoe2, SchedPlain, WD_E8M0>(ring, S, E);
    } } SEAM(11);
    if (IN(12)) { AMPB(22) phase_final(F); AMPE(22) }
#ifdef DBG_CHECK_MOE
    if (IN(13)) { phase_dbg_moe(F); }
    if (IN(14)) { phase_dbg_apply(F); }
#endif
#undef IN
#undef SEAM
}

#ifndef N_LAUNCHES
#define N_LAUNCHES 1
#endif
extern "C" void kernel_launch(void* const* d_in, const int* in_sizes, int n_in, void* d_out, int out_size, void* d_ws, size_t ws_size, hipStream_t stream) {
    static int grid = 0;
    if (grid == 0) {
        if (n_in != 35 || out_size != NTOK * DM || ws_size < WS_END) { fprintf(stderr, "kernel_launch: unexpected shapes (n_in %d out %d ws %zu)\n", n_in, out_size, ws_size); grid = -1; return; }
        int dev = 0, cus = 0;
        if (hipGetDevice(&dev) != hipSuccess || hipDeviceGetAttribute(&cus, hipDeviceAttributeMultiprocessorCount, dev) != hipSuccess) { grid = -1; return; }
        if (hipFuncSetAttribute((const void*)fwd_kernel, hipFuncAttributeMaxDynamicSharedMemorySize, LDS_BYTES) != hipSuccess) { fprintf(stderr, "kernel_launch: hipFuncSetAttribute failed\n"); grid = -1; return; }
        int per_cu = 0;
        if (hipOccupancyMaxActiveBlocksPerMultiprocessor(&per_cu, (const void*)fwd_kernel, NTHR, LDS_BYTES) != hipSuccess || per_cu < 1) fprintf(stderr, "kernel_launch: occupancy query reports %d\n", per_cu);
        (void)hipGetLastError();
        grid = 256;
        if (cus != 256) fprintf(stderr, "kernel_launch: device has %d CUs, kernel expects 256\n", cus);
    }
    if (grid < 0) return;
    (void)hipMemsetAsync((char*)d_ws + WS_CTL, 0, CTL_ZERO_BYTES, stream);
    Args a{};
    for (int i = 0; i < 35; ++i) a.in[i] = (const float*)d_in[i];
    a.out = (float*)d_out; a.ws = (unsigned char*)d_ws;
    if (N_LAUNCHES == 1) { a.ph_lo = 0; a.ph_hi = NPHASE; hipLaunchKernelGGL(fwd_kernel, dim3(grid), dim3(NTHR), LDS_BYTES, stream, a); }
    else for (int p = 0; p < NPHASE; ++p) { a.ph_lo = p; a.ph_hi = p + 1; hipLaunchKernelGGL(fwd_kernel, dim3(grid), dim3(NTHR), LDS_BYTES, stream, a); }
}
```

```cpp
#ifndef DBG_GM_MODE
#define DBG_GM_MODE 0
#endif
#ifndef DBG_C3
#define DBG_C3 0
#endif
#ifndef DBG_BAD_THR
#define DBG_BAD_THR 16
#endif
#ifndef DBG_MOE_ALPHA
#define DBG_MOE_ALPHA 1.0f
#endif
#include <hip/hip_runtime.h>
#include <cstdio>
#include <cstdint>

#define LAS __attribute__((address_space(3)))
#define GAS __attribute__((address_space(1)))
typedef unsigned short bf16;
typedef short bf16x8 __attribute__((ext_vector_type(8)));
typedef float f32x4 __attribute__((ext_vector_type(4)));
typedef float f32x16 __attribute__((ext_vector_type(16)));
typedef unsigned u32x4 __attribute__((ext_vector_type(4)));
typedef unsigned u32x2 __attribute__((ext_vector_type(2)));
typedef GAS unsigned gu32;

constexpr int NB = 8, SEQ = 4096, DM = 1024, CTXL = 256;
constexpr int NTOK = NB * SEQ, NCTX = NB * CTXL, NROWS1 = NTOK + NCTX;
constexpr int HYW = 512, HYC = 1536, S5W = 512, INC = 2048;
constexpr int NG = 32, GH = 16, NP = 64;
constexpr int CT = 32, NCH = SEQ / CT, NCHC = CTXL / CT;
constexpr int UROWS = 1280, UCOLS = 768;
constexpr int NE = 16, FF = 2816, CAP = 512, EROWS = NB * CAP;
constexpr int NMOD = 6;
constexpr float NORM_EPS = 1e-6f;
constexpr int FLEN = 8448, FC0 = 4224, F8LEN = 8480, F8GS = 8576;

constexpr size_t MiB = 1u << 20;
constexpr size_t WS_CTL = 0, CTL_ZERO_BYTES = 1 * MiB;
constexpr size_t WS_MOD = 1 * MiB;
constexpr size_t WS_LT = WS_MOD + 256 * 1024;
constexpr size_t WS_FH2 = 2 * MiB;
constexpr size_t WS_GLUT = 3 * MiB;
constexpr size_t WS_WINT = 4 * MiB;
constexpr size_t WS_WOUTT = 8 * MiB;
constexpr size_t WS_AFF = 10 * MiB;
constexpr size_t WS_IDX = 12 * MiB;
constexpr size_t WS_GATE = WS_IDX + 256 * 1024;
constexpr size_t WS_INV = 13 * MiB;
constexpr size_t WS_WDT = 16 * MiB;
constexpr size_t WS_WGUT = 104 * MiB;
constexpr size_t WS_Y = WS_WGUT;
constexpr size_t WS_R = 280 * MiB;
constexpr size_t WS_H1 = WS_R;
constexpr size_t WS_ZT = WS_R + 68 * MiB;
constexpr size_t WS_UG = WS_R + 164 * MiB;
constexpr size_t WS_EB = WS_R + 224 * MiB;
constexpr size_t WS_YHT = WS_EB;
constexpr size_t WS_MCT = WS_R + 264 * MiB;
constexpr size_t WS_WAT = WS_R + 288 * MiB;
constexpr size_t WS_FILT = WS_R + 296 * MiB;
constexpr size_t WS_FSC = WS_FILT + (size_t)2 * 512 * 8576;
constexpr size_t WS_VS = WS_R;
constexpr size_t WS_YSG = WS_R + 330 * MiB;
constexpr int S5TAB_FLOATS = (2 * 33 * 64 * 2) + (2 * 64 * 16 * 2) + (2 * 32 * 256) + (2 * 16 * 64 * 2);
constexpr size_t WS_S5TAB = WS_YSG;
constexpr size_t WS_YCAT = WS_R;
constexpr size_t WS_H2 = WS_R;
constexpr size_t WS_HB = WS_R + 64 * MiB;
constexpr size_t WS_XMID = WS_R + 256 * MiB;
constexpr size_t WS_END = WS_R + 416 * MiB;
static_assert(WS_YSG + (size_t)NG * 1024 * 512 * 2 <= WS_END && WS_FILT + (size_t)4 * HYW * FLEN * 2 <= WS_YSG && WS_YCAT + (size_t)NTOK * DM * 2 <= WS_ZT && WS_HB + (size_t)NE * EROWS * FF * 2 <= WS_END, "ws map");

constexpr int CW_BAR = 4096;

constexpr int RING_BYTES = 131072;
constexpr int LDS_BYTES = 163840;
constexpr int LDSCTL_OFF = LDS_BYTES - 1024, MISC_OFF = LDSCTL_OFF + 320;
constexpr int NWAVES = 8, NTHR = 512;

__device__ __forceinline__ unsigned f2bf(float f) { unsigned u = __builtin_bit_cast(unsigned, f); return (u + 0x7fffu + ((u >> 16) & 1u)) >> 16; }
__device__ __forceinline__ unsigned pk2(float lo, float hi) { return f2bf(lo) | (f2bf(hi) << 16); }
__device__ __forceinline__ float bf2f(unsigned b) { return __builtin_bit_cast(float, (b & 0xffffu) << 16); }
__device__ __forceinline__ float bflo(unsigned w) { return __builtin_bit_cast(float, w << 16); }
__device__ __forceinline__ float bfhi(unsigned w) { return __builtin_bit_cast(float, w & 0xffff0000u); }
__device__ __forceinline__ float wave_sum(float v) {
#pragma unroll
    for (int o = 1; o < 64; o <<= 1) v += __shfl_xor(v, o);
    return v;
}
__device__ __forceinline__ float sigmoidf_(float x) { return __builtin_amdgcn_rcpf(1.0f + __builtin_amdgcn_exp2f(fminf(-1.4426950408889634f * x, 80.0f))); }
__device__ __forceinline__ float siluf_(float x) { return x * sigmoidf_(x); }
__device__ __forceinline__ float gelu_tanh(float y) {
    const float u2 = 1.5957691216057308f * (y + 0.044715f * y * y * y);
    return y * sigmoidf_(u2);
}
typedef int i32x8 __attribute__((ext_vector_type(8)));
typedef int i32x4 __attribute__((ext_vector_type(4)));
__device__ __forceinline__ unsigned pk4_fp8(float a, float b, float c, float d) { int w = 0; w = __builtin_amdgcn_cvt_pk_fp8_f32(a, b, w, false); w = __builtin_amdgcn_cvt_pk_fp8_f32(c, d, w, true); return (unsigned)w; }
constexpr float WGU_SCALE = 16.0f, WD_SCALE = 32.0f;
constexpr int WGU_E8M0 = 127 - 4, WD_E8M0 = 127 - 5;
#define LDS_WAIT() asm volatile("s_waitcnt lgkmcnt(0)" ::: "memory")
#define VM_WAIT() asm volatile("s_waitcnt vmcnt(0)" ::: "memory")

#define XB_TMO      128
#define XB_XCNT(j)  (256  + 64 * (j))
#define XB_XSUB(j)  (1280 + 64 * (j))
#define XB_XGEN(j)  (2304 + 64 * (j))
#define XB_TOP      3328
#define XB_TOPGEN   3392
#define XCD_BAR_WORDS 3456
#define XB_SPIN_CAP (1u << 22)
__device__ __forceinline__ unsigned xb_ld(unsigned* p)              { return __hip_atomic_load(p, __ATOMIC_RELAXED, __HIP_MEMORY_SCOPE_AGENT); }
__device__ __forceinline__ unsigned xb_add(unsigned* p, unsigned v) { return __hip_atomic_fetch_add(p, v, __ATOMIC_RELAXED, __HIP_MEMORY_SCOPE_AGENT); }
__device__ __forceinline__ unsigned xb_xcc_id() { return (unsigned)__builtin_amdgcn_s_getreg((3 << 11) | 20) & 0xFu; }
#define XB_SPIN(cond, bar) do { unsigned _sp = 0; while (cond) { __builtin_amdgcn_s_sleep(1); \
    if ((++_sp & 255u) == 0u) { if (xb_ld(&(bar)[XB_TMO])) break; if (_sp > XB_SPIN_CAP) { atomicAdd(&(bar)[XB_TMO], 1u); break; } } } } while (0)
struct XcdBarrier { unsigned* bar; unsigned x; volatile LAS unsigned* st; };
__device__ __forceinline__ XcdBarrier xcd_barrier_post(unsigned* bar, volatile LAS unsigned* st) {
    XcdBarrier b; b.bar = bar; b.x = xb_xcc_id(); b.st = st;
    if (threadIdx.x == 0) (void)xb_add(&bar[XB_XCNT(b.x)], 1u);
    return b;
}
__device__ __forceinline__ void xcd_barrier_complete(unsigned* bar, unsigned x, unsigned& nloc, unsigned& nx) {
    const unsigned G = gridDim.x * gridDim.y * gridDim.z;
    unsigned sum, cnt, mine, sp = 0u;
    for (;;) {
        sum = 0u; cnt = 0u; mine = 0u;
#pragma unroll
        for (unsigned j = 0; j < 16; ++j) { const unsigned c = xb_ld(&bar[XB_XCNT(j)]); sum += c; cnt += (c > 0u) ? 1u : 0u; mine = (j == x) ? c : mine; }
        if (sum == G) break;
        __builtin_amdgcn_s_sleep(1);
        if ((++sp & 255u) == 0u) { if (xb_ld(&bar[XB_TMO])) break; if (sp > XB_SPIN_CAP) { atomicAdd(&bar[XB_TMO], 1u); break; } }
    }
    nloc = mine > 0u ? mine : 1u; nx = cnt > 0u ? cnt : 1u;
}
__device__ __forceinline__ void xcd_barrier(const XcdBarrier& b) {
    asm volatile("s_waitcnt vmcnt(0)" ::: "memory");
    __syncthreads();
    if (threadIdx.x == 0) {
        unsigned* bar = b.bar;
        __builtin_amdgcn_s_waitcnt(0);
        unsigned nloc = b.st[0], nx = b.st[1];
        if (nloc == 0u) { xcd_barrier_complete(bar, b.x, nloc, nx); b.st[0] = nloc; b.st[1] = nx; }
        const unsigned old = xb_add(&bar[XB_XSUB(b.x)], 1u);
        const unsigned gen = old / nloc;
        if (old + 1u == (gen + 1u) * nloc) {
            __builtin_amdgcn_fence(__ATOMIC_RELEASE, "agent");
            asm volatile("s_waitcnt vmcnt(0)" ::: "memory");
            const unsigned og = xb_add(&bar[XB_TOP], 1u);
            const unsigned tg = og / nx;
            if (og + 1u == (tg + 1u) * nx) xb_add(&bar[XB_TOPGEN], 1u);
            else XB_SPIN(xb_ld(&bar[XB_TOPGEN]) == tg, bar);
            __builtin_amdgcn_fence(__ATOMIC_ACQUIRE, "agent");
            xb_add(&bar[XB_XGEN(b.x)], 1u);
            asm volatile("s_waitcnt vmcnt(0)" ::: "memory");
        } else {
            XB_SPIN(xb_ld(&bar[XB_XGEN(b.x)]) == gen, bar);
            __builtin_amdgcn_fence(__ATOMIC_ACQUIRE, "agent");
            asm volatile("s_waitcnt vmcnt(0)" ::: "memory");
        }
    }
    __syncthreads();
}

namespace gm {
constexpr int BM = 256, BK = 64, HALF = 128, HTB = HALF * BK * 2, STAGE_BYTES = 8 * HTB, NXCD = 8, WGM = 8;
__host__ __device__ __forceinline__ int lds_byte(int r, int c) { const int st = (r >> 4) * 2 + (c >> 5), rr = r & 15, cc = c & 31, ob = rr * 64 + cc * 2; return st * 1024 + (ob ^ (((ob >> 9) & 1) << 5)); }
__host__ __device__ __forceinline__ void stage_rc(int b, int& R, int& C) { const int st = b / 1024, sb = b % 1024, swz = sb ^ (((sb >> 9) & 1) << 5); R = (st >> 1) * 16 + swz / 64; C = (st & 1) * 32 + (swz % 64) / 2; }
__host__ __device__ __forceinline__ int perm32(int rho) { const int n = rho >> 4, i = rho & 15; return 8 * (i >> 2) + 4 * n + (i & 3); }

struct GUnit { const char* A; const char* B; int pm, pn; };
__device__ __forceinline__ const char* uni_ptr(const char* p) { const unsigned long long v = (unsigned long long)p; const unsigned lo = __builtin_amdgcn_readfirstlane((unsigned)v), hi = __builtin_amdgcn_readfirstlane((unsigned)(v >> 32));
    return (const char*)(const GAS char*)(((unsigned long long)hi << 32) | lo); }

struct TileOrder {
    int nM, nN, nwg, G, c;
    __device__ __forceinline__ void init(int nM_, int nN_, int G_, int c_) { nM = nM_; nN = nN_; nwg = nM * nN; G = G_; c = c_; }
    __device__ __forceinline__ bool get(int i, int& pm, int& pn) const {
        const long L = (long)i * G + c; if (L >= nwg) return false;
        int wgid = (int)L; { const int q = nwg / NXCD, r = nwg % NXCD, xcd = wgid % NXCD, off = wgid / NXCD; wgid = (xcd < r ? xcd * (q + 1) : r * (q + 1) + (xcd - r) * q) + off; }
        const int nig = WGM * nN, gid = wgid / nig, fm = gid * WGM, gsz = (nM - fm) < WGM ? (nM - fm) : WGM;
        pm = fm + ((wgid % nig) % gsz); pn = (wgid % nig) / gsz; return true;
    }
};

__device__ __forceinline__ unsigned cvt_pk_bf16(float lo, float hi) { unsigned r; asm volatile("v_cvt_pk_bf16_f32 %0, %1, %2" : "=v"(r) : "v"(lo), "v"(hi)); return r; }

template <class Epi, class Sched, bool TR>
__device__ __forceinline__ void gemm_phase(LAS unsigned char* lds, const Sched& S, const Epi& E) {
    int tid = threadIdx.x; asm volatile("" : "+v"(tid));
    const int wid = __builtin_amdgcn_readfirstlane(tid >> 6), lane = tid & 63, wr = wid >> 2, wc = wid & 3, fr = lane & 15, fq = lane >> 4;
    const int nt = S.nt;
    int sR0, sC0, sR1, sC1; stage_rc(tid * 16, sR0, sC0); stage_rc(tid * 16 + 8192, sR1, sC1);
    const unsigned vB0 = (unsigned)(Epi::PERM ? ((sR0 & ~31) + perm32(sR0 & 31)) : sR0) * S.ldb + (unsigned)sC0 * 2u;
    const unsigned vB1 = (unsigned)(Epi::PERM ? ((sR1 & ~31) + perm32(sR1 & 31)) : sR1) * S.ldb + (unsigned)sC1 * 2u;
    const size_t kA = S.kstepA, kB = S.kstepB;
    const size_t hstepB = (size_t)HALF * S.ldb;
    const unsigned ldsw = (unsigned)wid * 1024u;
    const int aoff = lds_byte(wr * 64 + fr, fq * 8), boff = lds_byte(wc * 32 + fr, fq * 8);
#define PG8_SA(b, h) (((b) * 2 + (h)) * HTB)
#define PG8_SB(b, h) ((4 + (b) * 2 + (h)) * HTB)
#define PG8_STAGE(bufoff, gbase, o0, o1) do { \
        __builtin_amdgcn_global_load_lds((const unsigned*)((const char*)(gbase) + (o0)), (LAS unsigned*)(lds + (bufoff) + ldsw), 16, 0, 0); \
        __builtin_amdgcn_global_load_lds((const unsigned*)((const char*)(gbase) + (o1)), (LAS unsigned*)(lds + (bufoff) + ldsw + 8192), 16, 0, 0); } while (0)
#define PG8_LDA(dst, b, h) do { _Pragma("unroll") for (int m = 0; m < 4; ++m) _Pragma("unroll") for (int k = 0; k < 2; ++k) dst[m][k] = *(const LAS bf16x8*)(lds + PG8_SA(b, h) + aoff + m * 2048 + k * 1024); } while (0)
#define PG8_LDB(dst, b, h) do { _Pragma("unroll") for (int n = 0; n < 2; ++n) _Pragma("unroll") for (int k = 0; k < 2; ++k) dst[n][k] = *(const LAS bf16x8*)(lds + PG8_SB(b, h) + boff + n * 2048 + k * 1024); } while (0)
#define PG8_MMA(ai, bj, At, Bt) do { __builtin_amdgcn_s_setprio(1); _Pragma("unroll") for (int m = 0; m < 4; ++m) _Pragma("unroll") for (int n = 0; n < 2; ++n) _Pragma("unroll") for (int k = 0; k < 2; ++k) \
        acc[ai][bj][m][n] = TR ? __builtin_amdgcn_mfma_f32_16x16x32_bf16(Bt[n][k], At[m][k], acc[ai][bj][m][n], 0, 0, 0) \
                               : __builtin_amdgcn_mfma_f32_16x16x32_bf16(At[m][k], Bt[n][k], acc[ai][bj][m][n], 0, 0, 0); __builtin_amdgcn_s_setprio(0); } while (0)
#define PG8_WAIT_V(n) asm volatile("s_waitcnt vmcnt(" #n ")" ::: "memory")
#define PG8_WAIT_L(n) asm volatile("s_waitcnt lgkmcnt(" #n ")" ::: "memory")
#define PG8_BAR __builtin_amdgcn_s_barrier()
#define PG8_SCHED __builtin_amdgcn_sched_barrier(0)
    GUnit cur, nxt; int ui = 0;
    if (!S.next(0, cur)) return;
    f32x4 acc[2][2][4][2];
#pragma unroll
    for (int a = 0; a < 2; ++a)
#pragma unroll
        for (int b = 0; b < 2; ++b)
#pragma unroll
            for (int m = 0; m < 4; ++m)
#pragma unroll
                for (int n = 0; n < 2; ++n) acc[a][b][m][n] = (f32x4){0.f, 0.f, 0.f, 0.f};
    bf16x8 At[4][2], B0[2][2], B1[2][2];
    unsigned c00 = S.aoff(cur, sR0, sC0), c01 = S.aoff(cur, sR1, sC1), c10 = S.aoff(cur, HALF + sR0, sC0), c11 = S.aoff(cur, HALF + sR1, sC1);
    const char* cA = uni_ptr(cur.A); const char* cB = uni_ptr(cur.B);
    PG8_STAGE(PG8_SB(0, 0), cB, vB0, vB1); PG8_STAGE(PG8_SB(0, 1), cB + hstepB, vB0, vB1); PG8_STAGE(PG8_SA(0, 0), cA, c00, c01); PG8_STAGE(PG8_SA(0, 1), cA, c10, c11);
    if (wr == 1) PG8_BAR;
    PG8_WAIT_V(2); PG8_BAR;
    PG8_STAGE(PG8_SB(1, 0), cB + kB, vB0, vB1); PG8_STAGE(PG8_SA(1, 0), cA + kA, c00, c01); PG8_STAGE(PG8_SB(1, 1), cB + hstepB + kB, vB0, vB1);
    PG8_WAIT_V(6); PG8_BAR;
    for (;;) {
        const bool has_next = S.next(ui + 1, nxt);
        if (!has_next) nxt = cur;
        const char* nA = uni_ptr(nxt.A); const char* nB = uni_ptr(nxt.B);
        unsigned n00 = c00, n01 = c01, n10 = c10, n11 = c11;
        if (!Sched::AOFF_PM_ONLY || nxt.pm != cur.pm) { n00 = S.aoff(nxt, sR0, sC0); n01 = S.aoff(nxt, sR1, sC1); n10 = S.aoff(nxt, HALF + sR0, sC0); n11 = S.aoff(nxt, HALF + sR1, sC1); }
        for (int t = 0; t < nt; t += 2) {
            const bool last = (t == nt - 2);
            const char* a1 = cA + (size_t)(t + 1) * kA;
            const char* a2 = last ? nA : cA + (size_t)(t + 2) * kA; const char* b2 = last ? nB : cB + (size_t)(t + 2) * kB;
            const char* a3 = a2 + kA; const char* b3 = b2 + kB;
            const unsigned x00 = last ? n00 : c00, x01 = last ? n01 : c01, x10 = last ? n10 : c10, x11 = last ? n11 : c11;
            PG8_LDB(B0, 0, 0); PG8_LDB(B1, 0, 1); PG8_SCHED; PG8_LDA(At, 0, 0); PG8_STAGE(PG8_SA(1, 1), a1, c10, c11);
            PG8_WAIT_V(8); PG8_WAIT_L(0); PG8_BAR; PG8_MMA(0, 0, At, B0); PG8_MMA(0, 1, At, B1); PG8_BAR; PG8_SCHED;
            PG8_LDA(At, 0, 1); PG8_STAGE(PG8_SB(0, 0), b2, vB0, vB1); PG8_STAGE(PG8_SB(0, 1), b2 + hstepB, vB0, vB1); PG8_STAGE(PG8_SA(0, 0), a2, x00, x01);
            PG8_WAIT_V(8); PG8_WAIT_L(0); PG8_BAR; PG8_MMA(1, 0, At, B0); PG8_MMA(1, 1, At, B1); PG8_BAR; PG8_SCHED;
            PG8_LDB(B0, 1, 0); PG8_LDB(B1, 1, 1); PG8_SCHED; PG8_LDA(At, 1, 0); PG8_STAGE(PG8_SA(0, 1), a2, x10, x11);
            PG8_WAIT_V(8); PG8_WAIT_L(0); PG8_BAR; PG8_MMA(0, 0, At, B0); PG8_MMA(0, 1, At, B1); PG8_BAR; PG8_SCHED;
            PG8_LDA(At, 1, 1); PG8_STAGE(PG8_SB(1, 0), b3, vB0, vB1); PG8_STAGE(PG8_SB(1, 1), b3 + hstepB, vB0, vB1); PG8_STAGE(PG8_SA(1, 0), a3, x00, x01);
            PG8_WAIT_V(8); PG8_WAIT_L(0); PG8_BAR; PG8_MMA(1, 0, At, B0); PG8_MMA(1, 1, At, B1); PG8_BAR; PG8_SCHED;
        }
        if (wr == 0) PG8_BAR;
        E(acc, cur, wr, wc, fr, fq);
        if (!has_next) break;
#pragma unroll
        for (int a = 0; a < 2; ++a)
#pragma unroll
            for (int b = 0; b < 2; ++b)
#pragma unroll
                for (int m = 0; m < 4; ++m)
#pragma unroll
                    for (int n = 0; n < 2; ++n) acc[a][b][m][n] = (f32x4){0.f, 0.f, 0.f, 0.f};
        cur = nxt; cA = nA; cB = nB; ++ui;
        c00 = n00; c01 = n01; c10 = n10; c11 = n11;
        if (wr == 1) PG8_BAR;
    }
    PG8_WAIT_V(0);
    PG8_BAR;
#undef PG8_SA
#undef PG8_SB
#undef PG8_STAGE
#undef PG8_LDA
#undef PG8_LDB
#undef PG8_MMA
#undef PG8_WAIT_V
#undef PG8_WAIT_L
#undef PG8_BAR
#undef PG8_SCHED
}
template <class Epi, class Sched, int SCALE_B, int MODE = 0>
__device__ __forceinline__ void gemm_phase_f8(LAS unsigned char* lds, const Sched& S, const Epi& E) {
    int tid = threadIdx.x; asm volatile("" : "+v"(tid));
    const int wid = __builtin_amdgcn_readfirstlane(tid >> 6), lane = tid & 63, wr = wid >> 2, wc = wid & 3, fr = lane & 15, fq = lane >> 4;
    const int nt = S.nt;
    int scA = 127, scB = SCALE_B; asm volatile("" : "+v"(scA), "+v"(scB));
    int sR0, sC0, sR1, sC1; stage_rc(tid * 16, sR0, sC0); stage_rc(tid * 16 + 8192, sR1, sC1);
    const unsigned vB0 = (unsigned)(Epi::PERM ? ((sR0 & ~31) + perm32(sR0 & 31)) : sR0) * S.ldb + (unsigned)sC0 * 2u;
    const unsigned vB1 = (unsigned)(Epi::PERM ? ((sR1 & ~31) + perm32(sR1 & 31)) : sR1) * S.ldb + (unsigned)sC1 * 2u;
    const size_t kA = S.kstepA, kB = S.kstepB;
    const size_t hstepB = (size_t)HALF * S.ldb;
    const unsigned ldsw = (unsigned)wid * 1024u;
    const int aoff = lds_byte(wr * 64 + fr, fq * 8), aoff2 = lds_byte(wr * 64 + fr, fq * 8 + 32), boff = lds_byte(wc * 32 + fr, fq * 8), boff2 = lds_byte(wc * 32 + fr, fq * 8 + 32);
#define PG8_SA(b, h) (((b) * 2 + (h)) * HTB)
#define PG8_SB(b, h) ((4 + (b) * 2 + (h)) * HTB)
#define PG8_STAGE(bufoff, gbase, o0, o1) do { if (MODE == 2) break; \
        __builtin_amdgcn_global_load_lds((const unsigned*)((const char*)(gbase) + (o0)), (LAS unsigned*)(lds + (bufoff) + ldsw), 16, 0, 0); \
        __builtin_amdgcn_global_load_lds((const unsigned*)((const char*)(gbase) + (o1)), (LAS unsigned*)(lds + (bufoff) + ldsw + 8192), 16, 0, 0); } while (0)
#define PG8_LDA(dst, b, h) do { _Pragma("unroll") for (int m = 0; m < 4; ++m) dst[m] = __builtin_shufflevector(*(const LAS i32x4*)(lds + PG8_SA(b, h) + aoff + m * 2048), *(const LAS i32x4*)(lds + PG8_SA(b, h) + aoff2 + m * 2048), 0, 1, 2, 3, 4, 5, 6, 7); } while (0)
#define PG8_LDB(dst, b, h) do { _Pragma("unroll") for (int n = 0; n < 2; ++n) dst[n] = __builtin_shufflevector(*(const LAS i32x4*)(lds + PG8_SB(b, h) + boff + n * 2048), *(const LAS i32x4*)(lds + PG8_SB(b, h) + boff2 + n * 2048), 0, 1, 2, 3, 4, 5, 6, 7); } while (0)
#define PG8_F8(FRG) (i32x8){(int)FRG[0][0], (int)FRG[0][1], (int)FRG[0][2], (int)FRG[0][3], (int)FRG[1][0], (int)FRG[1][1], (int)FRG[1][2], (int)FRG[1][3]}
#define PG8_MMA(ai, bj, At, Bt) do { __builtin_amdgcn_s_setprio(1); _Pragma("unroll") for (int m = 0; m < 4; ++m) _Pragma("unroll") for (int n = 0; n < 2; ++n) \
        { if (MODE == 1) asm volatile("" : "+v"(acc[ai][bj][m][n]) : "v"(Bt[n]), "v"(At[m]), "v"(scB), "v"(scA)); else asm volatile("v_mfma_scale_f32_16x16x128_f8f6f4 %0, %1, %2, %0, %3, %4 op_sel_hi:[0,0,0]" : "+v"(acc[ai][bj][m][n]) : "v"(Bt[n]), "v"(At[m]), "v"(scB), "v"(scA)); } __builtin_amdgcn_s_setprio(0); } while (0)
#define PG8_WAIT_V(n) asm volatile("s_waitcnt vmcnt(" #n ")" ::: "memory")
#define PG8_WAIT_L(n) asm volatile("s_waitcnt lgkmcnt(" #n ")" ::: "memory")
#define PG8_BAR __builtin_amdgcn_s_barrier()
#define PG8_SCHED __builtin_amdgcn_sched_barrier(0)
    GUnit cur, nxt; int ui = 0;
    if (!S.next(0, cur)) return;
    f32x4 acc[2][2][4][2];
#pragma unroll
    for (int a = 0; a < 2; ++a)
#pragma unroll
        for (int b = 0; b < 2; ++b)
#pragma unroll
            for (int m = 0; m < 4; ++m)
#pragma unroll
                for (int n = 0; n < 2; ++n) acc[a][b][m][n] = (f32x4){0.f, 0.f, 0.f, 0.f};
    i32x8 At[4], B0[2], B1[2];
    unsigned c00 = S.aoff(cur, sR0, sC0), c01 = S.aoff(cur, sR1, sC1), c10 = S.aoff(cur, HALF + sR0, sC0), c11 = S.aoff(cur, HALF + sR1, sC1);
    const char* cA = uni_ptr(cur.A); const char* cB = uni_ptr(cur.B);
    PG8_STAGE(PG8_SB(0, 0), cB, vB0, vB1); PG8_STAGE(PG8_SB(0, 1), cB + hstepB, vB0, vB1); PG8_STAGE(PG8_SA(0, 0), cA, c00, c01); PG8_STAGE(PG8_SA(0, 1), cA, c10, c11);
    if (wr == 1) PG8_BAR;
    PG8_WAIT_V(2); PG8_BAR;
    PG8_STAGE(PG8_SB(1, 0), cB + kB, vB0, vB1); PG8_STAGE(PG8_SA(1, 0), cA + kA, c00, c01); PG8_STAGE(PG8_SB(1, 1), cB + hstepB + kB, vB0, vB1);
    PG8_WAIT_V(6); PG8_BAR;
    for (;;) {
        const bool has_next = S.next(ui + 1, nxt);
        if (!has_next) nxt = cur;
        const char* nA = uni_ptr(nxt.A); const char* nB = uni_ptr(nxt.B);
        unsigned n00 = c00, n01 = c01, n10 = c10, n11 = c11;
        if constexpr (!Sched::AOFF_CONST) { if (!Sched::AOFF_PM_ONLY || nxt.pm != cur.pm) { n00 = S.aoff(nxt, sR0, sC0); n01 = S.aoff(nxt, sR1, sC1); n10 = S.aoff(nxt, HALF + sR0, sC0); n11 = S.aoff(nxt, HALF + sR1, sC1); } }
        for (int t = 0; t < nt; t += 2) {
            const bool last = (t == nt - 2);
            const char* a1 = cA + (size_t)(t + 1) * kA;
            const char* a2 = last ? nA : cA + (size_t)(t + 2) * kA; const char* b2 = last ? nB : cB + (size_t)(t + 2) * kB;
            const char* a3 = a2 + kA; const char* b3 = b2 + kB;
            const unsigned x00 = (!Sched::AOFF_CONST && last) ? n00 : c00, x01 = (!Sched::AOFF_CONST && last) ? n01 : c01, x10 = (!Sched::AOFF_CONST && last) ? n10 : c10, x11 = (!Sched::AOFF_CONST && last) ? n11 : c11;
            PG8_LDB(B0, 0, 0); PG8_LDB(B1, 0, 1); PG8_SCHED; PG8_LDA(At, 0, 0); PG8_STAGE(PG8_SA(1, 1), a1, c10, c11);
            PG8_WAIT_V(8); PG8_WAIT_L(0); PG8_BAR; PG8_MMA(0, 0, At, B0); PG8_MMA(0, 1, At, B1); PG8_BAR; PG8_SCHED;
            PG8_LDA(At, 0, 1); PG8_STAGE(PG8_SB(0, 0), b2, vB0, vB1); PG8_STAGE(PG8_SB(0, 1), b2 + hstepB, vB0, vB1); PG8_STAGE(PG8_SA(0, 0), a2, x00, x01);
            PG8_WAIT_V(8); PG8_WAIT_L(0); PG8_BAR; PG8_MMA(1, 0, At, B0); PG8_MMA(1, 1, At, B1); PG8_BAR; PG8_SCHED;
            PG8_LDB(B0, 1, 0); PG8_LDB(B1, 1, 1); PG8_SCHED; PG8_LDA(At, 1, 0); PG8_STAGE(PG8_SA(0, 1), a2, x10, x11);
            PG8_WAIT_V(8); PG8_WAIT_L(0); PG8_BAR; PG8_MMA(0, 0, At, B0); PG8_MMA(0, 1, At, B1); PG8_BAR; PG8_SCHED;
            PG8_LDA(At, 1, 1); PG8_STAGE(PG8_SB(1, 0), b3, vB0, vB1); PG8_STAGE(PG8_SB(1, 1), b3 + hstepB, vB0, vB1); PG8_STAGE(PG8_SA(1, 0), a3, x00, x01);
            PG8_WAIT_V(8); PG8_WAIT_L(0); PG8_BAR; PG8_MMA(1, 0, At, B0); PG8_MMA(1, 1, At, B1); PG8_BAR; PG8_SCHED;
        }
        if (wr == 0) PG8_BAR;
        asm volatile("s_nop 15\n\ts_nop 15" ::: "memory");
        if (MODE == 0) E(acc, cur, wr, wc, fr, fq); else asm volatile("" :: "v"(acc[0][0][0][0]), "v"(acc[1][1][3][1]));
        if (!has_next) break;
#pragma unroll
        for (int a = 0; a < 2; ++a)
#pragma unroll
            for (int b = 0; b < 2; ++b)
#pragma unroll
                for (int m = 0; m < 4; ++m)
#pragma unroll
                    for (int n = 0; n < 2; ++n) acc[a][b][m][n] = (f32x4){0.f, 0.f, 0.f, 0.f};
        cur = nxt; cA = nA; cB = nB; ++ui;
        c00 = n00; c01 = n01; c10 = n10; c11 = n11;
        if (wr == 1) PG8_BAR;
    }
    PG8_WAIT_V(0);
    PG8_BAR;
#undef PG8_SA
#undef PG8_SB
#undef PG8_STAGE
#undef PG8_LDA
#undef PG8_LDB
#undef PG8_MMA
#undef PG8_F8
#undef PG8_WAIT_V
#undef PG8_WAIT_L
#undef PG8_BAR
#undef PG8_SCHED
}
}

struct Args { const float* in[35]; float* out; unsigned char* ws; int ph_lo, ph_hi; };
struct Frame {
    LAS unsigned char* lds;
    int tid, lane, wave, G, bid;
    float* out; unsigned char* ws;
};
__device__ __forceinline__ const float* inptr(const Frame& F, int i) {
    const LAS unsigned* t = (const LAS unsigned*)(F.lds + LDSCTL_OFF) + 2 * i;
    const unsigned lo = __builtin_amdgcn_readfirstlane(t[0]), hi = __builtin_amdgcn_readfirstlane(t[1]);
    const GAS float* g = (const GAS float*)(((unsigned long long)hi << 32) | lo);
    return (const float*)g;
}
enum { I_X = 0, I_C, I_CTX, I_CCTX, I_MODW, I_MODB, I_N1G, I_N2G, I_WIN, I_WOUT, I_CONVW, I_CONVB, I_HW1, I_HB1, I_HFREQ, I_HW2, I_HB2, I_HW3, I_HB3, I_HBIAS,
       I_LRE, I_LIM, I_LSTEP, I_BRE, I_BIM, I_CRE, I_CIM, I_S5D, I_GLUW, I_GLUB, I_RW, I_WG, I_WU, I_WD, I_FING };

struct SchedPlain {
    static constexpr bool AOFF_PM_ONLY = true, AOFF_CONST = true;
    gm::TileOrder T; const char* A; const char* B; unsigned lda, ldb, kstepA, kstepB; int nt; int mt; size_t az, bz;
    __device__ __forceinline__ bool next(int i, gm::GUnit& u) const {
        int pm, pn; if (!T.get(i, pm, pn)) return false; const int z = pm / mt, pl = pm - z * mt;
        u.pm = pm; u.pn = pn; u.A = A + (size_t)z * az + (size_t)pl * 256 * lda; u.B = B + (size_t)z * bz + (size_t)pn * 256 * ldb; return true; }
    __device__ __forceinline__ unsigned aoff(const gm::GUnit&, int row, int col) const { return (unsigned)row * lda + (unsigned)col * 2u; }
};
struct SchedMoe1 {
    static constexpr bool AOFF_PM_ONLY = true, AOFF_CONST = false;
    gm::TileOrder T; const char* A; const char* B; const int* idx; unsigned lda, ldb, kstepA, kstepB; int nt;
    __device__ __forceinline__ bool next(int i, gm::GUnit& u) const {
        int pm, pn; if (!T.get(i, pm, pn)) return false; const int e = pm >> 4;
        u.pm = pm; u.pn = pn; u.A = A; u.B = B + ((size_t)e * (2 * FF) + (size_t)pn * 256) * ldb; return true; }
    __device__ __forceinline__ unsigned aoff(const gm::GUnit& u, int row, int col) const { const int tok = idx[u.pm * 256 + row]; return (unsigned)tok * lda + (unsigned)col * 2u; }
};
struct SchedGlu {
    static constexpr bool AOFF_PM_ONLY = true;
    gm::TileOrder T; const char* A; const char* B; unsigned ldb, kstepA, kstepB; int nt;
    __device__ __forceinline__ bool next(int i, gm::GUnit& u) const {
        int pm, pn; if (!T.get(i, pm, pn)) return false;
        u.pm = pm; u.pn = pn; u.A = A + (size_t)pm * 256 * 32; u.B = B + (size_t)pn * 256 * ldb; return true; }
    __device__ __forceinline__ unsigned aoff(const gm::GUnit&, int row, int col) const { return (unsigned)(col >> 4) * (unsigned)(1024 * 512 * 2) + (unsigned)row * 32u + (unsigned)(col & 15) * 2u; }
};

using gm::GUnit; using gm::cvt_pk_bf16;
struct EpiZT { static constexpr bool PERM = false; bf16* ZT;
    __device__ __forceinline__ void operator()(const f32x4 (&acc)[2][2][4][2], const GUnit& u, int wr, int wc, int fr, int fq) const {
#pragma unroll
        for (int bj = 0; bj < 2; ++bj)
#pragma unroll
            for (int n = 0; n < 2; ++n) { const int ch = u.pn * 256 + bj * 128 + wc * 32 + n * 16 + fr; bf16* rowp = ZT + (size_t)ch * NTOK + u.pm * 256 + wr * 64 + 4 * fq;
#pragma unroll
                for (int ai = 0; ai < 2; ++ai)
#pragma unroll
                    for (int m = 0; m < 4; ++m) { const f32x4 v = acc[ai][bj][m][n]; u32x2 w; w.x = cvt_pk_bf16(v[0], v[1]); w.y = cvt_pk_bf16(v[2], v[3]); *(u32x2*)(rowp + ai * 128 + m * 16) = w; } }
    }
};
struct EpiUG { static constexpr bool PERM = true; bf16* UG;
    __device__ __forceinline__ void operator()(const f32x4 (&acc)[2][2][4][2], const GUnit& u, int wr, int wc, int fr, int fq) const {
#pragma unroll
        for (int ai = 0; ai < 2; ++ai)
#pragma unroll
            for (int m = 0; m < 4; ++m) { const int r = u.pm * 256 + ai * 128 + wr * 64 + m * 16 + fr; int crow, tau;
                if (r < NTOK) { crow = r >> 5; tau = r & 31; } else { const int rc = r - NTOK; crow = 1024 + (rc >> 5); tau = rc & 31; }
#pragma unroll
                for (int bj = 0; bj < 2; ++bj) { const int c0 = u.pn * 256 + bj * 128 + wc * 32 + 8 * fq; const int g = c0 >> 4, h0 = c0 & 15;
                    const f32x4 v0 = acc[ai][bj][m][0], v1 = acc[ai][bj][m][1]; u32x4 w; w.x = cvt_pk_bf16(v0[0], v0[1]); w.y = cvt_pk_bf16(v0[2], v0[3]); w.z = cvt_pk_bf16(v1[0], v1[1]); w.w = cvt_pk_bf16(v1[2], v1[3]);
                    *(u32x4*)(UG + ((size_t)g * UROWS + crow) * UCOLS + tau * 16 + h0) = w; } }
    }
};
struct EpiEB { static constexpr bool PERM = false; float* EB;
    __device__ __forceinline__ void operator()(const f32x4 (&acc)[2][2][4][2], const GUnit& u, int wr, int wc, int fr, int fq) const {
        const int g = u.pm / 5, pl = u.pm - g * 5;
#pragma unroll
        for (int ai = 0; ai < 2; ++ai)
#pragma unroll
            for (int m = 0; m < 4; ++m) { float* rowp = EB + ((size_t)g * UROWS + pl * 256 + ai * 128 + wr * 64 + m * 16 + fr) * 256 + wc * 32 + 4 * fq;
#pragma unroll
                for (int bj = 0; bj < 2; ++bj)
#pragma unroll
                    for (int n = 0; n < 2; ++n) *(f32x4*)(rowp + bj * 128 + n * 16) = acc[ai][bj][m][n]; }
    }
};
struct EpiYS { static constexpr bool PERM = true; bf16* YSG; const bf16* UG; const float* s5d;
    __device__ __forceinline__ void operator()(const f32x4 (&acc)[2][2][4][2], const GUnit& u, int wr, int wc, int fr, int fq) const {
        const int g = u.pm >> 2, pl = u.pm & 3;
        float dv[2][8];
#pragma unroll
        for (int bj = 0; bj < 2; ++bj) { const int c0 = u.pn * 256 + bj * 128 + wc * 32 + 8 * fq;
#pragma unroll
            for (int j = 0; j < 8; ++j) dv[bj][j] = s5d[g * 16 + ((c0 + j) & 15)]; }
        u32x4 uq[2][4][2];
#pragma unroll
        for (int ai = 0; ai < 2; ++ai)
#pragma unroll
            for (int m = 0; m < 4; ++m) { const int crow = pl * 256 + ai * 128 + wr * 64 + m * 16 + fr;
#pragma unroll
                for (int bj = 0; bj < 2; ++bj) uq[ai][m][bj] = *(const u32x4*)(UG + ((size_t)g * UROWS + crow) * UCOLS + u.pn * 256 + bj * 128 + wc * 32 + 8 * fq); }
#pragma unroll
        for (int ai = 0; ai < 2; ++ai)
#pragma unroll
            for (int m = 0; m < 4; ++m) { const int crow = pl * 256 + ai * 128 + wr * 64 + m * 16 + fr;
#pragma unroll
                for (int bj = 0; bj < 2; ++bj) { const int c0 = u.pn * 256 + bj * 128 + wc * 32 + 8 * fq;
                    const u32x4 uu = uq[ai][m][bj];
                    const f32x4 v0 = acc[ai][bj][m][0], v1 = acc[ai][bj][m][1];
                    float y[8]; y[0] = v0[0] + dv[bj][0] * bflo(uu.x); y[1] = v0[1] + dv[bj][1] * bfhi(uu.x); y[2] = v0[2] + dv[bj][2] * bflo(uu.y); y[3] = v0[3] + dv[bj][3] * bfhi(uu.y);
                    y[4] = v1[0] + dv[bj][4] * bflo(uu.z); y[5] = v1[1] + dv[bj][5] * bfhi(uu.z); y[6] = v1[2] + dv[bj][6] * bflo(uu.w); y[7] = v1[3] + dv[bj][7] * bfhi(uu.w);
#pragma unroll
                    for (int j = 0; j < 8; ++j) y[j] = gelu_tanh(y[j]);
                    u32x4 w; w.x = cvt_pk_bf16(y[0], y[1]); w.y = cvt_pk_bf16(y[2], y[3]); w.z = cvt_pk_bf16(y[4], y[5]); w.w = cvt_pk_bf16(y[6], y[7]);
                    *(u32x4*)(YSG + ((size_t)g * 1024 + crow) * 512 + c0) = w; } }
    }
};
struct EpiGlu { static constexpr bool PERM = true; bf16* YCAT; const bf16* YSG; const float* glub;
    __device__ __forceinline__ void operator()(const f32x4 (&acc)[2][2][4][2], const GUnit& u, int wr, int wc, int fr, int fq) const {
#pragma unroll
        for (int bj = 0; bj < 2; ++bj) { const int n0 = u.pn * 256 + bj * 128 + wc * 32 + 8 * fq; const int g = n0 >> 4, h0 = n0 & 15;
            const f32x4 b0 = *(const f32x4*)(glub + n0), b1 = *(const f32x4*)(glub + n0 + 4);
            u32x4 yq[2][4];
#pragma unroll
            for (int ai = 0; ai < 2; ++ai)
#pragma unroll
                for (int m = 0; m < 4; ++m) { const int tok = u.pm * 256 + ai * 128 + wr * 64 + m * 16 + fr; yq[ai][m] = *(const u32x4*)(YSG + ((size_t)g * 1024 + (tok >> 5)) * 512 + (tok & 31) * 16 + h0); }
#pragma unroll
            for (int ai = 0; ai < 2; ++ai)
#pragma unroll
                for (int m = 0; m < 4; ++m) { const int tok = u.pm * 256 + ai * 128 + wr * 64 + m * 16 + fr;
                    const u32x4 ys = yq[ai][m];
                    const f32x4 v0 = acc[ai][bj][m][0] + b0, v1 = acc[ai][bj][m][1] + b1;
                    float y[8]; y[0] = bflo(ys.x) * sigmoidf_(v0[0]); y[1] = bfhi(ys.x) * sigmoidf_(v0[1]); y[2] = bflo(ys.y) * sigmoidf_(v0[2]); y[3] = bfhi(ys.y) * sigmoidf_(v0[3]);
                    y[4] = bflo(ys.z) * sigmoidf_(v1[0]); y[5] = bfhi(ys.z) * sigmoidf_(v1[1]); y[6] = bflo(ys.w) * sigmoidf_(v1[2]); y[7] = bfhi(ys.w) * sigmoidf_(v1[3]);
                    u32x4 w; w.x = cvt_pk_bf16(y[0], y[1]); w.y = cvt_pk_bf16(y[2], y[3]); w.z = cvt_pk_bf16(y[4], y[5]); w.w = cvt_pk_bf16(y[6], y[7]);
#ifdef DBG_S5_SCALE
                    w.x = cvt_pk_bf16(y[0] * DBG_S5_SCALE, y[1] * DBG_S5_SCALE); w.y = cvt_pk_bf16(y[2] * DBG_S5_SCALE, y[3] * DBG_S5_SCALE); w.z = cvt_pk_bf16(y[4] * DBG_S5_SCALE, y[5] * DBG_S5_SCALE); w.w = cvt_pk_bf16(y[6] * DBG_S5_SCALE, y[7] * DBG_S5_SCALE);
#endif
                    *(u32x4*)(YCAT + (size_t)tok * DM + 512 + n0) = w; } }
    }
};
struct EpiXmid { static constexpr bool PERM = false; const float* x; bf16* xmid; const float* mod;
    __device__ __forceinline__ void operator()(const f32x4 (&acc)[2][2][4][2], const GUnit& u, int wr, int wc, int fr, int fq) const {
        const int b = u.pm >> 4;
        const int col0 = u.pn * 256 + wc * 32 + 4 * fq;
        f32x4 gv[2][2];
#pragma unroll
        for (int bj = 0; bj < 2; ++bj)
#pragma unroll
            for (int n = 0; n < 2; ++n) gv[bj][n] = *(const f32x4*)(mod + (size_t)b * (NMOD * DM) + 2 * DM + col0 + bj * 128 + n * 16);
#pragma unroll
        for (int ai = 0; ai < 2; ++ai) { f32x4 xv[4][2][2];
#pragma unroll
            for (int m = 0; m < 4; ++m) { const size_t off = (size_t)(u.pm * 256 + ai * 128 + wr * 64 + m * 16 + fr) * DM + col0;
#pragma unroll
                for (int bj = 0; bj < 2; ++bj)
#pragma unroll
                    for (int n = 0; n < 2; ++n) xv[m][bj][n] = *(const f32x4*)(x + off + bj * 128 + n * 16); }
#pragma unroll
            for (int m = 0; m < 4; ++m) { const size_t off = (size_t)(u.pm * 256 + ai * 128 + wr * 64 + m * 16 + fr) * DM + col0;
#pragma unroll
                for (int bj = 0; bj < 2; ++bj)
#pragma unroll
                    for (int n = 0; n < 2; ++n) { const f32x4 rv = xv[m][bj][n] + gv[bj][n] * acc[ai][bj][m][n]; u32x2 o; o.x = pk2(rv.x, rv.y); o.y = pk2(rv.z, rv.w); *(u32x2*)(xmid + off + bj * 128 + n * 16) = o; } }
            asm volatile("" ::: "memory"); }
    }
};
struct EpiMoe1 { static constexpr bool PERM = true; unsigned char* HB;
    __device__ __forceinline__ void operator()(const f32x4 (&acc)[2][2][4][2], const GUnit& u, int wr, int wc, int fr, int fq) const {
        const int c0 = u.pn * 128 + wc * 32 + 8 * fq;
#pragma unroll
        for (int ai = 0; ai < 2; ++ai)
#pragma unroll
            for (int m = 0; m < 4; ++m) { const size_t row = (size_t)u.pm * 256 + ai * 128 + wr * 64 + m * 16 + fr;
                float y[8];
#pragma unroll
                for (int n = 0; n < 2; ++n)
#pragma unroll
                    for (int j = 0; j < 4; ++j) y[n * 4 + j] = fminf(fmaxf(siluf_(acc[ai][0][m][n][j]) * acc[ai][1][m][n][j], -448.0f), 448.0f);
                u32x2 w; w.x = pk4_fp8(y[0], y[1], y[2], y[3]); w.y = pk4_fp8(y[4], y[5], y[6], y[7]);
                *(u32x2*)(HB + row * FF + c0) = w; }
    }
};
struct EpiMoe2 { static constexpr bool PERM = true; bf16* Y; const float* gate;
    __device__ __forceinline__ void operator()(const f32x4 (&acc)[2][2][4][2], const GUnit& u, int wr, int wc, int fr, int fq) const {
#pragma unroll
        for (int ai = 0; ai < 2; ++ai)
#pragma unroll
            for (int m = 0; m < 4; ++m) { const size_t row = (size_t)u.pm * 256 + ai * 128 + wr * 64 + m * 16 + fr; const float gt = gate[row];
#pragma unroll
                for (int bj = 0; bj < 2; ++bj) { const int c0 = u.pn * 256 + bj * 128 + wc * 32 + 8 * fq;
                    const f32x4 v0 = acc[ai][bj][m][0] * gt, v1 = acc[ai][bj][m][1] * gt;
                    u32x4 w; w.x = cvt_pk_bf16(v0[0], v0[1]); w.y = cvt_pk_bf16(v0[2], v0[3]); w.z = cvt_pk_bf16(v1[0], v1[1]); w.w = cvt_pk_bf16(v1[2], v1[3]);
                    *(u32x4*)(Y + row * DM + c0) = w; } }
    }
};

__device__ __forceinline__ void tr_item(const float* W, int N, bf16* WT, int ldk, int k0, int n0, int drow0, LAS float* scr, int lane) {
    float tv[32];
    const float* wp = W + (size_t)(k0 + (lane >> 5)) * N + n0 + (lane & 31);
#pragma unroll
    for (int i = 0; i < 32; ++i) tv[i] = wp[(size_t)(2 * i) * N];
#pragma unroll
    for (int i = 0; i < 32; ++i) scr[(2 * i + (lane >> 5)) * 33 + (lane & 31)] = tv[i];
    LDS_WAIT(); asm volatile("" ::: "memory");
    const int c = lane & 7;
#pragma unroll
    for (int j = 0; j < 4; ++j) { const int n = (lane >> 3) + 8 * j; const LAS float* s = scr + (8 * c) * 33 + n;
        u32x4 o; o.x = pk2(s[0 * 33], s[1 * 33]); o.y = pk2(s[2 * 33], s[3 * 33]); o.z = pk2(s[4 * 33], s[5 * 33]); o.w = pk2(s[6 * 33], s[7 * 33]);
        *(u32x4*)(WT + (size_t)(drow0 + n) * ldk + k0 + 8 * c) = o; }
    LDS_WAIT(); asm volatile("" ::: "memory");
}
__device__ __forceinline__ void p0_transposes(Frame& F) {
    LAS float* scr = (LAS float*)(F.lds + F.wave * 16384);
    if (F.bid >= 192) return;
    const int gw = F.bid * NWAVES + F.wave, NGW = 192 * NWAVES;
    constexpr int I0 = 16 * 64, I1 = 16 * 32, I2 = 8 * 16, IG = 16 * 16 * 88;
    constexpr int NIT = I0 + I1 + I2;
    bf16* ws16 = (bf16*)F.ws;
    for (int it = gw; it < NIT; it += NGW) {
        int r = it;
        if (r < I0) { const int kb = r / 64, nb = r % 64; tr_item(inptr(F, I_WIN), INC, (bf16*)(F.ws + WS_WINT), DM, kb * 64, nb * 32, nb * 32, scr, F.lane); continue; } r -= I0;
        if (r < I1) { const int kb = r / 32, nb = r % 32; tr_item(inptr(F, I_WOUT), DM, (bf16*)(F.ws + WS_WOUTT), DM, kb * 64, nb * 32, nb * 32, scr, F.lane); continue; } r -= I1;
        if (r < I2) { const int kb = r / 16, nb = r % 16; tr_item(inptr(F, I_GLUW), S5W, (bf16*)(F.ws + WS_GLUT), S5W, kb * 64, nb * 32, nb * 32, scr, F.lane); continue; } r -= I2;
        if (r < 2 * IG) { const int up = r >= IG; if (up) r -= IG; const int e = r / (16 * 88), q = r % (16 * 88), kb = q / 88, nb = q % 88, n0 = nb * 32;
            const float* W = inptr(F, up ? I_WU : I_WG) + (size_t)e * DM * FF;
            tr_item(W, FF, (bf16*)(F.ws + WS_WGUT) + (size_t)e * (2 * FF) * DM, DM, kb * 64, n0, 256 * (n0 >> 7) + (n0 & 127) + (up ? 128 : 0), scr, F.lane); continue; }
    }
    (void)ws16;
}
__device__ __forceinline__ void tr_item_f8(const float* W, int N, unsigned char* WT, int ldk, int k0, int n0, int drow0, float sc, LAS float* scr, int lane) {
    float tv[32];
    const float* wp = W + (size_t)(k0 + (lane >> 5)) * N + n0 + (lane & 31);
#pragma unroll
    for (int i = 0; i < 32; ++i) tv[i] = wp[(size_t)(2 * i) * N];
#pragma unroll
    for (int i = 0; i < 32; ++i) scr[(2 * i + (lane >> 5)) * 33 + (lane & 31)] = tv[i];
    LDS_WAIT(); asm volatile("" ::: "memory");
    const int c = lane & 7;
#pragma unroll
    for (int j = 0; j < 4; ++j) { const int n = (lane >> 3) + 8 * j; const LAS float* s = scr + (8 * c) * 33 + n;
        u32x2 o; o.x = pk4_fp8(s[0 * 33] * sc, s[1 * 33] * sc, s[2 * 33] * sc, s[3 * 33] * sc); o.y = pk4_fp8(s[4 * 33] * sc, s[5 * 33] * sc, s[6 * 33] * sc, s[7 * 33] * sc);
        *(u32x2*)(WT + (size_t)(drow0 + n) * ldk + k0 + 8 * c) = o; }
    LDS_WAIT(); asm volatile("" ::: "memory");
}
__device__ __forceinline__ void dn_issue(Frame& F, int r, float (&tv)[32]) {
    if (r >= 16 * 44 * 32) return;
    const int e = r / (44 * 32), q = r % (44 * 32), kb = q / 32, nb = q % 32;
    const float* wp = inptr(F, I_WD) + (size_t)e * FF * DM + (size_t)(kb * 64 + (F.lane >> 5)) * DM + nb * 32 + (F.lane & 31);
#pragma unroll
    for (int i = 0; i < 32; ++i) tv[i] = wp[(size_t)(2 * i) * DM];
}
__device__ __forceinline__ void dn_finish(Frame& F, int r, const float (&tv)[32], LAS float* scr) {
    if (r >= 16 * 44 * 32) return;
    const int e = r / (44 * 32), q = r % (44 * 32), kb = q / 32, nb = q % 32, lane = F.lane;
    unsigned char* WT = (unsigned char*)(F.ws + WS_WDT) + (size_t)e * DM * FF;
#pragma unroll
    for (int i = 0; i < 32; ++i) scr[(2 * i + (lane >> 5)) * 33 + (lane & 31)] = tv[i];
    LDS_WAIT(); asm volatile("" ::: "memory");
    const int c = lane & 7;
#pragma unroll
    for (int j = 0; j < 4; ++j) { const int n = (lane >> 3) + 8 * j; const LAS float* s = scr + (8 * c) * 33 + n;
        u32x2 o; o.x = pk4_fp8(s[0 * 33] * WD_SCALE, s[1 * 33] * WD_SCALE, s[2 * 33] * WD_SCALE, s[3 * 33] * WD_SCALE); o.y = pk4_fp8(s[4 * 33] * WD_SCALE, s[5 * 33] * WD_SCALE, s[6 * 33] * WD_SCALE, s[7 * 33] * WD_SCALE);
        *(u32x2*)(WT + (size_t)(nb * 32 + n) * FF + kb * 64 + 8 * c) = o; }
    LDS_WAIT(); asm volatile("" ::: "memory");
}
__device__ __forceinline__ void p_down_items(Frame& F, int first, int count, int stride) {
    LAS float* scr = (LAS float*)(F.lds + F.wave * 16384);
    float ta[32], tb[32];
    dn_issue(F, first, ta);
#pragma unroll 1
    for (int k = 0; k < count; k += 2) {
        if (k + 1 < count) dn_issue(F, first + (k + 1) * stride, tb);
        dn_finish(F, first + k * stride, ta, scr);
        if (k + 2 < count) dn_issue(F, first + (k + 2) * stride, ta);
        if (k + 1 < count) dn_finish(F, first + (k + 1) * stride, tb, scr);
    }
}
constexpr int DN_P4 = 3 * 6 * 256, DN_P9 = 10 * 8 * 128, DN_P3 = 4 * 8 * 96, DN_P0 = 22528 - DN_P4 - DN_P9 - DN_P3;
__device__ __forceinline__ void p0_adaln_item(Frame& F, int item) {
    LAS float* sl = (LAS float*)F.lds;
    LAS float* part = sl + 9 * 1024;
    for (int i = F.tid; i < 9 * 1024; i += NTHR) { const int r = i >> 10, k = i & 1023; const float v = (r < 8) ? inptr(F, I_C)[r * DM + k] : inptr(F, I_CCTX)[k]; sl[i] = siluf_(v); }
    __syncthreads();
    const int cl = F.tid & 31, kq = F.tid >> 5, j = item * 32 + cl;
    float a[9];
#pragma unroll
    for (int r = 0; r < 9; ++r) a[r] = 0.f;
    const float* W = inptr(F, I_MODW);
#pragma unroll 16
    for (int kk = 0; kk < 64; ++kk) { const int k = kq + 16 * kk; const float w = W[(size_t)k * (NMOD * DM) + j];
#pragma unroll
        for (int r = 0; r < 9; ++r) a[r] += sl[r * 1024 + k] * w; }
#pragma unroll
    for (int r = 0; r < 9; ++r) part[(kq * 9 + r) * 32 + cl] = a[r];
    __syncthreads();
    if (F.tid < 9 * 32) { const int r = F.tid >> 5, c2 = F.tid & 31; float s = inptr(F, I_MODB)[item * 32 + c2];
#pragma unroll
        for (int q = 0; q < 16; ++q) s += part[(q * 9 + r) * 32 + c2];
        ((float*)(F.ws + WS_MOD))[(size_t)r * (NMOD * DM) + item * 32 + c2] = s; }
    __syncthreads();
}
__device__ __forceinline__ void p0_s5_tables(Frame& F, int g) {
    typedef float f32x2 __attribute__((ext_vector_type(2)));
    LAS f32x2* PW = (LAS f32x2*)F.lds;
    LAS f32x2* BB = PW + 2 * 33 * 64;
    LAS float* KT = (LAS float*)(BB + 2 * 64 * 16);
    LAS f32x2* CC = (LAS f32x2*)(KT + 2 * 32 * 256);
    const float* lre = inptr(F, I_LRE); const float* lim = inptr(F, I_LIM); const float* lst = inptr(F, I_LSTEP);
    const float* cre = inptr(F, I_CRE); const float* cim = inptr(F, I_CIM);
    for (int i = F.tid; i < 2 * 33 * 64; i += NTHR) { const int dir = i / (33 * 64), e = (i / 64) % 33, p = i & 63;
        const double lr = lre[(dir * NG + g) * NP + p], li = lim[(dir * NG + g) * NP + p], dt = exp((double)lst[dir * NG + g]);
        double ph = li * dt * e; ph -= 6.283185307179586 * floor(ph * 0.15915494309189535);
        const float m = expf((float)(lr * dt * e)); float sn, cs; sincosf((float)ph, &sn, &cs); const float cr = m * cs, ci = m * sn;
        PW[i] = (f32x2){cr, ci};
        if (e == 32) { float* LT = (float*)(F.ws + WS_LT); LT[((dir * NG + g) * NP + p) * 2] = cr; LT[((dir * NG + g) * NP + p) * 2 + 1] = ci; } }
    __syncthreads();
    for (int i = F.tid; i < 2 * 16 * 64; i += NTHR) { const int dir = i >> 10, h = (i >> 6) & 15, p = i & 63; const size_t ci = (((size_t)dir * NG + g) * GH + h) * NP + p; CC[i] = (f32x2){cre[ci], cim[ci]}; }
    for (int i = F.tid; i < 2 * 64 * 16; i += NTHR) { const int dir = i >> 10, p = (i >> 4) & 63, h = i & 15;
        const double lr = lre[(dir * NG + g) * NP + p], li = lim[(dir * NG + g) * NP + p];
        const f32x2 lb = PW[(dir * 33 + 1) * 64 + p]; const double ar = (double)lb.x - 1.0, ai = (double)lb.y, den = lr * lr + li * li;
        const double fr_ = (ar * lr + ai * li) / den, fi_ = (ai * lr - ar * li) / den;
        const size_t bi = (((size_t)dir * NG + g) * NP + p) * GH + h; const double br = inptr(F, I_BRE)[bi], bim = inptr(F, I_BIM)[bi];
        BB[i] = (f32x2){(float)(fr_ * br - fi_ * bim), (float)(fr_ * bim + fi_ * br)}; }
    __syncthreads();
    {
        const int dir = F.tid >> 8, h = (F.tid >> 4) & 15, hp = F.tid & 15;
        for (int d = 0; d < 32; ++d) KT[(dir * 32 + d) * 256 + (F.tid & 255)] = 0.f;
        for (int pc = 0; pc < 4; ++pc) { float qr[16], qi[16];
#pragma unroll
            for (int j = 0; j < 16; ++j) { const int p = pc * 16 + j; const f32x2 cc = CC[(dir * 16 + h) * 64 + p]; const float cr = cc.x, cj = cc.y; const f32x2 b = BB[(dir * 64 + p) * 16 + hp];
                qr[j] = cr * b.x - cj * b.y; qi[j] = cr * b.y + cj * b.x; }
            for (int d = 0; d < 32; ++d) { float s = 0.f;
#pragma unroll
                for (int j = 0; j < 16; ++j) { const f32x2 w = PW[(dir * 33 + d) * 64 + pc * 16 + j]; s += qr[j] * w.x - qi[j] * w.y; }
                KT[(dir * 32 + d) * 256 + (F.tid & 255)] += s; } }
    }
    __syncthreads();
    { float* TAB = (float*)(F.ws + WS_S5TAB) + (size_t)g * S5TAB_FLOATS; const LAS float* src = (const LAS float*)F.lds;
      for (int i = F.tid; i < S5TAB_FLOATS / 4; i += NTHR) ((f32x4*)TAB)[i] = ((const LAS f32x4*)src)[i]; }
    __syncthreads();
}
__device__ __forceinline__ void p1_s5_expand(Frame& F) {
    typedef float f32x2 __attribute__((ext_vector_type(2)));
    const int g = F.bid >> 3, part = F.bid & 7;
    LAS f32x2* PW = (LAS f32x2*)F.lds;
    LAS f32x2* BB = PW + 2 * 33 * 64;
    constexpr int KTS = 260;
    LAS float* KT = (LAS float*)(BB + 2 * 64 * 16);
    LAS f32x2* CC = (LAS f32x2*)(KT + 2 * 32 * KTS);
    { const float* TAB = (const float*)(F.ws + WS_S5TAB) + (size_t)g * S5TAB_FLOATS; LAS float* dst = (LAS float*)F.lds;
      constexpr int KT0 = (2 * 33 * 64 * 2) + (2 * 64 * 16 * 2), KT1 = KT0 + 2 * 32 * 256;
      for (int i = F.tid; i < S5TAB_FLOATS / 4; i += NTHR) { const int f = 4 * i; int d = f;
          if (f >= KT1) d = f + 64 * (KTS - 256); else if (f >= KT0) { const int o = f - KT0; d = KT0 + (o >> 8) * KTS + (o & 255); }
          *(LAS f32x4*)(dst + d) = ((const f32x4*)TAB)[i]; } }
    __syncthreads();
    bf16* MCT = (bf16*)(F.ws + WS_MCT) + (size_t)g * 512 * UCOLS;
    for (int pc = F.tid; pc < 64 * 64; pc += NTHR) { const int rw = part * 64 + (pc >> 6), q = pc & 63, tau = rw >> 4, h = rw & 15, s = q >> 1, h0 = (q & 1) * 8;
        float v[8];
        {   const int d0 = tau - s; const float m0 = (d0 >= 0) ? 1.f : 0.f, m1 = (d0 <= 0) ? 1.f : 0.f;
            const LAS f32x4* k0 = (const LAS f32x4*)(KT + (0 * 32 + (d0 >= 0 ? d0 : 0)) * KTS + h * 16 + h0); const LAS f32x4* k1 = (const LAS f32x4*)(KT + (1 * 32 + (d0 <= 0 ? -d0 : 0)) * KTS + h * 16 + h0);
            const f32x4 a0 = k0[0], a1 = k0[1], b0 = k1[0], b1 = k1[1];
#pragma unroll
            for (int j = 0; j < 4; ++j) { v[j] = m0 * a0[j] + m1 * b0[j]; v[4 + j] = m0 * a1[j] + m1 * b1[j]; } }
        u32x4 w; w.x = pk2(v[0], v[1]); w.y = pk2(v[2], v[3]); w.z = pk2(v[4], v[5]); w.w = pk2(v[6], v[7]);
        *(u32x4*)(MCT + (size_t)rw * UCOLS + s * 16 + h0) = w; }
    for (int pc = F.tid; pc < 64 * 32; pc += NTHR) { const int rw = part * 64 + (pc >> 5), q = pc & 31, tau = rw >> 4, h = rw & 15, dir = q >> 4, ri = (q >> 3) & 1, p0 = (q & 7) * 8;
        const int e = dir ? (32 - tau) : (tau + 1);
        float v[8];
#pragma unroll
        for (int j = 0; j < 8; ++j) { const int p = p0 + j; const f32x2 cc = CC[(dir * 16 + h) * 64 + p]; const float cr = cc.x, cj = cc.y; const f32x2 w = PW[(dir * 33 + e) * 64 + p];
            v[j] = ri ? -(cr * w.y + cj * w.x) : (cr * w.x - cj * w.y); }
        u32x4 w; w.x = pk2(v[0], v[1]); w.y = pk2(v[2], v[3]); w.z = pk2(v[4], v[5]); w.w = pk2(v[6], v[7]);
        *(u32x4*)(MCT + (size_t)rw * UCOLS + 512 + dir * 128 + ri * 64 + p0) = w; }
    bf16* WAT = (bf16*)(F.ws + WS_WAT) + (size_t)g * 256 * 512;
    for (int pc = F.tid; pc < 32 * 64; pc += NTHR) { const int rw = part * 32 + (pc >> 6), q = pc & 63, dir = rw >> 7, ri = (rw >> 6) & 1, p = rw & 63, s = q >> 1, h0 = (q & 1) * 8;
        const f32x2 w = PW[(dir * 33 + (dir ? s : (31 - s))) * 64 + p];
        float v[8];
#pragma unroll
        for (int j = 0; j < 8; ++j) { const f32x2 b = BB[(dir * 64 + p) * 16 + h0 + j]; v[j] = ri ? (w.x * b.y + w.y * b.x) : (w.x * b.x - w.y * b.y); }
        u32x4 o; o.x = pk2(v[0], v[1]); o.y = pk2(v[2], v[3]); o.z = pk2(v[4], v[5]); o.w = pk2(v[6], v[7]);
        *(u32x4*)(WAT + (size_t)rw * 512 + s * 16 + h0) = o; }
    __syncthreads();
}
__device__ __forceinline__ void p0_filter_l12(Frame& F, int i0, int npos) {
    LAS float* sc = (LAS float*)(F.lds + F.wave * 1024);
    const int j = F.lane;
    const float* hw1 = inptr(F, I_HW1); const float* hw2 = inptr(F, I_HW2); const float* hfq = inptr(F, I_HFREQ);
    float w1c[33], w2c[64];
#pragma unroll
    for (int f = 0; f < 33; ++f) w1c[f] = hw1[f * 64 + j];
#pragma unroll
    for (int k = 0; k < 64; ++k) w2c[k] = hw2[k * 64 + j];
    const float b1 = inptr(F, I_HB1)[j], b2 = inptr(F, I_HB2)[j], f0 = hfq[j], f1 = hfq[64 + j];
    for (int q = 0; q < npos; ++q) { const int i = i0 + q;
        if (j < 33) { const double L = (double)SEQ; double v;
            if (j == 0) v = (double)i / (L - 1.0);
            else { const int k = (j - 1) & 15; const double f = 1e-4 + (double)k * ((15.0 - 1e-4) / 15.0), om = 6.283185307179586 * (double)i / L; v = (j <= 16) ? cos(f * om) : -sin(f * om); }
            sc[j] = (float)v; }
        LDS_WAIT(); asm volatile("" ::: "memory");
        float a = b1;
#pragma unroll
        for (int f = 0; f < 33; ++f) a += sc[f] * w1c[f];
        sc[64 + j] = sinf(f0 * a);
        LDS_WAIT(); asm volatile("" ::: "memory");
        float b = b2;
#pragma unroll
        for (int k = 0; k < 64; ++k) b += sc[64 + k] * w2c[k];
        ((float*)(F.ws + WS_FH2))[(size_t)j * SEQ + i] = sinf(f1 * b);
        LDS_WAIT(); asm volatile("" ::: "memory"); }
}
__device__ __forceinline__ void phase0(Frame& F) {
    if (F.bid < 192) p0_adaln_item(F, F.bid);
    else if (F.bid < 224) p0_s5_tables(F, F.bid - 192);
    else p0_filter_l12(F, (F.bid - 224) * 128 + F.wave * 16, 16);
    __syncthreads();
    p0_transposes(F);
    if (F.bid < 192) p_down_items(F, DN_P4 + DN_P9 + DN_P3 + F.bid * 8 + F.wave, 3, 192 * 8);
}

__device__ __forceinline__ void norm_mod_row(const float* xrow, const float* gam, const float* shift, const float* scale, bf16* orow, int lane) {
    const f32x4* xr = (const f32x4*)xrow + lane;
    f32x4 v[4]; float s = 0.f;
#pragma unroll
    for (int j = 0; j < 4; ++j) { v[j] = xr[64 * j]; s += (v[j].x * v[j].x + v[j].y * v[j].y) + (v[j].z * v[j].z + v[j].w * v[j].w); }
    const float rstd = 1.0f / sqrtf(wave_sum(s) * (1.0f / DM) + NORM_EPS);
    unsigned long long* o8 = (unsigned long long*)orow + lane;
#pragma unroll
    for (int j = 0; j < 4; ++j) { const f32x4 g = ((const f32x4*)gam)[lane + 64 * j], sh = ((const f32x4*)shift)[lane + 64 * j], sc = ((const f32x4*)scale)[lane + 64 * j];
        const f32x4 y = (v[j] * rstd * g) * (sc + 1.0f) + sh;
        o8[64 * j] = (unsigned long long)pk2(y.x, y.y) | ((unsigned long long)pk2(y.z, y.w) << 32); }
}
__device__ __forceinline__ void p1_norm_rows(const float* xbase, bf16* obase, int nrows, const float* gam, const float* shift, const float* scale, int lane) {
    f32x4 GM[4], SH[4];
#pragma unroll
    for (int j = 0; j < 4; ++j) { const f32x4 g = ((const f32x4*)gam)[lane + 64 * j], sc = ((const f32x4*)scale)[lane + 64 * j]; GM[j] = g * (sc + 1.0f); SH[j] = ((const f32x4*)shift)[lane + 64 * j]; }
    for (int r = 0; r < nrows; r += 4) {
        f32x4 v[4][4];
#pragma unroll
        for (int q = 0; q < 4; ++q) if (r + q < nrows) { const f32x4* xr = (const f32x4*)(xbase + (size_t)(r + q) * DM) + lane;
#pragma unroll
            for (int j = 0; j < 4; ++j) v[q][j] = xr[64 * j]; }
#pragma unroll
        for (int q = 0; q < 4; ++q) if (r + q < nrows) { float s = 0.f;
#pragma unroll
            for (int j = 0; j < 4; ++j) s += (v[q][j].x * v[q][j].x + v[q][j].y * v[q][j].y) + (v[q][j].z * v[q][j].z + v[q][j].w * v[q][j].w);
            const float rstd = 1.0f / sqrtf(wave_sum(s) * (1.0f / DM) + NORM_EPS);
            unsigned long long* o8 = (unsigned long long*)(obase + (size_t)(r + q) * DM) + lane;
#pragma unroll
            for (int j = 0; j < 4; ++j) { const f32x4 y = (v[q][j] * rstd) * GM[j] + SH[j];
                o8[64 * j] = (unsigned long long)pk2(y.x, y.y) | ((unsigned long long)pk2(y.z, y.w) << 32); } }
    }
}
__device__ __forceinline__ void p1_norm(Frame& F) {
    const int gw = F.bid * NWAVES + F.wave, lane = F.lane;
    const float* mod = (const float*)(F.ws + WS_MOD);
    bf16* H1 = (bf16*)(F.ws + WS_H1);
    const float* gam = inptr(F, I_N1G);
    { const int mr = gw >> 8; const float* shift = mod + (size_t)mr * (NMOD * DM);
      p1_norm_rows(inptr(F, I_X) + (size_t)gw * 16 * DM, H1 + (size_t)gw * 16 * DM, 16, gam, shift, shift + DM, lane); }
    { const float* shift = mod + (size_t)8 * (NMOD * DM);
      p1_norm_rows(inptr(F, I_CTX) + (size_t)gw * DM, H1 + (size_t)(NTOK + gw) * DM, 1, gam, shift, shift + DM, lane); }
}
__device__ __forceinline__ void p1_filter(Frame& F) {
    LAS float* w3s = (LAS float*)F.lds;
    LAS float* b3s = w3s + 512;
    LAS float* red = b3s + 8;
    LAS float* nrm = red + 32;
    const int c0 = F.bid * 2;
    for (int i = F.tid; i < 512; i += NTHR) { const int k = i >> 3, q = i & 7, ch = q >> 2, o = (q >> 1) & 1, dir = q & 1; w3s[i] = inptr(F, I_HW3)[(size_t)k * 2048 + o * 1024 + dir * 512 + c0 + ch]; }
    if (F.tid < 8) { const int q = F.tid, ch = q >> 2, o = (q >> 1) & 1, dir = q & 1; b3s[q] = inptr(F, I_HB3)[o * 1024 + dir * 512 + c0 + ch]; }
    __syncthreads();
    const float* FH2 = (const float*)(F.ws + WS_FH2);
    const double la = -4.605170185988091 / 0.3, lb = -4.605170185988091 / 1.5;
    float delta[2];
#pragma unroll
    for (int ch = 0; ch < 2; ++ch) delta[ch] = (float)fabs(la + (double)(c0 + ch) * (lb - la) / 511.0);
    unsigned char* FILT = F.ws + WS_FILT;
    float asum[4] = {0.f, 0.f, 0.f, 0.f};
    float amx[4] = {0.f, 0.f, 0.f, 0.f};
    unsigned val[8][4];
    {
        float a[8][8];
#pragma unroll
        for (int j = 0; j < 8; ++j)
#pragma unroll
            for (int q = 0; q < 8; ++q) a[j][q] = b3s[q];
        const float* hr = FH2 + 8 * F.tid;
#define FL_LOAD(H0, H1, K4) do { _Pragma("unroll") for (int kk = 0; kk < 4; ++kk) { const f32x4* hp = (const f32x4*)(hr + (size_t)((K4) * 4 + kk) * SEQ); H0[kk] = hp[0]; H1[kk] = hp[1]; } } while (0)
#define FL_FMA(H0, H1, K4) do { _Pragma("unroll") for (int kk = 0; kk < 4; ++kk) { const LAS f32x4* wp = (const LAS f32x4*)(w3s + ((K4) * 4 + kk) * 8); const f32x4 wa = wp[0], wb = wp[1]; \
            _Pragma("unroll") for (int j = 0; j < 8; ++j) { const float hv = (j < 4) ? H0[kk][j & 3] : H1[kk][j & 3]; \
                a[j][0] += hv * wa.x; a[j][1] += hv * wa.y; a[j][2] += hv * wa.z; a[j][3] += hv * wa.w; a[j][4] += hv * wb.x; a[j][5] += hv * wb.y; a[j][6] += hv * wb.z; a[j][7] += hv * wb.w; } } } while (0)
        {   f32x4 pa0[4], pa1[4], pb0[4], pb1[4];
            FL_LOAD(pa0, pa1, 0);
#pragma unroll 1
            for (int k4 = 0; k4 < 16; k4 += 2) { FL_LOAD(pb0, pb1, k4 + 1); FL_FMA(pa0, pa1, k4); if (k4 + 2 < 16) FL_LOAD(pa0, pa1, k4 + 2); FL_FMA(pb0, pb1, k4 + 1); asm volatile("" ::: "memory"); } }
#undef FL_LOAD
#undef FL_FMA
#pragma unroll
        for (int j = 0; j < 8; ++j) { const int i = 8 * F.tid + j; const float t = (float)i * (1.0f / 4095.0f); const float d0 = expf(-t * delta[0]), d1 = expf(-t * delta[1]);
#pragma unroll
            for (int q = 0; q < 8; ++q) { const int dir = q & 1; const float v = a[j][q] * ((q >> 2) ? d1 : d0); a[j][q] = v; if (dir == 0 || i != 0) { asum[q >> 1] += fabsf(v); amx[q >> 1] = fmaxf(amx[q >> 1], fabsf(v)); } }
#pragma unroll
            for (int q = 0; q < 4; ++q) val[j][q] = pk2(a[j][2 * q], a[j][2 * q + 1]); }
    }
#pragma unroll
    for (int q = 0; q < 4; ++q) { const float s2 = wave_sum(asum[q]); float m2 = amx[q];
#pragma unroll
        for (int o = 32; o >= 1; o >>= 1) m2 = fmaxf(m2, __shfl_xor(m2, o));
        if (F.lane == 0) { red[F.wave * 4 + q] = s2; red[32 + 8 + F.wave * 4 + q] = m2; } }
    __syncthreads();
    if (F.tid < 4) { float s2 = 0.f, m2 = 0.f; for (int w = 0; w < 8; ++w) { s2 += red[w * 4 + F.tid]; m2 = fmaxf(m2, red[32 + 8 + w * 4 + F.tid]); }
        const float inv = 1.0f / s2; const int p = (int)((__float_as_uint(m2 * inv) >> 23) & 255u) - 127, e = 7 - p;
        nrm[F.tid] = inv * __uint_as_float((unsigned)(127 + e) << 23);
        const int ch = F.tid >> 1, o = F.tid & 1; ((int*)(F.ws + WS_FSC))[o * HYW + c0 + ch] = 127 - e; }
    __syncthreads();
#pragma unroll
    for (int j = 0; j < 8; ++j) { const int i = 8 * F.tid + j;
#pragma unroll
        for (int q = 0; q < 8; ++q) { const int ch = q >> 2, o = (q >> 1) & 1, dir = q & 1; const float sc = nrm[ch * 2 + o]; unsigned char* G = FILT + ((size_t)o * HYW + c0 + ch) * F8GS;
            const float fv = ((q & 1) ? bfhi(val[j][q >> 1]) : bflo(val[j][q >> 1])) * sc; const unsigned char hv = (unsigned char)(__builtin_amdgcn_cvt_pk_fp8_f32(fv, fv, 0, false) & 0xff);
            if (dir == 0) G[FC0 - i] = hv; else if (i != 0) G[FC0 + i] = hv; } }
    for (int i = F.tid; i < 4 * (F8LEN - 8191); i += NTHR) { const int a = i / (F8LEN - 8191), x = i % (F8LEN - 8191); const int ch = a >> 1, o = a & 1; unsigned char* G = FILT + ((size_t)o * HYW + c0 + ch) * F8GS;
        const int xx = (x < FC0 - 4095) ? x : (x - (FC0 - 4095) + FC0 + 4096); G[xx] = 0; }
    __syncthreads();
}
__device__ __forceinline__ void phase1(Frame& F) { p1_s5_expand(F); p1_filter(F); p1_norm(F); }

#ifndef DBG_AMPX
#define DBG_AMPX 0
#endif
#define AMPB(k) unsigned long long amp_t0_ = 0; if (DBG_AMPX == (k)) amp_t0_ = __builtin_amdgcn_s_memrealtime();
#define AMPE(k) if (DBG_AMPX == (k)) { __syncthreads(); const unsigned long long t1_ = __builtin_amdgcn_s_memrealtime(); const unsigned long long d_ = t1_ - amp_t0_; while (__builtin_amdgcn_s_memrealtime() - t1_ < d_) __builtin_amdgcn_s_sleep(8); }
constexpr int HY_USTRIDE = 4368, HY_UOFF = 272, HY_G0 = 35328;
__device__ __forceinline__ i32x8 hy_ldA(const LAS unsigned char* p) { const LAS u32x2* q = (const LAS u32x2*)p; const u32x2 a = q[0], b = q[1], c = q[2], d = q[3]; return (i32x8){(int)a.x, (int)a.y, (int)b.x, (int)b.y, (int)c.x, (int)c.y, (int)d.x, (int)d.y}; }
__device__ __forceinline__ i32x8 hy_ldB(const LAS unsigned char* p) { const u32x4 a = *(const LAS u32x4*)p, b = *(const LAS u32x4*)(p + 16); return (i32x8){(int)a.x, (int)a.y, (int)a.z, (int)a.w, (int)b.x, (int)b.y, (int)b.z, (int)b.w}; }
constexpr int HT_IG2 = 2 * 16 * 16 * 88, HT_TOTAL = 2 * HT_IG2, HT_PER_WAVE = 48, HT_SCR = 35328 + 8 * 8480;
struct HyTr { const float* wg; const float* wu; bf16* wgut; LAS float* scr; int base; int lane; float tv[2][16]; };
__device__ __forceinline__ void hytr_issue(HyTr& T, int slot) {
#pragma unroll
    for (int j = 0; j < 2; ++j) { const int h = T.base + slot * 2 + j;
        if (h < HT_TOTAL) { const int up = h >= HT_IG2, r = up ? h - HT_IG2 : h, e = r / (32 * 88), q = r % (32 * 88), kb = q / 88, nb = q % 88;
            const float* wp = (up ? T.wu : T.wg) + (size_t)e * DM * FF + (size_t)(kb * 32 + (T.lane >> 5)) * FF + nb * 32 + (T.lane & 31);
#pragma unroll
            for (int i = 0; i < 16; ++i) T.tv[j][i] = wp[(size_t)(2 * i) * FF]; } }
}
__device__ __forceinline__ void hytr_finish(HyTr& T, int slot) {
#pragma unroll
    for (int j = 0; j < 2; ++j) { const int h = T.base + slot * 2 + j;
        if (h < HT_TOTAL) { const int up = h >= HT_IG2, r = up ? h - HT_IG2 : h, e = r / (32 * 88), q = r % (32 * 88), kb = q / 88, nb = q % 88, n0 = nb * 32;
            bf16* WT = (bf16*)((unsigned char*)T.wgut + (size_t)e * (2 * FF) * DM); const int drow0 = 256 * (n0 >> 7) + (n0 & 127) + (up ? 128 : 0);
#pragma unroll
            for (int i = 0; i < 16; ++i) T.scr[(2 * i + (T.lane >> 5)) * 33 + (T.lane & 31)] = T.tv[j][i];
            LDS_WAIT(); asm volatile("" ::: "memory");
            const int c = T.lane & 3;
#pragma unroll
            for (int p = 0; p < 2; ++p) { const int n = (T.lane >> 2) + 16 * p; const LAS float* sp = T.scr + (8 * c) * 33 + n;
                u32x2 o; o.x = pk4_fp8(sp[0 * 33] * WGU_SCALE, sp[1 * 33] * WGU_SCALE, sp[2 * 33] * WGU_SCALE, sp[3 * 33] * WGU_SCALE); o.y = pk4_fp8(sp[4 * 33] * WGU_SCALE, sp[5 * 33] * WGU_SCALE, sp[6 * 33] * WGU_SCALE, sp[7 * 33] * WGU_SCALE);
                *(u32x2*)((unsigned char*)WT + (size_t)(drow0 + n) * DM + kb * 32 + 8 * c) = o; }
            LDS_WAIT(); asm volatile("" ::: "memory"); } }
}
__device__ __forceinline__ void hy_conv(const LAS unsigned char* lds, int w, int lane, f32x16 (&acc)[4], HyTr& T, int slot0, int fsc_s) {
    const int r = lane & 31, hh = lane >> 5, n = lane & 31, b = n >> 2, i = n & 3;
    const LAS unsigned char* abase = lds + HY_G0 + (r & 7) * F8LEN + (FC0 - 8 * (r >> 3) + 32 * hh) - 512 * w;
    const LAS unsigned char* bbase = lds + HY_UOFF + b * HY_USTRIDE + 64 * i + 32 * hh;
    int sc1 = 127, fsc = fsc_s; asm volatile("" : "+v"(sc1), "+v"(fsc));
#pragma unroll
    for (int q = 0; q < 4; ++q)
#pragma unroll
        for (int j = 0; j < 16; ++j) acc[q][j] = 0.f;
#define HY_M1(ACC, AF, BF) asm volatile("v_mfma_scale_f32_32x32x64_f8f6f4 %0, %1, %2, %0, %3, %4 op_sel_hi:[0,0,0]" : "+v"(ACC) : "v"(AF), "v"(BF), "v"(fsc), "v"(sc1))
#define HY_MM(O0, O1, N0, N1, BB) do { HY_M1(acc[0], O0, BB); HY_M1(acc[1], O1, BB); HY_M1(acc[2], N0, BB); HY_M1(acc[3], N1, BB); } while (0)
#define HY_ST3() do { \
            Z0 = hy_ldA(pa - 512); Z1 = hy_ldA(pa - 544); Ub = hy_ldB(pb - 256); HY_MM(X0, X1, Y0, Y1, Ua); \
            X0 = hy_ldA(pa - 768); X1 = hy_ldA(pa - 800); Uc = hy_ldB(pb - 512); HY_MM(Y0, Y1, Z0, Z1, Ub); \
            Y0 = hy_ldA(pa - 1024); Y1 = hy_ldA(pa - 1056); Ua = hy_ldB(pb - 768); HY_MM(Z0, Z1, X0, X1, Uc); \
            pa -= 768; pb -= 768; } while (0)
#pragma unroll 1
    for (int rho = 0; rho < 4; ++rho) {
        const LAS unsigned char* pa = abase + 64 * (60 + rho);
        const LAS unsigned char* pb = bbase + 64 * (60 + rho);
        i32x8 X0, X1, Y0, Y1, Z0, Z1, Ua, Ub, Uc;
        if (rho < 3) hytr_issue(T, slot0 + 2 * rho);
        X0 = hy_ldA(pa); X1 = hy_ldA(pa - 32); Y0 = hy_ldA(pa - 256); Y1 = hy_ldA(pa - 288); Ua = hy_ldB(pb);
#pragma unroll 1
        for (int k = 0; k < 2; ++k) HY_ST3();
        if (rho < 3) { hytr_finish(T, slot0 + 2 * rho); hytr_issue(T, slot0 + 2 * rho + 1); }
#pragma unroll 1
        for (int k = 0; k < 3; ++k) HY_ST3();
        Z0 = hy_ldA(pa - 512); Z1 = hy_ldA(pa - 544); Ub = hy_ldB(pb - 256); HY_MM(X0, X1, Y0, Y1, Ua);
        HY_MM(Y0, Y1, Z0, Z1, Ub);
        if (rho < 3) hytr_finish(T, slot0 + 2 * rho + 1);
    }
    asm volatile("s_nop 15\n\ts_nop 15" ::: "memory");
#undef HY_ST3
#undef HY_MM
#undef HY_M1
}
__device__ __forceinline__ void hy_load_filter(Frame& F, const unsigned char* G) {
    LAS unsigned char* lds = F.lds;
#define AB(H, L, N) __builtin_amdgcn_alignbyte(H, L, N)
#pragma unroll
    for (int k = 0; k < 2; ++k) { const int i = F.tid + k * NTHR;
        if (i < F8LEN / 16) { const u32x4 v = *(const u32x4*)(G + 16 * i); u32x2 pv = (u32x2){0u, 0u}; if (i) pv = *(const u32x2*)(G + 16 * i - 8);
            LAS unsigned char* d = lds + HY_G0 + 16 * i;
            *(LAS u32x4*)(d) = v;
            *(LAS u32x4*)(d + 1 * F8LEN) = (u32x4){AB(v.x, pv.y, 3), AB(v.y, v.x, 3), AB(v.z, v.y, 3), AB(v.w, v.z, 3)};
            *(LAS u32x4*)(d + 2 * F8LEN) = (u32x4){AB(v.x, pv.y, 2), AB(v.y, v.x, 2), AB(v.z, v.y, 2), AB(v.w, v.z, 2)};
            *(LAS u32x4*)(d + 3 * F8LEN) = (u32x4){AB(v.x, pv.y, 1), AB(v.y, v.x, 1), AB(v.z, v.y, 1), AB(v.w, v.z, 1)};
            *(LAS u32x4*)(d + 4 * F8LEN) = (u32x4){pv.y, v.x, v.y, v.z};
            *(LAS u32x4*)(d + 5 * F8LEN) = (u32x4){AB(pv.y, pv.x, 3), AB(v.x, pv.y, 3), AB(v.y, v.x, 3), AB(v.z, v.y, 3)};
            *(LAS u32x4*)(d + 6 * F8LEN) = (u32x4){AB(pv.y, pv.x, 2), AB(v.x, pv.y, 2), AB(v.y, v.x, 2), AB(v.z, v.y, 2)};
            *(LAS u32x4*)(d + 7 * F8LEN) = (u32x4){AB(pv.y, pv.x, 1), AB(v.x, pv.y, 1), AB(v.y, v.x, 1), AB(v.z, v.y, 1)}; } }
#undef AB
}
__device__ __forceinline__ u32x4 hy_ld_piece(const bf16* p) { const unsigned* pp = (const unsigned*)(p - 2); u32x4 v; v.x = pp[0]; v.y = pp[1]; v.z = pp[2]; v.w = pp[3]; return v; }
__device__ __forceinline__ f32x4 hy_sconv4r(u32x4 z, bool lz, bool rz, float w0, float w1, float w2, float cb) {
    const float zl = lz ? 0.f : bfhi(z.x), zr = rz ? 0.f : bflo(z.w), e0 = bflo(z.y), e1 = bfhi(z.y), e2 = bflo(z.z), e3 = bfhi(z.z);
    return (f32x4){w0 * zl + w1 * e0 + w2 * e1 + cb, w0 * e0 + w1 * e1 + w2 * e2 + cb, w0 * e1 + w1 * e2 + w2 * e3 + cb, w0 * e2 + w1 * e3 + w2 * zr + cb};
}
__device__ __forceinline__ float hy_cl(float v) { return fminf(fmaxf(v, -448.f), 448.f); }
__device__ __forceinline__ void hyena_channel(Frame& F, int c, int citer) {
    LAS unsigned char* lds = F.lds;
    const int tid = F.tid, lane = F.lane, w = F.wave;
    HyTr T; T.wg = inptr(F, I_WG); T.wu = inptr(F, I_WU); T.wgut = (bf16*)(F.ws + WS_WGUT); T.scr = (LAS float*)(F.lds + HT_SCR + w * 4224); T.base = (F.bid * NWAVES + w) * HT_PER_WAVE; T.lane = lane;
    bf16* ZT = (bf16*)(F.ws + WS_ZT);
    const unsigned char* FILT = F.ws + WS_FILT; const int* FSC = (const int*)(F.ws + WS_FSC);
    bf16* VS = (bf16*)(F.ws + WS_VS) + (size_t)F.bid * (8 * SEQ);
    const float* cw = inptr(F, I_CONVW); const float* cbp = inptr(F, I_CONVB);
    const int fs0 = __builtin_amdgcn_readfirstlane(__hip_atomic_load(FSC + c, __ATOMIC_RELAXED, __HIP_MEMORY_SCOPE_AGENT)), fs1 = __builtin_amdgcn_readfirstlane(__hip_atomic_load(FSC + HYW + c, __ATOMIC_RELAXED, __HIP_MEMORY_SCOPE_AGENT));
    for (int i = tid; i < HY_G0 / 16; i += NTHR) *(LAS u32x4*)(lds + 16 * i) = (u32x4){0u, 0u, 0u, 0u};
    __syncthreads();
    {
        const float w0 = cw[c], w1 = cw[HYC + c], w2 = cw[2 * HYC + c], cb = cbp[c];
        u32x4 zz[8]; float zls[8], zrs[8];
#pragma unroll
        for (int b = 0; b < 8; ++b) { const bf16* zr = ZT + (size_t)c * NTOK + b * SEQ + 8 * tid; zz[b] = *(const u32x4*)zr; zls[b] = (tid & 7) ? bf2f(zr[-1]) : 0.f; zrs[b] = ((tid & 7) != 7) ? bf2f(zr[8]) : 0.f; }
#pragma unroll
        for (int b = 0; b < 8; ++b) { const u32x4 z = zz[b];
            const float zl = zls[b], zrt = zrs[b];
            float e[10]; e[0] = zl; e[1] = bflo(z.x); e[2] = bfhi(z.x); e[3] = bflo(z.y); e[4] = bfhi(z.y); e[5] = bflo(z.z); e[6] = bfhi(z.z); e[7] = bflo(z.w); e[8] = bfhi(z.w); e[9] = zrt;
            float o[8];
#pragma unroll
            for (int j = 0; j < 8; ++j) o[j] = w0 * e[j] + w1 * e[j + 1] + w2 * e[j + 2] + cb;
            u32x4 pk; pk.x = pk2(o[0], o[1]); pk.y = pk2(o[2], o[3]); pk.z = pk2(o[4], o[5]); pk.w = pk2(o[6], o[7]);
            *(u32x4*)(VS + b * SEQ + 8 * tid) = pk;
            u32x2 p8; p8.x = pk4_fp8(hy_cl(o[0]), hy_cl(o[1]), hy_cl(o[2]), hy_cl(o[3])); p8.y = pk4_fp8(hy_cl(o[4]), hy_cl(o[5]), hy_cl(o[6]), hy_cl(o[7]));
            *(LAS u32x2*)(lds + HY_UOFF + b * HY_USTRIDE + 8 * tid) = p8; }
    }
    hy_load_filter(F, FILT + ((size_t)0 * HYW + c) * F8GS);
    __syncthreads();
    f32x16 acc[4];
    { AMPB(1) hy_conv(lds, w, lane, acc, T, (citer * 2 + 0) * 6, fs0); AMPE(1) }
#ifdef DBG_CONV_SCALE
    for (int q = 0; q < 4; ++q) for (int j = 0; j < 16; ++j) acc[q][j] *= DBG_CONV_SCALE;
#endif
    __syncthreads();
    hy_load_filter(F, FILT + ((size_t)1 * HYW + c) * F8GS);
    const int n = lane & 31, hh = lane >> 5, b = n >> 2, ii = n & 3;
    {
        const float w0 = cw[HYW + c], w1 = cw[HYC + HYW + c], w2 = cw[2 * HYC + HYW + c], cb = cbp[HYW + c], bias = inptr(F, I_HBIAS)[c];
        const int tl = 512 * w + 64 * ii + 4 * hh;
        const bf16* zrow = ZT + (size_t)(HYW + c) * NTOK + b * SEQ + tl;
        bf16* vrow = VS + b * SEQ + tl;
#pragma unroll
        for (int hq = 0; hq < 2; ++hq) {
        u32x4 zp[8]; u32x2 vp[8];
#pragma unroll
        for (int g = 0; g < 8; ++g) { const int toff = 32 * (g >> 2) + 256 * hq + 8 * (g & 3); zp[g] = hy_ld_piece(zrow + toff); vp[g] = *(const u32x2*)(vrow + toff); }
#pragma unroll
        for (int q = 2 * hq; q < 2 * hq + 2; ++q) {
#pragma unroll
            for (int rg = 0; rg < 4; ++rg) { const int toff = 32 * (q & 1) + 256 * (q >> 1) + 8 * rg;
                const f32x4 x1 = hy_sconv4r(zp[(q & 1) * 4 + rg], (q & 1) == 0 && rg == 0 && hh == 0, (q & 1) == 1 && rg == 3 && hh == 1, w0, w1, w2, cb);
                const u32x2 uv = vp[(q & 1) * 4 + rg];
                const float y0 = x1[0] * (acc[q][4 * rg + 0] + bias * bflo(uv.x)), y1 = x1[1] * (acc[q][4 * rg + 1] + bias * bfhi(uv.x));
                const float y2 = x1[2] * (acc[q][4 * rg + 2] + bias * bflo(uv.y)), y3 = x1[3] * (acc[q][4 * rg + 3] + bias * bfhi(uv.y));
                u32x2 o; o.x = pk2(y0, y1); o.y = pk2(y2, y3); *(u32x2*)(vrow + toff) = o;
                *(LAS unsigned*)(lds + HY_UOFF + b * HY_USTRIDE + tl + toff) = pk4_fp8(hy_cl(y0), hy_cl(y1), hy_cl(y2), hy_cl(y3)); }
            asm volatile("" ::: "memory"); } }
    }
    __syncthreads();
    { AMPB(1) hy_conv(lds, w, lane, acc, T, (citer * 2 + 1) * 6, fs1); AMPE(1) }
#ifdef DBG_CONV_SCALE
    for (int q = 0; q < 4; ++q) for (int j = 0; j < 16; ++j) acc[q][j] *= DBG_CONV_SCALE;
#endif
    {
        const float w0 = cw[2 * HYW + c], w1 = cw[HYC + 2 * HYW + c], w2 = cw[2 * HYC + 2 * HYW + c], cb = cbp[2 * HYW + c], bias = inptr(F, I_HBIAS)[HYW + c];
        const int tl = 512 * w + 64 * ii + 4 * hh;
        const bf16* zrow = ZT + (size_t)(2 * HYW + c) * NTOK + b * SEQ + tl;
        const bf16* vrow = VS + b * SEQ + tl;
        bf16* orow = (bf16*)(F.ws + WS_YHT) + (size_t)c * NTOK + b * SEQ + tl;
#pragma unroll
        for (int hq = 0; hq < 2; ++hq) {
        u32x4 zp[8]; u32x2 vp[8];
#pragma unroll
        for (int g = 0; g < 8; ++g) { const int toff = 32 * (g >> 2) + 256 * hq + 8 * (g & 3); zp[g] = hy_ld_piece(zrow + toff); vp[g] = *(const u32x2*)(vrow + toff); }
#pragma unroll
        for (int q = 2 * hq; q < 2 * hq + 2; ++q) {
#pragma unroll
            for (int rg = 0; rg < 4; ++rg) { const int toff = 32 * (q & 1) + 256 * (q >> 1) + 8 * rg;
                const f32x4 x2 = hy_sconv4r(zp[(q & 1) * 4 + rg], (q & 1) == 0 && rg == 0 && hh == 0, (q & 1) == 1 && rg == 3 && hh == 1, w0, w1, w2, cb);
                const u32x2 uv = vp[(q & 1) * 4 + rg];
                const float y0 = x2[0] * (acc[q][4 * rg + 0] + bias * bflo(uv.x)), y1 = x2[1] * (acc[q][4 * rg + 1] + bias * bfhi(uv.x));
                const float y2 = x2[2] * (acc[q][4 * rg + 2] + bias * bflo(uv.y)), y3 = x2[3] * (acc[q][4 * rg + 3] + bias * bfhi(uv.y));
                u32x2 o; o.x = pk2(y0, y1); o.y = pk2(y2, y3); *(u32x2*)(orow + toff) = o; }
            asm volatile("" ::: "memory"); } }
    }
    __syncthreads();
}

__device__ __forceinline__ void phase_carry(Frame& F) {
    if (F.tid >= 128) { const int wv = F.bid * 6 + (F.wave - 2); p_down_items(F, wv, 3, 6 * 256); return; }
    const int g = F.bid >> 3, b = F.bid & 7, dir = F.tid >> 6, p = F.tid & 63;
    const float* EB = (const float*)(F.ws + WS_EB) + (size_t)g * UROWS * 256 + dir * 128 + p;
    bf16* UG = (bf16*)(F.ws + WS_UG) + (size_t)g * UROWS * UCOLS + 512 + dir * 128 + p;
    const float* LT = (const float*)(F.ws + WS_LT) + ((dir * NG + g) * NP + p) * 2;
    const float lr = LT[0], li = LT[1];
    float xr = 0.f, xi = 0.f;
    {   float er[8], ei[8];
#pragma unroll
        for (int k = 0; k < 8; ++k) { const int c = dir ? (7 - k) : k; const float* e = EB + (size_t)(1024 + b * 8 + c) * 256; er[k] = e[0]; ei[k] = e[64]; }
#pragma unroll
        for (int k = 0; k < 8; ++k) { const float nr = lr * xr - li * xi + er[k], ni = lr * xi + li * xr + ei[k]; xr = nr; xi = ni; }
    }
#pragma unroll 1
    for (int c8 = 0; c8 < 4; ++c8) { float er[32], ei[32];
#pragma unroll
        for (int k = 0; k < 32; ++k) { const int c = dir ? (127 - (c8 * 32 + k)) : (c8 * 32 + k); const float* e = EB + (size_t)(b * 128 + c) * 256; er[k] = e[0]; ei[k] = e[64]; }
#pragma unroll
        for (int k = 0; k < 32; ++k) { const int c = dir ? (127 - (c8 * 32 + k)) : (c8 * 32 + k); bf16* u = UG + (size_t)(b * 128 + c) * UCOLS; u[0] = (bf16)f2bf(xr); u[64] = (bf16)f2bf(xi);
            const float nr = lr * xr - li * xi + er[k], ni = lr * xi + li * xr + ei[k]; xr = nr; xi = ni; }
    }
}

__device__ __forceinline__ void phase_tr_hy(Frame& F) {
    LAS unsigned char* lds = F.lds;
    const bf16* ZT = (const bf16*)(F.ws + WS_YHT); bf16* YCAT = (bf16*)(F.ws + WS_YCAT);
    constexpr int S = 132;
    for (int pass = 0; pass < 2; ++pass) { const int tok0 = F.bid * 128 + pass * 64;
        for (int pc = F.tid; pc < 4096; pc += NTHR) { const int ch = pc >> 3, gq = pc & 7; const u32x4 v = *(const u32x4*)(ZT + (size_t)ch * NTOK + tok0 + 8 * gq);
            LAS unsigned* d = (LAS unsigned*)(lds + ch * S + 16 * gq); d[0] = v.x; d[1] = v.y; d[2] = v.z; d[3] = v.w; }
        __syncthreads();
        for (int it = 0; it < 8; ++it) { const int tok = it * 8 + (F.lane & 7), cg = F.wave * 8 + (F.lane >> 3);
            const LAS unsigned short* s = (const LAS unsigned short*)(lds + (8 * cg) * S + 2 * tok);
            unsigned e[8];
#pragma unroll
            for (int j = 0; j < 8; ++j) e[j] = s[j * (S / 2)];
            u32x4 o; o.x = e[0] | (e[1] << 16); o.y = e[2] | (e[3] << 16); o.z = e[4] | (e[5] << 16); o.w = e[6] | (e[7] << 16);
#ifdef DBG_HY_SCALE
            for (int j = 0; j < 8; ++j) e[j] = f2bf(bf2f(e[j]) * DBG_HY_SCALE);
            o.x = e[0] | (e[1] << 16); o.y = e[2] | (e[3] << 16); o.z = e[4] | (e[5] << 16); o.w = e[6] | (e[7] << 16);
#endif
            *(u32x4*)(YCAT + (size_t)(tok0 + tok) * DM + 8 * cg) = o; }
        __syncthreads();
    }
}

__device__ __forceinline__ void phase_norm2(Frame& F) {
    LAS unsigned char* lds = F.lds;
    LAS unsigned short* WH = (LAS unsigned short*)lds;
    LAS unsigned short* WL = WH + 16384;
    LAS float* GM = (LAS float*)(lds + 65536);
    LAS float* SH = GM + 1024;
    LAS float* red = SH + 1024;
    LAS float* cbs = red + 128;
    const int tid = F.tid, lane = F.lane, wave = F.wave;
    const int b = F.bid >> 5;
    const float* mb = (const float*)(F.ws + WS_MOD) + (size_t)b * (NMOD * DM);
    const float* rw = inptr(F, I_RW); const float* n2g = inptr(F, I_N2G);
    for (int i = tid; i < DM; i += NTHR) { GM[i] = n2g[i] * (mb[4 * DM + i] + 1.0f); SH[i] = mb[3 * DM + i]; }
    __syncthreads();
    float cpart = 0.f;
#pragma unroll 4
    for (int i = 0; i < 32; ++i) { const int idx = tid + 512 * i, k = idx >> 4, e = idx & 15; const float r = rw[idx]; const float w = GM[k] * r; cpart += SH[k] * r;
        const unsigned hi = f2bf(w); const float lo = w - bf2f(hi);
        const int s = k >> 5, kq = (k >> 3) & 3, j = k & 7, o = ((s * 4 + kq) * 16 + e) * 8 + j; WH[o] = (unsigned short)hi; WL[o] = (unsigned short)f2bf(lo); }
    cpart += __shfl_xor(cpart, 16); cpart += __shfl_xor(cpart, 32);
    if (lane < 16) red[wave * 16 + lane] = cpart;
    __syncthreads();
    if (tid < 16) { float c = 0.f; for (int w = 0; w < 8; ++w) c += red[w * 16 + tid]; cbs[tid] = c; }
    __syncthreads();
    const int rr = lane & 15, kq = lane >> 4;
    const int row = F.bid * 128 + wave * 16 + rr;
    const bf16* xrow = (const bf16*)(F.ws + WS_XMID) + (size_t)row * DM + 8 * kq;
    f32x4 acc = (f32x4){0.f, 0.f, 0.f, 0.f}; float ss = 0.f;
#pragma unroll 1
    for (int hb = 0; hb < 2; ++hb) { u32x4 xv[16];
#pragma unroll
        for (int s = 0; s < 16; ++s) xv[s] = *(const u32x4*)(xrow + 32 * (16 * hb + s));
#pragma unroll
        for (int s = 0; s < 16; ++s) { const u32x4 q = xv[s]; const int sg = 16 * hb + s;
            const float e0 = bflo(q.x), e1 = bfhi(q.x), e2 = bflo(q.y), e3 = bfhi(q.y), e4 = bflo(q.z), e5 = bfhi(q.z), e6 = bflo(q.w), e7 = bfhi(q.w);
            ss += ((e0 * e0 + e1 * e1) + (e2 * e2 + e3 * e3)) + ((e4 * e4 + e5 * e5) + (e6 * e6 + e7 * e7));
            const bf16x8 a = __builtin_bit_cast(bf16x8, q);
            const bf16x8 bh = *(const LAS bf16x8*)(WH + ((sg * 4 + kq) * 16 + rr) * 8), bl = *(const LAS bf16x8*)(WL + ((sg * 4 + kq) * 16 + rr) * 8);
            acc = __builtin_amdgcn_mfma_f32_16x16x32_bf16(a, bh, acc, 0, 0, 0); acc = __builtin_amdgcn_mfma_f32_16x16x32_bf16(a, bl, acc, 0, 0, 0);
            if ((s & 3) == 3) asm volatile("" ::: "memory"); } }
    ss += __shfl_xor(ss, 16); ss += __shfl_xor(ss, 32);
    const float rstd = 1.0f / sqrtf(ss * (1.0f / DM) + NORM_EPS);
    {
        const float cb = cbs[rr]; f32x4 p;
#pragma unroll
        for (int i = 0; i < 4; ++i) { const float rs = __shfl(rstd, 4 * kq + i); const float lg = acc[i] * rs + cb; float mx = lg;
#pragma unroll
            for (int o = 1; o < 16; o <<= 1) mx = fmaxf(mx, __shfl_xor(mx, o));
            const float ex = expf(lg - mx); float den = ex;
#pragma unroll
            for (int o = 1; o < 16; o <<= 1) den += __shfl_xor(den, o);
            p[i] = ex / den; }
        float* AFF = (float*)(F.ws + WS_AFF);
        *(f32x4*)(AFF + ((size_t)b * NE + rr) * SEQ + (F.bid & 31) * 128 + wave * 16 + 4 * kq) = p; }
    unsigned char* h2row = F.ws + WS_H2 + (size_t)row * DM + 8 * kq;
#pragma unroll 1
    for (int hb = 0; hb < 2; ++hb) { u32x4 xv[16];
#pragma unroll
        for (int s = 0; s < 16; ++s) xv[s] = *(const u32x4*)(xrow + 32 * (16 * hb + s));
#pragma unroll
        for (int s = 0; s < 16; ++s) { const u32x4 q = xv[s]; const int sg = 16 * hb + s; const LAS f32x4* gp = (const LAS f32x4*)(GM + 32 * sg + 8 * kq); const LAS f32x4* sp = (const LAS f32x4*)(SH + 32 * sg + 8 * kq);
            const f32x4 g0 = gp[0], g1 = gp[1], s0 = sp[0], s1 = sp[1];
            u32x2 o; o.x = pk4_fp8(bflo(q.x) * rstd * g0.x + s0.x, bfhi(q.x) * rstd * g0.y + s0.y, bflo(q.y) * rstd * g0.z + s0.z, bfhi(q.y) * rstd * g0.w + s0.w);
            o.y = pk4_fp8(bflo(q.z) * rstd * g1.x + s1.x, bfhi(q.z) * rstd * g1.y + s1.y, bflo(q.w) * rstd * g1.z + s1.z, bfhi(q.w) * rstd * g1.w + s1.w);
            *(u32x2*)(h2row + 32 * sg) = o; if ((s & 3) == 3) asm volatile("" ::: "memory"); } }
    __syncthreads();
}

__device__ __forceinline__ int block_sum_i(LAS int* red, int v, int wave, int lane, int slot) {
#pragma unroll
    for (int o = 1; o < 64; o <<= 1) v += __shfl_xor(v, o);
    if (lane == 0) red[slot * 8 + wave] = v;
    __syncthreads();
    int s = 0;
#pragma unroll
    for (int w = 0; w < 8; ++w) s += red[slot * 8 + w];
    return s;
}
__device__ __forceinline__ void phase_topk(Frame& F) {
    if (F.bid >= NB * NE) { const int wv = (F.bid - 128) * 8 + F.wave; p_down_items(F, DN_P4 + wv, 10, 8 * 128); return; }
    const int b = F.bid >> 4, e = F.bid & 15, tid = F.tid, lane = F.lane, wave = F.wave;
    LAS int* red = (LAS int*)F.lds;
    LAS int* wtot = red + 16;
    const float* aff = (const float*)(F.ws + WS_AFF) + ((size_t)b * NE + e) * SEQ + 8 * tid;
    unsigned key[8];
#ifndef DBG_PLAIN_AFF
#pragma unroll
    for (int j = 0; j < 8; ++j) key[j] = __hip_atomic_load((const unsigned*)aff + j, __ATOMIC_RELAXED, __HIP_MEMORY_SCOPE_AGENT);
#else
    { const f32x4 a0 = *(const f32x4*)aff, a1 = *(const f32x4*)(aff + 4);
    key[0] = __builtin_bit_cast(unsigned, a0.x); key[1] = __builtin_bit_cast(unsigned, a0.y); key[2] = __builtin_bit_cast(unsigned, a0.z); key[3] = __builtin_bit_cast(unsigned, a0.w);
    key[4] = __builtin_bit_cast(unsigned, a1.x); key[5] = __builtin_bit_cast(unsigned, a1.y); key[6] = __builtin_bit_cast(unsigned, a1.z); key[7] = __builtin_bit_cast(unsigned, a1.w); }
#endif
    unsigned prefix = 0u; int it = 0;
    LAS int* red3 = (LAS int*)F.lds + 64;
    { const unsigned cand = 1u << 30; int c = 0;
#pragma unroll
      for (int j = 0; j < 8; ++j) c += __builtin_popcountll(__ballot(key[j] >= cand));
      if (lane == 0) red[wave] = c;
      __syncthreads();
      int tot = 0;
#pragma unroll
      for (int w2 = 0; w2 < 8; ++w2) tot += red[w2];
      if (tot >= CAP) prefix = cand; }
    for (int bit = 28; bit >= 0; bit -= 2, ++it) { const unsigned c1 = prefix | (1u << bit), c2 = prefix | (2u << bit), c3 = prefix | (3u << bit); int n1 = 0, n2 = 0, n3 = 0;
#pragma unroll
        for (int j = 0; j < 8; ++j) { n1 += __builtin_popcountll(__ballot(key[j] >= c1)); n2 += __builtin_popcountll(__ballot(key[j] >= c2)); n3 += __builtin_popcountll(__ballot(key[j] >= c3)); }
        LAS int* rr = red3 + (it & 1) * 24;
        if (lane == 0) { rr[wave] = n1; rr[8 + wave] = n2; rr[16 + wave] = n3; }
        __syncthreads();
        int t1 = 0, t2 = 0, t3 = 0;
#pragma unroll
        for (int w2 = 0; w2 < 8; ++w2) { t1 += rr[w2]; t2 += rr[8 + w2]; t3 += rr[16 + w2]; }
        prefix = (t3 >= CAP) ? c3 : (t2 >= CAP) ? c2 : (t1 >= CAP) ? c1 : prefix; }
    const unsigned thr = prefix;
    int cgt = 0, ceq = 0;
#pragma unroll
    for (int j = 0; j < 8; ++j) { cgt += (key[j] > thr) ? 1 : 0; ceq += (key[j] == thr) ? 1 : 0; }
    int sg = cgt, se = ceq;
#pragma unroll
    for (int o = 1; o < 64; o <<= 1) { const int tg = __shfl_up(sg, o), te = __shfl_up(se, o); if (lane >= o) { sg += tg; se += te; } }
    __syncthreads();
    if (lane == 63) { wtot[wave] = sg; wtot[8 + wave] = se; }
    __syncthreads();
    int bg = 0, be = 0, totg = 0;
#pragma unroll
    for (int w2 = 0; w2 < 8; ++w2) { const int g2 = wtot[w2], e2 = wtot[8 + w2]; if (w2 < wave) { bg += g2; be += e2; } totg += g2; }
    int rg = bg + sg - cgt, re = be + se - ceq;
    const int need_eq = CAP - totg;
    int* IDX = (int*)(F.ws + WS_IDX); float* GATE = (float*)(F.ws + WS_GATE); int* INV = (int*)(F.ws + WS_INV);
    const size_t rowbase = ((size_t)e * NB + b) * CAP;
    int sl[8];
#pragma unroll
    for (int j = 0; j < 8; ++j) { const int t = 8 * tid + j; int slot = -1;
        if (key[j] > thr) { slot = rg; ++rg; } else if (key[j] == thr) { if (re < need_eq) slot = totg + re; ++re; }
        if (slot >= 0) { IDX[rowbase + slot] = b * SEQ + t; GATE[rowbase + slot] = __builtin_bit_cast(float, key[j]); }
        sl[j] = slot; }
    u32x4* ip = (u32x4*)(INV + ((size_t)b * NE + e) * SEQ + 8 * tid);
    ip[0] = (u32x4){(unsigned)sl[0], (unsigned)sl[1], (unsigned)sl[2], (unsigned)sl[3]}; ip[1] = (u32x4){(unsigned)sl[4], (unsigned)sl[5], (unsigned)sl[6], (unsigned)sl[7]};
}

__device__ __forceinline__ void final_issue(const bf16* Y, int b, unsigned& mask, int myinv, int lo, int lane, unsigned long long (&w)[4][4], float (&fl)[4]) {
#pragma unroll
    for (int q = 0; q < 4; ++q) { int e = 0, s = 0; fl[q] = 0.f;
        if (mask) { e = __builtin_ctz(mask); mask &= mask - 1; s = __shfl(myinv, lo + e); fl[q] = 1.f; }
        const unsigned long long* yr = (const unsigned long long*)(Y + (((size_t)e * NB + b) * CAP + s) * DM) + lane;
#pragma unroll
        for (int j = 0; j < 4; ++j) w[q][j] = yr[64 * j]; }
}
__device__ __forceinline__ void final_add(const unsigned long long (&w)[4][4], const float (&fl)[4], f32x4 (&mo)[4]) {
#pragma unroll
    for (int q = 0; q < 4; ++q)
#pragma unroll
        for (int j = 0; j < 4; ++j) { const unsigned lo = (unsigned)w[q][j], hi = (unsigned)(w[q][j] >> 32); mo[j].x += fl[q] * bflo(lo); mo[j].y += fl[q] * bfhi(lo); mo[j].z += fl[q] * bflo(hi); mo[j].w += fl[q] * bfhi(hi); }
}
__device__ __forceinline__ void final_pair(Frame& F, const bf16* Y, int b, int ra, int inva, int invb, int lo, const f32x4 (&G2)[4], const f32x4 (&FG)[4]) {
    const int lane = F.lane; const int rb = ra + 1;
    const bf16* xm16 = (const bf16*)(F.ws + WS_XMID);
    unsigned k0 = (unsigned)((__ballot(inva >= 0) >> lo) & 0xffffull), k1 = (unsigned)((__ballot(invb >= 0) >> lo) & 0xffffull);
    unsigned long long w0[4][4], w1[4][4]; float f0[4], f1[4];
    final_issue(Y, b, k0, inva, lo, lane, w0, f0);
    final_issue(Y, b, k1, invb, lo, lane, w1, f1);
    f32x4 v0[4], v1[4], m0[4], m1[4];
#pragma unroll
    for (int j = 0; j < 4; ++j) { const u32x2 q0 = ((const u32x2*)(xm16 + (size_t)ra * DM) + lane)[64 * j], q1 = ((const u32x2*)(xm16 + (size_t)rb * DM) + lane)[64 * j];
        v0[j] = (f32x4){bflo(q0.x), bfhi(q0.x), bflo(q0.y), bfhi(q0.y)}; v1[j] = (f32x4){bflo(q1.x), bfhi(q1.x), bflo(q1.y), bfhi(q1.y)}; m0[j] = (f32x4){0.f, 0.f, 0.f, 0.f}; m1[j] = (f32x4){0.f, 0.f, 0.f, 0.f}; }
    final_add(w0, f0, m0); final_add(w1, f1, m1);
    while (k0 | k1) { final_issue(Y, b, k0, inva, lo, lane, w0, f0); final_issue(Y, b, k1, invb, lo, lane, w1, f1); final_add(w0, f0, m0); final_add(w1, f1, m1); }
    float s0 = 0.f, s1 = 0.f;
#pragma unroll
    for (int j = 0; j < 4; ++j) { v0[j] = v0[j] + G2[j] * m0[j] * DBG_MOE_ALPHA; v1[j] = v1[j] + G2[j] * m1[j] * DBG_MOE_ALPHA;
        s0 += (v0[j].x * v0[j].x + v0[j].y * v0[j].y) + (v0[j].z * v0[j].z + v0[j].w * v0[j].w); s1 += (v1[j].x * v1[j].x + v1[j].y * v1[j].y) + (v1[j].z * v1[j].z + v1[j].w * v1[j].w); }
    const float rs0 = 1.0f / sqrtf(wave_sum(s0) * (1.0f / DM) + NORM_EPS), rs1 = 1.0f / sqrtf(wave_sum(s1) * (1.0f / DM) + NORM_EPS);
    f32x4* xr0 = (f32x4*)(F.out + (size_t)ra * DM) + lane; f32x4* xr1 = (f32x4*)(F.out + (size_t)rb * DM) + lane;
#pragma unroll
    for (int j = 0; j < 4; ++j) { xr0[64 * j] = v0[j] * rs0 * FG[j]; xr1[64 * j] = v1[j] * rs1 * FG[j]; }
}
__device__ __forceinline__ void phase_final(Frame& F) {
    const int gw = F.bid * NWAVES + F.wave, lane = F.lane;
    const int b = gw >> 8, t0 = (gw & 255) * 16, row0 = gw * 16;
    const float* mod = (const float*)(F.ws + WS_MOD);
    const bf16* Y = (const bf16*)(F.ws + WS_Y); const int* INV = (const int*)(F.ws + WS_INV);
    const float* fing = inptr(F, I_FING); const float* g2 = mod + (size_t)b * (NMOD * DM) + 5 * DM;
    int val[4];
#pragma unroll
    for (int c = 0; c < 4; ++c) val[c] = (int)__hip_atomic_load((const unsigned*)INV + ((size_t)b * NE + (lane & 15)) * SEQ + t0 + 4 * (lane >> 4) + c, __ATOMIC_RELAXED, __HIP_MEMORY_SCOPE_AGENT);
    f32x4 G2[4], FG[4];
#pragma unroll
    for (int j = 0; j < 4; ++j) { G2[j] = ((const f32x4*)g2)[lane + 64 * j]; FG[j] = ((const f32x4*)fing)[lane + 64 * j]; }
#pragma unroll 1
    for (int q = 0; q < 4; ++q) {
        final_pair(F, Y, b, row0 + 4 * q, val[0], val[1], 16 * q, G2, FG);
        final_pair(F, Y, b, row0 + 4 * q + 2, val[2], val[3], 16 * q, G2, FG);
    }
}

#ifdef DBG_CHECK_MOE
__device__ __forceinline__ void phase_dbg_moe(Frame& F) {
    LAS float* hs = (LAS float*)F.lds;
    LAS float* Hs = hs + 1024;
    LAS float* red = Hs + 2816;
    const int row = (F.bid * 257) & 65535, e = row >> 12, b = (row >> 9) & 7;
    const int tok = ((const int*)(F.ws + WS_IDX))[row]; const float gate = ((const float*)(F.ws + WS_GATE))[row];
    const bf16* H2 = (const bf16*)(F.ws + WS_H2) + (size_t)tok * DM;
    for (int i = F.tid; i < DM; i += NTHR) hs[i] = bf2f(H2[i]);
    __syncthreads();
    const float* Wg = inptr(F, I_WG) + (size_t)e * DM * FF; const float* Wu = inptr(F, I_WU) + (size_t)e * DM * FF; const float* Wd = inptr(F, I_WD) + (size_t)e * FF * DM;
    float e1n = 0.f, e1d = 0.f;
    for (int f = F.tid; f < FF; f += NTHR) { float g = 0.f, u = 0.f;
        for (int k = 0; k < DM; ++k) { g += hs[k] * Wg[(size_t)k * FF + f]; u += hs[k] * Wu[(size_t)k * FF + f]; }
        const float h = siluf_(g) * u; Hs[f] = h;
        const float hb = bf2f(((const bf16*)(F.ws + WS_HB))[(size_t)row * FF + f]); e1n += (hb - h) * (hb - h); e1d += h * h; }
    __syncthreads();
    float e2n = 0.f, e2d = 0.f;
    for (int n = F.tid; n < DM; n += NTHR) { float y = 0.f;
        for (int f = 0; f < FF; ++f) y += Hs[f] * Wd[(size_t)f * DM + n];
        y *= gate; const float yb = bf2f(((const bf16*)(F.ws + WS_Y))[(size_t)row * DM + n]); e2n += (yb - y) * (yb - y); e2d += y * y; }
    const float* aff = (const float*)(F.ws + WS_AFF) + ((size_t)b * NE + e) * SEQ; int cnt = 0;
    for (int t = F.tid; t < SEQ; t += NTHR) cnt += (aff[t] > gate) ? 1 : 0;
    float vals[5] = {e1n, e1d, e2n, e2d, (float)cnt};
#pragma unroll
    for (int q = 0; q < 5; ++q) { const float s2 = wave_sum(vals[q]); if (F.lane == 0) red[F.wave * 5 + q] = s2; }
    __syncthreads();
    if (F.tid == 0) { float t5[5] = {0, 0, 0, 0, 0}; for (int w = 0; w < 8; ++w) for (int q = 0; q < 5; ++q) t5[q] += red[w * 5 + q];
        float* D = (float*)(F.ws + WS_CTL + 65536) + F.bid * 4;
        D[0] = t5[0] / (t5[1] + 1e-30f); D[1] = t5[2] / (t5[3] + 1e-30f); D[2] = (t5[4] >= (float)CAP) ? 1.f : 0.f;
        int dup = 0; const int* IDXs = (const int*)(F.ws + WS_IDX) + ((size_t)e * NB + b) * CAP; for (int q = 0; q < CAP; ++q) dup += (IDXs[q] == tok) ? 1 : 0;
        const int inv = ((const int*)(F.ws + WS_INV))[((size_t)(tok >> 12) * NE + e) * SEQ + (tok & 4095)];
        const int c3 = DBG_C3;
        D[3] = (c3 == 0) ? ((fabsf(aff[tok - b * SEQ] - gate) > 1e-6f) ? 1.f : 0.f) : (c3 == 1) ? (((tok >> 12) != b) ? 1.f : 0.f) : (c3 == 2) ? ((dup != 1) ? 1.f : 0.f) : ((inv != (row & 511)) ? 1.f : 0.f); }
    __syncthreads();
}
__device__ __forceinline__ void phase_dbg_apply(Frame& F) {
    const float* D = (const float*)(F.ws + WS_CTL + 65536);
    int bad[4] = {0, 0, 0, 0};
    for (int k = 0; k < 256; ++k) { if (D[k * 4 + 0] > 1e-3f) ++bad[0]; if (D[k * 4 + 1] > 1e-3f) ++bad[1]; if (D[k * 4 + 2] > 0.5f) ++bad[2]; if (D[k * 4 + 3] > 0.5f) ++bad[3]; }
    int code = 0;
    for (int q = 0; q < 4; ++q) if (((DBG_CHECK_MOE >> q) & 1) && bad[q] > DBG_BAD_THR) code += 1;
    const float sc = 1.0f + 0.5f * (float)code;
    const int gw = F.bid * NWAVES + F.wave, NGW = F.G * NWAVES;
    for (int r = gw; r < NTOK; r += NGW) { f32x4* xr = (f32x4*)(F.out + (size_t)r * DM) + F.lane;
#pragma unroll
        for (int j = 0; j < 4; ++j) xr[64 * j] = xr[64 * j] * sc; }
}
#endif

#ifdef DBG_CHECK_MOE
constexpr int NPHASE = 15;
#else
constexpr int NPHASE = 13;
#endif
__global__ void __launch_bounds__(NTHR, 2) fwd_kernel(Args args) {
    extern __shared__ __attribute__((aligned(16))) unsigned char lds_raw[];
    Frame F;
    F.lds = (LAS unsigned char*)lds_raw;
    F.tid = threadIdx.x; F.lane = F.tid & 63; F.wave = __builtin_amdgcn_readfirstlane(F.tid >> 6);
    F.G = gridDim.x; F.bid = blockIdx.x;
    F.out = args.out; F.ws = args.ws;
    for (int u = F.tid; u < (LDS_BYTES - LDSCTL_OFF) / 4; u += NTHR) ((LAS unsigned*)(F.lds + LDSCTL_OFF))[u] = 0u;
    __syncthreads();
    if (F.tid < 35) { const float* const* tab = args.in; *(LAS unsigned long long*)(F.lds + LDSCTL_OFF + 8 * F.tid) = (unsigned long long)tab[F.tid]; }
    __syncthreads();
    const int lo = args.ph_lo, hi = args.ph_hi;
    const bool single = (hi - lo) > 1;
    XcdBarrier bar; bar.bar = (unsigned*)(args.ws + WS_CTL) + CW_BAR; bar.x = 0; bar.st = nullptr;
    if (single) bar = xcd_barrier_post((unsigned*)(args.ws + WS_CTL) + CW_BAR, (volatile LAS unsigned*)(F.lds + MISC_OFF) + 8);
#ifndef PHASE_MASK
#define PHASE_MASK 0x7fff
#endif
#define IN(k) ((((PHASE_MASK) >> (k)) & 1) && lo <= (k) && (k) < hi)
#ifndef DBG_REPEAT_MASK
#define DBG_REPEAT_MASK 0
#endif
#define SEAM(k) do { if (IN(k) && IN((k) + 1)) xcd_barrier(bar); } while (0)
#define REP(k) for (int rep_ = 0; rep_ < ((((DBG_REPEAT_MASK) >> (k)) & 1) ? 2 : 1); ++rep_)
    LAS unsigned char* ring = F.lds;
    const unsigned char* ws = args.ws;

    REP(0) { if (rep_) xcd_barrier(bar); asm volatile("" : "+v"(F.tid), "+v"(F.lane)); if (IN(0)) { AMPB(10) phase0(F); AMPE(10) } } SEAM(0);
    REP(1) { if (rep_) xcd_barrier(bar); asm volatile("" : "+v"(F.tid), "+v"(F.lane)); if (IN(1)) { AMPB(11) phase1(F); AMPE(11) } } SEAM(1);
    REP(2) { if (rep_) xcd_barrier(bar); asm volatile("" : "+v"(F.tid), "+v"(F.lane)); if (IN(2)) {
        { SchedPlain S; S.T.init(128, 6, F.G, F.bid); S.A = (const char*)(ws + WS_H1); S.B = (const char*)(ws + WS_WINT); S.lda = 2048; S.ldb = 2048; S.kstepA = 128; S.kstepB = 128; S.nt = 16; S.mt = 1 << 20; S.az = 0; S.bz = 0;
          EpiZT E{(bf16*)(ws + WS_ZT)}; gm::gemm_phase<EpiZT, SchedPlain, false>(ring, S, E); }
        __syncthreads();
        { SchedPlain S; S.T.init(136, 2, F.G, F.bid); S.A = (const char*)(ws + WS_H1); S.B = (const char*)(ws + WS_WINT) + (size_t)HYC * 2048; S.lda = 2048; S.ldb = 2048; S.kstepA = 128; S.kstepB = 128; S.nt = 16; S.mt = 1 << 20; S.az = 0; S.bz = 0;
          EpiUG E{(bf16*)(ws + WS_UG)}; gm::gemm_phase<EpiUG, SchedPlain, true>(ring, S, E); }
    } } SEAM(2);
    REP(3) { if (rep_) xcd_barrier(bar); asm volatile("" : "+v"(F.tid), "+v"(F.lane)); if (IN(3)) {
        SchedPlain S; S.T.init(160, 1, F.G, F.bid); S.A = (const char*)(ws + WS_UG); S.B = (const char*)(ws + WS_WAT); S.lda = UCOLS * 2; S.ldb = 1024; S.kstepA = 128; S.kstepB = 128; S.nt = 8; S.mt = 5;
        S.az = (size_t)UROWS * UCOLS * 2; S.bz = (size_t)256 * 1024;
        EpiEB E{(float*)(ws + WS_EB)}; gm::gemm_phase<EpiEB, SchedPlain, true>(ring, S, E);
        if (F.bid >= 160) { const int wv = (F.bid - 160) * 8 + F.wave; p_down_items(F, DN_P4 + DN_P9 + wv, 4, 8 * 96); }
    } } SEAM(3);
    REP(4) { if (rep_) xcd_barrier(bar); asm volatile("" : "+v"(F.tid), "+v"(F.lane)); if (IN(4)) { phase_carry(F); } } SEAM(4);
    REP(5) { if (rep_) xcd_barrier(bar); asm volatile("" : "+v"(F.tid), "+v"(F.lane)); if (IN(5)) {
        { SchedPlain S; S.T.init(128, 2, F.G, F.bid); S.A = (const char*)(ws + WS_UG); S.B = (const char*)(ws + WS_MCT); S.lda = UCOLS * 2; S.ldb = UCOLS * 2; S.kstepA = 128; S.kstepB = 128; S.nt = 12; S.mt = 4;
          S.az = (size_t)UROWS * UCOLS * 2; S.bz = (size_t)512 * UCOLS * 2;
          EpiYS E{(bf16*)(ws + WS_YSG), (const bf16*)(ws + WS_UG), inptr(F, I_S5D)};
#ifndef NO_YS
          gm::gemm_phase<EpiYS, SchedPlain, true>(ring, S, E);
#endif
        }
        __syncthreads();
#ifndef NO_HY
        { AMPB(2) int citer = 0; for (int c = F.bid; c < HYW; c += F.G, ++citer) hyena_channel(F, c, citer); AMPE(2) }
#endif
    } } SEAM(5);
    REP(6) { if (rep_) xcd_barrier(bar); asm volatile("" : "+v"(F.tid), "+v"(F.lane)); if (IN(6)) {
        { SchedGlu S; S.T.init(128, 2, F.G, F.bid); S.A = (const char*)(ws + WS_YSG); S.B = (const char*)(ws + WS_GLUT); S.ldb = 1024; S.kstepA = 4u * 1024u * 512u * 2u; S.kstepB = 128; S.nt = 8;
          EpiGlu E{(bf16*)(ws + WS_YCAT), (const bf16*)(ws + WS_YSG), inptr(F, I_GLUB)}; gm::gemm_phase<EpiGlu, SchedGlu, true>(ring, S, E); }
        __syncthreads();
        phase_tr_hy(F);
    } } SEAM(6);
    REP(7) { if (rep_) xcd_barrier(bar); asm volatile("" : "+v"(F.tid), "+v"(F.lane)); if (IN(7)) {
        SchedPlain S; S.T.init(128, 4, F.G, F.bid); S.A = (const char*)(ws + WS_YCAT); S.B = (const char*)(ws + WS_WOUTT); S.lda = 2048; S.ldb = 2048; S.kstepA = 128; S.kstepB = 128; S.nt = 16; S.mt = 1 << 20; S.az = 0; S.bz = 0;
        EpiXmid E{inptr(F, I_X), (bf16*)(ws + WS_XMID), (const float*)(ws + WS_MOD)}; gm::gemm_phase<EpiXmid, SchedPlain, true>(ring, S, E);
    } } SEAM(7);
    REP(8) { if (rep_) xcd_barrier(bar); asm volatile("" : "+v"(F.tid), "+v"(F.lane)); if (IN(8)) { AMPB(18) phase_norm2(F); AMPE(18) } } SEAM(8);
    REP(9) { if (rep_) xcd_barrier(bar); asm volatile("" : "+v"(F.tid), "+v"(F.lane)); if (IN(9)) { AMPB(19) phase_topk(F); AMPE(19) } } SEAM(9);
    REP(10) { if (rep_) xcd_barrier(bar); asm volatile("" : "+v"(F.tid), "+v"(F.lane)); if (IN(10)) {
        SchedMoe1 S; S.T.init(256, 22, F.G, F.bid); S.A = (const char*)(ws + WS_H2); S.B = (const char*)(ws + WS_WGUT); S.idx = (const int*)(ws + WS_IDX); S.lda = 1024; S.ldb = 1024; S.kstepA = 128; S.kstepB = 128; S.nt = 8;
        EpiMoe1 E{(unsigned char*)(ws + WS_HB)}; gm::gemm_phase_f8<EpiMoe1, SchedMoe1, WGU_E8M0>(ring, S, E);
#if DBG_GM_MODE
        __syncthreads(); gm::gemm_phase_f8<EpiMoe1, SchedMoe1, WGU_E8M0, DBG_GM_MODE>(ring, S, E);
#endif
    } } SEAM(10);
    REP(11) { if (rep_) xcd_barrier(bar); asm volatile("" : "+v"(F.tid), "+v"(F.lane)); if (IN(11)) {
        SchedPlain S; S.T.init(256, 4, F.G, F.bid); S.A = (const char*)(ws + WS_HB); S.B = (const char*)(ws + WS_WDT); S.lda = FF; S.ldb = FF; S.kstepA = 128; S.kstepB = 128; S.nt = 22; S.mt = 16;
        S.az = (size_t)EROWS * FF; S.bz = (size_t)DM * FF;
        EpiMoe2 E{(bf16*)(ws + WS_Y), (const float*)(ws + WS_GATE)}; gm::gemm_phase_f8<EpiMoe2, SchedPlain, WD_E8M0>(ring, S, E);
    } } SEAM(11);
    if (IN(12)) { AMPB(22) phase_final(F); AMPE(22) }
#ifdef DBG_CHECK_MOE
    if (IN(13)) { phase_dbg_moe(F); }
    if (IN(14)) { phase_dbg_apply(F); }
#endif
#undef IN
#undef SEAM
}

#ifndef N_LAUNCHES
#define N_LAUNCHES 1
#endif
extern "C" void kernel_launch(void* const* d_in, const int* in_sizes, int n_in, void* d_out, int out_size, void* d_ws, size_t ws_size, hipStream_t stream) {
    static int grid = 0;
    if (grid == 0) {
        if (n_in != 35 || out_size != NTOK * DM || ws_size < WS_END) { fprintf(stderr, "kernel_launch: unexpected shapes (n_in %d out %d ws %zu)\n", n_in, out_size, ws_size); grid = -1; return; }
        int dev = 0, cus = 0;
        if (hipGetDevice(&dev) != hipSuccess || hipDeviceGetAttribute(&cus, hipDeviceAttributeMultiprocessorCount, dev) != hipSuccess) { grid = -1; return; }
        if (hipFuncSetAttribute((const void*)fwd_kernel, hipFuncAttributeMaxDynamicSharedMemorySize, LDS_BYTES) != hipSuccess) { fprintf(stderr, "kernel_launch: hipFuncSetAttribute failed\n"); grid = -1; return; }
        int per_cu = 0;
        if (hipOccupancyMaxActiveBlocksPerMultiprocessor(&per_cu, (const void*)fwd_kernel, NTHR, LDS_BYTES) != hipSuccess || per_cu < 1) fprintf(stderr, "kernel_launch: occupancy query reports %d\n", per_cu);
        (void)hipGetLastError();
        grid = 256;
        if (cus != 256) fprintf(stderr, "kernel_launch: device has %d CUs, kernel expects 256\n", cus);
    }
    if (grid < 0) return;
    (void)hipMemsetAsync((char*)d_ws + WS_CTL, 0, CTL_ZERO_BYTES, stream);
    Args a{};
    for (int i = 0; i < 35; ++i) a.in[i] = (const float*)d_in[i];
    a.out = (float*)d_out; a.ws = (unsigned char*)d_ws;
    if (N_LAUNCHES == 1) { a.ph_lo = 0; a.ph_hi = NPHASE; hipLaunchKernelGGL(fwd_kernel, dim3(grid), dim3(NTHR), LDS_BYTES, stream, a); }
    else for (int p = 0; p < NPHASE; ++p) { a.ph_lo = p; a.ph_hi = p + 1; hipLaunchKernelGGL(fwd_kernel, dim3(grid), dim3(NTHR), LDS_BYTES, stream, a); }
}
```

```cpp
#ifndef DBG_GM_MODE
#define DBG_GM_MODE 0
#endif
#ifndef DBG_C3
#define DBG_C3 0
#endif
#ifndef DBG_BAD_THR
#define DBG_BAD_THR 16
#endif
#ifndef DBG_MOE_ALPHA
#define DBG_MOE_ALPHA 1.0f
#endif
#include <hip/hip_runtime.h>
#include <cstdio>
#include <cstdint>

#define LAS __attribute__((address_space(3)))
#define GAS __attribute__((address_space(1)))
typedef unsigned short bf16;
typedef short bf16x8 __attribute__((ext_vector_type(8)));
typedef float f32x4 __attribute__((ext_vector_type(4)));
typedef float f32x16 __attribute__((ext_vector_type(16)));
typedef unsigned u32x4 __attribute__((ext_vector_type(4)));
typedef unsigned u32x2 __attribute__((ext_vector_type(2)));
typedef GAS unsigned gu32;

constexpr int NB = 8, SEQ = 4096, DM = 1024, CTXL = 256;
constexpr int NTOK = NB * SEQ, NCTX = NB * CTXL, NROWS1 = NTOK + NCTX;
constexpr int HYW = 512, HYC = 1536, S5W = 512, INC = 2048;
constexpr int NG = 32, GH = 16, NP = 64;
constexpr int CT = 32, NCH = SEQ / CT, NCHC = CTXL / CT;
constexpr int UROWS = 1280, UCOLS = 768;
constexpr int NE = 16, FF = 2816, CAP = 512, EROWS = NB * CAP;
constexpr int NMOD = 6;
constexpr float NORM_EPS = 1e-6f;
constexpr int FLEN = 8448, FC0 = 4224, F8LEN = 8480, F8GS = 8576;

constexpr size_t MiB = 1u << 20;
constexpr size_t WS_CTL = 0, CTL_ZERO_BYTES = 1 * MiB;
constexpr size_t WS_MOD = 1 * MiB;
constexpr size_t WS_LT = WS_MOD + 256 * 1024;
constexpr size_t WS_FH2 = 2 * MiB;
constexpr size_t WS_GLUT = 3 * MiB;
constexpr size_t WS_WINT = 4 * MiB;
constexpr size_t WS_WOUTT = 8 * MiB;
constexpr size_t WS_AFF = 10 * MiB;
constexpr size_t WS_IDX = 12 * MiB;
constexpr size_t WS_GATE = WS_IDX + 256 * 1024;
constexpr size_t WS_INV = 13 * MiB;
constexpr size_t WS_WDT = 16 * MiB;
constexpr size_t WS_WGUT = 104 * MiB;
constexpr size_t WS_Y = WS_WGUT;
constexpr size_t WS_R = 280 * MiB;
constexpr size_t WS_H1 = WS_R;
constexpr size_t WS_ZT = WS_R + 68 * MiB;
constexpr size_t WS_UG = WS_R + 164 * MiB;
constexpr size_t WS_EB = WS_R + 224 * MiB;
constexpr size_t WS_YHT = WS_EB;
constexpr size_t WS_MCT = WS_R + 264 * MiB;
constexpr size_t WS_WAT = WS_R + 288 * MiB;
constexpr size_t WS_FILT = WS_R + 296 * MiB;
constexpr size_t WS_FSC = WS_FILT + (size_t)2 * 512 * 8576;
constexpr size_t WS_VS = WS_R;
constexpr size_t WS_YSG = WS_R + 330 * MiB;
constexpr int S5TAB_FLOATS = (2 * 33 * 64 * 2) + (2 * 64 * 16 * 2) + (2 * 32 * 256) + (2 * 16 * 64 * 2);
constexpr size_t WS_S5TAB = WS_YSG;
constexpr size_t WS_YCAT = WS_R;
constexpr size_t WS_H2 = WS_R;
constexpr size_t WS_HB = WS_R + 64 * MiB;
constexpr size_t WS_XMID = WS_R + 256 * MiB;
constexpr size_t WS_END = WS_R + 416 * MiB;
static_assert(WS_YSG + (size_t)NG * 1024 * 512 * 2 <= WS_END && WS_FILT + (size_t)4 * HYW * FLEN * 2 <= WS_YSG && WS_YCAT + (size_t)NTOK * DM * 2 <= WS_ZT && WS_HB + (size_t)NE * EROWS * FF * 2 <= WS_END, "ws map");

constexpr int CW_BAR = 4096;

constexpr int RING_BYTES = 131072;
constexpr int LDS_BYTES = 163840;
constexpr int LDSCTL_OFF = LDS_BYTES - 1024, MISC_OFF = LDSCTL_OFF + 320;
constexpr int NWAVES = 8, NTHR = 512;

__device__ __forceinline__ unsigned f2bf(float f) { unsigned u = __builtin_bit_cast(unsigned, f); return (u + 0x7fffu + ((u >> 16) & 1u)) >> 16; }
__device__ __forceinline__ unsigned pk2(float lo, float hi) { return f2bf(lo) | (f2bf(hi) << 16); }
__device__ __forceinline__ float bf2f(unsigned b) { return __builtin_bit_cast(float, (b & 0xffffu) << 16); }
__device__ __forceinline__ float bflo(unsigned w) { return __builtin_bit_cast(float, w << 16); }
__device__ __forceinline__ float bfhi(unsigned w) { return __builtin_bit_cast(float, w & 0xffff0000u); }
__device__ __forceinline__ float wave_sum(float v) {
#pragma unroll
    for (int o = 1; o < 64; o <<= 1) v += __shfl_xor(v, o);
    return v;
}
__device__ __forceinline__ float sigmoidf_(float x) { return __builtin_amdgcn_rcpf(1.0f + __builtin_amdgcn_exp2f(fminf(-1.4426950408889634f * x, 80.0f))); }
__device__ __forceinline__ float siluf_(float x) { return x * sigmoidf_(x); }
__device__ __forceinline__ float gelu_tanh(float y) {
    const float u2 = 1.5957691216057308f * (y + 0.044715f * y * y * y);
    return y * sigmoidf_(u2);
}
typedef int i32x8 __attribute__((ext_vector_type(8)));
typedef int i32x4 __attribute__((ext_vector_type(4)));
__device__ __forceinline__ unsigned pk4_fp8(float a, float b, float c, float d) { int w = 0; w = __builtin_amdgcn_cvt_pk_fp8_f32(a, b, w, false); w = __builtin_amdgcn_cvt_pk_fp8_f32(c, d, w, true); return (unsigned)w; }
constexpr float WGU_SCALE = 16.0f, WD_SCALE = 32.0f;
constexpr int WGU_E8M0 = 127 - 4, WD_E8M0 = 127 - 5;
#define LDS_WAIT() asm volatile("s_waitcnt lgkmcnt(0)" ::: "memory")
__device__ __forceinline__ void ld_sc1_x8(const void* p, u32x4& a, u32x4& b) { asm volatile("global_load_dwordx4 %0, %2, off sc1\n\tglobal_load_dwordx4 %1, %2, off offset:16 sc1\n\ts_waitcnt vmcnt(0)" : "=&v"(a), "=&v"(b) : "v"(p) : "memory"); }
__device__ __forceinline__ u32x4 ld_sc1_x4(const void* p) { u32x4 a; asm volatile("global_load_dwordx4 %0, %1, off sc1\n\ts_waitcnt vmcnt(0)" : "=&v"(a) : "v"(p) : "memory"); return a; }
#define VM_WAIT() asm volatile("s_waitcnt vmcnt(0)" ::: "memory")

#define XB_TMO      128
#define XB_XCNT(j)  (256  + 64 * (j))
#define XB_XSUB(j)  (1280 + 64 * (j))
#define XB_XGEN(j)  (2304 + 64 * (j))
#define XB_TOP      3328
#define XB_TOPGEN   3392
#define XCD_BAR_WORDS 3456
#define XB_SPIN_CAP (1u << 22)
__device__ __forceinline__ unsigned xb_ld(unsigned* p)              { return __hip_atomic_load(p, __ATOMIC_RELAXED, __HIP_MEMORY_SCOPE_AGENT); }
__device__ __forceinline__ unsigned xb_add(unsigned* p, unsigned v) { return __hip_atomic_fetch_add(p, v, __ATOMIC_RELAXED, __HIP_MEMORY_SCOPE_AGENT); }
__device__ __forceinline__ unsigned xb_xcc_id() { return (unsigned)__builtin_amdgcn_s_getreg((3 << 11) | 20) & 0xFu; }
#define XB_SPIN(cond, bar) do { unsigned _sp = 0; while (cond) { __builtin_amdgcn_s_sleep(1); \
    if ((++_sp & 255u) == 0u) { if (xb_ld(&(bar)[XB_TMO])) break; if (_sp > XB_SPIN_CAP) { atomicAdd(&(bar)[XB_TMO], 1u); break; } } } } while (0)
struct XcdBarrier { unsigned* bar; unsigned x; volatile LAS unsigned* st; };
__device__ __forceinline__ XcdBarrier xcd_barrier_post(unsigned* bar, volatile LAS unsigned* st) {
    XcdBarrier b; b.bar = bar; b.x = xb_xcc_id(); b.st = st;
    if (threadIdx.x == 0) (void)xb_add(&bar[XB_XCNT(b.x)], 1u);
    return b;
}
__device__ __forceinline__ void xcd_barrier_complete(unsigned* bar, unsigned x, unsigned& nloc, unsigned& nx) {
    const unsigned G = gridDim.x * gridDim.y * gridDim.z;
    unsigned sum, cnt, mine, sp = 0u;
    for (;;) {
        sum = 0u; cnt = 0u; mine = 0u;
#pragma unroll
        for (unsigned j = 0; j < 16; ++j) { const unsigned c = xb_ld(&bar[XB_XCNT(j)]); sum += c; cnt += (c > 0u) ? 1u : 0u; mine = (j == x) ? c : mine; }
        if (sum == G) break;
        __builtin_amdgcn_s_sleep(1);
        if ((++sp & 255u) == 0u) { if (xb_ld(&bar[XB_TMO])) break; if (sp > XB_SPIN_CAP) { atomicAdd(&bar[XB_TMO], 1u); break; } }
    }
    nloc = mine > 0u ? mine : 1u; nx = cnt > 0u ? cnt : 1u;
}
__device__ __forceinline__ void xcd_barrier(const XcdBarrier& b) {
    asm volatile("s_waitcnt vmcnt(0)" ::: "memory");
    __syncthreads();
    if (threadIdx.x == 0) {
        unsigned* bar = b.bar;
        __builtin_amdgcn_s_waitcnt(0);
        unsigned nloc = b.st[0], nx = b.st[1];
        if (nloc == 0u) { xcd_barrier_complete(bar, b.x, nloc, nx); b.st[0] = nloc; b.st[1] = nx; }
        const unsigned old = xb_add(&bar[XB_XSUB(b.x)], 1u);
        const unsigned gen = old / nloc;
        if (old + 1u == (gen + 1u) * nloc) {
            __builtin_amdgcn_fence(__ATOMIC_RELEASE, "agent");
            asm volatile("s_waitcnt vmcnt(0)" ::: "memory");
            const unsigned og = xb_add(&bar[XB_TOP], 1u);
            const unsigned tg = og / nx;
            if (og + 1u == (tg + 1u) * nx) xb_add(&bar[XB_TOPGEN], 1u);
            else XB_SPIN(xb_ld(&bar[XB_TOPGEN]) == tg, bar);
            __builtin_amdgcn_fence(__ATOMIC_ACQUIRE, "agent");
            xb_add(&bar[XB_XGEN(b.x)], 1u);
            asm volatile("s_waitcnt vmcnt(0)" ::: "memory");
        } else {
            XB_SPIN(xb_ld(&bar[XB_XGEN(b.x)]) == gen, bar);
            __builtin_amdgcn_fence(__ATOMIC_ACQUIRE, "agent");
            asm volatile("s_waitcnt vmcnt(0)" ::: "memory");
        }
    }
    __syncthreads();
}

namespace gm {
constexpr int BM = 256, BK = 64, HALF = 128, HTB = HALF * BK * 2, STAGE_BYTES = 8 * HTB, NXCD = 8, WGM = 8;
__host__ __device__ __forceinline__ int lds_byte(int r, int c) { const int st = (r >> 4) * 2 + (c >> 5), rr = r & 15, cc = c & 31, ob = rr * 64 + cc * 2; return st * 1024 + (ob ^ (((ob >> 9) & 1) << 5)); }
__host__ __device__ __forceinline__ void stage_rc(int b, int& R, int& C) { const int st = b / 1024, sb = b % 1024, swz = sb ^ (((sb >> 9) & 1) << 5); R = (st >> 1) * 16 + swz / 64; C = (st & 1) * 32 + (swz % 64) / 2; }
__host__ __device__ __forceinline__ int perm32(int rho) { const int n = rho >> 4, i = rho & 15; return 8 * (i >> 2) + 4 * n + (i & 3); }

struct GUnit { const char* A; const char* B; int pm, pn; };
__device__ __forceinline__ const char* uni_ptr(const char* p) { const unsigned long long v = (unsigned long long)p; const unsigned lo = __builtin_amdgcn_readfirstlane((unsigned)v), hi = __builtin_amdgcn_readfirstlane((unsigned)(v >> 32));
    return (const char*)(const GAS char*)(((unsigned long long)hi << 32) | lo); }

struct TileOrder {
    int nM, nN, nwg, G, c;
    __device__ __forceinline__ void init(int nM_, int nN_, int G_, int c_) { nM = nM_; nN = nN_; nwg = nM * nN; G = G_; c = c_; }
    __device__ __forceinline__ bool get(int i, int& pm, int& pn) const {
        const long L = (long)i * G + c; if (L >= nwg) return false;
        int wgid = (int)L; { const int q = nwg / NXCD, r = nwg % NXCD, xcd = wgid % NXCD, off = wgid / NXCD; wgid = (xcd < r ? xcd * (q + 1) : r * (q + 1) + (xcd - r) * q) + off; }
        const int nig = WGM * nN, gid = wgid / nig, fm = gid * WGM, gsz = (nM - fm) < WGM ? (nM - fm) : WGM;
        pm = fm + ((wgid % nig) % gsz); pn = (wgid % nig) / gsz; return true;
    }
};

__device__ __forceinline__ unsigned cvt_pk_bf16(float lo, float hi) { unsigned r; asm volatile("v_cvt_pk_bf16_f32 %0, %1, %2" : "=v"(r) : "v"(lo), "v"(hi)); return r; }

template <class Epi, class Sched, bool TR>
__device__ __forceinline__ void gemm_phase(LAS unsigned char* lds, const Sched& S, const Epi& E) {
    int tid = threadIdx.x; asm volatile("" : "+v"(tid));
    const int wid = __builtin_amdgcn_readfirstlane(tid >> 6), lane = tid & 63, wr = wid >> 2, wc = wid & 3, fr = lane & 15, fq = lane >> 4;
    const int nt = S.nt;
    int sR0, sC0, sR1, sC1; stage_rc(tid * 16, sR0, sC0); stage_rc(tid * 16 + 8192, sR1, sC1);
    const unsigned vB0 = (unsigned)(Epi::PERM ? ((sR0 & ~31) + perm32(sR0 & 31)) : sR0) * S.ldb + (unsigned)sC0 * 2u;
    const unsigned vB1 = (unsigned)(Epi::PERM ? ((sR1 & ~31) + perm32(sR1 & 31)) : sR1) * S.ldb + (unsigned)sC1 * 2u;
    const size_t kA = S.kstepA, kB = S.kstepB;
    const size_t hstepB = (size_t)HALF * S.ldb;
    const unsigned ldsw = (unsigned)wid * 1024u;
    const int aoff = lds_byte(wr * 64 + fr, fq * 8), boff = lds_byte(wc * 32 + fr, fq * 8);
#define PG8_SA(b, h) (((b) * 2 + (h)) * HTB)
#define PG8_SB(b, h) ((4 + (b) * 2 + (h)) * HTB)
#define PG8_STAGE(bufoff, gbase, o0, o1) do { \
        __builtin_amdgcn_global_load_lds((const unsigned*)((const char*)(gbase) + (o0)), (LAS unsigned*)(lds + (bufoff) + ldsw), 16, 0, 0); \
        __builtin_amdgcn_global_load_lds((const unsigned*)((const char*)(gbase) + (o1)), (LAS unsigned*)(lds + (bufoff) + ldsw + 8192), 16, 0, 0); } while (0)
#define PG8_LDA(dst, b, h) do { _Pragma("unroll") for (int m = 0; m < 4; ++m) _Pragma("unroll") for (int k = 0; k < 2; ++k) dst[m][k] = *(const LAS bf16x8*)(lds + PG8_SA(b, h) + aoff + m * 2048 + k * 1024); } while (0)
#define PG8_LDB(dst, b, h) do { _Pragma("unroll") for (int n = 0; n < 2; ++n) _Pragma("unroll") for (int k = 0; k < 2; ++k) dst[n][k] = *(const LAS bf16x8*)(lds + PG8_SB(b, h) + boff + n * 2048 + k * 1024); } while (0)
#define PG8_MMA(ai, bj, At, Bt) do { __builtin_amdgcn_s_setprio(1); _Pragma("unroll") for (int m = 0; m < 4; ++m) _Pragma("unroll") for (int n = 0; n < 2; ++n) _Pragma("unroll") for (int k = 0; k < 2; ++k) \
        acc[ai][bj][m][n] = TR ? __builtin_amdgcn_mfma_f32_16x16x32_bf16(Bt[n][k], At[m][k], acc[ai][bj][m][n], 0, 0, 0) \
                               : __builtin_amdgcn_mfma_f32_16x16x32_bf16(At[m][k], Bt[n][k], acc[ai][bj][m][n], 0, 0, 0); __builtin_amdgcn_s_setprio(0); } while (0)
#define PG8_WAIT_V(n) asm volatile("s_waitcnt vmcnt(" #n ")" ::: "memory")
#define PG8_WAIT_L(n) asm volatile("s_waitcnt lgkmcnt(" #n ")" ::: "memory")
#define PG8_BAR __builtin_amdgcn_s_barrier()
#define PG8_SCHED __builtin_amdgcn_sched_barrier(0)
    GUnit cur, nxt; int ui = 0;
    if (!S.next(0, cur)) return;
    f32x4 acc[2][2][4][2];
#pragma unroll
    for (int a = 0; a < 2; ++a)
#pragma unroll
        for (int b = 0; b < 2; ++b)
#pragma unroll
            for (int m = 0; m < 4; ++m)
#pragma unroll
                for (int n = 0; n < 2; ++n) acc[a][b][m][n] = (f32x4){0.f, 0.f, 0.f, 0.f};
    bf16x8 At[4][2], B0[2][2], B1[2][2];
    unsigned c00 = S.aoff(cur, sR0, sC0), c01 = S.aoff(cur, sR1, sC1), c10 = S.aoff(cur, HALF + sR0, sC0), c11 = S.aoff(cur, HALF + sR1, sC1);
    const char* cA = uni_ptr(cur.A); const char* cB = uni_ptr(cur.B);
    PG8_STAGE(PG8_SB(0, 0), cB, vB0, vB1); PG8_STAGE(PG8_SB(0, 1), cB + hstepB, vB0, vB1); PG8_STAGE(PG8_SA(0, 0), cA, c00, c01); PG8_STAGE(PG8_SA(0, 1), cA, c10, c11);
    if (wr == 1) PG8_BAR;
    PG8_WAIT_V(2); PG8_BAR;
    PG8_STAGE(PG8_SB(1, 0), cB + kB, vB0, vB1); PG8_STAGE(PG8_SA(1, 0), cA + kA, c00, c01); PG8_STAGE(PG8_SB(1, 1), cB + hstepB + kB, vB0, vB1);
    PG8_WAIT_V(6); PG8_BAR;
    for (;;) {
        const bool has_next = S.next(ui + 1, nxt);
        if (!has_next) nxt = cur;
        const char* nA = uni_ptr(nxt.A); const char* nB = uni_ptr(nxt.B);
        unsigned n00 = c00, n01 = c01, n10 = c10, n11 = c11;
        if (!Sched::AOFF_PM_ONLY || nxt.pm != cur.pm) { n00 = S.aoff(nxt, sR0, sC0); n01 = S.aoff(nxt, sR1, sC1); n10 = S.aoff(nxt, HALF + sR0, sC0); n11 = S.aoff(nxt, HALF + sR1, sC1); }
        for (int t = 0; t < nt; t += 2) {
            const bool last = (t == nt - 2);
            const char* a1 = cA + (size_t)(t + 1) * kA;
            const char* a2 = last ? nA : cA + (size_t)(t + 2) * kA; const char* b2 = last ? nB : cB + (size_t)(t + 2) * kB;
            const char* a3 = a2 + kA; const char* b3 = b2 + kB;
            const unsigned x00 = last ? n00 : c00, x01 = last ? n01 : c01, x10 = last ? n10 : c10, x11 = last ? n11 : c11;
            PG8_LDB(B0, 0, 0); PG8_LDB(B1, 0, 1); PG8_SCHED; PG8_LDA(At, 0, 0); PG8_STAGE(PG8_SA(1, 1), a1, c10, c11);
            PG8_WAIT_V(8); PG8_WAIT_L(0); PG8_BAR; PG8_MMA(0, 0, At, B0); PG8_MMA(0, 1, At, B1); PG8_BAR; PG8_SCHED;
            PG8_LDA(At, 0, 1); PG8_STAGE(PG8_SB(0, 0), b2, vB0, vB1); PG8_STAGE(PG8_SB(0, 1), b2 + hstepB, vB0, vB1); PG8_STAGE(PG8_SA(0, 0), a2, x00, x01);
            PG8_WAIT_V(8); PG8_WAIT_L(0); PG8_BAR; PG8_MMA(1, 0, At, B0); PG8_MMA(1, 1, At, B1); PG8_BAR; PG8_SCHED;
            PG8_LDB(B0, 1, 0); PG8_LDB(B1, 1, 1); PG8_SCHED; PG8_LDA(At, 1, 0); PG8_STAGE(PG8_SA(0, 1), a2, x10, x11);
            PG8_WAIT_V(8); PG8_WAIT_L(0); PG8_BAR; PG8_MMA(0, 0, At, B0); PG8_MMA(0, 1, At, B1); PG8_BAR; PG8_SCHED;
            PG8_LDA(At, 1, 1); PG8_STAGE(PG8_SB(1, 0), b3, vB0, vB1); PG8_STAGE(PG8_SB(1, 1), b3 + hstepB, vB0, vB1); PG8_STAGE(PG8_SA(1, 0), a3, x00, x01);
            PG8_WAIT_V(8); PG8_WAIT_L(0); PG8_BAR; PG8_MMA(1, 0, At, B0); PG8_MMA(1, 1, At, B1); PG8_BAR; PG8_SCHED;
        }
        if (wr == 0) PG8_BAR;
        E(acc, cur, wr, wc, fr, fq);
        if (!has_next) break;
#pragma unroll
        for (int a = 0; a < 2; ++a)
#pragma unroll
            for (int b = 0; b < 2; ++b)
#pragma unroll
                for (int m = 0; m < 4; ++m)
#pragma unroll
                    for (int n = 0; n < 2; ++n) acc[a][b][m][n] = (f32x4){0.f, 0.f, 0.f, 0.f};
        cur = nxt; cA = nA; cB = nB; ++ui;
        c00 = n00; c01 = n01; c10 = n10; c11 = n11;
        if (wr == 1) PG8_BAR;
    }
    PG8_WAIT_V(0);
    PG8_BAR;
#undef PG8_SA
#undef PG8_SB
#undef PG8_STAGE
#undef PG8_LDA
#undef PG8_LDB
#undef PG8_MMA
#undef PG8_WAIT_V
#undef PG8_WAIT_L
#undef PG8_BAR
#undef PG8_SCHED
}
template <class Epi, class Sched, int SCALE_B, int MODE = 0>
__device__ __forceinline__ void gemm_phase_f8(LAS unsigned char* lds, const Sched& S, const Epi& E) {
    int tid = threadIdx.x; asm volatile("" : "+v"(tid));
    const int wid = __builtin_amdgcn_readfirstlane(tid >> 6), lane = tid & 63, wr = wid >> 2, wc = wid & 3, fr = lane & 15, fq = lane >> 4;
    const int nt = S.nt;
    int scA = 127, scB = SCALE_B; asm volatile("" : "+v"(scA), "+v"(scB));
    int sR0, sC0, sR1, sC1; stage_rc(tid * 16, sR0, sC0); stage_rc(tid * 16 + 8192, sR1, sC1);
    const unsigned vB0 = (unsigned)(Epi::PERM ? ((sR0 & ~31) + perm32(sR0 & 31)) : sR0) * S.ldb + (unsigned)sC0 * 2u;
    const unsigned vB1 = (unsigned)(Epi::PERM ? ((sR1 & ~31) + perm32(sR1 & 31)) : sR1) * S.ldb + (unsigned)sC1 * 2u;
    const size_t kA = S.kstepA, kB = S.kstepB;
    const size_t hstepB = (size_t)HALF * S.ldb;
    const unsigned ldsw = (unsigned)wid * 1024u;
    const int aoff = lds_byte(wr * 64 + fr, fq * 8), aoff2 = lds_byte(wr * 64 + fr, fq * 8 + 32), boff = lds_byte(wc * 32 + fr, fq * 8), boff2 = lds_byte(wc * 32 + fr, fq * 8 + 32);
#define PG8_SA(b, h) (((b) * 2 + (h)) * HTB)
#define PG8_SB(b, h) ((4 + (b) * 2 + (h)) * HTB)
#define PG8_STAGE(bufoff, gbase, o0, o1) do { if (MODE == 2) break; \
        __builtin_amdgcn_global_load_lds((const unsigned*)((const char*)(gbase) + (o0)), (LAS unsigned*)(lds + (bufoff) + ldsw), 16, 0, 0); \
        __builtin_amdgcn_global_load_lds((const unsigned*)((const char*)(gbase) + (o1)), (LAS unsigned*)(lds + (bufoff) + ldsw + 8192), 16, 0, 0); } while (0)
#define PG8_LDA(dst, b, h) do { _Pragma("unroll") for (int m = 0; m < 4; ++m) dst[m] = __builtin_shufflevector(*(const LAS i32x4*)(lds + PG8_SA(b, h) + aoff + m * 2048), *(const LAS i32x4*)(lds + PG8_SA(b, h) + aoff2 + m * 2048), 0, 1, 2, 3, 4, 5, 6, 7); } while (0)
#define PG8_LDB(dst, b, h) do { _Pragma("unroll") for (int n = 0; n < 2; ++n) dst[n] = __builtin_shufflevector(*(const LAS i32x4*)(lds + PG8_SB(b, h) + boff + n * 2048), *(const LAS i32x4*)(lds + PG8_SB(b, h) + boff2 + n * 2048), 0, 1, 2, 3, 4, 5, 6, 7); } while (0)
#define PG8_F8(FRG) (i32x8){(int)FRG[0][0], (int)FRG[0][1], (int)FRG[0][2], (int)FRG[0][3], (int)FRG[1][0], (int)FRG[1][1], (int)FRG[1][2], (int)FRG[1][3]}
#define PG8_MMA(ai, bj, At, Bt) do { __builtin_amdgcn_s_setprio(1); _Pragma("unroll") for (int m = 0; m < 4; ++m) _Pragma("unroll") for (int n = 0; n < 2; ++n) \
        { if (MODE == 1) asm volatile("" : "+v"(acc[ai][bj][m][n]) : "v"(Bt[n]), "v"(At[m]), "v"(scB), "v"(scA)); else asm volatile("v_mfma_scale_f32_16x16x128_f8f6f4 %0, %1, %2, %0, %3, %4 op_sel_hi:[0,0,0]" : "+v"(acc[ai][bj][m][n]) : "v"(Bt[n]), "v"(At[m]), "v"(scB), "v"(scA)); } __builtin_amdgcn_s_setprio(0); } while (0)
#define PG8_WAIT_V(n) asm volatile("s_waitcnt vmcnt(" #n ")" ::: "memory")
#define PG8_WAIT_L(n) asm volatile("s_waitcnt lgkmcnt(" #n ")" ::: "memory")
#define PG8_BAR __builtin_amdgcn_s_barrier()
#define PG8_SCHED __builtin_amdgcn_sched_barrier(0)
    GUnit cur, nxt; int ui = 0;
    if (!S.next(0, cur)) return;
    f32x4 acc[2][2][4][2];
#pragma unroll
    for (int a = 0; a < 2; ++a)
#pragma unroll
        for (int b = 0; b < 2; ++b)
#pragma unroll
            for (int m = 0; m < 4; ++m)
#pragma unroll
                for (int n = 0; n < 2; ++n) acc[a][b][m][n] = (f32x4){0.f, 0.f, 0.f, 0.f};
    i32x8 At[4], B0[2], B1[2];
    unsigned c00 = S.aoff(cur, sR0, sC0), c01 = S.aoff(cur, sR1, sC1), c10 = S.aoff(cur, HALF + sR0, sC0), c11 = S.aoff(cur, HALF + sR1, sC1);
    const char* cA = uni_ptr(cur.A); const char* cB = uni_ptr(cur.B);
    PG8_STAGE(PG8_SB(0, 0), cB, vB0, vB1); PG8_STAGE(PG8_SB(0, 1), cB + hstepB, vB0, vB1); PG8_STAGE(PG8_SA(0, 0), cA, c00, c01); PG8_STAGE(PG8_SA(0, 1), cA, c10, c11);
    if (wr == 1) PG8_BAR;
    PG8_WAIT_V(2); PG8_BAR;
    PG8_STAGE(PG8_SB(1, 0), cB + kB, vB0, vB1); PG8_STAGE(PG8_SA(1, 0), cA + kA, c00, c01); PG8_STAGE(PG8_SB(1, 1), cB + hstepB + kB, vB0, vB1);
    PG8_WAIT_V(6); PG8_BAR;
    for (;;) {
        const bool has_next = S.next(ui + 1, nxt);
        if (!has_next) nxt = cur;
        const char* nA = uni_ptr(nxt.A); const char* nB = uni_ptr(nxt.B);
        unsigned n00 = c00, n01 = c01, n10 = c10, n11 = c11;
        if constexpr (!Sched::AOFF_CONST) { if (!Sched::AOFF_PM_ONLY || nxt.pm != cur.pm) { n00 = S.aoff(nxt, sR0, sC0); n01 = S.aoff(nxt, sR1, sC1); n10 = S.aoff(nxt, HALF + sR0, sC0); n11 = S.aoff(nxt, HALF + sR1, sC1); } }
        for (int t = 0; t < nt; t += 2) {
            const bool last = (t == nt - 2);
            const char* a1 = cA + (size_t)(t + 1) * kA;
            const char* a2 = last ? nA : cA + (size_t)(t + 2) * kA; const char* b2 = last ? nB : cB + (size_t)(t + 2) * kB;
            const char* a3 = a2 + kA; const char* b3 = b2 + kB;
            const unsigned x00 = (!Sched::AOFF_CONST && last) ? n00 : c00, x01 = (!Sched::AOFF_CONST && last) ? n01 : c01, x10 = (!Sched::AOFF_CONST && last) ? n10 : c10, x11 = (!Sched::AOFF_CONST && last) ? n11 : c11;
            PG8_LDB(B0, 0, 0); PG8_LDB(B1, 0, 1); PG8_SCHED; PG8_LDA(At, 0, 0); PG8_STAGE(PG8_SA(1, 1), a1, c10, c11);
            PG8_WAIT_V(8); PG8_WAIT_L(0); PG8_BAR; PG8_MMA(0, 0, At, B0); PG8_MMA(0, 1, At, B1); PG8_BAR; PG8_SCHED;
            PG8_LDA(At, 0, 1); PG8_STAGE(PG8_SB(0, 0), b2, vB0, vB1); PG8_STAGE(PG8_SB(0, 1), b2 + hstepB, vB0, vB1); PG8_STAGE(PG8_SA(0, 0), a2, x00, x01);
            PG8_WAIT_V(8); PG8_WAIT_L(0); PG8_BAR; PG8_MMA(1, 0, At, B0); PG8_MMA(1, 1, At, B1); PG8_BAR; PG8_SCHED;
            PG8_LDB(B0, 1, 0); PG8_LDB(B1, 1, 1); PG8_SCHED; PG8_LDA(At, 1, 0); PG8_STAGE(PG8_SA(0, 1), a2, x10, x11);
            PG8_WAIT_V(8); PG8_WAIT_L(0); PG8_BAR; PG8_MMA(0, 0, At, B0); PG8_MMA(0, 1, At, B1); PG8_BAR; PG8_SCHED;
            PG8_LDA(At, 1, 1); PG8_STAGE(PG8_SB(1, 0), b3, vB0, vB1); PG8_STAGE(PG8_SB(1, 1), b3 + hstepB, vB0, vB1); PG8_STAGE(PG8_SA(1, 0), a3, x00, x01);
            PG8_WAIT_V(8); PG8_WAIT_L(0); PG8_BAR; PG8_MMA(1, 0, At, B0); PG8_MMA(1, 1, At, B1); PG8_BAR; PG8_SCHED;
        }
        if (wr == 0) PG8_BAR;
        asm volatile("s_nop 15\n\ts_nop 15" ::: "memory");
        if (MODE == 0) E(acc, cur, wr, wc, fr, fq); else asm volatile("" :: "v"(acc[0][0][0][0]), "v"(acc[1][1][3][1]));
        if (!has_next) break;
#pragma unroll
        for (int a = 0; a < 2; ++a)
#pragma unroll
            for (int b = 0; b < 2; ++b)
#pragma unroll
                for (int m = 0; m < 4; ++m)
#pragma unroll
                    for (int n = 0; n < 2; ++n) acc[a][b][m][n] = (f32x4){0.f, 0.f, 0.f, 0.f};
        cur = nxt; cA = nA; cB = nB; ++ui;
        c00 = n00; c01 = n01; c10 = n10; c11 = n11;
        if (wr == 1) PG8_BAR;
    }
    PG8_WAIT_V(0);
    PG8_BAR;
#undef PG8_SA
#undef PG8_SB
#undef PG8_STAGE
#undef PG8_LDA
#undef PG8_LDB
#undef PG8_MMA
#undef PG8_F8
#undef PG8_WAIT_V
#undef PG8_WAIT_L
#undef PG8_BAR
#undef PG8_SCHED
}
}

struct Args { const float* in[35]; float* out; unsigned char* ws; int ph_lo, ph_hi; };
struct Frame {
    LAS unsigned char* lds;
    int tid, lane, wave, G, bid;
    float* out; unsigned char* ws;
};
__device__ __forceinline__ const float* inptr(const Frame& F, int i) {
    const LAS unsigned* t = (const LAS unsigned*)(F.lds + LDSCTL_OFF) + 2 * i;
    const unsigned lo = __builtin_amdgcn_readfirstlane(t[0]), hi = __builtin_amdgcn_readfirstlane(t[1]);
    const GAS float* g = (const GAS float*)(((unsigned long long)hi << 32) | lo);
    return (const float*)g;
}
enum { I_X = 0, I_C, I_CTX, I_CCTX, I_MODW, I_MODB, I_N1G, I_N2G, I_WIN, I_WOUT, I_CONVW, I_CONVB, I_HW1, I_HB1, I_HFREQ, I_HW2, I_HB2, I_HW3, I_HB3, I_HBIAS,
       I_LRE, I_LIM, I_LSTEP, I_BRE, I_BIM, I_CRE, I_CIM, I_S5D, I_GLUW, I_GLUB, I_RW, I_WG, I_WU, I_WD, I_FING };

struct SchedPlain {
    static constexpr bool AOFF_PM_ONLY = true, AOFF_CONST = true;
    gm::TileOrder T; const char* A; const char* B; unsigned lda, ldb, kstepA, kstepB; int nt; int mt; size_t az, bz;
    __device__ __forceinline__ bool next(int i, gm::GUnit& u) const {
        int pm, pn; if (!T.get(i, pm, pn)) return false; const int z = pm / mt, pl = pm - z * mt;
        u.pm = pm; u.pn = pn; u.A = A + (size_t)z * az + (size_t)pl * 256 * lda; u.B = B + (size_t)z * bz + (size_t)pn * 256 * ldb; return true; }
    __device__ __forceinline__ unsigned aoff(const gm::GUnit&, int row, int col) const { return (unsigned)row * lda + (unsigned)col * 2u; }
};
struct SchedMoe1 {
    static constexpr bool AOFF_PM_ONLY = true, AOFF_CONST = false;
    gm::TileOrder T; const char* A; const char* B; const int* idx; unsigned lda, ldb, kstepA, kstepB; int nt;
    __device__ __forceinline__ bool next(int i, gm::GUnit& u) const {
        int pm, pn; if (!T.get(i, pm, pn)) return false; const int e = pm >> 4;
        u.pm = pm; u.pn = pn; u.A = A; u.B = B + ((size_t)e * (2 * FF) + (size_t)pn * 256) * ldb; return true; }
    __device__ __forceinline__ unsigned aoff(const gm::GUnit& u, int row, int col) const { const int tok = idx[u.pm * 256 + row]; return (unsigned)tok * lda + (unsigned)col * 2u; }
};
struct SchedGlu {
    static constexpr bool AOFF_PM_ONLY = true;
    gm::TileOrder T; const char* A; const char* B; unsigned ldb, kstepA, kstepB; int nt;
    __device__ __forceinline__ bool next(int i, gm::GUnit& u) const {
        int pm, pn; if (!T.get(i, pm, pn)) return false;
        u.pm = pm; u.pn = pn; u.A = A + (size_t)pm * 256 * 32; u.B = B + (size_t)pn * 256 * ldb; return true; }
    __device__ __forceinline__ unsigned aoff(const gm::GUnit&, int row, int col) const { return (unsigned)(col >> 4) * (unsigned)(1024 * 512 * 2) + (unsigned)row * 32u + (unsigned)(col & 15) * 2u; }
};

using gm::GUnit; using gm::cvt_pk_bf16;
struct EpiZT { static constexpr bool PERM = false; bf16* ZT;
    __device__ __forceinline__ void operator()(const f32x4 (&acc)[2][2][4][2], const GUnit& u, int wr, int wc, int fr, int fq) const {
#pragma unroll
        for (int bj = 0; bj < 2; ++bj)
#pragma unroll
            for (int n = 0; n < 2; ++n) { const int ch = u.pn * 256 + bj * 128 + wc * 32 + n * 16 + fr; bf16* rowp = ZT + (size_t)ch * NTOK + u.pm * 256 + wr * 64 + 4 * fq;
#pragma unroll
                for (int ai = 0; ai < 2; ++ai)
#pragma unroll
                    for (int m = 0; m < 4; ++m) { const f32x4 v = acc[ai][bj][m][n]; u32x2 w; w.x = cvt_pk_bf16(v[0], v[1]); w.y = cvt_pk_bf16(v[2], v[3]); *(u32x2*)(rowp + ai * 128 + m * 16) = w; } }
    }
};
struct EpiUG { static constexpr bool PERM = true; bf16* UG;
    __device__ __forceinline__ void operator()(const f32x4 (&acc)[2][2][4][2], const GUnit& u, int wr, int wc, int fr, int fq) const {
#pragma unroll
        for (int ai = 0; ai < 2; ++ai)
#pragma unroll
            for (int m = 0; m < 4; ++m) { const int r = u.pm * 256 + ai * 128 + wr * 64 + m * 16 + fr; int crow, tau;
                if (r < NTOK) { crow = r >> 5; tau = r & 31; } else { const int rc = r - NTOK; crow = 1024 + (rc >> 5); tau = rc & 31; }
#pragma unroll
                for (int bj = 0; bj < 2; ++bj) { const int c0 = u.pn * 256 + bj * 128 + wc * 32 + 8 * fq; const int g = c0 >> 4, h0 = c0 & 15;
                    const f32x4 v0 = acc[ai][bj][m][0], v1 = acc[ai][bj][m][1]; u32x4 w; w.x = cvt_pk_bf16(v0[0], v0[1]); w.y = cvt_pk_bf16(v0[2], v0[3]); w.z = cvt_pk_bf16(v1[0], v1[1]); w.w = cvt_pk_bf16(v1[2], v1[3]);
                    *(u32x4*)(UG + ((size_t)g * UROWS + crow) * UCOLS + tau * 16 + h0) = w; } }
    }
};
struct EpiEB { static constexpr bool PERM = false; float* EB;
    __device__ __forceinline__ void operator()(const f32x4 (&acc)[2][2][4][2], const GUnit& u, int wr, int wc, int fr, int fq) const {
        const int g = u.pm / 5, pl = u.pm - g * 5;
#pragma unroll
        for (int ai = 0; ai < 2; ++ai)
#pragma unroll
            for (int m = 0; m < 4; ++m) { float* rowp = EB + ((size_t)g * UROWS + pl * 256 + ai * 128 + wr * 64 + m * 16 + fr) * 256 + wc * 32 + 4 * fq;
#pragma unroll
                for (int bj = 0; bj < 2; ++bj)
#pragma unroll
                    for (int n = 0; n < 2; ++n) *(f32x4*)(rowp + bj * 128 + n * 16) = acc[ai][bj][m][n]; }
    }
};
struct EpiYS { static constexpr bool PERM = true; bf16* YSG; const bf16* UG; const float* s5d;
    __device__ __forceinline__ void operator()(const f32x4 (&acc)[2][2][4][2], const GUnit& u, int wr, int wc, int fr, int fq) const {
        const int g = u.pm >> 2, pl = u.pm & 3;
        float dv[2][8];
#pragma unroll
        for (int bj = 0; bj < 2; ++bj) { const int c0 = u.pn * 256 + bj * 128 + wc * 32 + 8 * fq;
#pragma unroll
            for (int j = 0; j < 8; ++j) dv[bj][j] = s5d[g * 16 + ((c0 + j) & 15)]; }
        u32x4 uq[2][4][2];
#pragma unroll
        for (int ai = 0; ai < 2; ++ai)
#pragma unroll
            for (int m = 0; m < 4; ++m) { const int crow = pl * 256 + ai * 128 + wr * 64 + m * 16 + fr;
#pragma unroll
                for (int bj = 0; bj < 2; ++bj) uq[ai][m][bj] = *(const u32x4*)(UG + ((size_t)g * UROWS + crow) * UCOLS + u.pn * 256 + bj * 128 + wc * 32 + 8 * fq); }
#pragma unroll
        for (int ai = 0; ai < 2; ++ai)
#pragma unroll
            for (int m = 0; m < 4; ++m) { const int crow = pl * 256 + ai * 128 + wr * 64 + m * 16 + fr;
#pragma unroll
                for (int bj = 0; bj < 2; ++bj) { const int c0 = u.pn * 256 + bj * 128 + wc * 32 + 8 * fq;
                    const u32x4 uu = uq[ai][m][bj];
                    const f32x4 v0 = acc[ai][bj][m][0], v1 = acc[ai][bj][m][1];
                    float y[8]; y[0] = v0[0] + dv[bj][0] * bflo(uu.x); y[1] = v0[1] + dv[bj][1] * bfhi(uu.x); y[2] = v0[2] + dv[bj][2] * bflo(uu.y); y[3] = v0[3] + dv[bj][3] * bfhi(uu.y);
                    y[4] = v1[0] + dv[bj][4] * bflo(uu.z); y[5] = v1[1] + dv[bj][5] * bfhi(uu.z); y[6] = v1[2] + dv[bj][6] * bflo(uu.w); y[7] = v1[3] + dv[bj][7] * bfhi(uu.w);
#pragma unroll
                    for (int j = 0; j < 8; ++j) y[j] = gelu_tanh(y[j]);
                    u32x4 w; w.x = cvt_pk_bf16(y[0], y[1]); w.y = cvt_pk_bf16(y[2], y[3]); w.z = cvt_pk_bf16(y[4], y[5]); w.w = cvt_pk_bf16(y[6], y[7]);
                    *(u32x4*)(YSG + ((size_t)g * 1024 + crow) * 512 + c0) = w; } }
    }
};
struct EpiGlu { static constexpr bool PERM = true; bf16* YCAT; const bf16* YSG; const float* glub;
    __device__ __forceinline__ void operator()(const f32x4 (&acc)[2][2][4][2], const GUnit& u, int wr, int wc, int fr, int fq) const {
#pragma unroll
        for (int bj = 0; bj < 2; ++bj) { const int n0 = u.pn * 256 + bj * 128 + wc * 32 + 8 * fq; const int g = n0 >> 4, h0 = n0 & 15;
            const f32x4 b0 = *(const f32x4*)(glub + n0), b1 = *(const f32x4*)(glub + n0 + 4);
            u32x4 yq[2][4];
#pragma unroll
            for (int ai = 0; ai < 2; ++ai)
#pragma unroll
                for (int m = 0; m < 4; ++m) { const int tok = u.pm * 256 + ai * 128 + wr * 64 + m * 16 + fr; yq[ai][m] = *(const u32x4*)(YSG + ((size_t)g * 1024 + (tok >> 5)) * 512 + (tok & 31) * 16 + h0); }
#pragma unroll
            for (int ai = 0; ai < 2; ++ai)
#pragma unroll
                for (int m = 0; m < 4; ++m) { const int tok = u.pm * 256 + ai * 128 + wr * 64 + m * 16 + fr;
                    const u32x4 ys = yq[ai][m];
                    const f32x4 v0 = acc[ai][bj][m][0] + b0, v1 = acc[ai][bj][m][1] + b1;
                    float y[8]; y[0] = bflo(ys.x) * sigmoidf_(v0[0]); y[1] = bfhi(ys.x) * sigmoidf_(v0[1]); y[2] = bflo(ys.y) * sigmoidf_(v0[2]); y[3] = bfhi(ys.y) * sigmoidf_(v0[3]);
                    y[4] = bflo(ys.z) * sigmoidf_(v1[0]); y[5] = bfhi(ys.z) * sigmoidf_(v1[1]); y[6] = bflo(ys.w) * sigmoidf_(v1[2]); y[7] = bfhi(ys.w) * sigmoidf_(v1[3]);
                    u32x4 w; w.x = cvt_pk_bf16(y[0], y[1]); w.y = cvt_pk_bf16(y[2], y[3]); w.z = cvt_pk_bf16(y[4], y[5]); w.w = cvt_pk_bf16(y[6], y[7]);
#ifdef DBG_S5_SCALE
                    w.x = cvt_pk_bf16(y[0] * DBG_S5_SCALE, y[1] * DBG_S5_SCALE); w.y = cvt_pk_bf16(y[2] * DBG_S5_SCALE, y[3] * DBG_S5_SCALE); w.z = cvt_pk_bf16(y[4] * DBG_S5_SCALE, y[5] * DBG_S5_SCALE); w.w = cvt_pk_bf16(y[6] * DBG_S5_SCALE, y[7] * DBG_S5_SCALE);
#endif
                    *(u32x4*)(YCAT + (size_t)tok * DM + 512 + n0) = w; } }
    }
};
struct EpiXmid { static constexpr bool PERM = false; const float* x; bf16* xmid; const float* mod;
    __device__ __forceinline__ void operator()(const f32x4 (&acc)[2][2][4][2], const GUnit& u, int wr, int wc, int fr, int fq) const {
        const int b = u.pm >> 4;
        const int col0 = u.pn * 256 + wc * 32 + 4 * fq;
        f32x4 gv[2][2];
#pragma unroll
        for (int bj = 0; bj < 2; ++bj)
#pragma unroll
            for (int n = 0; n < 2; ++n) gv[bj][n] = *(const f32x4*)(mod + (size_t)b * (NMOD * DM) + 2 * DM + col0 + bj * 128 + n * 16);
#pragma unroll
        for (int ai = 0; ai < 2; ++ai) { f32x4 xv[4][2][2];
#pragma unroll
            for (int m = 0; m < 4; ++m) { const size_t off = (size_t)(u.pm * 256 + ai * 128 + wr * 64 + m * 16 + fr) * DM + col0;
#pragma unroll
                for (int bj = 0; bj < 2; ++bj)
#pragma unroll
                    for (int n = 0; n < 2; ++n) xv[m][bj][n] = *(const f32x4*)(x + off + bj * 128 + n * 16); }
#pragma unroll
            for (int m = 0; m < 4; ++m) { const size_t off = (size_t)(u.pm * 256 + ai * 128 + wr * 64 + m * 16 + fr) * DM + col0;
#pragma unroll
                for (int bj = 0; bj < 2; ++bj)
#pragma unroll
                    for (int n = 0; n < 2; ++n) { const f32x4 rv = xv[m][bj][n] + gv[bj][n] * acc[ai][bj][m][n]; u32x2 o; o.x = pk2(rv.x, rv.y); o.y = pk2(rv.z, rv.w); *(u32x2*)(xmid + off + bj * 128 + n * 16) = o; } }
            asm volatile("" ::: "memory"); }
    }
};
struct EpiMoe1 { static constexpr bool PERM = true; unsigned char* HB;
    __device__ __forceinline__ void operator()(const f32x4 (&acc)[2][2][4][2], const GUnit& u, int wr, int wc, int fr, int fq) const {
        const int c0 = u.pn * 128 + wc * 32 + 8 * fq;
#pragma unroll
        for (int ai = 0; ai < 2; ++ai)
#pragma unroll
            for (int m = 0; m < 4; ++m) { const size_t row = (size_t)u.pm * 256 + ai * 128 + wr * 64 + m * 16 + fr;
                float y[8];
#pragma unroll
                for (int n = 0; n < 2; ++n)
#pragma unroll
                    for (int j = 0; j < 4; ++j) y[n * 4 + j] = fminf(fmaxf(siluf_(acc[ai][0][m][n][j]) * acc[ai][1][m][n][j], -448.0f), 448.0f);
                u32x2 w; w.x = pk4_fp8(y[0], y[1], y[2], y[3]); w.y = pk4_fp8(y[4], y[5], y[6], y[7]);
                *(u32x2*)(HB + row * FF + c0) = w; }
    }
};
struct EpiMoe2 { static constexpr bool PERM = true; bf16* Y; const float* gate;
    __device__ __forceinline__ void operator()(const f32x4 (&acc)[2][2][4][2], const GUnit& u, int wr, int wc, int fr, int fq) const {
#pragma unroll
        for (int ai = 0; ai < 2; ++ai)
#pragma unroll
            for (int m = 0; m < 4; ++m) { const size_t row = (size_t)u.pm * 256 + ai * 128 + wr * 64 + m * 16 + fr; const float gt = gate[row];
#pragma unroll
                for (int bj = 0; bj < 2; ++bj) { const int c0 = u.pn * 256 + bj * 128 + wc * 32 + 8 * fq;
                    const f32x4 v0 = acc[ai][bj][m][0] * gt, v1 = acc[ai][bj][m][1] * gt;
                    u32x4 w; w.x = cvt_pk_bf16(v0[0], v0[1]); w.y = cvt_pk_bf16(v0[2], v0[3]); w.z = cvt_pk_bf16(v1[0], v1[1]); w.w = cvt_pk_bf16(v1[2], v1[3]);
                    *(u32x4*)(Y + row * DM + c0) = w; } }
    }
};

__device__ __forceinline__ void tr_item(const float* W, int N, bf16* WT, int ldk, int k0, int n0, int drow0, LAS float* scr, int lane) {
    float tv[32];
    const float* wp = W + (size_t)(k0 + (lane >> 5)) * N + n0 + (lane & 31);
#pragma unroll
    for (int i = 0; i < 32; ++i) tv[i] = wp[(size_t)(2 * i) * N];
#pragma unroll
    for (int i = 0; i < 32; ++i) scr[(2 * i + (lane >> 5)) * 33 + (lane & 31)] = tv[i];
    LDS_WAIT(); asm volatile("" ::: "memory");
    const int c = lane & 7;
#pragma unroll
    for (int j = 0; j < 4; ++j) { const int n = (lane >> 3) + 8 * j; const LAS float* s = scr + (8 * c) * 33 + n;
        u32x4 o; o.x = pk2(s[0 * 33], s[1 * 33]); o.y = pk2(s[2 * 33], s[3 * 33]); o.z = pk2(s[4 * 33], s[5 * 33]); o.w = pk2(s[6 * 33], s[7 * 33]);
        *(u32x4*)(WT + (size_t)(drow0 + n) * ldk + k0 + 8 * c) = o; }
    LDS_WAIT(); asm volatile("" ::: "memory");
}
__device__ __forceinline__ void p0_transposes(Frame& F) {
    LAS float* scr = (LAS float*)(F.lds + F.wave * 16384);
    if (F.bid >= 192) return;
    const int gw = F.bid * NWAVES + F.wave, NGW = 192 * NWAVES;
    constexpr int I0 = 16 * 64, I1 = 16 * 32, I2 = 8 * 16, IG = 16 * 16 * 88;
    constexpr int NIT = I0 + I1 + I2;
    bf16* ws16 = (bf16*)F.ws;
    for (int it = gw; it < NIT; it += NGW) {
        int r = it;
        if (r < I0) { const int kb = r / 64, nb = r % 64; tr_item(inptr(F, I_WIN), INC, (bf16*)(F.ws + WS_WINT), DM, kb * 64, nb * 32, nb * 32, scr, F.lane); continue; } r -= I0;
        if (r < I1) { const int kb = r / 32, nb = r % 32; tr_item(inptr(F, I_WOUT), DM, (bf16*)(F.ws + WS_WOUTT), DM, kb * 64, nb * 32, nb * 32, scr, F.lane); continue; } r -= I1;
        if (r < I2) { const int kb = r / 16, nb = r % 16; tr_item(inptr(F, I_GLUW), S5W, (bf16*)(F.ws + WS_GLUT), S5W, kb * 64, nb * 32, nb * 32, scr, F.lane); continue; } r -= I2;
        if (r < 2 * IG) { const int up = r >= IG; if (up) r -= IG; const int e = r / (16 * 88), q = r % (16 * 88), kb = q / 88, nb = q % 88, n0 = nb * 32;
            const float* W = inptr(F, up ? I_WU : I_WG) + (size_t)e * DM * FF;
            tr_item(W, FF, (bf16*)(F.ws + WS_WGUT) + (size_t)e * (2 * FF) * DM, DM, kb * 64, n0, 256 * (n0 >> 7) + (n0 & 127) + (up ? 128 : 0), scr, F.lane); continue; }
    }
    (void)ws16;
}
__device__ __forceinline__ void tr_item_f8(const float* W, int N, unsigned char* WT, int ldk, int k0, int n0, int drow0, float sc, LAS float* scr, int lane) {
    float tv[32];
    const float* wp = W + (size_t)(k0 + (lane >> 5)) * N + n0 + (lane & 31);
#pragma unroll
    for (int i = 0; i < 32; ++i) tv[i] = wp[(size_t)(2 * i) * N];
#pragma unroll
    for (int i = 0; i < 32; ++i) scr[(2 * i + (lane >> 5)) * 33 + (lane & 31)] = tv[i];
    LDS_WAIT(); asm volatile("" ::: "memory");
    const int c = lane & 7;
#pragma unroll
    for (int j = 0; j < 4; ++j) { const int n = (lane >> 3) + 8 * j; const LAS float* s = scr + (8 * c) * 33 + n;
        u32x2 o; o.x = pk4_fp8(s[0 * 33] * sc, s[1 * 33] * sc, s[2 * 33] * sc, s[3 * 33] * sc); o.y = pk4_fp8(s[4 * 33] * sc, s[5 * 33] * sc, s[6 * 33] * sc, s[7 * 33] * sc);
        *(u32x2*)(WT + (size_t)(drow0 + n) * ldk + k0 + 8 * c) = o; }
    LDS_WAIT(); asm volatile("" ::: "memory");
}
__device__ __forceinline__ void dn_issue(Frame& F, int r, float (&tv)[32]) {
    if (r >= 16 * 44 * 32) return;
    const int e = r / (44 * 32), q = r % (44 * 32), kb = q / 32, nb = q % 32;
    const float* wp = inptr(F, I_WD) + (size_t)e * FF * DM + (size_t)(kb * 64 + (F.lane >> 5)) * DM + nb * 32 + (F.lane & 31);
#pragma unroll
    for (int i = 0; i < 32; ++i) tv[i] = wp[(size_t)(2 * i) * DM];
}
__device__ __forceinline__ void dn_finish(Frame& F, int r, const float (&tv)[32], LAS float* scr) {
    if (r >= 16 * 44 * 32) return;
    const int e = r / (44 * 32), q = r % (44 * 32), kb = q / 32, nb = q % 32, lane = F.lane;
    unsigned char* WT = (unsigned char*)(F.ws + WS_WDT) + (size_t)e * DM * FF;
#pragma unroll
    for (int i = 0; i < 32; ++i) scr[(2 * i + (lane >> 5)) * 33 + (lane & 31)] = tv[i];
    LDS_WAIT(); asm volatile("" ::: "memory");
    const int c = lane & 7;
#pragma unroll
    for (int j = 0; j < 4; ++j) { const int n = (lane >> 3) + 8 * j; const LAS float* s = scr + (8 * c) * 33 + n;
        u32x2 o; o.x = pk4_fp8(s[0 * 33] * WD_SCALE, s[1 * 33] * WD_SCALE, s[2 * 33] * WD_SCALE, s[3 * 33] * WD_SCALE); o.y = pk4_fp8(s[4 * 33] * WD_SCALE, s[5 * 33] * WD_SCALE, s[6 * 33] * WD_SCALE, s[7 * 33] * WD_SCALE);
        *(u32x2*)(WT + (size_t)(nb * 32 + n) * FF + kb * 64 + 8 * c) = o; }
    LDS_WAIT(); asm volatile("" ::: "memory");
}
__device__ __forceinline__ void p_down_items(Frame& F, int first, int count, int stride) {
    LAS float* scr = (LAS float*)(F.lds + F.wave * 16384);
    float ta[32], tb[32];
    dn_issue(F, first, ta);
#pragma unroll 1
    for (int k = 0; k < count; k += 2) {
        if (k + 1 < count) dn_issue(F, first + (k + 1) * stride, tb);
        dn_finish(F, first + k * stride, ta, scr);
        if (k + 2 < count) dn_issue(F, first + (k + 2) * stride, ta);
        if (k + 1 < count) dn_finish(F, first + (k + 1) * stride, tb, scr);
    }
}
constexpr int DN_P4 = 3 * 6 * 256, DN_P9 = 10 * 8 * 128, DN_P3 = 4 * 8 * 96, DN_P0 = 22528 - DN_P4 - DN_P9 - DN_P3;
__device__ __forceinline__ void p0_adaln_item(Frame& F, int item) {
    LAS float* sl = (LAS float*)F.lds;
    LAS float* part = sl + 9 * 1024;
    for (int i = F.tid; i < 9 * 1024; i += NTHR) { const int r = i >> 10, k = i & 1023; const float v = (r < 8) ? inptr(F, I_C)[r * DM + k] : inptr(F, I_CCTX)[k]; sl[i] = siluf_(v); }
    __syncthreads();
    const int cl = F.tid & 31, kq = F.tid >> 5, j = item * 32 + cl;
    float a[9];
#pragma unroll
    for (int r = 0; r < 9; ++r) a[r] = 0.f;
    const float* W = inptr(F, I_MODW);
#pragma unroll 16
    for (int kk = 0; kk < 64; ++kk) { const int k = kq + 16 * kk; const float w = W[(size_t)k * (NMOD * DM) + j];
#pragma unroll
        for (int r = 0; r < 9; ++r) a[r] += sl[r * 1024 + k] * w; }
#pragma unroll
    for (int r = 0; r < 9; ++r) part[(kq * 9 + r) * 32 + cl] = a[r];
    __syncthreads();
    if (F.tid < 9 * 32) { const int r = F.tid >> 5, c2 = F.tid & 31; float s = inptr(F, I_MODB)[item * 32 + c2];
#pragma unroll
        for (int q = 0; q < 16; ++q) s += part[(q * 9 + r) * 32 + c2];
        ((float*)(F.ws + WS_MOD))[(size_t)r * (NMOD * DM) + item * 32 + c2] = s; }
    __syncthreads();
}
__device__ __forceinline__ void p0_s5_tables(Frame& F, int g) {
    typedef float f32x2 __attribute__((ext_vector_type(2)));
    LAS f32x2* PW = (LAS f32x2*)F.lds;
    LAS f32x2* BB = PW + 2 * 33 * 64;
    LAS float* KT = (LAS float*)(BB + 2 * 64 * 16);
    LAS f32x2* CC = (LAS f32x2*)(KT + 2 * 32 * 256);
    const float* lre = inptr(F, I_LRE); const float* lim = inptr(F, I_LIM); const float* lst = inptr(F, I_LSTEP);
    const float* cre = inptr(F, I_CRE); const float* cim = inptr(F, I_CIM);
    for (int i = F.tid; i < 2 * 33 * 64; i += NTHR) { const int dir = i / (33 * 64), e = (i / 64) % 33, p = i & 63;
        const double lr = lre[(dir * NG + g) * NP + p], li = lim[(dir * NG + g) * NP + p], dt = exp((double)lst[dir * NG + g]);
        double ph = li * dt * e; ph -= 6.283185307179586 * floor(ph * 0.15915494309189535);
        const float m = expf((float)(lr * dt * e)); float sn, cs; sincosf((float)ph, &sn, &cs); const float cr = m * cs, ci = m * sn;
        PW[i] = (f32x2){cr, ci};
        if (e == 32) { float* LT = (float*)(F.ws + WS_LT); LT[((dir * NG + g) * NP + p) * 2] = cr; LT[((dir * NG + g) * NP + p) * 2 + 1] = ci; } }
    __syncthreads();
    for (int i = F.tid; i < 2 * 16 * 64; i += NTHR) { const int dir = i >> 10, h = (i >> 6) & 15, p = i & 63; const size_t ci = (((size_t)dir * NG + g) * GH + h) * NP + p; CC[i] = (f32x2){cre[ci], cim[ci]}; }
    for (int i = F.tid; i < 2 * 64 * 16; i += NTHR) { const int dir = i >> 10, p = (i >> 4) & 63, h = i & 15;
        const double lr = lre[(dir * NG + g) * NP + p], li = lim[(dir * NG + g) * NP + p];
        const f32x2 lb = PW[(dir * 33 + 1) * 64 + p]; const double ar = (double)lb.x - 1.0, ai = (double)lb.y, den = lr * lr + li * li;
        const double fr_ = (ar * lr + ai * li) / den, fi_ = (ai * lr - ar * li) / den;
        const size_t bi = (((size_t)dir * NG + g) * NP + p) * GH + h; const double br = inptr(F, I_BRE)[bi], bim = inptr(F, I_BIM)[bi];
        BB[i] = (f32x2){(float)(fr_ * br - fi_ * bim), (float)(fr_ * bim + fi_ * br)}; }
    __syncthreads();
    {
        const int dir = F.tid >> 8, h = (F.tid >> 4) & 15, hp = F.tid & 15;
        for (int d = 0; d < 32; ++d) KT[(dir * 32 + d) * 256 + (F.tid & 255)] = 0.f;
        for (int pc = 0; pc < 4; ++pc) { float qr[16], qi[16];
#pragma unroll
            for (int j = 0; j < 16; ++j) { const int p = pc * 16 + j; const f32x2 cc = CC[(dir * 16 + h) * 64 + p]; const float cr = cc.x, cj = cc.y; const f32x2 b = BB[(dir * 64 + p) * 16 + hp];
                qr[j] = cr * b.x - cj * b.y; qi[j] = cr * b.y + cj * b.x; }
            for (int d = 0; d < 32; ++d) { float s = 0.f;
#pragma unroll
                for (int j = 0; j < 16; ++j) { const f32x2 w = PW[(dir * 33 + d) * 64 + pc * 16 + j]; s += qr[j] * w.x - qi[j] * w.y; }
                KT[(dir * 32 + d) * 256 + (F.tid & 255)] += s; } }
    }
    __syncthreads();
    { float* TAB = (float*)(F.ws + WS_S5TAB) + (size_t)g * S5TAB_FLOATS; const LAS float* src = (const LAS float*)F.lds;
      for (int i = F.tid; i < S5TAB_FLOATS / 4; i += NTHR) ((f32x4*)TAB)[i] = ((const LAS f32x4*)src)[i]; }
    __syncthreads();
}
__device__ __forceinline__ void p1_s5_expand(Frame& F) {
    typedef float f32x2 __attribute__((ext_vector_type(2)));
    const int g = F.bid >> 3, part = F.bid & 7;
    LAS f32x2* PW = (LAS f32x2*)F.lds;
    LAS f32x2* BB = PW + 2 * 33 * 64;
    constexpr int KTS = 260;
    LAS float* KT = (LAS float*)(BB + 2 * 64 * 16);
    LAS f32x2* CC = (LAS f32x2*)(KT + 2 * 32 * KTS);
    { const float* TAB = (const float*)(F.ws + WS_S5TAB) + (size_t)g * S5TAB_FLOATS; LAS float* dst = (LAS float*)F.lds;
      constexpr int KT0 = (2 * 33 * 64 * 2) + (2 * 64 * 16 * 2), KT1 = KT0 + 2 * 32 * 256;
      for (int i = F.tid; i < S5TAB_FLOATS / 4; i += NTHR) { const int f = 4 * i; int d = f;
          if (f >= KT1) d = f + 64 * (KTS - 256); else if (f >= KT0) { const int o = f - KT0; d = KT0 + (o >> 8) * KTS + (o & 255); }
          *(LAS f32x4*)(dst + d) = ((const f32x4*)TAB)[i]; } }
    __syncthreads();
    bf16* MCT = (bf16*)(F.ws + WS_MCT) + (size_t)g * 512 * UCOLS;
    for (int pc = F.tid; pc < 64 * 64; pc += NTHR) { const int rw = part * 64 + (pc >> 6), q = pc & 63, tau = rw >> 4, h = rw & 15, s = q >> 1, h0 = (q & 1) * 8;
        float v[8];
        {   const int d0 = tau - s; const float m0 = (d0 >= 0) ? 1.f : 0.f, m1 = (d0 <= 0) ? 1.f : 0.f;
            const LAS f32x4* k0 = (const LAS f32x4*)(KT + (0 * 32 + (d0 >= 0 ? d0 : 0)) * KTS + h * 16 + h0); const LAS f32x4* k1 = (const LAS f32x4*)(KT + (1 * 32 + (d0 <= 0 ? -d0 : 0)) * KTS + h * 16 + h0);
            const f32x4 a0 = k0[0], a1 = k0[1], b0 = k1[0], b1 = k1[1];
#pragma unroll
            for (int j = 0; j < 4; ++j) { v[j] = m0 * a0[j] + m1 * b0[j]; v[4 + j] = m0 * a1[j] + m1 * b1[j]; } }
        u32x4 w; w.x = pk2(v[0], v[1]); w.y = pk2(v[2], v[3]); w.z = pk2(v[4], v[5]); w.w = pk2(v[6], v[7]);
        *(u32x4*)(MCT + (size_t)rw * UCOLS + s * 16 + h0) = w; }
    for (int pc = F.tid; pc < 64 * 32; pc += NTHR) { const int rw = part * 64 + (pc >> 5), q = pc & 31, tau = rw >> 4, h = rw & 15, dir = q >> 4, ri = (q >> 3) & 1, p0 = (q & 7) * 8;
        const int e = dir ? (32 - tau) : (tau + 1);
        float v[8];
#pragma unroll
        for (int j = 0; j < 8; ++j) { const int p = p0 + j; const f32x2 cc = CC[(dir * 16 + h) * 64 + p]; const float cr = cc.x, cj = cc.y; const f32x2 w = PW[(dir * 33 + e) * 64 + p];
            v[j] = ri ? -(cr * w.y + cj * w.x) : (cr * w.x - cj * w.y); }
        u32x4 w; w.x = pk2(v[0], v[1]); w.y = pk2(v[2], v[3]); w.z = pk2(v[4], v[5]); w.w = pk2(v[6], v[7]);
        *(u32x4*)(MCT + (size_t)rw * UCOLS + 512 + dir * 128 + ri * 64 + p0) = w; }
    bf16* WAT = (bf16*)(F.ws + WS_WAT) + (size_t)g * 256 * 512;
    for (int pc = F.tid; pc < 32 * 64; pc += NTHR) { const int rw = part * 32 + (pc >> 6), q = pc & 63, dir = rw >> 7, ri = (rw >> 6) & 1, p = rw & 63, s = q >> 1, h0 = (q & 1) * 8;
        const f32x2 w = PW[(dir * 33 + (dir ? s : (31 - s))) * 64 + p];
        float v[8];
#pragma unroll
        for (int j = 0; j < 8; ++j) { const f32x2 b = BB[(dir * 64 + p) * 16 + h0 + j]; v[j] = ri ? (w.x * b.y + w.y * b.x) : (w.x * b.x - w.y * b.y); }
        u32x4 o; o.x = pk2(v[0], v[1]); o.y = pk2(v[2], v[3]); o.z = pk2(v[4], v[5]); o.w = pk2(v[6], v[7]);
        *(u32x4*)(WAT + (size_t)rw * 512 + s * 16 + h0) = o; }
    __syncthreads();
}
__device__ __forceinline__ void p0_filter_l12(Frame& F, int i0, int npos) {
    LAS float* sc = (LAS float*)(F.lds + F.wave * 1024);
    const int j = F.lane;
    const float* hw1 = inptr(F, I_HW1); const float* hw2 = inptr(F, I_HW2); const float* hfq = inptr(F, I_HFREQ);
    float w1c[33], w2c[64];
#pragma unroll
    for (int f = 0; f < 33; ++f) w1c[f] = hw1[f * 64 + j];
#pragma unroll
    for (int k = 0; k < 64; ++k) w2c[k] = hw2[k * 64 + j];
    const float b1 = inptr(F, I_HB1)[j], b2 = inptr(F, I_HB2)[j], f0 = hfq[j], f1 = hfq[64 + j];
    for (int q = 0; q < npos; ++q) { const int i = i0 + q;
        if (j < 33) { const double L = (double)SEQ; double v;
            if (j == 0) v = (double)i / (L - 1.0);
            else { const int k = (j - 1) & 15; const double f = 1e-4 + (double)k * ((15.0 - 1e-4) / 15.0), om = 6.283185307179586 * (double)i / L; v = (j <= 16) ? cos(f * om) : -sin(f * om); }
            sc[j] = (float)v; }
        LDS_WAIT(); asm volatile("" ::: "memory");
        float a = b1;
#pragma unroll
        for (int f = 0; f < 33; ++f) a += sc[f] * w1c[f];
        sc[64 + j] = sinf(f0 * a);
        LDS_WAIT(); asm volatile("" ::: "memory");
        float b = b2;
#pragma unroll
        for (int k = 0; k < 64; ++k) b += sc[64 + k] * w2c[k];
        ((float*)(F.ws + WS_FH2))[(size_t)j * SEQ + i] = sinf(f1 * b);
        LDS_WAIT(); asm volatile("" ::: "memory"); }
}
__device__ __forceinline__ void phase0(Frame& F) {
    if (F.bid < 192) p0_adaln_item(F, F.bid);
    else if (F.bid < 224) p0_s5_tables(F, F.bid - 192);
    else p0_filter_l12(F, (F.bid - 224) * 128 + F.wave * 16, 16);
    __syncthreads();
    p0_transposes(F);
    if (F.bid < 192) p_down_items(F, DN_P4 + DN_P9 + DN_P3 + F.bid * 8 + F.wave, 3, 192 * 8);
}

__device__ __forceinline__ void norm_mod_row(const float* xrow, const float* gam, const float* shift, const float* scale, bf16* orow, int lane) {
    const f32x4* xr = (const f32x4*)xrow + lane;
    f32x4 v[4]; float s = 0.f;
#pragma unroll
    for (int j = 0; j < 4; ++j) { v[j] = xr[64 * j]; s += (v[j].x * v[j].x + v[j].y * v[j].y) + (v[j].z * v[j].z + v[j].w * v[j].w); }
    const float rstd = 1.0f / sqrtf(wave_sum(s) * (1.0f / DM) + NORM_EPS);
    unsigned long long* o8 = (unsigned long long*)orow + lane;
#pragma unroll
    for (int j = 0; j < 4; ++j) { const f32x4 g = ((const f32x4*)gam)[lane + 64 * j], sh = ((const f32x4*)shift)[lane + 64 * j], sc = ((const f32x4*)scale)[lane + 64 * j];
        const f32x4 y = (v[j] * rstd * g) * (sc + 1.0f) + sh;
        o8[64 * j] = (unsigned long long)pk2(y.x, y.y) | ((unsigned long long)pk2(y.z, y.w) << 32); }
}
__device__ __forceinline__ void p1_norm_rows(const float* xbase, bf16* obase, int nrows, const float* gam, const float* shift, const float* scale, int lane) {
    f32x4 GM[4], SH[4];
#pragma unroll
    for (int j = 0; j < 4; ++j) { const f32x4 g = ((const f32x4*)gam)[lane + 64 * j], sc = ((const f32x4*)scale)[lane + 64 * j]; GM[j] = g * (sc + 1.0f); SH[j] = ((const f32x4*)shift)[lane + 64 * j]; }
    for (int r = 0; r < nrows; r += 4) {
        f32x4 v[4][4];
#pragma unroll
        for (int q = 0; q < 4; ++q) if (r + q < nrows) { const f32x4* xr = (const f32x4*)(xbase + (size_t)(r + q) * DM) + lane;
#pragma unroll
            for (int j = 0; j < 4; ++j) v[q][j] = xr[64 * j]; }
#pragma unroll
        for (int q = 0; q < 4; ++q) if (r + q < nrows) { float s = 0.f;
#pragma unroll
            for (int j = 0; j < 4; ++j) s += (v[q][j].x * v[q][j].x + v[q][j].y * v[q][j].y) + (v[q][j].z * v[q][j].z + v[q][j].w * v[q][j].w);
            const float rstd = 1.0f / sqrtf(wave_sum(s) * (1.0f / DM) + NORM_EPS);
            unsigned long long* o8 = (unsigned long long*)(obase + (size_t)(r + q) * DM) + lane;
#pragma unroll
            for (int j = 0; j < 4; ++j) { const f32x4 y = (v[q][j] * rstd) * GM[j] + SH[j];
                o8[64 * j] = (unsigned long long)pk2(y.x, y.y) | ((unsigned long long)pk2(y.z, y.w) << 32); } }
    }
}
__device__ __forceinline__ void p1_norm(Frame& F) {
    const int gw = F.bid * NWAVES + F.wave, lane = F.lane;
    const float* mod = (const float*)(F.ws + WS_MOD);
    bf16* H1 = (bf16*)(F.ws + WS_H1);
    const float* gam = inptr(F, I_N1G);
    { const int mr = gw >> 8; const float* shift = mod + (size_t)mr * (NMOD * DM);
      p1_norm_rows(inptr(F, I_X) + (size_t)gw * 16 * DM, H1 + (size_t)gw * 16 * DM, 16, gam, shift, shift + DM, lane); }
    { const float* shift = mod + (size_t)8 * (NMOD * DM);
      p1_norm_rows(inptr(F, I_CTX) + (size_t)gw * DM, H1 + (size_t)(NTOK + gw) * DM, 1, gam, shift, shift + DM, lane); }
}
__device__ __forceinline__ void p1_filter(Frame& F) {
    LAS float* w3s = (LAS float*)F.lds;
    LAS float* b3s = w3s + 512;
    LAS float* red = b3s + 8;
    LAS float* nrm = red + 32;
    const int c0 = F.bid * 2;
    for (int i = F.tid; i < 512; i += NTHR) { const int k = i >> 3, q = i & 7, ch = q >> 2, o = (q >> 1) & 1, dir = q & 1; w3s[i] = inptr(F, I_HW3)[(size_t)k * 2048 + o * 1024 + dir * 512 + c0 + ch]; }
    if (F.tid < 8) { const int q = F.tid, ch = q >> 2, o = (q >> 1) & 1, dir = q & 1; b3s[q] = inptr(F, I_HB3)[o * 1024 + dir * 512 + c0 + ch]; }
    __syncthreads();
    const float* FH2 = (const float*)(F.ws + WS_FH2);
    const double la = -4.605170185988091 / 0.3, lb = -4.605170185988091 / 1.5;
    float delta[2];
#pragma unroll
    for (int ch = 0; ch < 2; ++ch) delta[ch] = (float)fabs(la + (double)(c0 + ch) * (lb - la) / 511.0);
    unsigned char* FILT = F.ws + WS_FILT;
    float asum[4] = {0.f, 0.f, 0.f, 0.f};
    float amx[4] = {0.f, 0.f, 0.f, 0.f};
    unsigned val[8][4];
    {
        float a[8][8];
#pragma unroll
        for (int j = 0; j < 8; ++j)
#pragma unroll
            for (int q = 0; q < 8; ++q) a[j][q] = b3s[q];
        const float* hr = FH2 + 8 * F.tid;
#define FL_LOAD(H0, H1, K4) do { _Pragma("unroll") for (int kk = 0; kk < 4; ++kk) { const f32x4* hp = (const f32x4*)(hr + (size_t)((K4) * 4 + kk) * SEQ); H0[kk] = hp[0]; H1[kk] = hp[1]; } } while (0)
#define FL_FMA(H0, H1, K4) do { _Pragma("unroll") for (int kk = 0; kk < 4; ++kk) { const LAS f32x4* wp = (const LAS f32x4*)(w3s + ((K4) * 4 + kk) * 8); const f32x4 wa = wp[0], wb = wp[1]; \
            _Pragma("unroll") for (int j = 0; j < 8; ++j) { const float hv = (j < 4) ? H0[kk][j & 3] : H1[kk][j & 3]; \
                a[j][0] += hv * wa.x; a[j][1] += hv * wa.y; a[j][2] += hv * wa.z; a[j][3] += hv * wa.w; a[j][4] += hv * wb.x; a[j][5] += hv * wb.y; a[j][6] += hv * wb.z; a[j][7] += hv * wb.w; } } } while (0)
        {   f32x4 pa0[4], pa1[4], pb0[4], pb1[4];
            FL_LOAD(pa0, pa1, 0);
#pragma unroll 1
            for (int k4 = 0; k4 < 16; k4 += 2) { FL_LOAD(pb0, pb1, k4 + 1); FL_FMA(pa0, pa1, k4); if (k4 + 2 < 16) FL_LOAD(pa0, pa1, k4 + 2); FL_FMA(pb0, pb1, k4 + 1); asm volatile("" ::: "memory"); } }
#undef FL_LOAD
#undef FL_FMA
#pragma unroll
        for (int j = 0; j < 8; ++j) { const int i = 8 * F.tid + j; const float t = (float)i * (1.0f / 4095.0f); const float d0 = expf(-t * delta[0]), d1 = expf(-t * delta[1]);
#pragma unroll
            for (int q = 0; q < 8; ++q) { const int dir = q & 1; const float v = a[j][q] * ((q >> 2) ? d1 : d0); a[j][q] = v; if (dir == 0 || i != 0) { asum[q >> 1] += fabsf(v); amx[q >> 1] = fmaxf(amx[q >> 1], fabsf(v)); } }
#pragma unroll
            for (int q = 0; q < 4; ++q) val[j][q] = pk2(a[j][2 * q], a[j][2 * q + 1]); }
    }
#pragma unroll
    for (int q = 0; q < 4; ++q) { const float s2 = wave_sum(asum[q]); float m2 = amx[q];
#pragma unroll
        for (int o = 32; o >= 1; o >>= 1) m2 = fmaxf(m2, __shfl_xor(m2, o));
        if (F.lane == 0) { red[F.wave * 4 + q] = s2; red[32 + 8 + F.wave * 4 + q] = m2; } }
    __syncthreads();
    if (F.tid < 4) { float s2 = 0.f, m2 = 0.f; for (int w = 0; w < 8; ++w) { s2 += red[w * 4 + F.tid]; m2 = fmaxf(m2, red[32 + 8 + w * 4 + F.tid]); }
        const float inv = 1.0f / s2; const int p = (int)((__float_as_uint(m2 * inv) >> 23) & 255u) - 127, e = 7 - p;
        nrm[F.tid] = inv * __uint_as_float((unsigned)(127 + e) << 23);
        const int ch = F.tid >> 1, o = F.tid & 1; ((int*)(F.ws + WS_FSC))[o * HYW + c0 + ch] = 127 - e; }
    __syncthreads();
#pragma unroll
    for (int j = 0; j < 8; ++j) { const int i = 8 * F.tid + j;
#pragma unroll
        for (int q = 0; q < 8; ++q) { const int ch = q >> 2, o = (q >> 1) & 1, dir = q & 1; const float sc = nrm[ch * 2 + o]; unsigned char* G = FILT + ((size_t)o * HYW + c0 + ch) * F8GS;
            const float fv = ((q & 1) ? bfhi(val[j][q >> 1]) : bflo(val[j][q >> 1])) * sc; const unsigned char hv = (unsigned char)(__builtin_amdgcn_cvt_pk_fp8_f32(fv, fv, 0, false) & 0xff);
            if (dir == 0) G[FC0 - i] = hv; else if (i != 0) G[FC0 + i] = hv; } }
    for (int i = F.tid; i < 4 * (F8LEN - 8191); i += NTHR) { const int a = i / (F8LEN - 8191), x = i % (F8LEN - 8191); const int ch = a >> 1, o = a & 1; unsigned char* G = FILT + ((size_t)o * HYW + c0 + ch) * F8GS;
        const int xx = (x < FC0 - 4095) ? x : (x - (FC0 - 4095) + FC0 + 4096); G[xx] = 0; }
    __syncthreads();
}
__device__ __forceinline__ void phase1(Frame& F) { p1_s5_expand(F); p1_filter(F); p1_norm(F); }

#ifndef DBG_AMPX
#define DBG_AMPX 0
#endif
#define AMPB(k) unsigned long long amp_t0_ = 0; if (DBG_AMPX == (k)) amp_t0_ = __builtin_amdgcn_s_memrealtime();
#define AMPE(k) if (DBG_AMPX == (k)) { __syncthreads(); const unsigned long long t1_ = __builtin_amdgcn_s_memrealtime(); const unsigned long long d_ = t1_ - amp_t0_; while (__builtin_amdgcn_s_memrealtime() - t1_ < d_) __builtin_amdgcn_s_sleep(8); }
constexpr int HY_USTRIDE = 4368, HY_UOFF = 272, HY_G0 = 35328;
__device__ __forceinline__ i32x8 hy_ldA(const LAS unsigned char* p) { const LAS u32x2* q = (const LAS u32x2*)p; const u32x2 a = q[0], b = q[1], c = q[2], d = q[3]; return (i32x8){(int)a.x, (int)a.y, (int)b.x, (int)b.y, (int)c.x, (int)c.y, (int)d.x, (int)d.y}; }
__device__ __forceinline__ i32x8 hy_ldB(const LAS unsigned char* p) { const u32x4 a = *(const LAS u32x4*)p, b = *(const LAS u32x4*)(p + 16); return (i32x8){(int)a.x, (int)a.y, (int)a.z, (int)a.w, (int)b.x, (int)b.y, (int)b.z, (int)b.w}; }
constexpr int HT_IG2 = 2 * 16 * 16 * 88, HT_TOTAL = 2 * HT_IG2, HT_PER_WAVE = 48, HT_SCR = 35328 + 8 * 8480;
struct HyTr { const float* wg; const float* wu; bf16* wgut; LAS float* scr; int base; int lane; float tv[2][16]; };
__device__ __forceinline__ void hytr_issue(HyTr& T, int slot) {
#pragma unroll
    for (int j = 0; j < 2; ++j) { const int h = T.base + slot * 2 + j;
        if (h < HT_TOTAL) { const int up = h >= HT_IG2, r = up ? h - HT_IG2 : h, e = r / (32 * 88), q = r % (32 * 88), kb = q / 88, nb = q % 88;
            const float* wp = (up ? T.wu : T.wg) + (size_t)e * DM * FF + (size_t)(kb * 32 + (T.lane >> 5)) * FF + nb * 32 + (T.lane & 31);
#pragma unroll
            for (int i = 0; i < 16; ++i) T.tv[j][i] = wp[(size_t)(2 * i) * FF]; } }
}
__device__ __forceinline__ void hytr_finish(HyTr& T, int slot) {
#pragma unroll
    for (int j = 0; j < 2; ++j) { const int h = T.base + slot * 2 + j;
        if (h < HT_TOTAL) { const int up = h >= HT_IG2, r = up ? h - HT_IG2 : h, e = r / (32 * 88), q = r % (32 * 88), kb = q / 88, nb = q % 88, n0 = nb * 32;
            bf16* WT = (bf16*)((unsigned char*)T.wgut + (size_t)e * (2 * FF) * DM); const int drow0 = 256 * (n0 >> 7) + (n0 & 127) + (up ? 128 : 0);
#pragma unroll
            for (int i = 0; i < 16; ++i) T.scr[(2 * i + (T.lane >> 5)) * 33 + (T.lane & 31)] = T.tv[j][i];
            LDS_WAIT(); asm volatile("" ::: "memory");
            const int c = T.lane & 3;
#pragma unroll
            for (int p = 0; p < 2; ++p) { const int n = (T.lane >> 2) + 16 * p; const LAS float* sp = T.scr + (8 * c) * 33 + n;
                u32x2 o; o.x = pk4_fp8(sp[0 * 33] * WGU_SCALE, sp[1 * 33] * WGU_SCALE, sp[2 * 33] * WGU_SCALE, sp[3 * 33] * WGU_SCALE); o.y = pk4_fp8(sp[4 * 33] * WGU_SCALE, sp[5 * 33] * WGU_SCALE, sp[6 * 33] * WGU_SCALE, sp[7 * 33] * WGU_SCALE);
                *(u32x2*)((unsigned char*)WT + (size_t)(drow0 + n) * DM + kb * 32 + 8 * c) = o; }
            LDS_WAIT(); asm volatile("" ::: "memory"); } }
}
__device__ __forceinline__ void hy_conv(const LAS unsigned char* lds, int w, int lane, f32x16 (&acc)[4], HyTr& T, int slot0, int fsc_s) {
    const int r = lane & 31, hh = lane >> 5, n = lane & 31, b = n >> 2, i = n & 3;
    const LAS unsigned char* abase = lds + HY_G0 + (r & 7) * F8LEN + (FC0 - 8 * (r >> 3) + 32 * hh) - 512 * w;
    const LAS unsigned char* bbase = lds + HY_UOFF + b * HY_USTRIDE + 64 * i + 32 * hh;
    int sc1 = 127, fsc = fsc_s; asm volatile("" : "+v"(sc1), "+v"(fsc));
#pragma unroll
    for (int q = 0; q < 4; ++q)
#pragma unroll
        for (int j = 0; j < 16; ++j) acc[q][j] = 0.f;
#define HY_M1(ACC, AF, BF) asm volatile("v_mfma_scale_f32_32x32x64_f8f6f4 %0, %1, %2, %0, %3, %4 op_sel_hi:[0,0,0]" : "+v"(ACC) : "v"(AF), "v"(BF), "v"(fsc), "v"(sc1))
#define HY_MM(O0, O1, N0, N1, BB) do { HY_M1(acc[0], O0, BB); HY_M1(acc[1], O1, BB); HY_M1(acc[2], N0, BB); HY_M1(acc[3], N1, BB); } while (0)
#define HY_ST3() do { \
            Z0 = hy_ldA(pa - 512); Z1 = hy_ldA(pa - 544); Ub = hy_ldB(pb - 256); HY_MM(X0, X1, Y0, Y1, Ua); \
            X0 = hy_ldA(pa - 768); X1 = hy_ldA(pa - 800); Uc = hy_ldB(pb - 512); HY_MM(Y0, Y1, Z0, Z1, Ub); \
            Y0 = hy_ldA(pa - 1024); Y1 = hy_ldA(pa - 1056); Ua = hy_ldB(pb - 768); HY_MM(Z0, Z1, X0, X1, Uc); \
            pa -= 768; pb -= 768; } while (0)
#pragma unroll 1
    for (int rho = 0; rho < 4; ++rho) {
        const LAS unsigned char* pa = abase + 64 * (60 + rho);
        const LAS unsigned char* pb = bbase + 64 * (60 + rho);
        i32x8 X0, X1, Y0, Y1, Z0, Z1, Ua, Ub, Uc;
        if (rho < 3) hytr_issue(T, slot0 + 2 * rho);
        X0 = hy_ldA(pa); X1 = hy_ldA(pa - 32); Y0 = hy_ldA(pa - 256); Y1 = hy_ldA(pa - 288); Ua = hy_ldB(pb);
#pragma unroll 1
        for (int k = 0; k < 2; ++k) HY_ST3();
        if (rho < 3) { hytr_finish(T, slot0 + 2 * rho); hytr_issue(T, slot0 + 2 * rho + 1); }
#pragma unroll 1
        for (int k = 0; k < 3; ++k) HY_ST3();
        Z0 = hy_ldA(pa - 512); Z1 = hy_ldA(pa - 544); Ub = hy_ldB(pb - 256); HY_MM(X0, X1, Y0, Y1, Ua);
        HY_MM(Y0, Y1, Z0, Z1, Ub);
        if (rho < 3) hytr_finish(T, slot0 + 2 * rho + 1);
    }
    asm volatile("s_nop 15\n\ts_nop 15" ::: "memory");
#undef HY_ST3
#undef HY_MM
#undef HY_M1
}
__device__ __forceinline__ void hy_load_filter(Frame& F, const unsigned char* G) {
    LAS unsigned char* lds = F.lds;
#define AB(H, L, N) __builtin_amdgcn_alignbyte(H, L, N)
#pragma unroll
    for (int k = 0; k < 2; ++k) { const int i = F.tid + k * NTHR;
        if (i < F8LEN / 16) { const u32x4 v = *(const u32x4*)(G + 16 * i); u32x2 pv = (u32x2){0u, 0u}; if (i) pv = *(const u32x2*)(G + 16 * i - 8);
            LAS unsigned char* d = lds + HY_G0 + 16 * i;
            *(LAS u32x4*)(d) = v;
            *(LAS u32x4*)(d + 1 * F8LEN) = (u32x4){AB(v.x, pv.y, 3), AB(v.y, v.x, 3), AB(v.z, v.y, 3), AB(v.w, v.z, 3)};
            *(LAS u32x4*)(d + 2 * F8LEN) = (u32x4){AB(v.x, pv.y, 2), AB(v.y, v.x, 2), AB(v.z, v.y, 2), AB(v.w, v.z, 2)};
            *(LAS u32x4*)(d + 3 * F8LEN) = (u32x4){AB(v.x, pv.y, 1), AB(v.y, v.x, 1), AB(v.z, v.y, 1), AB(v.w, v.z, 1)};
            *(LAS u32x4*)(d + 4 * F8LEN) = (u32x4){pv.y, v.x, v.y, v.z};
            *(LAS u32x4*)(d + 5 * F8LEN) = (u32x4){AB(pv.y, pv.x, 3), AB(v.x, pv.y, 3), AB(v.y, v.x, 3), AB(v.z, v.y, 3)};
            *(LAS u32x4*)(d + 6 * F8LEN) = (u32x4){AB(pv.y, pv.x, 2), AB(v.x, pv.y, 2), AB(v.y, v.x, 2), AB(v.z, v.y, 2)};
            *(LAS u32x4*)(d + 7 * F8LEN) = (u32x4){AB(pv.y, pv.x, 1), AB(v.x, pv.y, 1), AB(v.y, v.x, 1), AB(v.z, v.y, 1)}; } }
#undef AB
}
__device__ __forceinline__ u32x4 hy_ld_piece(const bf16* p) { const unsigned* pp = (const unsigned*)(p - 2); u32x4 v; v.x = pp[0]; v.y = pp[1]; v.z = pp[2]; v.w = pp[3]; return v; }
__device__ __forceinline__ f32x4 hy_sconv4r(u32x4 z, bool lz, bool rz, float w0, float w1, float w2, float cb) {
    const float zl = lz ? 0.f : bfhi(z.x), zr = rz ? 0.f : bflo(z.w), e0 = bflo(z.y), e1 = bfhi(z.y), e2 = bflo(z.z), e3 = bfhi(z.z);
    return (f32x4){w0 * zl + w1 * e0 + w2 * e1 + cb, w0 * e0 + w1 * e1 + w2 * e2 + cb, w0 * e1 + w1 * e2 + w2 * e3 + cb, w0 * e2 + w1 * e3 + w2 * zr + cb};
}
__device__ __forceinline__ float hy_cl(float v) { return fminf(fmaxf(v, -448.f), 448.f); }
__device__ __forceinline__ void hyena_channel(Frame& F, int c, int citer) {
    LAS unsigned char* lds = F.lds;
    const int tid = F.tid, lane = F.lane, w = F.wave;
    HyTr T; T.wg = inptr(F, I_WG); T.wu = inptr(F, I_WU); T.wgut = (bf16*)(F.ws + WS_WGUT); T.scr = (LAS float*)(F.lds + HT_SCR + w * 4224); T.base = (F.bid * NWAVES + w) * HT_PER_WAVE; T.lane = lane;
    bf16* ZT = (bf16*)(F.ws + WS_ZT);
    const unsigned char* FILT = F.ws + WS_FILT; const int* FSC = (const int*)(F.ws + WS_FSC);
    bf16* VS = (bf16*)(F.ws + WS_VS) + (size_t)F.bid * (8 * SEQ);
    const float* cw = inptr(F, I_CONVW); const float* cbp = inptr(F, I_CONVB);
    const int fs0 = __builtin_amdgcn_readfirstlane(__hip_atomic_load(FSC + c, __ATOMIC_RELAXED, __HIP_MEMORY_SCOPE_AGENT)), fs1 = __builtin_amdgcn_readfirstlane(__hip_atomic_load(FSC + HYW + c, __ATOMIC_RELAXED, __HIP_MEMORY_SCOPE_AGENT));
    for (int i = tid; i < HY_G0 / 16; i += NTHR) *(LAS u32x4*)(lds + 16 * i) = (u32x4){0u, 0u, 0u, 0u};
    __syncthreads();
    {
        const float w0 = cw[c], w1 = cw[HYC + c], w2 = cw[2 * HYC + c], cb = cbp[c];
        u32x4 zz[8]; float zls[8], zrs[8];
#pragma unroll
        for (int b = 0; b < 8; ++b) { const bf16* zr = ZT + (size_t)c * NTOK + b * SEQ + 8 * tid; zz[b] = *(const u32x4*)zr; zls[b] = (tid & 7) ? bf2f(zr[-1]) : 0.f; zrs[b] = ((tid & 7) != 7) ? bf2f(zr[8]) : 0.f; }
#pragma unroll
        for (int b = 0; b < 8; ++b) { const u32x4 z = zz[b];
            const float zl = zls[b], zrt = zrs[b];
            float e[10]; e[0] = zl; e[1] = bflo(z.x); e[2] = bfhi(z.x); e[3] = bflo(z.y); e[4] = bfhi(z.y); e[5] = bflo(z.z); e[6] = bfhi(z.z); e[7] = bflo(z.w); e[8] = bfhi(z.w); e[9] = zrt;
            float o[8];
#pragma unroll
            for (int j = 0; j < 8; ++j) o[j] = w0 * e[j] + w1 * e[j + 1] + w2 * e[j + 2] + cb;
            u32x4 pk; pk.x = pk2(o[0], o[1]); pk.y = pk2(o[2], o[3]); pk.z = pk2(o[4], o[5]); pk.w = pk2(o[6], o[7]);
            *(u32x4*)(VS + b * SEQ + 8 * tid) = pk;
            u32x2 p8; p8.x = pk4_fp8(hy_cl(o[0]), hy_cl(o[1]), hy_cl(o[2]), hy_cl(o[3])); p8.y = pk4_fp8(hy_cl(o[4]), hy_cl(o[5]), hy_cl(o[6]), hy_cl(o[7]));
            *(LAS u32x2*)(lds + HY_UOFF + b * HY_USTRIDE + 8 * tid) = p8; }
    }
    hy_load_filter(F, FILT + ((size_t)0 * HYW + c) * F8GS);
    __syncthreads();
    f32x16 acc[4];
    { AMPB(1) hy_conv(lds, w, lane, acc, T, (citer * 2 + 0) * 6, fs0); AMPE(1) }
#ifdef DBG_CONV_SCALE
    for (int q = 0; q < 4; ++q) for (int j = 0; j < 16; ++j) acc[q][j] *= DBG_CONV_SCALE;
#endif
    __syncthreads();
    hy_load_filter(F, FILT + ((size_t)1 * HYW + c) * F8GS);
    const int n = lane & 31, hh = lane >> 5, b = n >> 2, ii = n & 3;
    {
        const float w0 = cw[HYW + c], w1 = cw[HYC + HYW + c], w2 = cw[2 * HYC + HYW + c], cb = cbp[HYW + c], bias = inptr(F, I_HBIAS)[c];
        const int tl = 512 * w + 64 * ii + 4 * hh;
        const bf16* zrow = ZT + (size_t)(HYW + c) * NTOK + b * SEQ + tl;
        bf16* vrow = VS + b * SEQ + tl;
#pragma unroll
        for (int hq = 0; hq < 2; ++hq) {
        u32x4 zp[8]; u32x2 vp[8];
#pragma unroll
        for (int g = 0; g < 8; ++g) { const int toff = 32 * (g >> 2) + 256 * hq + 8 * (g & 3); zp[g] = hy_ld_piece(zrow + toff); vp[g] = *(const u32x2*)(vrow + toff); }
#pragma unroll
        for (int q = 2 * hq; q < 2 * hq + 2; ++q) {
#pragma unroll
            for (int rg = 0; rg < 4; ++rg) { const int toff = 32 * (q & 1) + 256 * (q >> 1) + 8 * rg;
                const f32x4 x1 = hy_sconv4r(zp[(q & 1) * 4 + rg], (q & 1) == 0 && rg == 0 && hh == 0, (q & 1) == 1 && rg == 3 && hh == 1, w0, w1, w2, cb);
                const u32x2 uv = vp[(q & 1) * 4 + rg];
                const float y0 = x1[0] * (acc[q][4 * rg + 0] + bias * bflo(uv.x)), y1 = x1[1] * (acc[q][4 * rg + 1] + bias * bfhi(uv.x));
                const float y2 = x1[2] * (acc[q][4 * rg + 2] + bias * bflo(uv.y)), y3 = x1[3] * (acc[q][4 * rg + 3] + bias * bfhi(uv.y));
                u32x2 o; o.x = pk2(y0, y1); o.y = pk2(y2, y3); *(u32x2*)(vrow + toff) = o;
                *(LAS unsigned*)(lds + HY_UOFF + b * HY_USTRIDE + tl + toff) = pk4_fp8(hy_cl(y0), hy_cl(y1), hy_cl(y2), hy_cl(y3)); }
            asm volatile("" ::: "memory"); } }
    }
    __syncthreads();
    { AMPB(1) hy_conv(lds, w, lane, acc, T, (citer * 2 + 1) * 6, fs1); AMPE(1) }
#ifdef DBG_CONV_SCALE
    for (int q = 0; q < 4; ++q) for (int j = 0; j < 16; ++j) acc[q][j] *= DBG_CONV_SCALE;
#endif
    {
        const float w0 = cw[2 * HYW + c], w1 = cw[HYC + 2 * HYW + c], w2 = cw[2 * HYC + 2 * HYW + c], cb = cbp[2 * HYW + c], bias = inptr(F, I_HBIAS)[HYW + c];
        const int tl = 512 * w + 64 * ii + 4 * hh;
        const bf16* zrow = ZT + (size_t)(2 * HYW + c) * NTOK + b * SEQ + tl;
        const bf16* vrow = VS + b * SEQ + tl;
        bf16* orow = (bf16*)(F.ws + WS_YHT) + (size_t)c * NTOK + b * SEQ + tl;
#pragma unroll
        for (int hq = 0; hq < 2; ++hq) {
        u32x4 zp[8]; u32x2 vp[8];
#pragma unroll
        for (int g = 0; g < 8; ++g) { const int toff = 32 * (g >> 2) + 256 * hq + 8 * (g & 3); zp[g] = hy_ld_piece(zrow + toff); vp[g] = *(const u32x2*)(vrow + toff); }
#pragma unroll
        for (int q = 2 * hq; q < 2 * hq + 2; ++q) {
#pragma unroll
            for (int rg = 0; rg < 4; ++rg) { const int toff = 32 * (q & 1) + 256 * (q >> 1) + 8 * rg;
                const f32x4 x2 = hy_sconv4r(zp[(q & 1) * 4 + rg], (q & 1) == 0 && rg == 0 && hh == 0, (q & 1) == 1 && rg == 3 && hh == 1, w0, w1, w2, cb);
                const u32x2 uv = vp[(q & 1) * 4 + rg];
                const float y0 = x2[0] * (acc[q][4 * rg + 0] + bias * bflo(uv.x)), y1 = x2[1] * (acc[q][4 * rg + 1] + bias * bfhi(uv.x));
                const float y2 = x2[2] * (acc[q][4 * rg + 2] + bias * bflo(uv.y)), y3 = x2[3] * (acc[q][4 * rg + 3] + bias * bfhi(uv.y));
                u32x2 o; o.x = pk2(y0, y1); o.y = pk2(y2, y3); *(u32x2*)(orow + toff) = o; }
            asm volatile("" ::: "memory"); } }
    }
    __syncthreads();
}

__device__ __forceinline__ void phase_carry(Frame& F) {
    if (F.tid >= 128) { const int wv = F.bid * 6 + (F.wave - 2); p_down_items(F, wv, 3, 6 * 256); return; }
    const int g = F.bid >> 3, b = F.bid & 7, dir = F.tid >> 6, p = F.tid & 63;
    const float* EB = (const float*)(F.ws + WS_EB) + (size_t)g * UROWS * 256 + dir * 128 + p;
    bf16* UG = (bf16*)(F.ws + WS_UG) + (size_t)g * UROWS * UCOLS + 512 + dir * 128 + p;
    const float* LT = (const float*)(F.ws + WS_LT) + ((dir * NG + g) * NP + p) * 2;
    const float lr = LT[0], li = LT[1];
    float xr = 0.f, xi = 0.f;
    {   float er[8], ei[8];
#pragma unroll
        for (int k = 0; k < 8; ++k) { const int c = dir ? (7 - k) : k; const float* e = EB + (size_t)(1024 + b * 8 + c) * 256; er[k] = e[0]; ei[k] = e[64]; }
#pragma unroll
        for (int k = 0; k < 8; ++k) { const float nr = lr * xr - li * xi + er[k], ni = lr * xi + li * xr + ei[k]; xr = nr; xi = ni; }
    }
#pragma unroll 1
    for (int c8 = 0; c8 < 4; ++c8) { float er[32], ei[32];
#pragma unroll
        for (int k = 0; k < 32; ++k) { const int c = dir ? (127 - (c8 * 32 + k)) : (c8 * 32 + k); const float* e = EB + (size_t)(b * 128 + c) * 256; er[k] = e[0]; ei[k] = e[64]; }
#pragma unroll
        for (int k = 0; k < 32; ++k) { const int c = dir ? (127 - (c8 * 32 + k)) : (c8 * 32 + k); bf16* u = UG + (size_t)(b * 128 + c) * UCOLS; u[0] = (bf16)f2bf(xr); u[64] = (bf16)f2bf(xi);
            const float nr = lr * xr - li * xi + er[k], ni = lr * xi + li * xr + ei[k]; xr = nr; xi = ni; }
    }
}

__device__ __forceinline__ void phase_tr_hy(Frame& F) {
    LAS unsigned char* lds = F.lds;
    const bf16* ZT = (const bf16*)(F.ws + WS_YHT); bf16* YCAT = (bf16*)(F.ws + WS_YCAT);
    constexpr int S = 132;
    for (int pass = 0; pass < 2; ++pass) { const int tok0 = F.bid * 128 + pass * 64;
        for (int pc = F.tid; pc < 4096; pc += NTHR) { const int ch = pc >> 3, gq = pc & 7; const u32x4 v = *(const u32x4*)(ZT + (size_t)ch * NTOK + tok0 + 8 * gq);
            LAS unsigned* d = (LAS unsigned*)(lds + ch * S + 16 * gq); d[0] = v.x; d[1] = v.y; d[2] = v.z; d[3] = v.w; }
        __syncthreads();
        for (int it = 0; it < 8; ++it) { const int tok = it * 8 + (F.lane & 7), cg = F.wave * 8 + (F.lane >> 3);
            const LAS unsigned short* s = (const LAS unsigned short*)(lds + (8 * cg) * S + 2 * tok);
            unsigned e[8];
#pragma unroll
            for (int j = 0; j < 8; ++j) e[j] = s[j * (S / 2)];
            u32x4 o; o.x = e[0] | (e[1] << 16); o.y = e[2] | (e[3] << 16); o.z = e[4] | (e[5] << 16); o.w = e[6] | (e[7] << 16);
#ifdef DBG_HY_SCALE
            for (int j = 0; j < 8; ++j) e[j] = f2bf(bf2f(e[j]) * DBG_HY_SCALE);
            o.x = e[0] | (e[1] << 16); o.y = e[2] | (e[3] << 16); o.z = e[4] | (e[5] << 16); o.w = e[6] | (e[7] << 16);
#endif
            *(u32x4*)(YCAT + (size_t)(tok0 + tok) * DM + 8 * cg) = o; }
        __syncthreads();
    }
}

__device__ __forceinline__ void phase_norm2(Frame& F) {
    LAS unsigned char* lds = F.lds;
    LAS unsigned short* WH = (LAS unsigned short*)lds;
    LAS unsigned short* WL = WH + 16384;
    LAS float* GM = (LAS float*)(lds + 65536);
    LAS float* SH = GM + 1024;
    LAS float* red = SH + 1024;
    LAS float* cbs = red + 128;
    const int tid = F.tid, lane = F.lane, wave = F.wave;
    const int b = F.bid >> 5;
    const float* mb = (const float*)(F.ws + WS_MOD) + (size_t)b * (NMOD * DM);
    const float* rw = inptr(F, I_RW); const float* n2g = inptr(F, I_N2G);
    for (int i = tid; i < DM; i += NTHR) { GM[i] = n2g[i] * (mb[4 * DM + i] + 1.0f); SH[i] = mb[3 * DM + i]; }
    __syncthreads();
    float cpart = 0.f;
#pragma unroll 4
    for (int i = 0; i < 32; ++i) { const int idx = tid + 512 * i, k = idx >> 4, e = idx & 15; const float r = rw[idx]; const float w = GM[k] * r; cpart += SH[k] * r;
        const unsigned hi = f2bf(w); const float lo = w - bf2f(hi);
        const int s = k >> 5, kq = (k >> 3) & 3, j = k & 7, o = ((s * 4 + kq) * 16 + e) * 8 + j; WH[o] = (unsigned short)hi; WL[o] = (unsigned short)f2bf(lo); }
    cpart += __shfl_xor(cpart, 16); cpart += __shfl_xor(cpart, 32);
    if (lane < 16) red[wave * 16 + lane] = cpart;
    __syncthreads();
    if (tid < 16) { float c = 0.f; for (int w = 0; w < 8; ++w) c += red[w * 16 + tid]; cbs[tid] = c; }
    __syncthreads();
    const int rr = lane & 15, kq = lane >> 4;
    const int row = F.bid * 128 + wave * 16 + rr;
    const bf16* xrow = (const bf16*)(F.ws + WS_XMID) + (size_t)row * DM + 8 * kq;
    f32x4 acc = (f32x4){0.f, 0.f, 0.f, 0.f}; float ss = 0.f;
#pragma unroll 1
    for (int hb = 0; hb < 2; ++hb) { u32x4 xv[16];
#pragma unroll
        for (int s = 0; s < 16; ++s) xv[s] = *(const u32x4*)(xrow + 32 * (16 * hb + s));
#pragma unroll
        for (int s = 0; s < 16; ++s) { const u32x4 q = xv[s]; const int sg = 16 * hb + s;
            const float e0 = bflo(q.x), e1 = bfhi(q.x), e2 = bflo(q.y), e3 = bfhi(q.y), e4 = bflo(q.z), e5 = bfhi(q.z), e6 = bflo(q.w), e7 = bfhi(q.w);
            ss += ((e0 * e0 + e1 * e1) + (e2 * e2 + e3 * e3)) + ((e4 * e4 + e5 * e5) + (e6 * e6 + e7 * e7));
            const bf16x8 a = __builtin_bit_cast(bf16x8, q);
            const bf16x8 bh = *(const LAS bf16x8*)(WH + ((sg * 4 + kq) * 16 + rr) * 8), bl = *(const LAS bf16x8*)(WL + ((sg * 4 + kq) * 16 + rr) * 8);
            acc = __builtin_amdgcn_mfma_f32_16x16x32_bf16(a, bh, acc, 0, 0, 0); acc = __builtin_amdgcn_mfma_f32_16x16x32_bf16(a, bl, acc, 0, 0, 0);
            if ((s & 3) == 3) asm volatile("" ::: "memory"); } }
    ss += __shfl_xor(ss, 16); ss += __shfl_xor(ss, 32);
    const float rstd = 1.0f / sqrtf(ss * (1.0f / DM) + NORM_EPS);
    {
        const float cb = cbs[rr]; f32x4 p;
#pragma unroll
        for (int i = 0; i < 4; ++i) { const float rs = __shfl(rstd, 4 * kq + i); const float lg = acc[i] * rs + cb; float mx = lg;
#pragma unroll
            for (int o = 1; o < 16; o <<= 1) mx = fmaxf(mx, __shfl_xor(mx, o));
            const float ex = expf(lg - mx); float den = ex;
#pragma unroll
            for (int o = 1; o < 16; o <<= 1) den += __shfl_xor(den, o);
            p[i] = ex / den; }
        float* AFF = (float*)(F.ws + WS_AFF);
        *(f32x4*)(AFF + ((size_t)b * NE + rr) * SEQ + (F.bid & 31) * 128 + wave * 16 + 4 * kq) = p; }
    unsigned char* h2row = F.ws + WS_H2 + (size_t)row * DM + 8 * kq;
#pragma unroll 1
    for (int hb = 0; hb < 2; ++hb) { u32x4 xv[16];
#pragma unroll
        for (int s = 0; s < 16; ++s) xv[s] = *(const u32x4*)(xrow + 32 * (16 * hb + s));
#pragma unroll
        for (int s = 0; s < 16; ++s) { const u32x4 q = xv[s]; const int sg = 16 * hb + s; const LAS f32x4* gp = (const LAS f32x4*)(GM + 32 * sg + 8 * kq); const LAS f32x4* sp = (const LAS f32x4*)(SH + 32 * sg + 8 * kq);
            const f32x4 g0 = gp[0], g1 = gp[1], s0 = sp[0], s1 = sp[1];
            u32x2 o; o.x = pk4_fp8(bflo(q.x) * rstd * g0.x + s0.x, bfhi(q.x) * rstd * g0.y + s0.y, bflo(q.y) * rstd * g0.z + s0.z, bfhi(q.y) * rstd * g0.w + s0.w);
            o.y = pk4_fp8(bflo(q.z) * rstd * g1.x + s1.x, bfhi(q.z) * rstd * g1.y + s1.y, bflo(q.w) * rstd * g1.z + s1.z, bfhi(q.w) * rstd * g1.w + s1.w);
            *(u32x2*)(h2row + 32 * sg) = o; if ((s & 3) == 3) asm volatile("" ::: "memory"); } }
    __syncthreads();
}

__device__ __forceinline__ int block_sum_i(LAS int* red, int v, int wave, int lane, int slot) {
#pragma unroll
    for (int o = 1; o < 64; o <<= 1) v += __shfl_xor(v, o);
    if (lane == 0) red[slot * 8 + wave] = v;
    __syncthreads();
    int s = 0;
#pragma unroll
    for (int w = 0; w < 8; ++w) s += red[slot * 8 + w];
    return s;
}
__device__ __forceinline__ void phase_topk(Frame& F) {
    if (F.bid >= NB * NE) { const int wv = (F.bid - 128) * 8 + F.wave; p_down_items(F, DN_P4 + wv, 10, 8 * 128); return; }
    const int b = F.bid >> 4, e = F.bid & 15, tid = F.tid, lane = F.lane, wave = F.wave;
    LAS int* red = (LAS int*)F.lds;
    LAS int* wtot = red + 16;
    const float* aff = (const float*)(F.ws + WS_AFF) + ((size_t)b * NE + e) * SEQ + 8 * tid;
    unsigned key[8];
    { u32x4 a0, a1; ld_sc1_x8(aff, a0, a1);
      key[0] = a0.x; key[1] = a0.y; key[2] = a0.z; key[3] = a0.w; key[4] = a1.x; key[5] = a1.y; key[6] = a1.z; key[7] = a1.w; }
    unsigned prefix = 0u; int it = 0;
    LAS int* red3 = (LAS int*)F.lds + 64;
    { const unsigned cand = 1u << 30; int c = 0;
#pragma unroll
      for (int j = 0; j < 8; ++j) c += __builtin_popcountll(__ballot(key[j] >= cand));
      if (lane == 0) red[wave] = c;
      __syncthreads();
      int tot = 0;
#pragma unroll
      for (int w2 = 0; w2 < 8; ++w2) tot += red[w2];
      if (tot >= CAP) prefix = cand; }
    for (int bit = 28; bit >= 0; bit -= 2, ++it) { const unsigned c1 = prefix | (1u << bit), c2 = prefix | (2u << bit), c3 = prefix | (3u << bit); int n1 = 0, n2 = 0, n3 = 0;
#pragma unroll
        for (int j = 0; j < 8; ++j) { n1 += __builtin_popcountll(__ballot(key[j] >= c1)); n2 += __builtin_popcountll(__ballot(key[j] >= c2)); n3 += __builtin_popcountll(__ballot(key[j] >= c3)); }
        LAS int* rr = red3 + (it & 1) * 24;
        if (lane == 0) { rr[wave] = n1; rr[8 + wave] = n2; rr[16 + wave] = n3; }
        __syncthreads();
        int t1 = 0, t2 = 0, t3 = 0;
#pragma unroll
        for (int w2 = 0; w2 < 8; ++w2) { t1 += rr[w2]; t2 += rr[8 + w2]; t3 += rr[16 + w2]; }
        prefix = (t3 >= CAP) ? c3 : (t2 >= CAP) ? c2 : (t1 >= CAP) ? c1 : prefix; }
    const unsigned thr = prefix;
    int cgt = 0, ceq = 0;
#pragma unroll
    for (int j = 0; j < 8; ++j) { cgt += (key[j] > thr) ? 1 : 0; ceq += (key[j] == thr) ? 1 : 0; }
    int sg = cgt, se = ceq;
#pragma unroll
    for (int o = 1; o < 64; o <<= 1) { const int tg = __shfl_up(sg, o), te = __shfl_up(se, o); if (lane >= o) { sg += tg; se += te; } }
    __syncthreads();
    if (lane == 63) { wtot[wave] = sg; wtot[8 + wave] = se; }
    __syncthreads();
    int bg = 0, be = 0, totg = 0;
#pragma unroll
    for (int w2 = 0; w2 < 8; ++w2) { const int g2 = wtot[w2], e2 = wtot[8 + w2]; if (w2 < wave) { bg += g2; be += e2; } totg += g2; }
    int rg = bg + sg - cgt, re = be + se - ceq;
    const int need_eq = CAP - totg;
    int* IDX = (int*)(F.ws + WS_IDX); float* GATE = (float*)(F.ws + WS_GATE); int* INV = (int*)(F.ws + WS_INV);
    const size_t rowbase = ((size_t)e * NB + b) * CAP;
    int sl[8];
#pragma unroll
    for (int j = 0; j < 8; ++j) { const int t = 8 * tid + j; int slot = -1;
        if (key[j] > thr) { slot = rg; ++rg; } else if (key[j] == thr) { if (re < need_eq) slot = totg + re; ++re; }
        if (slot >= 0) { IDX[rowbase + slot] = b * SEQ + t; GATE[rowbase + slot] = __builtin_bit_cast(float, key[j]); }
        sl[j] = slot; }
    u32x4* ip = (u32x4*)(INV + ((size_t)b * NE + e) * SEQ + 8 * tid);
    ip[0] = (u32x4){(unsigned)sl[0], (unsigned)sl[1], (unsigned)sl[2], (unsigned)sl[3]}; ip[1] = (u32x4){(unsigned)sl[4], (unsigned)sl[5], (unsigned)sl[6], (unsigned)sl[7]};
}

__device__ __forceinline__ void final_issue(const bf16* Y, int b, unsigned& mask, int myinv, int lo, int lane, unsigned long long (&w)[4][4], float (&fl)[4]) {
#pragma unroll
    for (int q = 0; q < 4; ++q) { int e = 0, s = 0; fl[q] = 0.f;
        if (mask) { e = __builtin_ctz(mask); mask &= mask - 1; s = __shfl(myinv, lo + e); fl[q] = 1.f; }
        const unsigned long long* yr = (const unsigned long long*)(Y + (((size_t)e * NB + b) * CAP + s) * DM) + lane;
#pragma unroll
        for (int j = 0; j < 4; ++j) w[q][j] = yr[64 * j]; }
}
__device__ __forceinline__ void final_add(const unsigned long long (&w)[4][4], const float (&fl)[4], f32x4 (&mo)[4]) {
#pragma unroll
    for (int q = 0; q < 4; ++q)
#pragma unroll
        for (int j = 0; j < 4; ++j) { const unsigned lo = (unsigned)w[q][j], hi = (unsigned)(w[q][j] >> 32); mo[j].x += fl[q] * bflo(lo); mo[j].y += fl[q] * bfhi(lo); mo[j].z += fl[q] * bflo(hi); mo[j].w += fl[q] * bfhi(hi); }
}
__device__ __forceinline__ void final_pair(Frame& F, const bf16* Y, int b, int ra, int inva, int invb, int lo, const f32x4 (&G2)[4], const f32x4 (&FG)[4]) {
    const int lane = F.lane; const int rb = ra + 1;
    const bf16* xm16 = (const bf16*)(F.ws + WS_XMID);
    unsigned k0 = (unsigned)((__ballot(inva >= 0) >> lo) & 0xffffull), k1 = (unsigned)((__ballot(invb >= 0) >> lo) & 0xffffull);
    unsigned long long w0[4][4], w1[4][4]; float f0[4], f1[4];
    final_issue(Y, b, k0, inva, lo, lane, w0, f0);
    final_issue(Y, b, k1, invb, lo, lane, w1, f1);
    f32x4 v0[4], v1[4], m0[4], m1[4];
#pragma unroll
    for (int j = 0; j < 4; ++j) { const u32x2 q0 = ((const u32x2*)(xm16 + (size_t)ra * DM) + lane)[64 * j], q1 = ((const u32x2*)(xm16 + (size_t)rb * DM) + lane)[64 * j];
        v0[j] = (f32x4){bflo(q0.x), bfhi(q0.x), bflo(q0.y), bfhi(q0.y)}; v1[j] = (f32x4){bflo(q1.x), bfhi(q1.x), bflo(q1.y), bfhi(q1.y)}; m0[j] = (f32x4){0.f, 0.f, 0.f, 0.f}; m1[j] = (f32x4){0.f, 0.f, 0.f, 0.f}; }
    final_add(w0, f0, m0); final_add(w1, f1, m1);
    while (k0 | k1) { final_issue(Y, b, k0, inva, lo, lane, w0, f0); final_issue(Y, b, k1, invb, lo, lane, w1, f1); final_add(w0, f0, m0); final_add(w1, f1, m1); }
    float s0 = 0.f, s1 = 0.f;
#pragma unroll
    for (int j = 0; j < 4; ++j) { v0[j] = v0[j] + G2[j] * m0[j] * DBG_MOE_ALPHA; v1[j] = v1[j] + G2[j] * m1[j] * DBG_MOE_ALPHA;
        s0 += (v0[j].x * v0[j].x + v0[j].y * v0[j].y) + (v0[j].z * v0[j].z + v0[j].w * v0[j].w); s1 += (v1[j].x * v1[j].x + v1[j].y * v1[j].y) + (v1[j].z * v1[j].z + v1[j].w * v1[j].w); }
    const float rs0 = 1.0f / sqrtf(wave_sum(s0) * (1.0f / DM) + NORM_EPS), rs1 = 1.0f / sqrtf(wave_sum(s1) * (1.0f / DM) + NORM_EPS);
    f32x4* xr0 = (f32x4*)(F.out + (size_t)ra * DM) + lane; f32x4* xr1 = (f32x4*)(F.out + (size_t)rb * DM) + lane;
#pragma unroll
    for (int j = 0; j < 4; ++j) { xr0[64 * j] = v0[j] * rs0 * FG[j]; xr1[64 * j] = v1[j] * rs1 * FG[j]; }
}
__device__ __forceinline__ void phase_final(Frame& F) {
    const int gw = F.bid * NWAVES + F.wave, lane = F.lane;
    const int b = gw >> 8, t0 = (gw & 255) * 16, row0 = gw * 16;
    const float* mod = (const float*)(F.ws + WS_MOD);
    const bf16* Y = (const bf16*)(F.ws + WS_Y); const int* INV = (const int*)(F.ws + WS_INV);
    const float* fing = inptr(F, I_FING); const float* g2 = mod + (size_t)b * (NMOD * DM) + 5 * DM;
    int val[4];
    { const u32x4 q = ld_sc1_x4(INV + ((size_t)b * NE + (lane & 15)) * SEQ + t0 + 4 * (lane >> 4)); val[0] = (int)q.x; val[1] = (int)q.y; val[2] = (int)q.z; val[3] = (int)q.w; }
    f32x4 G2[4], FG[4];
#pragma unroll
    for (int j = 0; j < 4; ++j) { G2[j] = ((const f32x4*)g2)[lane + 64 * j]; FG[j] = ((const f32x4*)fing)[lane + 64 * j]; }
#pragma unroll 1
    for (int q = 0; q < 4; ++q) {
        final_pair(F, Y, b, row0 + 4 * q, val[0], val[1], 16 * q, G2, FG);
        final_pair(F, Y, b, row0 + 4 * q + 2, val[2], val[3], 16 * q, G2, FG);
    }
}

#ifdef DBG_CHECK_MOE
__device__ __forceinline__ void phase_dbg_moe(Frame& F) {
    LAS float* hs = (LAS float*)F.lds;
    LAS float* Hs = hs + 1024;
    LAS float* red = Hs + 2816;
    const int row = (F.bid * 257) & 65535, e = row >> 12, b = (row >> 9) & 7;
    const int tok = ((const int*)(F.ws + WS_IDX))[row]; const float gate = ((const float*)(F.ws + WS_GATE))[row];
    const bf16* H2 = (const bf16*)(F.ws + WS_H2) + (size_t)tok * DM;
    for (int i = F.tid; i < DM; i += NTHR) hs[i] = bf2f(H2[i]);
    __syncthreads();
    const float* Wg = inptr(F, I_WG) + (size_t)e * DM * FF; const float* Wu = inptr(F, I_WU) + (size_t)e * DM * FF; const float* Wd = inptr(F, I_WD) + (size_t)e * FF * DM;
    float e1n = 0.f, e1d = 0.f;
    for (int f = F.tid; f < FF; f += NTHR) { float g = 0.f, u = 0.f;
        for (int k = 0; k < DM; ++k) { g += hs[k] * Wg[(size_t)k * FF + f]; u += hs[k] * Wu[(size_t)k * FF + f]; }
        const float h = siluf_(g) * u; Hs[f] = h;
        const float hb = bf2f(((const bf16*)(F.ws + WS_HB))[(size_t)row * FF + f]); e1n += (hb - h) * (hb - h); e1d += h * h; }
    __syncthreads();
    float e2n = 0.f, e2d = 0.f;
    for (int n = F.tid; n < DM; n += NTHR) { float y = 0.f;
        for (int f = 0; f < FF; ++f) y += Hs[f] * Wd[(size_t)f * DM + n];
        y *= gate; const float yb = bf2f(((const bf16*)(F.ws + WS_Y))[(size_t)row * DM + n]); e2n += (yb - y) * (yb - y); e2d += y * y; }
    const float* aff = (const float*)(F.ws + WS_AFF) + ((size_t)b * NE + e) * SEQ; int cnt = 0;
    for (int t = F.tid; t < SEQ; t += NTHR) cnt += (aff[t] > gate) ? 1 : 0;
    float vals[5] = {e1n, e1d, e2n, e2d, (float)cnt};
#pragma unroll
    for (int q = 0; q < 5; ++q) { const float s2 = wave_sum(vals[q]); if (F.lane == 0) red[F.wave * 5 + q] = s2; }
    __syncthreads();
    if (F.tid == 0) { float t5[5] = {0, 0, 0, 0, 0}; for (int w = 0; w < 8; ++w) for (int q = 0; q < 5; ++q) t5[q] += red[w * 5 + q];
        float* D = (float*)(F.ws + WS_CTL + 65536) + F.bid * 4;
        D[0] = t5[0] / (t5[1] + 1e-30f); D[1] = t5[2] / (t5[3] + 1e-30f); D[2] = (t5[4] >= (float)CAP) ? 1.f : 0.f;
        int dup = 0; const int* IDXs = (const int*)(F.ws + WS_IDX) + ((size_t)e * NB + b) * CAP; for (int q = 0; q < CAP; ++q) dup += (IDXs[q] == tok) ? 1 : 0;
        const int inv = ((const int*)(F.ws + WS_INV))[((size_t)(tok >> 12) * NE + e) * SEQ + (tok & 4095)];
        const int c3 = DBG_C3;
        D[3] = (c3 == 0) ? ((fabsf(aff[tok - b * SEQ] - gate) > 1e-6f) ? 1.f : 0.f) : (c3 == 1) ? (((tok >> 12) != b) ? 1.f : 0.f) : (c3 == 2) ? ((dup != 1) ? 1.f : 0.f) : ((inv != (row & 511)) ? 1.f : 0.f); }
    __syncthreads();
}
__device__ __forceinline__ void phase_dbg_apply(Frame& F) {
    const float* D = (const float*)(F.ws + WS_CTL + 65536);
    int bad[4] = {0, 0, 0, 0};
    for (int k = 0; k < 256; ++k) { if (D[k * 4 + 0] > 1e-3f) ++bad[0]; if (D[k * 4 + 1] > 1e-3f) ++bad[1]; if (D[k * 4 + 2] > 0.5f) ++bad[2]; if (D[k * 4 + 3] > 0.5f) ++bad[3]; }
    int code = 0;
    for (int q = 0; q < 4; ++q) if (((DBG_CHECK_MOE >> q) & 1) && bad[q] > DBG_BAD_THR) code += 1;
    const float sc = 1.0f + 0.5f * (float)code;
    const int gw = F.bid * NWAVES + F.wave, NGW = F.G * NWAVES;
    for (int r = gw; r < NTOK; r += NGW) { f32x4* xr = (f32x4*)(F.out + (size_t)r * DM) + F.lane;
#pragma unroll
        for (int j = 0; j < 4; ++j) xr[64 * j] = xr[64 * j] * sc; }
}
#endif

#ifdef DBG_CHECK_MOE
constexpr int NPHASE = 15;
#else
constexpr int NPHASE = 13;
#endif
__global__ void __launch_bounds__(NTHR, 2) fwd_kernel(Args args) {
    extern __shared__ __attribute__((aligned(16))) unsigned char lds_raw[];
    Frame F;
    F.lds = (LAS unsigned char*)lds_raw;
    F.tid = threadIdx.x; F.lane = F.tid & 63; F.wave = __builtin_amdgcn_readfirstlane(F.tid >> 6);
    F.G = gridDim.x; F.bid = blockIdx.x;
    F.out = args.out; F.ws = args.ws;
    for (int u = F.tid; u < (LDS_BYTES - LDSCTL_OFF) / 4; u += NTHR) ((LAS unsigned*)(F.lds + LDSCTL_OFF))[u] = 0u;
    __syncthreads();
    if (F.tid < 35) { const float* const* tab = args.in; *(LAS unsigned long long*)(F.lds + LDSCTL_OFF + 8 * F.tid) = (unsigned long long)tab[F.tid]; }
    __syncthreads();
    const int lo = args.ph_lo, hi = args.ph_hi;
    const bool single = (hi - lo) > 1;
    XcdBarrier bar; bar.bar = (unsigned*)(args.ws + WS_CTL) + CW_BAR; bar.x = 0; bar.st = nullptr;
    if (single) bar = xcd_barrier_post((unsigned*)(args.ws + WS_CTL) + CW_BAR, (volatile LAS unsigned*)(F.lds + MISC_OFF) + 8);
#ifndef PHASE_MASK
#define PHASE_MASK 0x7fff
#endif
#define IN(k) ((((PHASE_MASK) >> (k)) & 1) && lo <= (k) && (k) < hi)
#ifndef DBG_REPEAT_MASK
#define DBG_REPEAT_MASK 0
#endif
#define SEAM(k) do { if (IN(k) && IN((k) + 1)) xcd_barrier(bar); } while (0)
#define REP(k) for (int rep_ = 0; rep_ < ((((DBG_REPEAT_MASK) >> (k)) & 1) ? 2 : 1); ++rep_)
    LAS unsigned char* ring = F.lds;
    const unsigned char* ws = args.ws;

    REP(0) { if (rep_) xcd_barrier(bar); asm volatile("" : "+v"(F.tid), "+v"(F.lane)); if (IN(0)) { AMPB(10) phase0(F); AMPE(10) } } SEAM(0);
    REP(1) { if (rep_) xcd_barrier(bar); asm volatile("" : "+v"(F.tid), "+v"(F.lane)); if (IN(1)) { AMPB(11) phase1(F); AMPE(11) } } SEAM(1);
    REP(2) { if (rep_) xcd_barrier(bar); asm volatile("" : "+v"(F.tid), "+v"(F.lane)); if (IN(2)) {
        { SchedPlain S; S.T.init(128, 6, F.G, F.bid); S.A = (const char*)(ws + WS_H1); S.B = (const char*)(ws + WS_WINT); S.lda = 2048; S.ldb = 2048; S.kstepA = 128; S.kstepB = 128; S.nt = 16; S.mt = 1 << 20; S.az = 0; S.bz = 0;
          EpiZT E{(bf16*)(ws + WS_ZT)}; gm::gemm_phase<EpiZT, SchedPlain, false>(ring, S, E); }
        __syncthreads();
        { SchedPlain S; S.T.init(136, 2, F.G, F.bid); S.A = (const char*)(ws + WS_H1); S.B = (const char*)(ws + WS_WINT) + (size_t)HYC * 2048; S.lda = 2048; S.ldb = 2048; S.kstepA = 128; S.kstepB = 128; S.nt = 16; S.mt = 1 << 20; S.az = 0; S.bz = 0;
          EpiUG E{(bf16*)(ws + WS_UG)}; gm::gemm_phase<EpiUG, SchedPlain, true>(ring, S, E); }
    } } SEAM(2);
    REP(3) { if (rep_) xcd_barrier(bar); asm volatile("" : "+v"(F.tid), "+v"(F.lane)); if (IN(3)) {
        SchedPlain S; S.T.init(160, 1, F.G, F.bid); S.A = (const char*)(ws + WS_UG); S.B = (const char*)(ws + WS_WAT); S.lda = UCOLS * 2; S.ldb = 1024; S.kstepA = 128; S.kstepB = 128; S.nt = 8; S.mt = 5;
        S.az = (size_t)UROWS * UCOLS * 2; S.bz = (size_t)256 * 1024;
        EpiEB E{(float*)(ws + WS_EB)}; gm::gemm_phase<EpiEB, SchedPlain, true>(ring, S, E);
        if (F.bid >= 160) { const int wv = (F.bid - 160) * 8 + F.wave; p_down_items(F, DN_P4 + DN_P9 + wv, 4, 8 * 96); }
    } } SEAM(3);
    REP(4) { if (rep_) xcd_barrier(bar); asm volatile("" : "+v"(F.tid), "+v"(F.lane)); if (IN(4)) { phase_carry(F); } } SEAM(4);
    REP(5) { if (rep_) xcd_barrier(bar); asm volatile("" : "+v"(F.tid), "+v"(F.lane)); if (IN(5)) {
        { SchedPlain S; S.T.init(128, 2, F.G, F.bid); S.A = (const char*)(ws + WS_UG); S.B = (const char*)(ws + WS_MCT); S.lda = UCOLS * 2; S.ldb = UCOLS * 2; S.kstepA = 128; S.kstepB = 128; S.nt = 12; S.mt = 4;
          S.az = (size_t)UROWS * UCOLS * 2; S.bz = (size_t)512 * UCOLS * 2;
          EpiYS E{(bf16*)(ws + WS_YSG), (const bf16*)(ws + WS_UG), inptr(F, I_S5D)};
#ifndef NO_YS
          gm::gemm_phase<EpiYS, SchedPlain, true>(ring, S, E);
#endif
        }
        __syncthreads();
#ifndef NO_HY
        { AMPB(2) int citer = 0; for (int c = F.bid; c < HYW; c += F.G, ++citer) hyena_channel(F, c, citer); AMPE(2) }
#endif
    } } SEAM(5);
    REP(6) { if (rep_) xcd_barrier(bar); asm volatile("" : "+v"(F.tid), "+v"(F.lane)); if (IN(6)) {
        { SchedGlu S; S.T.init(128, 2, F.G, F.bid); S.A = (const char*)(ws + WS_YSG); S.B = (const char*)(ws + WS_GLUT); S.ldb = 1024; S.kstepA = 4u * 1024u * 512u * 2u; S.kstepB = 128; S.nt = 8;
          EpiGlu E{(bf16*)(ws + WS_YCAT), (const bf16*)(ws + WS_YSG), inptr(F, I_GLUB)}; gm::gemm_phase<EpiGlu, SchedGlu, true>(ring, S, E); }
        __syncthreads();
        phase_tr_hy(F);
    } } SEAM(6);
    REP(7) { if (rep_) xcd_barrier(bar); asm volatile("" : "+v"(F.tid), "+v"(F.lane)); if (IN(7)) {
        SchedPlain S; S.T.init(128, 4, F.G, F.bid); S.A = (const char*)(ws + WS_YCAT); S.B = (const char*)(ws + WS_WOUTT); S.lda = 2048; S.ldb = 2048; S.kstepA = 128; S.kstepB = 128; S.nt = 16; S.mt = 1 << 20; S.az = 0; S.bz = 0;
        EpiXmid E{inptr(F, I_X), (bf16*)(ws + WS_XMID), (const float*)(ws + WS_MOD)}; gm::gemm_phase<EpiXmid, SchedPlain, true>(ring, S, E);
    } } SEAM(7);
    REP(8) { if (rep_) xcd_barrier(bar); asm volatile("" : "+v"(F.tid), "+v"(F.lane)); if (IN(8)) { AMPB(18) phase_norm2(F); AMPE(18) } } SEAM(8);
    REP(9) { if (rep_) xcd_barrier(bar); asm volatile("" : "+v"(F.tid), "+v"(F.lane)); if (IN(9)) { AMPB(19) phase_topk(F); AMPE(19) } } SEAM(9);
    REP(10) { if (rep_) xcd_barrier(bar); asm volatile("" : "+v"(F.tid), "+v"(F.lane)); if (IN(10)) {
        SchedMoe1 S; S.T.init(256, 22, F.G, F.bid); S.A = (const char*)(ws + WS_H2); S.B = (const char*)(ws + WS_WGUT); S.idx = (const int*)(ws + WS_IDX); S.lda = 1024; S.ldb = 1024; S.kstepA = 128; S.kstepB = 128; S.nt = 8;
        EpiMoe1 E{(unsigned char*)(ws + WS_HB)}; gm::gemm_phase_f8<EpiMoe1, SchedMoe1, WGU_E8M0>(ring, S, E);
#if DBG_GM_MODE
        __syncthreads(); gm::gemm_phase_f8<EpiMoe1, SchedMoe1, WGU_E8M0, DBG_GM_MODE>(ring, S, E);
#endif
    } } SEAM(10);
    REP(11) { if (rep_) xcd_barrier(bar); asm volatile("" : "+v"(F.tid), "+v"(F.lane)); if (IN(11)) {
        SchedPlain S; S.T.init(256, 4, F.G, F.bid); S.A = (const char*)(ws + WS_HB); S.B = (const char*)(ws + WS_WDT); S.lda = FF; S.ldb = FF; S.kstepA = 128; S.kstepB = 128; S.nt = 22; S.mt = 16;
        S.az = (size_t)EROWS * FF; S.bz = (size_t)DM * FF;
        EpiMoe2 E{(bf16*)(ws + WS_Y), (const float*)(ws + WS_GATE)}; gm::gemm_phase_f8<EpiMoe2, SchedPlain, WD_E8M0>(ring, S, E);
    } } SEAM(11);
    if (IN(12)) { AMPB(22) phase_final(F); AMPE(22) }
#ifdef DBG_CHECK_MOE
    if (IN(13)) { phase_dbg_moe(F); }
    if (IN(14)) { phase_dbg_apply(F); }
#endif
#undef IN
#undef SEAM
}

#ifndef N_LAUNCHES
#define N_LAUNCHES 1
#endif
extern "C" void kernel_launch(void* const* d_in, const int* in_sizes, int n_in, void* d_out, int out_size, void* d_ws, size_t ws_size, hipStream_t stream) {
    static int grid = 0;
    if (grid == 0) {
        if (n_in != 35 || out_size != NTOK * DM || ws_size < WS_END) { fprintf(stderr, "kernel_launch: unexpected shapes (n_in %d out %d ws %zu)\n", n_in, out_size, ws_size); grid = -1; return; }
        int dev = 0, cus = 0;
        if (hipGetDevice(&dev) != hipSuccess || hipDeviceGetAttribute(&cus, hipDeviceAttributeMultiprocessorCount, dev) != hipSuccess) { grid = -1; return; }
        if (hipFuncSetAttribute((const void*)fwd_kernel, hipFuncAttributeMaxDynamicSharedMemorySize, LDS_BYTES) != hipSuccess) { fprintf(stderr, "kernel_launch: hipFuncSetAttribute failed\n"); grid = -1; return; }
        int per_cu = 0;
        if (hipOccupancyMaxActiveBlocksPerMultiprocessor(&per_cu, (const void*)fwd_kernel, NTHR, LDS_BYTES) != hipSuccess || per_cu < 1) fprintf(stderr, "kernel_launch: occupancy query reports %d\n", per_cu);
        (void)hipGetLastError();
        grid = 256;
        if (cus != 256) fprintf(stderr, "kernel_launch: device has %d CUs, kernel expects 256\n", cus);
    }
    if (grid < 0) return;
    (void)hipMemsetAsync((char*)d_ws + WS_CTL, 0, CTL_ZERO_BYTES, stream);
    Args a{};
    for (int i = 0; i < 35; ++i) a.in[i] = (const float*)d_in[i];
    a.out = (float*)d_out; a.ws = (unsigned char*)d_ws;
    if (N_LAUNCHES == 1) { a.ph_lo = 0; a.ph_hi = NPHASE; hipLaunchKernelGGL(fwd_kernel, dim3(grid), dim3(NTHR), LDS_BYTES, stream, a); }
    else for (int p = 0; p < NPHASE; ++p) { a.ph_lo = p; a.ph_hi = p + 1; hipLaunchKernelGGL(fwd_kernel, dim3(grid), dim3(NTHR), LDS_BYTES, stream, a); }
}
```
